# Optimizing an MI355X kernel written in HIP

```python
import math
import jax, jax.numpy as jnp
from jax import lax
import numpy as np

D_MODEL = 1024
BATCH = 8
SEQ = 4096
DEPTH = 1

N_META = 16
EPS = 1e-6
ROPE_THETA = 10000.0

DA_HEADS = 4
DA_HEAD_DIM = D_MODEL // 16
DA_V_DIM = 2 * DA_HEAD_DIM
DA_QK_WIDTH = DA_HEADS * 2 * DA_HEAD_DIM
DA_V_WIDTH = DA_HEADS * DA_V_DIM
Q_BLOCK = 128

GLA_HEADS = 4
GLA_DK = D_MODEL // 16
GLA_DV = D_MODEL // 8
GLA_QK_WIDTH = GLA_HEADS * GLA_DK
GLA_V_WIDTH = GLA_HEADS * GLA_DV
GLA_GATE_RANK = 16
GLA_GATE_TAU = 16.0
GLA_CHUNK = 64

N_BRANCH = 2
BRANCH_WIDTH = DA_V_WIDTH

IN_SPLITS = (DA_QK_WIDTH, DA_QK_WIDTH, DA_V_WIDTH,
             GLA_QK_WIDTH, GLA_QK_WIDTH, GLA_V_WIDTH, GLA_V_WIDTH, GLA_GATE_RANK,
             N_BRANCH * D_MODEL)
D_IN = 2 * DA_QK_WIDTH + DA_V_WIDTH + 2 * GLA_QK_WIDTH + 2 * GLA_V_WIDTH + GLA_GATE_RANK + N_BRANCH * D_MODEL

N_GROUPS = 4
EXPERTS_PER_GROUP = 8
N_EXPERTS = N_GROUPS * EXPERTS_PER_GROUP
TOP_K = 2
D_EXPERT = D_MODEL // 2
MOE_BLOCK = 128

kernel_name = 'hybrid_diffattn_gla_hier_moe'


def rms_norm(x, gain):
    xf = x.astype(jnp.float32)
    y = xf * lax.rsqrt(jnp.mean(xf * xf, axis=-1, keepdims=True) + EPS)
    return (y * gain.astype(jnp.float32)).astype(x.dtype)


def apply_rope(x, pos):
    d = x.shape[-1]
    half = d // 2
    inv_freq = jnp.power(ROPE_THETA, -jnp.arange(half, dtype=jnp.float32) * 2.0 / d)
    ang = pos[:, None] * inv_freq[None, :]
    bshape = (pos.shape[0],) + (1,) * (x.ndim - 3) + (half,)
    cos = jnp.cos(ang).reshape(bshape).astype(x.dtype)
    sin = jnp.sin(ang).reshape(bshape).astype(x.dtype)
    x1, x2 = x[..., :half], x[..., half:]
    return jnp.concatenate([x1 * cos - x2 * sin, x2 * cos + x1 * sin], axis=-1)


def pad_time(x, left, right):
    pw = [(0, 0)] * x.ndim
    pw[1] = (left, right)
    return jnp.pad(x, pw)


def split_columns(z):
    outs = []
    off = 0
    for s in IN_SPLITS:
        outs.append(z[..., off:off + s])
        off += s
    return outs


def diff_attention(q, k, v, g_q, g_k, g_subln, lam_q1, lam_k1, lam_q2, lam_k2, layer_idx):
    bsz, length, _ = q.shape
    q = rms_norm(q.reshape(bsz, length, DA_HEADS, 2, DA_HEAD_DIM), g_q)
    k = rms_norm(k.reshape(bsz, length, DA_HEADS, 2, DA_HEAD_DIM), g_k)
    pos = jnp.arange(length, dtype=jnp.float32)
    q = apply_rope(q, pos)
    k = apply_rope(k, pos)
    n_blocks = -(-length // Q_BLOCK)
    lp = n_blocks * Q_BLOCK
    q = pad_time(q, 0, lp - length).transpose(0, 2, 3, 1, 4)
    k = pad_time(k, 0, lp - length).transpose(0, 2, 3, 1, 4)
    v = pad_time(v.reshape(bsz, length, DA_HEADS, DA_V_DIM), 0, lp - length).transpose(0, 2, 1, 3)
    lam_init = 0.8 - 0.6 * math.exp(-0.3 * layer_idx)
    lam = (jnp.exp(jnp.sum(lam_q1.astype(jnp.float32) * lam_k1.astype(jnp.float32)))
           - jnp.exp(jnp.sum(lam_q2.astype(jnp.float32) * lam_k2.astype(jnp.float32))) + lam_init)
    scale = DA_HEAD_DIM ** -0.5
    k_pos = jnp.arange(lp)

    def one_block(i):
        q_blk = lax.dynamic_slice_in_dim(q, i * Q_BLOCK, Q_BLOCK, axis=3)
        s = jnp.einsum('bhmqd,bhmkd->bhmqk', q_blk, k, preferred_element_type=jnp.float32) * scale
        q_pos = i * Q_BLOCK + jnp.arange(Q_BLOCK)
        s = jnp.where(k_pos[None, :] <= q_pos[:, None], s, -jnp.inf)
        p = jax.nn.softmax(s, axis=-1)
        a = p[:, :, 0] - lam * p[:, :, 1]
        return jnp.einsum('bhqk,bhke->bhqe', a.astype(v.dtype), v)

    o = lax.map(one_block, jnp.arange(n_blocks))
    o = o.transpose(1, 0, 3, 2, 4).reshape(bsz, lp, DA_HEADS, DA_V_DIM)[:, :length]
    o = rms_norm(o, g_subln) * (1.0 - lam_init)
    return o.reshape(bsz, length, DA_V_WIDTH)


def gated_linear_attention(q, k, v, r, g_lr, w_gate_up, b_gate, g_norm):
    bsz, length, _ = q.shape
    f32 = jnp.float32
    q = q.astype(f32).reshape(bsz, length, GLA_HEADS, GLA_DK) * (GLA_DK ** -0.5)
    k = k.astype(f32).reshape(bsz, length, GLA_HEADS, GLA_DK)
    v = v.astype(f32).reshape(bsz, length, GLA_HEADS, GLA_DV)
    log_a = jax.nn.log_sigmoid(jnp.einsum('blr,rk->blk', g_lr, w_gate_up, preferred_element_type=f32)
                               + b_gate.astype(f32)) / GLA_GATE_TAU
    log_a = log_a.reshape(bsz, length, GLA_HEADS, GLA_DK)
    left = (-N_META) % GLA_CHUNK
    right = (-(length + left)) % GLA_CHUNK
    n_chunks = (length + left + right) // GLA_CHUNK

    def to_chunks(t):
        t = pad_time(t, left, right)
        return t.reshape(bsz, n_chunks, GLA_CHUNK, GLA_HEADS, t.shape[-1]).transpose(1, 0, 3, 2, 4)

    causal = jnp.tril(jnp.ones((GLA_CHUNK, GLA_CHUNK), dtype=bool))

    def chunk_step(state, inp):
        q_c, k_c, v_c, a_c = inp
        b = jnp.cumsum(a_c, axis=2)
        b_last = b[:, :, -1:, :]
        inter = jnp.einsum('bhtd,bhde->bhte', q_c * jnp.exp(b), state)
        rel = jnp.where(causal[:, :, None], b[:, :, :, None, :] - b[:, :, None, :, :], -jnp.inf)
        scores = jnp.einsum('bhtd,bhsd,bhtsd->bhts', q_c, k_c, jnp.exp(rel))
        o = inter + jnp.einsum('bhts,bhse->bhte', scores, v_c)
        state = (jnp.exp(b_last[:, :, 0, :])[..., None] * state
                 + jnp.einsum('bhsd,bhse->bhde', k_c * jnp.exp(b_last - b), v_c))
        return state, o

    state0 = jnp.zeros((bsz, GLA_HEADS, GLA_DK, GLA_DV), f32)
    _, o = lax.scan(chunk_step, state0, (to_chunks(q), to_chunks(k), to_chunks(v), to_chunks(log_a)))
    o = o.transpose(1, 0, 3, 2, 4).reshape(bsz, n_chunks * GLA_CHUNK, GLA_HEADS, GLA_DV)[:, left:left + length]
    o = rms_norm(o, g_norm).reshape(bsz, length, GLA_V_WIDTH) * jax.nn.silu(r.astype(f32))
    return o.astype(r.dtype)


def hierarchical_moe(h, w_rg, b_rg, w_re, b_re, w_g, w_u, w_d):
    bsz, length, d = h.shape
    n = bsz * length
    t = h.reshape(n, d)
    g_logits = jnp.einsum('nd,dg->ng', t, w_rg, preferred_element_type=jnp.float32) + b_rg.astype(jnp.float32)
    g_prob = jax.nn.softmax(g_logits, axis=-1)
    g_idx = jnp.argmax(g_logits, axis=-1)
    g_w = jnp.take_along_axis(g_prob, g_idx[:, None], axis=1)[:, 0]
    e_logits_all = jnp.einsum('nd,dge->nge', t, w_re, preferred_element_type=jnp.float32) + b_re.astype(jnp.float32)
    e_logits = jnp.take_along_axis(e_logits_all, g_idx[:, None, None], axis=1)[:, 0]
    top_v, top_i = lax.top_k(e_logits, TOP_K)
    e_w = jax.nn.softmax(top_v, axis=-1)
    ids = (g_idx[:, None] * EXPERTS_PER_GROUP + top_i).reshape(-1).astype(jnp.int32)
    wts = (g_w[:, None] * e_w).reshape(-1)
    tok = jnp.repeat(jnp.arange(n, dtype=jnp.int32), TOP_K)
    order = jnp.argsort(ids)
    ids_s, tok_s, w_s = ids[order], tok[order], wts[order]
    counts = jnp.bincount(ids, length=N_EXPERTS)
    starts = jnp.cumsum(counts) - counts
    padded = (counts + MOE_BLOCK - 1) // MOE_BLOCK * MOE_BLOCK
    pends = jnp.cumsum(padded)
    pstarts = pends - padded
    dest = pstarts[ids_s] + jnp.arange(n * TOP_K) - starts[ids_s]
    n_slots = -(-(n * TOP_K) // MOE_BLOCK) * MOE_BLOCK + N_EXPERTS * MOE_BLOCK
    n_blocks = n_slots // MOE_BLOCK
    slot_tok = jnp.full((n_slots,), n, jnp.int32).at[dest].set(tok_s)
    slot_w = jnp.zeros((n_slots,), jnp.float32).at[dest].set(w_s)
    block_e = jnp.minimum(jnp.searchsorted(pends, jnp.arange(n_blocks) * MOE_BLOCK, side='right'), N_EXPERTS - 1)
    t_pad = jnp.concatenate([t, jnp.zeros((1, d), t.dtype)], axis=0)

    def run_block(args):
        tok_b, w_b, e = args
        xb = t_pad[tok_b]
        hid = jax.nn.silu(xb @ w_g[e]) * (xb @ w_u[e])
        return (hid @ w_d[e]) * w_b[:, None].astype(xb.dtype)

    y = lax.map(run_block, (slot_tok.reshape(n_blocks, MOE_BLOCK), slot_w.reshape(n_blocks, MOE_BLOCK), block_e))
    out = jnp.zeros((n + 1, d), h.dtype).at[slot_tok].add(y.reshape(n_slots, d).astype(h.dtype))
    return out[:n].reshape(bsz, length, d)


def setup_inputs(seed: int = 0) -> dict:
    key = jax.random.key(seed)
    ks = jax.random.split(key, 26)
    f32 = jnp.float32

    def nrm(k, shape, scale):
        return jax.random.normal(k, shape, f32) * scale

    return {
        'x': nrm(ks[0], (BATCH, SEQ, D_MODEL), 1.0),
        'meta_tokens': nrm(ks[1], (N_META, D_MODEL), 1.0),
        'g_mix_norm': 1.0 + nrm(ks[2], (DEPTH, D_MODEL), 0.02),
        'w_in': nrm(ks[3], (DEPTH, D_MODEL, D_IN), D_MODEL ** -0.5),
        'g_q_norm': 1.0 + nrm(ks[4], (DEPTH, DA_HEAD_DIM), 0.02),
        'g_k_norm': 1.0 + nrm(ks[5], (DEPTH, DA_HEAD_DIM), 0.02),
        'lambda_q1': nrm(ks[6], (DEPTH, DA_HEAD_DIM), 0.1),
        'lambda_k1': nrm(ks[7], (DEPTH, DA_HEAD_DIM), 0.1),
        'lambda_q2': nrm(ks[8], (DEPTH, DA_HEAD_DIM), 0.1),
        'lambda_k2': nrm(ks[9], (DEPTH, DA_HEAD_DIM), 0.1),
        'g_diff_subln': 1.0 + nrm(ks[10], (DEPTH, DA_V_DIM), 0.02),
        'w_gla_gate_up': nrm(ks[11], (DEPTH, GLA_GATE_RANK, GLA_QK_WIDTH), GLA_GATE_RANK ** -0.5),
        'b_gla_gate': nrm(ks[12], (DEPTH, GLA_QK_WIDTH), 0.1),
        'g_gla_norm': 1.0 + nrm(ks[13], (DEPTH, GLA_DV), 0.02),
        'w_branch': nrm(ks[14], (DEPTH, N_BRANCH, BRANCH_WIDTH, D_MODEL), BRANCH_WIDTH ** -0.5),
        'b_merge_gate': nrm(ks[15], (DEPTH, N_BRANCH, D_MODEL), 0.1),
        'w_out': nrm(ks[16], (DEPTH, D_MODEL, D_MODEL), D_MODEL ** -0.5),
        'g_ffn_norm': 1.0 + nrm(ks[17], (DEPTH, D_MODEL), 0.02),
        'w_router_group': nrm(ks[18], (DEPTH, D_MODEL, N_GROUPS), D_MODEL ** -0.5),
        'b_router_group': nrm(ks[19], (DEPTH, N_GROUPS), 0.01),
        'w_router_expert': nrm(ks[20], (DEPTH, D_MODEL, N_GROUPS, EXPERTS_PER_GROUP), D_MODEL ** -0.5),
        'b_router_expert': nrm(ks[21], (DEPTH, N_GROUPS, EXPERTS_PER_GROUP), 0.01),
        'w_exp_gate': nrm(ks[22], (DEPTH, N_EXPERTS, D_MODEL, D_EXPERT), D_MODEL ** -0.5),
        'w_exp_up': nrm(ks[23], (DEPTH, N_EXPERTS, D_MODEL, D_EXPERT), D_MODEL ** -0.5),
        'w_exp_down': nrm(ks[24], (DEPTH, N_EXPERTS, D_EXPERT, D_MODEL), D_EXPERT ** -0.5),
    }


def reference(x, meta_tokens, g_mix_norm, w_in, g_q_norm, g_k_norm, lambda_q1, lambda_k1, lambda_q2, lambda_k2,
              g_diff_subln, w_gla_gate_up, b_gla_gate, g_gla_norm, w_branch, b_merge_gate, w_out, g_ffn_norm,
              w_router_group, b_router_group, w_router_expert, b_router_expert, w_exp_gate, w_exp_up, w_exp_down):
    bsz = x.shape[0]
    meta = jnp.broadcast_to(meta_tokens.astype(x.dtype)[None], (bsz, N_META, D_MODEL))
    u = jnp.concatenate([meta, x], axis=1)
    length = u.shape[1]
    for l in range(DEPTH):
        h = rms_norm(u, g_mix_norm[l])
        z = jnp.einsum('bld,de->ble', h, w_in[l])
        da_q, da_k, da_v, gla_q, gla_k, gla_v, gla_r, gla_g, gate_logits = split_columns(z)
        o_a = diff_attention(da_q, da_k, da_v, g_q_norm[l], g_k_norm[l], g_diff_subln[l],
                             lambda_q1[l], lambda_k1[l], lambda_q2[l], lambda_k2[l], l)
        o_b = gated_linear_attention(gla_q, gla_k, gla_v, gla_r, gla_g, w_gla_gate_up[l], b_gla_gate[l], g_gla_norm[l])
        branches = jnp.stack([o_a, o_b], axis=2)
        y = jnp.einsum('blnw,nwd->blnd', branches, w_branch[l])
        gates = jax.nn.sigmoid(gate_logits.reshape(bsz, length, N_BRANCH, D_MODEL) + b_merge_gate[l])
        merged = jnp.sum(gates * y, axis=2)
        u = u + jnp.einsum('bld,de->ble', merged, w_out[l])
        h2 = rms_norm(u, g_ffn_norm[l])
        u = u + hierarchical_moe(h2, w_router_group[l], b_router_group[l], w_router_expert[l], b_router_expert[l],
                                 w_exp_gate[l], w_exp_up[l], w_exp_down[l])
    return u[:, N_META:]
```

```cpp
#include <hip/hip_runtime.h>
#include <hip/hip_bf16.h>
#include <cstdio>
#include <cstdint>
#include <cmath>

namespace pg8 {
#define PG8_LAS __attribute__((address_space(3)))
typedef unsigned short bf16_t;
typedef short bf16x8 __attribute__((ext_vector_type(8)));
typedef float f32x4 __attribute__((ext_vector_type(4)));
typedef float f32x2 __attribute__((ext_vector_type(2)));
typedef unsigned u32x4 __attribute__((ext_vector_type(4)));
typedef unsigned u32x2 __attribute__((ext_vector_type(2)));
constexpr int BM = 256, BK = 64, HALF = 128, HTB = HALF * BK * 2, STAGE_BYTES = 8 * HTB, NXCD = 8, WGM = 8;

__host__ __device__ __forceinline__ int lds_byte(int r, int c) { const int st = (r >> 4) * 2 + (c >> 5), rr = r & 15, cc = c & 31, ob = rr * 64 + cc * 2; return st * 1024 + (ob ^ (((ob >> 9) & 1) << 5)); }
__host__ __device__ __forceinline__ void stage_rc(int b, int& R, int& C) { const int st = b / 1024, sb = b % 1024, swz = sb ^ (((sb >> 9) & 1) << 5); R = (st >> 1) * 16 + swz / 64; C = (st & 1) * 32 + (swz % 64) / 2; }
__host__ __device__ __forceinline__ int perm32(int rho) { const int n = rho >> 4, i = rho & 15; return 8 * (i >> 2) + 4 * n + (i & 3); }

struct Unit { int pm, pn, aux; };
struct Gemm { const bf16_t* A; const bf16_t* Bt; int K; };

__device__ __forceinline__ void tile_of(int L, int nM, int nN, int& pm, int& pn) {
    const int nwg = nM * nN; int wgid = L;
    { const int q = nwg / NXCD, r = nwg % NXCD, xcd = wgid % NXCD, off = wgid / NXCD; wgid = (xcd < r ? xcd * (q + 1) : r * (q + 1) + (xcd - r) * q) + off; }
    const int nig = WGM * nN, gid = wgid / nig, fm = gid * WGM, gsz = (nM - fm) < WGM ? (nM - fm) : WGM;
    pm = fm + ((wgid % nig) % gsz); pn = (wgid % nig) / gsz;
}
struct StaticOrder {
    static constexpr bool GATHER = false;
    int nM, nN, G, c;
    __device__ __forceinline__ bool next(int i, Unit& u) const { const long L = (long)i * G + c; if (L >= (long)nM * nN) return false; tile_of((int)L, nM, nN, u.pm, u.pn); u.aux = 0; return true; }
    __device__ __forceinline__ int grow(const Unit&, int) const { return 0; }
};
struct PairOrder {
    static constexpr bool GATHER = false;
    int nM, nN, G, c;
    __device__ __forceinline__ bool next(int i, Unit& u) const { const long L = (long)(i >> 1) * G + c; if (L >= (long)nM * nN) return false; tile_of((int)L, nM, nN, u.pm, u.pn); const int br = i & 1; u.pm += nM * br; u.pn += nN * br; u.aux = br; return true; }
    __device__ __forceinline__ int grow(const Unit&, int) const { return 0; }
};

__device__ __forceinline__ unsigned cvt_pk_bf16(float lo, float hi) { unsigned r; asm volatile("v_cvt_pk_bf16_f32 %0, %1, %2" : "=v"(r) : "v"(lo), "v"(hi)); return r; }
__device__ __forceinline__ u32x4 pack8(const f32x4 a, const f32x4 b) { u32x4 w; w.x = cvt_pk_bf16(a[0], a[1]); w.y = cvt_pk_bf16(a[2], a[3]); w.z = cvt_pk_bf16(b[0], b[1]); w.w = cvt_pk_bf16(b[2], b[3]); return w; }
__device__ __forceinline__ float bf_lo(unsigned w) { return __uint_as_float(w << 16); }
__device__ __forceinline__ float bf_hi(unsigned w) { return __uint_as_float(w & 0xffff0000u); }

template <class Epi, class Sched>
__device__ __forceinline__ void gemm_phase(PG8_LAS unsigned char* lds, const Gemm g, const Sched& S, const Epi& E) {
    constexpr bool GA = Sched::GATHER;
    const int tid = threadIdx.x, wid = __builtin_amdgcn_readfirstlane(tid >> 6), lane = tid & 63, wr = wid >> 2, wc = wid & 3, fr = lane & 15, fq = lane >> 4;
    const int K = g.K, nt = K / BK;
    unsigned voffA[2], voffB[2]; int RA[2], CA[2];
#pragma unroll
    for (int i = 0; i < 2; ++i) { int R, C; stage_rc(tid * 16 + i * 8192, R, C); const int Rb = (R & ~31) + perm32(R & 31);
        voffA[i] = (unsigned)(R * K + C) * 2u; voffB[i] = (unsigned)(Rb * K + C) * 2u; RA[i] = R; CA[i] = C; }
    const size_t kstep = (size_t)(BK * 2);
    const size_t hstep = (size_t)HALF * K * 2;
    const size_t tstep = 2 * hstep;
    const unsigned ldsw = (unsigned)wid * 1024u;
    const int aoff = lds_byte(wr * 64 + fr, fq * 8), boff = lds_byte(wc * 32 + fr, fq * 8);
    unsigned gc[2][2], gn[2][2];
#define PG8_SA(b, h) (((b) * 2 + (h)) * HTB)
#define PG8_SB(b, h) ((4 + (b) * 2 + (h)) * HTB)
#define PG8_GL(src, dstoff) __builtin_amdgcn_global_load_lds((const unsigned*)(src), (PG8_LAS unsigned*)(lds + (dstoff)), 16, 0, 0)
#define PG8_STAGE(bufoff, gbase, voff) do { _Pragma("unroll") for (int _i = 0; _i < 2; ++_i) PG8_GL((const char*)(gbase) + (voff)[_i], (bufoff) + ldsw + _i * 8192); } while (0)
#define PG8_STA(bufoff, kptr, h, NX) do { if constexpr (GA) { _Pragma("unroll") for (int _i = 0; _i < 2; ++_i) { const unsigned _o = (NX) ? gn[h][_i] : gc[h][_i]; PG8_GL((const char*)(kptr) + _o, (bufoff) + ldsw + _i * 8192); } } \
        else { PG8_STAGE(bufoff, (const char*)(kptr) + (h) * hstep, voffA); } } while (0)
#define PG8_GOFF(dst, un) do { _Pragma("unroll") for (int _h = 0; _h < 2; ++_h) _Pragma("unroll") for (int _i = 0; _i < 2; ++_i) dst[_h][_i] = ((unsigned)S.grow(un, _h * HALF + RA[_i]) * (unsigned)K + (unsigned)CA[_i]) * 2u; } while (0)
#define PG8_LDA(dst, b, h) do { _Pragma("unroll") for (int m = 0; m < 4; ++m) _Pragma("unroll") for (int k = 0; k < 2; ++k) dst[m][k] = *(const PG8_LAS bf16x8*)(lds + PG8_SA(b, h) + aoff + m * 2048 + k * 1024); } while (0)
#define PG8_LDB(dst, b, h) do { _Pragma("unroll") for (int n = 0; n < 2; ++n) _Pragma("unroll") for (int k = 0; k < 2; ++k) dst[n][k] = *(const PG8_LAS bf16x8*)(lds + PG8_SB(b, h) + boff + n * 2048 + k * 1024); } while (0)
#define PG8_MMA(ai, bj, At, Bt) do { __builtin_amdgcn_s_setprio(1); _Pragma("unroll") for (int m = 0; m < 4; ++m) _Pragma("unroll") for (int n = 0; n < 2; ++n) _Pragma("unroll") for (int k = 0; k < 2; ++k) \
        acc[ai][bj][m][n] = __builtin_amdgcn_mfma_f32_16x16x32_bf16(Bt[n][k], At[m][k], acc[ai][bj][m][n], 0, 0, 0); __builtin_amdgcn_s_setprio(0); } while (0)
#define PG8_WAIT_V(n) asm volatile("s_waitcnt vmcnt(" #n ")" ::: "memory")
#define PG8_WAIT_L(n) asm volatile("s_waitcnt lgkmcnt(" #n ")" ::: "memory")
#define PG8_BAR __builtin_amdgcn_s_barrier()
#define PG8_SCHED __builtin_amdgcn_sched_barrier(0)
#define PG8_ZERO() do { _Pragma("unroll") for (int a = 0; a < 2; ++a) _Pragma("unroll") for (int b = 0; b < 2; ++b) _Pragma("unroll") for (int m = 0; m < 4; ++m) _Pragma("unroll") for (int n = 0; n < 2; ++n) acc[a][b][m][n] = (f32x4){0.f, 0.f, 0.f, 0.f}; } while (0)
    Unit cur, nxt; int ui = 0;
    if (!S.next(0, cur)) return;
    f32x4 acc[2][2][4][2];
    PG8_ZERO();
    bf16x8 At[4][2], B0[2][2], B1[2][2];
    const char* cA = GA ? (const char*)g.A : (const char*)g.A + (size_t)cur.pm * tstep; const char* cB = (const char*)g.Bt + (size_t)cur.pn * tstep;
    if constexpr (GA) { PG8_GOFF(gc, cur); }
    PG8_STAGE(PG8_SB(0, 0), cB, voffB); PG8_STAGE(PG8_SB(0, 1), cB + hstep, voffB); PG8_STA(PG8_SA(0, 0), cA, 0, false); PG8_STA(PG8_SA(0, 1), cA, 1, false);
    if (wr == 1) PG8_BAR;
    PG8_WAIT_V(2); PG8_BAR;
    PG8_STAGE(PG8_SB(1, 0), cB + kstep, voffB); PG8_STA(PG8_SA(1, 0), cA + kstep, 0, false); PG8_STAGE(PG8_SB(1, 1), cB + hstep + kstep, voffB);
    PG8_WAIT_V(6); PG8_BAR;
    for (;;) {
        const bool has_next = S.next(ui + 1, nxt);
        const char* nA = GA ? (const char*)g.A : (has_next ? (const char*)g.A + (size_t)nxt.pm * tstep : cA); const char* nB = has_next ? (const char*)g.Bt + (size_t)nxt.pn * tstep : cB;
        if constexpr (GA) { if (has_next) { PG8_GOFF(gn, nxt); } else { _Pragma("unroll") for (int _h = 0; _h < 2; ++_h) _Pragma("unroll") for (int _i = 0; _i < 2; ++_i) gn[_h][_i] = gc[_h][_i]; } }
        for (int t = 0; t < nt; t += 2) {
            const bool last = (t == nt - 2);
            const char* a1 = cA + (size_t)(t + 1) * kstep;
            const char* a2 = last ? nA : cA + (size_t)(t + 2) * kstep; const char* b2 = last ? nB : cB + (size_t)(t + 2) * kstep;
            const char* a3 = a2 + kstep; const char* b3 = b2 + kstep;
            PG8_LDB(B0, 0, 0); PG8_LDB(B1, 0, 1); PG8_SCHED; PG8_LDA(At, 0, 0); PG8_STA(PG8_SA(1, 1), a1, 1, false);
            PG8_WAIT_V(8); PG8_WAIT_L(0); PG8_BAR; PG8_MMA(0, 0, At, B0); PG8_MMA(0, 1, At, B1); PG8_BAR; PG8_SCHED;
            PG8_LDA(At, 0, 1); PG8_STAGE(PG8_SB(0, 0), b2, voffB); PG8_STAGE(PG8_SB(0, 1), b2 + hstep, voffB); PG8_STA(PG8_SA(0, 0), a2, 0, last);
            PG8_WAIT_V(8); PG8_WAIT_L(0); PG8_BAR; PG8_MMA(1, 0, At, B0); PG8_MMA(1, 1, At, B1); PG8_BAR; PG8_SCHED;
            PG8_LDB(B0, 1, 0); PG8_LDB(B1, 1, 1); PG8_SCHED; PG8_LDA(At, 1, 0); PG8_STA(PG8_SA(0, 1), a2, 1, last);
            PG8_WAIT_V(8); PG8_WAIT_L(0); PG8_BAR; PG8_MMA(0, 0, At, B0); PG8_MMA(0, 1, At, B1); PG8_BAR; PG8_SCHED;
            PG8_LDA(At, 1, 1); PG8_STAGE(PG8_SB(1, 0), b3, voffB); PG8_STAGE(PG8_SB(1, 1), b3 + hstep, voffB); PG8_STA(PG8_SA(1, 0), a3, 0, last);
            PG8_WAIT_V(8); PG8_WAIT_L(0); PG8_BAR; PG8_MMA(1, 0, At, B0); PG8_MMA(1, 1, At, B1); PG8_BAR; PG8_SCHED;
        }
        if (wr == 0) PG8_BAR;
        const bool keep = E(acc, cur, wr, wc, fr, fq);
        if (!has_next) break;
        if (!keep) { PG8_ZERO(); }
        cur = nxt; cA = nA; cB = nB; ++ui;
        if constexpr (GA) { _Pragma("unroll") for (int _h = 0; _h < 2; ++_h) _Pragma("unroll") for (int _i = 0; _i < 2; ++_i) gc[_h][_i] = gn[_h][_i]; }
        if (wr == 1) PG8_BAR;
    }
    PG8_WAIT_V(0);
    PG8_BAR;
#undef PG8_SA
#undef PG8_SB
#undef PG8_GL
#undef PG8_STAGE
#undef PG8_STA
#undef PG8_GOFF
#undef PG8_LDA
#undef PG8_LDB
#undef PG8_MMA
#undef PG8_WAIT_V
#undef PG8_WAIT_L
#undef PG8_BAR
#undef PG8_SCHED
#undef PG8_ZERO
}
}
#include <hip/hip_bf16.h>
#include <cmath>
namespace attn_body {
using bf16=__hip_bfloat16;
using bf16x8=__attribute__((ext_vector_type(8)))short;
using s16x4=__attribute__((ext_vector_type(4)))short;
using f32x16=__attribute__((ext_vector_type(16)))float;
using u32x4=__attribute__((ext_vector_type(4)))unsigned;
constexpr int D=64,QP=512,KP=512,VP=512,OP=1024,QSEQ=4096,KSEQ=4160;
constexpr int NW=8,QBLK=32,QB=QBLK*NW,KVBLK=64,NQB=QSEQ/QB;
constexpr int ATTN_UNIT_ROWS=QB;
__device__ __forceinline__ int crow(int r,int hi){return (r&3)+8*(r>>2)+4*hi;}
#define SBAR() __builtin_amdgcn_sched_barrier(0)
__device__ __forceinline__ void cmask(f32x16&p0,f32x16&p1,int jb,int qrel,int hi){
  const float NEG=-INFINITY; int kb=64*jb+4*hi;
  #pragma unroll
  for(int r=0;r<16;++r){int kv=kb+(r&3)+8*(r>>2); if(kv>qrel)p0[r]=NEG; if(kv+32>qrel)p1[r]=NEG;}
}

constexpr int NSLOT=3, SLOTB=8192;
constexpr int LDS_K=0, LDS_V=NSLOT*SLOTB, LDS_WS=2*NSLOT*SLOTB, LDS_OST=LDS_WS+NW*64*4, LDS_BYTES=LDS_OST+NW*4096;
constexpr float C2=0.125f*1.4426950408889634f;
__device__ __forceinline__ void glds16(const void*gsrc,unsigned lds_dst){unsigned keep;
  asm volatile("s_mov_b32 %0, m0\n\ts_mov_b32 m0, %2\n\ts_nop 0\n\tglobal_load_lds_dwordx4 %1, off\n\ts_mov_b32 m0, %0":"=&s"(keep):"v"(gsrc),"s"(lds_dst):"memory");}
__device__ __forceinline__ float max3f(float a,float b,float c){float r;asm("v_max3_f32 %0, %1, %2, %3":"=v"(r):"v"(a),"v"(b),"v"(c));return r;}
__device__ __forceinline__ float max2f(float a,float b){float r;asm("v_max_f32_e32 %0, %1, %2":"=v"(r):"v"(a),"v"(b));return r;}
__device__ __forceinline__ float fadd_s(float a,float b){float r;asm("v_add_f32_e32 %0, %1, %2":"=v"(r):"v"(a),"v"(b));return r;}
__device__ __forceinline__ float fsub_s(float a,float b){float r;asm("v_sub_f32_e32 %0, %1, %2":"=v"(r):"v"(a),"v"(b));return r;}
typedef float f32x2_t __attribute__((ext_vector_type(2))); typedef __bf16 bf16x2_t __attribute__((ext_vector_type(2)));
__device__ __forceinline__ unsigned cvtpk_s(float lo,float hi){f32x2_t v={lo,hi};bf16x2_t b=__builtin_convertvector(v,bf16x2_t);return __builtin_bit_cast(unsigned,b);}
#define WAIT_BAR(N) asm volatile("s_waitcnt vmcnt(" #N ") lgkmcnt(0)\n\ts_barrier":::"memory")

__device__ __forceinline__ void qkt(f32x16&p0,f32x16&p1,const char*Kslot,const bf16x8*qr,const f32x16&negm,int r32,int hi){
  const char*kb=Kslot+hi*1024+r32*16;
  #pragma unroll
  for(int d0=0;d0<4;++d0){
    const bf16x8 b0=*reinterpret_cast<const bf16x8*>(kb+d0*2048);
    const bf16x8 b1=*reinterpret_cast<const bf16x8*>(kb+d0*2048+512);
    if(d0==0){p0=__builtin_amdgcn_mfma_f32_32x32x16_bf16(b0,qr[0],negm,0,0,0);p1=__builtin_amdgcn_mfma_f32_32x32x16_bf16(b1,qr[0],negm,0,0,0);}
    else{p0=__builtin_amdgcn_mfma_f32_32x32x16_bf16(b0,qr[d0],p0,0,0,0);p1=__builtin_amdgcn_mfma_f32_32x32x16_bf16(b1,qr[d0],p1,0,0,0);}}
}
typedef __attribute__((address_space(3))) const char* lds_cptr;
typedef short v4i16_t __attribute__((ext_vector_type(4)));
__device__ __forceinline__ void kload8(bf16x8*kf,lds_cptr kp){
  kf[0]=*(const __attribute__((address_space(3))) bf16x8*)(kp);      kf[1]=*(const __attribute__((address_space(3))) bf16x8*)(kp+512);
  kf[2]=*(const __attribute__((address_space(3))) bf16x8*)(kp+2048); kf[3]=*(const __attribute__((address_space(3))) bf16x8*)(kp+2560);
  kf[4]=*(const __attribute__((address_space(3))) bf16x8*)(kp+4096); kf[5]=*(const __attribute__((address_space(3))) bf16x8*)(kp+4608);
  kf[6]=*(const __attribute__((address_space(3))) bf16x8*)(kp+6144); kf[7]=*(const __attribute__((address_space(3))) bf16x8*)(kp+6656);
}
__device__ __forceinline__ void kload2(bf16x8*kf,lds_cptr kp,int j){ kf[2*j]=*(const __attribute__((address_space(3))) bf16x8*)(kp+j*2048); kf[2*j+1]=*(const __attribute__((address_space(3))) bf16x8*)(kp+j*2048+512); }
__device__ __forceinline__ s16x4 vtr(lds_cptr p){ return __builtin_bit_cast(s16x4,__builtin_amdgcn_ds_read_tr16_b64_v4i16((__attribute__((address_space(3))) v4i16_t*)p)); }
__device__ __forceinline__ float rowmax(const f32x16&p0,const f32x16&p1){
  float a=max3f(p0[0],p0[1],p1[0]),b=max3f(p0[2],p0[3],p1[1]);a=max3f(a,p1[2],p1[3]);
  #pragma unroll
  for(int r=4;r<16;r+=4){a=max3f(a,p0[r],p0[r+1]);b=max3f(b,p0[r+2],p0[r+3]);a=max3f(a,p1[r],p1[r+1]);b=max3f(b,p1[r+2],p1[r+3]);}
  const float m=max2f(a,b);
  auto rr=__builtin_amdgcn_permlane32_swap(__float_as_uint(m),__float_as_uint(m),false,false);
  return max2f(__uint_as_float(rr[0]),__uint_as_float(rr[1]));
}
__device__ __forceinline__ void pv(f32x16*o,int vb,bf16x8 pa0,bf16x8 pa1,bf16x8 pa2,bf16x8 pa3){
  #pragma unroll
  for(int d0=0;d0<2;++d0){s16x4 lo[4],hi[4];
    #pragma unroll
    for(int ks=0;ks<4;++ks){
      asm volatile("ds_read_b64_tr_b16 %0,%1 offset:%c2":"=&v"(lo[ks]):"v"(vb),"i"(d0*4096+ks*1024):"memory");
      asm volatile("ds_read_b64_tr_b16 %0,%1 offset:%c2":"=&v"(hi[ks]):"v"(vb),"i"(d0*4096+ks*1024+512):"memory");}
    asm volatile("s_waitcnt lgkmcnt(0)":::"memory");SBAR();
    #define PK(k) (bf16x8){lo[k][0],lo[k][1],lo[k][2],lo[k][3],hi[k][0],hi[k][1],hi[k][2],hi[k][3]}
    o[d0]=__builtin_amdgcn_mfma_f32_32x32x16_bf16(pa0,PK(0),o[d0],0,0,0);
    o[d0]=__builtin_amdgcn_mfma_f32_32x32x16_bf16(pa1,PK(1),o[d0],0,0,0);
    o[d0]=__builtin_amdgcn_mfma_f32_32x32x16_bf16(pa2,PK(2),o[d0],0,0,0);
    o[d0]=__builtin_amdgcn_mfma_f32_32x32x16_bf16(pa3,PK(3),o[d0],0,0,0);
    #undef PK
  }
}

#ifndef ATTN_STORE16
#define ATTN_STORE16(p,v) (*(u32x4*)(p)=(v))
#endif
template<int THRL> __device__ __forceinline__ void attn_unit(int b,int qcol,int kcol,int vcol,int ocol,int qb,const bf16*Q,const bf16*__restrict__ K,const bf16*__restrict__ V,bf16*O,char*shm){
  const int tid=threadIdx.x,lane=tid&63,r32=lane&31,hi=lane>>5; const int wid=__builtin_amdgcn_readfirstlane(tid>>6);
  const long qrow0=(long)b*QSEQ, krow0=(long)b*KSEQ; const int q0=qb*QB;
  const bf16*Qw=Q+(qrow0+q0+wid*QBLK)*QP+qcol;
  const bf16*Kh=K+krow0*KP+kcol,*Vh=V+krow0*VP+vcol;
  const unsigned lds0=(unsigned)(uintptr_t)shm;
  float*wsf=(float*)(shm+LDS_WS)+wid*64;
  const bf16*ksrc=Kh+(long)lane*KP+wid*8;
  const bf16*vsrc=Vh+(long)(16*(wid&3)+(lane>>2))*VP+(wid>>2)*32+(lane&3)*8;
  const unsigned kdst=lds0+LDS_K+wid*1024, vdst=lds0+LDS_V+wid*1024;
  #define DMA_K(t,slot) glds16(ksrc+(long)(t)*KVBLK*KP,(unsigned)__builtin_amdgcn_readfirstlane(kdst+(slot)))
  #define DMA_V(t,slot) glds16(vsrc+(long)(t)*KVBLK*VP,(unsigned)__builtin_amdgcn_readfirstlane(vdst+(slot)))
  const int vb0=(int)(lds0+LDS_V)+((lane>>4)&1)*32+(lane&3)*8+(4*hi+((lane&15)>>2))*64;
  const char*Kbase=shm+LDS_K; bf16x8 kf[8];
  const lds_cptr shm3=(lds_cptr)shm; const lds_cptr kp0=shm3+LDS_K+hi*1024+r32*16; const lds_cptr vp0=shm3+LDS_V+((lane>>4)&1)*32+(lane&3)*8+(4*hi+((lane&15)>>2))*64;
  const int NT=(q0+QB)/KVBLK+2;
  DMA_K(0,0);DMA_V(0,0);DMA_K(1,SLOTB);
  bf16x8 qr[4];
  #pragma unroll
  for(int d0=0;d0<4;++d0)qr[d0]=*reinterpret_cast<const bf16x8*>(&Qw[(long)r32*QP+d0*16+hi*8]);
  float mhat=0.f,l_reg=0.f;f32x16 o[2];o[0]=f32x16{};o[1]=f32x16{};f32x16 negm=f32x16{};asm volatile("":"+v"(negm));
  const int qrel=wid*QBLK+r32;
  #define CMASK(P0,P1,t) do{int jb_=(t)-(NT-5); if(jb_>=0)cmask(P0,P1,jb_,qrel,hi);}while(0)
  bool resc=false;
  #define START(P0,P1) do{ const float rm=rowmax(P0,P1); resc=false; \
    { const float dl=rm; mhat=fadd_s(mhat,dl); \
      _Pragma("unroll") for(int r=0;r<16;++r){P0[r]=fsub_s(P0[r],dl);P1[r]=fsub_s(P1[r],dl);} \
      _Pragma("unroll") for(int r=0;r<16;++r)negm[r]=-mhat; asm volatile("":"+v"(negm)); } \
    _Pragma("unroll") for(int r=0;r<16;++r)P0[r]=__builtin_amdgcn_exp2f(P0[r]); }while(0)
  #define RESC() do{ if(resc){ asm volatile("s_waitcnt lgkmcnt(0)":::"memory"); \
      _Pragma("unroll") for(int d_=0;d_<2;++d_) _Pragma("unroll") for(int r=0;r<16;++r)o[d_][r]*=wsf[crow(r,hi)]; } }while(0)
  f32x16 pA0,pA1,pB0,pB1;
  int sl_prev=0,sl_cur=0,sl_next=SLOTB;
  #define ROT() do{sl_prev=sl_cur;sl_cur=sl_next;sl_next=(sl_next==(NSLOT-1)*SLOTB)?0:sl_next+SLOTB;}while(0)
  DMA_K(2,2*SLOTB);
  WAIT_BAR(3);
  qkt(pA0,pA1,Kbase,qr,negm,r32,hi);asm volatile("s_nop 15\n\ts_nop 7":"+v"(pA0),"+v"(pA1));
  { _Pragma("unroll") for(int r=8;r<16;++r)pA0[r]=-INFINITY; _Pragma("unroll") for(int r=0;r<16;++r)pA1[r]=-INFINITY; }
  START(pA0,pA1);
  _Pragma("unroll") for(int r=0;r<16;++r)pA1[r]=__builtin_amdgcn_exp2f(pA1[r]);
  WAIT_BAR(0);
  DMA_K(3,0);DMA_V(1,SLOTB);
  ROT();
  kload8(kf,kp0+sl_cur);
  WAIT_BAR(2);
  s16x4 vlo[8],vhi[8]; u32x4 pw0,pw1,pw2,pw3;
  #define PKW(P,B) cvtpk_s(P[B],P[B+1])
  #define PAF(k) __builtin_bit_cast(bf16x8,pw##k)
  #define VFR(i) (bf16x8){vlo[i][0],vlo[i][1],vlo[i][2],vlo[i][3],vhi[i][0],vhi[i][1],vhi[i][2],vhi[i][3]}
  #define PIN(x) asm volatile("":"+v"(x))
  #define MX3(a,b,c) __builtin_fmaxf(__builtin_fmaxf((a),(b)),(c))
  #define GAPA(MF,A0,A1,A2,A3,W0,W1,PW) do{ MF; sacc+=A0; sacc+=A1; sacc+=A2; sacc+=A3; PIN(sacc); W0; W1; PIN(PW); SBAR(); }while(0)
  #define EX(v) __builtin_amdgcn_exp2f(v)
  #define GAPB(MF,X,B) do{ MF; X[B]=EX(X[B]); X[B+1]=EX(X[B+1]); X[B+2]=EX(X[B+2]); X[B+3]=EX(X[B+3]); PIN(X); SBAR(); }while(0)
  #define VRD(i) do{ vlo[i]=vtr(vp_+(((i)>>2)*4096+((i)&3)*1024)); vhi[i]=vtr(vp_+(((i)>>2)*4096+((i)&3)*1024+512)); }while(0)
  #define KRD(G,j) do{ if(G){ kload2(kf,kp0+sl_next,j); SBAR(); } }while(0)
  #define STEP(C0,C1,P0,P1,t,GK,GV,GL) do{ SBAR(); \
    const lds_cptr vp_=vp0+sl_prev; \
    VRD(0); SBAR(); float sacc=(P0[0]+P0[1]); \
    GAPA(C0=__builtin_amdgcn_mfma_f32_32x32x16_bf16(kf[0],qr[0],negm,0,0,0), P0[2],P0[3],P0[4],P0[5],     pw0[0]=PKW(P0,0), pw0[1]=PKW(P0,2), pw0); \
    VRD(4); SBAR(); GAPA(C1=__builtin_amdgcn_mfma_f32_32x32x16_bf16(kf[1],qr[0],negm,0,0,0), P0[6],P0[7],P0[8],P0[9],     pw0[2]=PKW(P0,4), pw0[3]=PKW(P0,6), pw0); \
    VRD(1); SBAR(); GAPA(C0=__builtin_amdgcn_mfma_f32_32x32x16_bf16(kf[2],qr[1],C0,0,0,0),   P0[10],P0[11],P0[12],P0[13], pw1[0]=PKW(P0,8), pw1[1]=PKW(P0,10), pw1); \
    VRD(5); SBAR(); GAPA(C1=__builtin_amdgcn_mfma_f32_32x32x16_bf16(kf[3],qr[1],C1,0,0,0),   P0[14],P0[15],P1[0],P1[1],   pw1[2]=PKW(P0,12),pw1[3]=PKW(P0,14), pw1); \
    VRD(2); SBAR(); GAPA(C0=__builtin_amdgcn_mfma_f32_32x32x16_bf16(kf[4],qr[2],C0,0,0,0),   P1[2],P1[3],P1[4],P1[5],     pw2[0]=PKW(P1,0), pw2[1]=PKW(P1,2), pw2); \
    VRD(6); SBAR(); GAPA(C1=__builtin_amdgcn_mfma_f32_32x32x16_bf16(kf[5],qr[2],C1,0,0,0),   P1[6],P1[7],P1[8],P1[9],     pw2[2]=PKW(P1,4), pw2[3]=PKW(P1,6), pw2); \
    VRD(3); SBAR(); GAPA(C0=__builtin_amdgcn_mfma_f32_32x32x16_bf16(kf[6],qr[3],C0,0,0,0),   P1[10],P1[11],P1[12],P1[13], pw3[0]=PKW(P1,8), pw3[1]=PKW(P1,10), pw3); \
    VRD(7); SBAR(); GAPA(C1=__builtin_amdgcn_mfma_f32_32x32x16_bf16(kf[7],qr[3],C1,0,0,0),   P1[14],P1[15],0.f,0.f,       pw3[2]=PKW(P1,12),pw3[3]=PKW(P1,14), pw3); \
    l_reg+=sacc; \
    if(GK){DMA_K((t)+3,sl_cur);} if(GV){DMA_V((t)+1,sl_next);} \
    CMASK(C0,C1,t); \
    { float a=MX3(C0[0],C0[1],C1[0]),b=MX3(C0[2],C0[3],C1[1]); a=MX3(a,C1[2],C1[3]); \
      _Pragma("unroll") for(int r=4;r<16;r+=4){a=MX3(a,C0[r],C0[r+1]);b=MX3(b,C0[r+2],C0[r+3]);a=MX3(a,C1[r],C1[r+1]);b=MX3(b,C1[r+2],C1[r+3]);} \
      float rm=__builtin_fmaxf(a,b); { auto rr=__builtin_amdgcn_permlane32_swap(__float_as_uint(rm),__float_as_uint(rm),false,false); rm=__builtin_fmaxf(__uint_as_float(rr[0]),__uint_as_float(rr[1])); } \
      resc=false; \
      if(__builtin_expect(__any(rm>(float)THRL),0)){ const float dl=__builtin_fmaxf(rm,0.f); mhat+=dl; \
        _Pragma("unroll") for(int r=0;r<16;++r){C0[r]-=dl;C1[r]-=dl;} \
        _Pragma("unroll") for(int r=0;r<16;++r)negm[r]=-mhat; asm volatile("":"+v"(negm)); \
        const float f=__builtin_amdgcn_exp2f(-dl); l_reg*=f; if(hi==0)wsf[r32]=f; resc=true; } } \
    SBAR(); \
    GAPB(o[0]=__builtin_amdgcn_mfma_f32_32x32x16_bf16(PAF(0),VFR(0),o[0],0,0,0), C0,0); \
    GAPB(o[1]=__builtin_amdgcn_mfma_f32_32x32x16_bf16(PAF(0),VFR(4),o[1],0,0,0), C0,4); \
    KRD(GL,0); GAPB(o[0]=__builtin_amdgcn_mfma_f32_32x32x16_bf16(PAF(1),VFR(1),o[0],0,0,0), C0,8); \
    KRD(GL,1); GAPB(o[1]=__builtin_amdgcn_mfma_f32_32x32x16_bf16(PAF(1),VFR(5),o[1],0,0,0), C0,12); \
    KRD(GL,2); GAPB(o[0]=__builtin_amdgcn_mfma_f32_32x32x16_bf16(PAF(2),VFR(2),o[0],0,0,0), C1,0); \
    KRD(GL,3); GAPB(o[1]=__builtin_amdgcn_mfma_f32_32x32x16_bf16(PAF(2),VFR(6),o[1],0,0,0), C1,4); \
    GAPB(o[0]=__builtin_amdgcn_mfma_f32_32x32x16_bf16(PAF(3),VFR(3),o[0],0,0,0), C1,8); \
    GAPB(o[1]=__builtin_amdgcn_mfma_f32_32x32x16_bf16(PAF(3),VFR(7),o[1],0,0,0), C1,12); \
    }while(0)
  int t=1;
  #undef CMASK
  #define CMASK(P0,P1,t) do{}while(0)
  for(;t+6<NT;t+=2){
    STEP(pB0,pB1,pA0,pA1,t,true,true,true);     WAIT_BAR(2); RESC(); ROT();
    STEP(pA0,pA1,pB0,pB1,t+1,true,true,true);   WAIT_BAR(2); RESC(); ROT();
  }
  #undef CMASK
  #define CMASK(P0,P1,t) do{int jb_=(t)-(NT-5); if(jb_>=0)cmask(P0,P1,jb_,qrel,hi);}while(0)
  #define ENDW(tt) do{ if((tt)+3<NT){WAIT_BAR(2);} else if((tt)+2<NT){WAIT_BAR(1);} else {WAIT_BAR(0);} }while(0)
  for(;t+1<NT;t+=2){
    STEP(pB0,pB1,pA0,pA1,t,(t+3<NT),(t+1<NT),(t+1<NT));       ENDW(t);   RESC(); ROT();
    STEP(pA0,pA1,pB0,pB1,t+1,(t+4<NT),(t+2<NT),(t+2<NT));     ENDW(t+1); RESC(); ROT();
  }
  #undef CMASK
  #define CMASK(P0,P1,t) do{ _Pragma("unroll") for(int r=0;r<16;++r){P0[r]=-INFINITY;P1[r]=-INFINITY;} }while(0)
  STEP(pB0,pB1,pA0,pA1,NT-1,false,false,false); RESC();
  { float sacc=pB0[0]+pB0[1]; _Pragma("unroll") for(int r=2;r<16;++r)sacc+=pB0[r]; _Pragma("unroll") for(int r=0;r<16;++r)sacc+=pB1[r]; l_reg+=sacc;
    pw0=(u32x4){PKW(pB0,0),PKW(pB0,2),PKW(pB0,4),PKW(pB0,6)};pw1=(u32x4){PKW(pB0,8),PKW(pB0,10),PKW(pB0,12),PKW(pB0,14)};pw2=(u32x4){PKW(pB1,0),PKW(pB1,2),PKW(pB1,4),PKW(pB1,6)};pw3=(u32x4){PKW(pB1,8),PKW(pB1,10),PKW(pB1,12),PKW(pB1,14)};
    SBAR(); pv(o,vb0+sl_cur,PAF(0),PAF(1),PAF(2),PAF(3)); }
  #undef PKW
  #undef PAF
  #undef VFR
  #undef PIN
  #undef MX3
  #undef GAPA
  #undef GAPB
  #undef EX
  #undef VRD
  #undef KRD
  #undef STEP
  #undef ENDW
  {auto rr=__builtin_amdgcn_permlane32_swap(__float_as_uint(l_reg),__float_as_uint(l_reg),false,false);l_reg=__uint_as_float(rr[0])+__uint_as_float(rr[1]);}
  if(hi==0)wsf[32+r32]=l_reg;asm volatile("s_waitcnt lgkmcnt(0)":::"memory");
  float rli[16];
  #pragma unroll
  for(int r=0;r<16;++r)rli[r]=__builtin_amdgcn_rcpf(wsf[32+crow(r,hi)]);
  bf16*Ow=O+(qrow0+q0+wid*QBLK)*OP+ocol;
  { bf16*stg=(bf16*)(shm+LDS_OST)+wid*2048;
    #pragma unroll
    for(int r=0;r<16;++r){const int orow=crow(r,hi);
      #pragma unroll
      for(int d0=0;d0<2;++d0)stg[orow*64+d0*32+r32]=__float2bfloat16(o[d0][r]*rli[r]);}
    asm volatile("s_waitcnt lgkmcnt(0)":::"memory");
    #pragma unroll
    for(int i=0;i<4;++i){const int row=i*8+(lane>>3),ch=lane&7; const u32x4 v=*(const u32x4*)(stg+row*64+ch*8); ATTN_STORE16(Ow+(long)row*OP+ch*8,v);} }
  asm volatile("s_waitcnt lgkmcnt(0)\n\ts_barrier":::"memory");
  #undef DMA_K
  #undef DMA_V
  #undef CMASK
  #undef START
  #undef RESC
  #undef ROT
}
constexpr int ATTN_LDS_BYTES=LDS_BYTES;
struct AttnTensors { const bf16* Q; const bf16* K; const bf16* V; bf16* O; };
template<int THRL=8> __device__ __forceinline__ void attn_phase(char*lds,const AttnTensors&T,int vcu,int G){
  for(int i=0;;++i){ const int p=(i>>1)*G+vcu; if(p>=1024)break; const int bp=p>>3,s=p&7; const int b=bp>>4,ph=bp&15,h=ph>>2,mp=(ph>>1)&1,vh=ph&1; const int qb=(i&1)?15-s:s;
    attn_unit<THRL>(b,(2*h+mp)*64,(2*h+mp)*64,h*128+vh*64,(2*h+mp)*128+vh*64,qb,T.Q,T.K,T.V,T.O,lds); }
}
#undef SBAR
#undef WAIT_BAR
}
#define GAS __attribute__((address_space(1)))
#define LAS __attribute__((address_space(3)))
typedef unsigned short bf16;
typedef unsigned v4u __attribute__((ext_vector_type(4)));
typedef float f32x4 __attribute__((ext_vector_type(4)));
typedef short bf16x8 __attribute__((ext_vector_type(8)));
typedef GAS unsigned gu32;
typedef GAS unsigned long long gu64;
#define RLX_AGENT __ATOMIC_RELAXED, __HIP_MEMORY_SCOPE_AGENT
#define LDS_WAIT() asm volatile("s_waitcnt lgkmcnt(0)" ::: "memory")
#define VM_WAIT() asm volatile("s_waitcnt vmcnt(0)" ::: "memory")
__device__ __forceinline__ unsigned long long rt() { return __builtin_amdgcn_s_memrealtime(); }
__device__ __forceinline__ unsigned f2bf(float f) { unsigned u = __builtin_bit_cast(unsigned, f); return (u + 0x7fffu + ((u >> 16) & 1u)) >> 16; }
__device__ __forceinline__ unsigned pk2(float lo, float hi) { return f2bf(lo) | (f2bf(hi) << 16); }

#define XB_TMO      128
#define XB_XCNT(j)  (256  + 64 * (j))
#define XB_XSUB(j)  (1280 + 64 * (j))
#define XB_XGEN(j)  (2304 + 64 * (j))
#define XB_TOP      3328
#define XB_TOPGEN   3392
#define XCD_BAR_WORDS 3456
#define XB_SPIN_CAP (1u << 18)

__device__ __forceinline__ unsigned xb_ld(unsigned* p)              { return __hip_atomic_load(p, __ATOMIC_RELAXED, __HIP_MEMORY_SCOPE_AGENT); }
__device__ __forceinline__ unsigned xb_add(unsigned* p, unsigned v) { return __hip_atomic_fetch_add(p, v, __ATOMIC_RELAXED, __HIP_MEMORY_SCOPE_AGENT); }
__device__ __forceinline__ unsigned xb_xcc_id() { return (unsigned)__builtin_amdgcn_s_getreg((3 << 11) | 20) & 0xFu; }
#define XB_SPIN(cond, bar) do { unsigned _sp = 0; while (cond) { __builtin_amdgcn_s_sleep(1); \
    if ((++_sp & 255u) == 0u) { if (xb_ld(&(bar)[XB_TMO])) break; if (_sp > XB_SPIN_CAP) { atomicAdd(&(bar)[XB_TMO], 1u); break; } } } } while (0)

struct XcdBarrier {
    unsigned* bar; unsigned x;
    volatile LAS unsigned* st;
};

__device__ __forceinline__ XcdBarrier xcd_barrier_post(unsigned* bar, volatile LAS unsigned* st) {
    XcdBarrier b; b.bar = bar; b.x = xb_xcc_id(); b.st = st;
    if (threadIdx.x == 0) (void)xb_add(&bar[XB_XCNT(b.x)], 1u);
    return b;
}
__device__ __forceinline__ void xcd_barrier_complete(unsigned* bar, unsigned x, unsigned& nloc, unsigned& nx) {
    const unsigned G = gridDim.x * gridDim.y * gridDim.z;
    unsigned sum, cnt, mine, sp = 0u;
    for (;;) {
        sum = 0u; cnt = 0u; mine = 0u;
#pragma unroll
        for (unsigned j = 0; j < 16; ++j) { const unsigned c = xb_ld(&bar[XB_XCNT(j)]); sum += c; cnt += (c > 0u) ? 1u : 0u; mine = (j == x) ? c : mine; }
        if (sum == G) break;
        __builtin_amdgcn_s_sleep(1);
        if ((++sp & 255u) == 0u) { if (xb_ld(&bar[XB_TMO])) break; if (sp > XB_SPIN_CAP) { atomicAdd(&bar[XB_TMO], 1u); break; } }
    }
    nloc = mine > 0u ? mine : 1u; nx = cnt > 0u ? cnt : 1u;
}

__device__ __forceinline__ void xcd_barrier(const XcdBarrier& b) {
    asm volatile("s_waitcnt vmcnt(0)" ::: "memory");
    __syncthreads();
    if (threadIdx.x == 0) {
        unsigned* bar = b.bar;
        __builtin_amdgcn_s_waitcnt(0);
        unsigned nloc = b.st[0], nx = b.st[1];
        if (nloc == 0u) { xcd_barrier_complete(bar, b.x, nloc, nx); b.st[0] = nloc; b.st[1] = nx; }
        const unsigned old = xb_add(&bar[XB_XSUB(b.x)], 1u);
        const unsigned gen = old / nloc;
        if (old + 1u == (gen + 1u) * nloc) {
            __builtin_amdgcn_fence(__ATOMIC_RELEASE, "agent");
            asm volatile("s_waitcnt vmcnt(0)" ::: "memory");
            const unsigned og = xb_add(&bar[XB_TOP], 1u);
            const unsigned tg = og / nx;
            if (og + 1u == (tg + 1u) * nx) xb_add(&bar[XB_TOPGEN], 1u);
            else XB_SPIN(xb_ld(&bar[XB_TOPGEN]) == tg, bar);
            __builtin_amdgcn_fence(__ATOMIC_ACQUIRE, "agent");
            xb_add(&bar[XB_XGEN(b.x)], 1u);
            asm volatile("s_waitcnt vmcnt(0)" ::: "memory");
        } else {
            XB_SPIN(xb_ld(&bar[XB_XGEN(b.x)]) == gen, bar);
            __builtin_amdgcn_fence(__ATOMIC_ACQUIRE, "agent");
            asm volatile("s_waitcnt vmcnt(0)" ::: "memory");
        }
    }
    __syncthreads();
}
constexpr int NWAVES = 8;
constexpr int DM = 1024, NBATCH = 8, SEQ = 4096, NMETA = 16;
constexpr int MROWS = NBATCH * SEQ;
constexpr int LPB = SEQ + 64;
constexpr int PROWS = NBATCH * LPB + 64;
constexpr int MZ = MROWS + 256;
constexpr int NZ = 5376, DIN = 5136;
constexpr int C_DAQ = 0, C_DAK = 512, C_DAV = 1024, C_GQ = 1536, C_GK = 1792, C_GV = 2048, C_GR = 2560, C_GG = 3072, C_GL = 3088;
constexpr float EPS = 1e-6f;
constexpr int NEXP = 32, DEXP = 512, LCAP = 32768;
constexpr int NPOS = SEQ + NMETA;

constexpr size_t MiB = 1u << 20;
constexpr size_t WS_CTL = 0, CTL_ZERO_BYTES = 1 * MiB;
constexpr size_t WS_ROPE = 1 * MiB;
constexpr size_t WS_WRH = 3 * MiB, WS_WRL = 3 * MiB + 128 * 1024;
constexpr size_t WS_DECAY = 3 * MiB + 512 * 1024;
constexpr size_t WS_LTOK = 4 * MiB, WS_LRS = 12 * MiB, WS_LW = 20 * MiB;
constexpr size_t WS_WIN = 28 * MiB, WS_WBR = 39 * MiB, WS_WOUT = 41 * MiB, WS_WGU = 43 * MiB, WS_WD = 107 * MiB;
constexpr size_t WS_R1 = 139 * MiB;
constexpr size_t WS_Q = 204 * MiB, WS_K = 236 * MiB, WS_V = 269 * MiB;
constexpr size_t WS_OA = 204 * MiB, WS_H2U = 204 * MiB;
constexpr size_t WS_GQ = 302 * MiB, WS_GK = 319 * MiB, WS_GV = 336 * MiB, WS_GR = 369 * MiB, WS_LOGA = 402 * MiB;
constexpr size_t WS_HID = 302 * MiB;
constexpr size_t WS_DS = 435 * MiB, WS_END = 500 * MiB;
static_assert(WS_R1 + (size_t)MZ * DM * 2 <= WS_Q && WS_K + (size_t)PROWS * 512 * 2 <= WS_V && WS_V + (size_t)PROWS * 512 * 2 <= WS_GQ, "ws map 1");
static_assert(WS_GQ + (size_t)PROWS * 256 * 2 <= WS_GK && WS_GK + (size_t)PROWS * 256 * 2 <= WS_GV && WS_GV + (size_t)PROWS * 512 * 2 <= WS_GR && WS_GR + (size_t)PROWS * 512 * 2 <= WS_LOGA && WS_LOGA + (size_t)PROWS * 256 * 4 <= WS_DS, "ws map 2");
static_assert(WS_HID + (size_t)81920 * 512 * 2 <= WS_DS && WS_DS + (size_t)32 * 64 * 8192 * 4 <= WS_END && WS_WIN + (size_t)NZ * DM * 2 <= WS_WBR && WS_WD + (size_t)32 * 1024 * 512 * 2 <= WS_R1, "ws map 3");
constexpr int CW_TMO = 0, CW_BAR = 4096, CW_CNT = 16384;

constexpr int RING_OFF = 0, RING_BYTES = 131072;
constexpr int LDSCTL_OFF = RING_BYTES, MISC_OFF = LDSCTL_OFF + 320, TB_OFF = LDSCTL_OFF + 1024, CN_OFF = LDSCTL_OFF + 1536;
constexpr int LDS_BYTES = 147456;
struct Frame {
    LAS unsigned char* lds;
    volatile LAS unsigned* MISC;
    gu32* ctl;
    int tid, lane, wave, vcu, G;
    const float* in[25]; float* out; unsigned char* ws;
};
enum { I_X = 0, I_META, I_GMIX, I_WIN, I_GQN, I_GKN, I_LQ1, I_LK1, I_LQ2, I_LK2, I_GSUB, I_WGUP, I_BGATE, I_GGLA, I_WBR, I_BMERGE, I_WOUT, I_GFFN, I_WRG, I_BRG, I_WRE, I_BRE, I_WEG, I_WEU, I_WED };
#define WSP(T, off) ((T*)(F.ws + (off)))

__device__ __forceinline__ float wave_sum(float v) {
#pragma unroll
    for (int o = 1; o < 64; o <<= 1) v += __shfl_xor(v, o);
    return v;
}
__device__ __forceinline__ float bf2f(bf16 v) { return __uint_as_float((unsigned)v << 16); }
__device__ __forceinline__ float sigmoidf_(float x) { return 1.0f / (1.0f + __expf(-x)); }

__device__ __forceinline__ void transpose_tile(const float* src, int Ns, bf16* dst, int Kd, LAS float* scr, int lane) {
#pragma unroll 8
    for (int i = 0; i < 32; ++i) { const int kk = 2 * i + (lane >> 5); scr[kk * 33 + (lane & 31)] = src[(size_t)kk * Ns + (lane & 31)]; }
    LDS_WAIT(); asm volatile("" ::: "memory");
    const int c = lane & 7;
#pragma unroll
    for (int j = 0; j < 4; ++j) { const int n = (lane >> 3) + 8 * j; const LAS float* s = scr + (8 * c) * 33 + n;
        v4u o; o.x = pk2(s[0 * 33], s[1 * 33]); o.y = pk2(s[2 * 33], s[3 * 33]); o.z = pk2(s[4 * 33], s[5 * 33]); o.w = pk2(s[6 * 33], s[7 * 33]);
        *(GAS v4u*)(dst + (size_t)n * Kd + 8 * c) = o; }
    LDS_WAIT(); asm volatile("" ::: "memory");
}
__device__ __forceinline__ void product_tile(const float* win, const float* wgu, int k0, int n0, bf16* dst, LAS float* scr, int lane) {
    float wg[16];
#pragma unroll
    for (int r = 0; r < 16; ++r) wg[r] = wgu[r * 256 + n0 + (lane & 31)];
#pragma unroll 4
    for (int i = 0; i < 32; ++i) { const int kk = 2 * i + (lane >> 5); const float* wr = win + (size_t)(k0 + kk) * DIN + C_GG; float s = 0.f;
#pragma unroll
        for (int r = 0; r < 16; ++r) s += wr[r] * wg[r];
        scr[kk * 33 + (lane & 31)] = s; }
    LDS_WAIT(); asm volatile("" ::: "memory");
    const int c = lane & 7;
#pragma unroll
    for (int j = 0; j < 4; ++j) { const int n = (lane >> 3) + 8 * j; const LAS float* s = scr + (8 * c) * 33 + n;
        v4u o; o.x = pk2(s[0 * 33], s[1 * 33]); o.y = pk2(s[2 * 33], s[3 * 33]); o.z = pk2(s[4 * 33], s[5 * 33]); o.w = pk2(s[6 * 33], s[7 * 33]);
        *(GAS v4u*)(dst + (size_t)n * DM + 8 * c) = o; }
    LDS_WAIT(); asm volatile("" ::: "memory");
}
__device__ __forceinline__ int win_src_col(int T, int p0) {
    if (T < 4) { const int bj = p0 >> 7, wc = (p0 >> 5) & 3; return (T < 2 ? C_DAQ + 256 * T : C_DAK + 256 * (T - 2)) + 64 * wc + 32 * bj; }
    if (T < 6) return C_DAV + 256 * (T - 4) + p0;
    if (T == 6) return C_GQ + p0;
    if (T == 7) return C_GK + p0;
    if (T < 10) return C_GV + 256 * (T - 8) + p0;
    if (T < 12) return C_GR + 256 * (T - 10) + p0;
    const int t = T - 13; return p0 < 128 ? C_GL + 128 * t + p0 : C_GL + 1024 + 128 * t + (p0 - 128);
}
__device__ __forceinline__ void rms_row_to_bf16(Frame& F, const float* xrow, const float* gain, bf16* orow) {
    const GAS f32x4* xr = (const GAS f32x4*)xrow + F.lane; const GAS f32x4* gr = (const GAS f32x4*)gain + F.lane;
    f32x4 v[4]; float s = 0.f;
#pragma unroll
    for (int j = 0; j < 4; ++j) { v[j] = xr[64 * j]; s += (v[j].x * v[j].x + v[j].y * v[j].y) + (v[j].z * v[j].z + v[j].w * v[j].w); }
    const float rstd = 1.f / sqrtf(wave_sum(s) * (1.f / DM) + EPS);
    GAS unsigned long long* o8 = (GAS unsigned long long*)orow + F.lane;
#pragma unroll
    for (int j = 0; j < 4; ++j) { const f32x4 g = gr[64 * j]; o8[64 * j] = (unsigned long long)pk2(v[j].x * rstd * g.x, v[j].y * rstd * g.y) | ((unsigned long long)pk2(v[j].z * rstd * g.z, v[j].w * rstd * g.w) << 32); }
}
__device__ __forceinline__ void p0_prologue(Frame& F) {
    LAS float* scr = (LAS float*)(F.lds + RING_OFF + F.wave * 16384);
    const int gw = F.vcu * NWAVES + F.wave, NGW = F.G * NWAVES;
    constexpr int I_A = (NZ / 32) * 16, I_B = 2 * 32 * 8, I_C = 32 * 16, I_D = NEXP * 32 * 16, I_E = NEXP * 32 * 8, NITEMS = I_A + I_B + I_C + I_D + I_E;
    bf16* WIN = WSP(bf16, WS_WIN);
    for (int it = gw; it < NITEMS; it += NGW) {
        int r = it;
        if (r < I_A) { const int nb = r >> 4, kb = r & 15, T = nb >> 3, p0 = (nb & 7) * 32; bf16* dst = WIN + (size_t)(nb * 32) * DM + kb * 64;
            if (T == 12) product_tile(F.in[I_WIN], F.in[I_WGUP], kb * 64, p0, dst, scr, F.lane);
            else transpose_tile(F.in[I_WIN] + (size_t)(kb * 64) * DIN + win_src_col(T, p0), DIN, dst, DM, scr, F.lane);
            continue; } r -= I_A;
        if (r < I_B) { const int br = r >> 8, q = r & 255, nb = q >> 3, kb = q & 7;
            transpose_tile(F.in[I_WBR] + (size_t)br * 512 * 1024 + (size_t)(kb * 64) * 1024 + nb * 32, 1024, WSP(bf16, WS_WBR) + (size_t)(br * 1024 + nb * 32) * 512 + kb * 64, 512, scr, F.lane); continue; } r -= I_B;
        if (r < I_C) { const int nb = r >> 4, kb = r & 15;
            transpose_tile(F.in[I_WOUT] + (size_t)(kb * 64) * 1024 + nb * 32, 1024, WSP(bf16, WS_WOUT) + (size_t)(nb * 32) * 1024 + kb * 64, 1024, scr, F.lane); continue; } r -= I_C;
        if (r < I_D) { const int e = r >> 9, q = r & 511, nb = q >> 4, kb = q & 15, P0 = nb * 32, pn = P0 >> 8, p = P0 & 255;
            const float* mat = (p < 128 ? F.in[I_WEG] : F.in[I_WEU]) + (size_t)e * 1024 * 512 + (size_t)(kb * 64) * 512 + 128 * pn + (p & 127);
            transpose_tile(mat, 512, WSP(bf16, WS_WGU) + (size_t)(e * 1024 + P0) * 1024 + kb * 64, 1024, scr, F.lane); continue; } r -= I_D;
        { const int e = r >> 8, q = r & 255, nb = q >> 3, kb = q & 7;
            transpose_tile(F.in[I_WED] + (size_t)e * 512 * 1024 + (size_t)(kb * 64) * 1024 + nb * 32, 1024, WSP(bf16, WS_WD) + (size_t)(e * 1024 + nb * 32) * 512 + kb * 64, 512, scr, F.lane); }
    }
    bf16* XN = WSP(bf16, WS_R1);
    for (int m = gw; m < MZ; m += NGW) {
        if (m < MROWS) rms_row_to_bf16(F, F.in[I_X] + (size_t)m * DM, F.in[I_GMIX], XN + (size_t)m * DM);
        else if (m < MROWS + NMETA) rms_row_to_bf16(F, F.in[I_META] + (size_t)(m - MROWS) * DM, F.in[I_GMIX], XN + (size_t)m * DM);
        else { GAS v4u* o = (GAS v4u*)(XN + (size_t)m * DM) + F.lane; o[0] = (v4u){0u, 0u, 0u, 0u}; o[64] = (v4u){0u, 0u, 0u, 0u}; }
    }
    const int gt = gw * 64 + F.lane, NGT = NGW * 64;
    { float* rc = WSP(float, WS_ROPE); float* rs = rc + NPOS * 32;
      for (int i = gt; i < NPOS * 32; i += NGT) { const int pos = i >> 5, j = i & 31; const float inv = exp2f(-(float)j * 0.41524101186092029f); const float ang = (float)pos * inv;
          const double rev = (double)ang * 0.15915494309189535; const float x = (float)(rev - rint(rev));
          rc[i] = __builtin_amdgcn_cosf(x); rs[i] = __builtin_amdgcn_sinf(x); } }
    { bf16* wh = WSP(bf16, WS_WRH); bf16* wl = WSP(bf16, WS_WRL);
      for (int i = gt; i < 48 * 1024; i += NGT) { const int n = i >> 10, k = i & 1023; float v = n < 4 ? F.in[I_WRG][k * 4 + n] : (n < 36 ? F.in[I_WRE][k * 32 + (n - 4)] : 0.f); v *= F.in[I_GFFN][k];
          const unsigned h = f2bf(v); const float hf = __uint_as_float(h << 16); wh[i] = (bf16)h; wl[i] = (bf16)f2bf(v - hf); } }
    { unsigned* kz = (unsigned*)(WSP(bf16, WS_K) + (size_t)NBATCH * LPB * 512); unsigned* vz = (unsigned*)(WSP(bf16, WS_V) + (size_t)NBATCH * LPB * 512);
      for (int i = gt; i < 64 * 512 / 2; i += NGT) { kz[i] = 0u; vz[i] = 0u; } }
}
namespace epi {
using pg8::f32x4; using pg8::u32x4; using pg8::Unit; using pg8::pack8; using pg8::HALF;
__device__ __forceinline__ float log_sigmoid(float x) { return fminf(x, 0.f) - __logf(1.0f + __expf(-fabsf(x))); }

struct EpiZ {
    bf16 *Q, *K, *V, *GQ, *GK, *GV, *GR, *RATIO, *G1; float* LOGA;
    const float *gq, *gk, *bgate, *bmerge, *ropec, *ropes;
    __device__ __forceinline__ bool operator()(f32x4 (&acc)[2][2][4][2], const Unit& u, int wr, int wc, int fr, int fq) const {
        const int pn = u.pn, pm = u.pm; const bool meta = (pm == MROWS / 256);
        int oz; asm volatile("v_mov_b32 %0, 0" : "=v"(oz));
        const int r0 = wr * 64 + fr + oz, cl = wc * 32 + 8 * fq;
        const int bsh = 64 * ((pm >> 4) + 1);
        if (pn < 4) {
            const bool isq = pn < 2; if (isq && meta) return false;
            const float* gn = isq ? gq : gk;
            const f32x4 ga0 = *(const f32x4*)(gn + 8 * fq), ga1 = *(const f32x4*)(gn + 8 * fq + 4), gb0 = *(const f32x4*)(gn + 32 + 8 * fq), gb1 = *(const f32x4*)(gn + 36 + 8 * fq);
            const int hcol = ((pn & 1) * 4 + wc) * 64 + 8 * fq;
            const float osc = isq ? 0.125f * 1.4426950408889634f : 1.0f;
#pragma unroll
            for (int ai = 0; ai < 2; ++ai)
#pragma unroll
                for (int m = 0; m < 4; ++m) {
                    if (meta && (ai != 0 || wr != 0)) continue;
                    const int r = r0 + ai * HALF + m * 16;
                    const f32x4 x1a = acc[ai][0][m][0], x1b = acc[ai][0][m][1], x2a = acc[ai][1][m][0], x2b = acc[ai][1][m][1];
                    float ss = (x1a[0] * x1a[0] + x1a[1] * x1a[1]) + (x1a[2] * x1a[2] + x1a[3] * x1a[3]) + (x1b[0] * x1b[0] + x1b[1] * x1b[1]) + (x1b[2] * x1b[2] + x1b[3] * x1b[3])
                             + (x2a[0] * x2a[0] + x2a[1] * x2a[1]) + (x2a[2] * x2a[2] + x2a[3] * x2a[3]) + (x2b[0] * x2b[0] + x2b[1] * x2b[1]) + (x2b[2] * x2b[2] + x2b[3] * x2b[3]);
                    ss += __shfl_xor(ss, 16); ss += __shfl_xor(ss, 32);
                    const float rn = 1.0f / sqrtf(ss * (1.0f / 64.0f) + EPS);
                    const int pos = meta ? r : NMETA + ((pm * 256 + r) & (SEQ - 1));
                    const f32x4 c0 = *(const f32x4*)(ropec + pos * 32 + 8 * fq), c1 = *(const f32x4*)(ropec + pos * 32 + 8 * fq + 4), s0 = *(const f32x4*)(ropes + pos * 32 + 8 * fq), s1 = *(const f32x4*)(ropes + pos * 32 + 8 * fq + 4);
                    const f32x4 y1a = x1a * rn * ga0, y1b = x1b * rn * ga1, y2a = x2a * rn * gb0, y2b = x2b * rn * gb1;
                    const f32x4 o1a = (y1a * c0 - y2a * s0) * osc, o1b = (y1b * c1 - y2b * s1) * osc, o2a = (y2a * c0 + y1a * s0) * osc, o2b = (y2b * c1 + y1b * s1) * osc;
                    const u32x4 w1 = pack8(o1a, o1b), w2 = pack8(o2a, o2b);
                    if (isq) { bf16* p = Q + (size_t)(pm * 256 + r) * 512 + hcol; *(u32x4*)p = w1; *(u32x4*)(p + 32) = w2; }
                    else if (!meta) { bf16* p = K + (size_t)(pm * 256 + r + bsh) * 512 + hcol; *(u32x4*)p = w1; *(u32x4*)(p + 32) = w2; }
                    else { for (int b = 0; b < NBATCH; ++b) { bf16* p = K + (size_t)(b * LPB + r) * 512 + hcol; *(u32x4*)p = w1; *(u32x4*)(p + 32) = w2; } }
                    asm volatile("" ::: "memory");
                }
            return false;
        }
        if (pn < 12) {
            bf16* T; int pitch, cb; float sc = 1.0f; bool wmeta = true;
            if (pn < 6) { T = V; pitch = 512; cb = (pn - 4) * 256; }
            else if (pn == 6) { T = GQ; pitch = 256; cb = 0; sc = 0.125f; wmeta = false; }
            else if (pn == 7) { T = GK; pitch = 256; cb = 0; }
            else if (pn < 10) { T = GV; pitch = 512; cb = (pn - 8) * 256; }
            else { T = GR; pitch = 512; cb = (pn - 10) * 256; wmeta = false; }
            if (meta && !wmeta) return false;
#pragma unroll
            for (int ai = 0; ai < 2; ++ai)
#pragma unroll
                for (int m = 0; m < 4; ++m) {
                    if (meta && (ai != 0 || wr != 0)) continue;
                    const int r = r0 + ai * HALF + m * 16;
#pragma unroll
                    for (int bj = 0; bj < 2; ++bj) { const u32x4 w = pack8(acc[ai][bj][m][0] * sc, acc[ai][bj][m][1] * sc); const int col = cb + bj * HALF + cl;
                        if (!meta) *(u32x4*)(T + (size_t)(pm * 256 + r + bsh) * pitch + col) = w;
                        else for (int b = 0; b < NBATCH; ++b) *(u32x4*)(T + (size_t)(b * LPB + r) * pitch + col) = w; }
                    asm volatile("" ::: "memory");
                }
            return false;
        }
        if (pn == 12) {
#pragma unroll
            for (int bj = 0; bj < 2; ++bj) { const int col = bj * HALF + cl; const f32x4 b0 = *(const f32x4*)(bgate + col), b1 = *(const f32x4*)(bgate + col + 4);
#pragma unroll
                for (int ai = 0; ai < 2; ++ai)
#pragma unroll
                    for (int m = 0; m < 4; ++m) {
                        if (meta && (ai != 0 || wr != 0)) continue;
                        const int r = r0 + ai * HALF + m * 16; const f32x4 a0 = acc[ai][bj][m][0] + b0, a1 = acc[ai][bj][m][1] + b1; f32x4 v0, v1;
#pragma unroll
                        for (int i = 0; i < 4; ++i) { v0[i] = log_sigmoid(a0[i]) * (1.0f / 16.0f); v1[i] = log_sigmoid(a1[i]) * (1.0f / 16.0f); }
                        if (!meta) { float* p = LOGA + (size_t)(pm * 256 + r + bsh) * 256 + col; *(f32x4*)p = v0; *(f32x4*)(p + 4) = v1; }
                        else { if (r >= NMETA) { v0 = (f32x4){0.f, 0.f, 0.f, 0.f}; v1 = v0; }
                               for (int b = 0; b < NBATCH; ++b) { float* p = LOGA + (size_t)(b * LPB + r) * 256 + col; *(f32x4*)p = v0; *(f32x4*)(p + 4) = v1; } }
                        asm volatile("" ::: "memory");
                    } }
            return false;
        }
        if (meta) return false;
        { const int d = 128 * (pn - 13) + cl;
          const f32x4 b00 = *(const f32x4*)(bmerge + d), b01 = *(const f32x4*)(bmerge + d + 4), b10 = *(const f32x4*)(bmerge + DM + d), b11 = *(const f32x4*)(bmerge + DM + d + 4);
#pragma unroll
          for (int ai = 0; ai < 2; ++ai)
#pragma unroll
              for (int m = 0; m < 4; ++m) { const int r = r0 + ai * HALF + m * 16;
                  const f32x4 x00 = acc[ai][0][m][0] + b00, x01 = acc[ai][0][m][1] + b01, x10 = acc[ai][1][m][0] + b10, x11 = acc[ai][1][m][1] + b11; f32x4 ra, rb, ga, gb;
#pragma unroll
                  for (int i = 0; i < 4; ++i) { const float e0 = 1.0f + __expf(-x00[i]), e1 = 1.0f + __expf(-x10[i]); ra[i] = e1 * __builtin_amdgcn_rcpf(e0); ga[i] = __builtin_amdgcn_rcpf(e1);
                                                const float f0 = 1.0f + __expf(-x01[i]), f1 = 1.0f + __expf(-x11[i]); rb[i] = f1 * __builtin_amdgcn_rcpf(f0); gb[i] = __builtin_amdgcn_rcpf(f1); }
                  const size_t o = (size_t)(pm * 256 + r) * DM + d; *(u32x4*)(RATIO + o) = pack8(ra, rb); *(u32x4*)(G1 + o) = pack8(ga, gb); asm volatile("" ::: "memory"); } }
        return false;
    }
};
struct EpiMerge {
    const bf16 *RATIO, *G1; bf16* MERGED;
    __device__ __forceinline__ bool operator()(f32x4 (&acc)[2][2][4][2], const Unit& u, int wr, int wc, int fr, int fq) const {
        const int br = u.aux, pm = u.pm - (MROWS / 256) * br, pn = u.pn - 4 * br;
        const int r0 = pm * 256 + wr * 64 + fr, c0 = pn * 256 + wc * 32 + 8 * fq;
        const bf16* src = br ? G1 : RATIO;
#pragma unroll
        for (int ai = 0; ai < 2; ++ai)
#pragma unroll
            for (int m = 0; m < 4; ++m)
#pragma unroll
                for (int bj = 0; bj < 2; ++bj) { const size_t o = (size_t)(r0 + ai * HALF + m * 16) * DM + c0 + bj * HALF; const u32x4 g = *(const u32x4*)(src + o);
                    const f32x4 g0 = {pg8::bf_lo(g.x), pg8::bf_hi(g.x), pg8::bf_lo(g.y), pg8::bf_hi(g.y)}, g1 = {pg8::bf_lo(g.z), pg8::bf_hi(g.z), pg8::bf_lo(g.w), pg8::bf_hi(g.w)};
                    const f32x4 v0 = acc[ai][bj][m][0] * g0, v1 = acc[ai][bj][m][1] * g1;
                    if (br) *(u32x4*)(MERGED + o) = pack8(v0, v1); else { acc[ai][bj][m][0] = v0; acc[ai][bj][m][1] = v1; } }
        return br == 0;
    }
};
struct EpiOut {
    const float* x; float* out; bf16* H2U; const float* gffn;
    __device__ __forceinline__ bool operator()(f32x4 (&acc)[2][2][4][2], const Unit& u, int wr, int wc, int fr, int fq) const {
        const int r0 = u.pm * 256 + wr * 64 + fr, c0 = u.pn * 256 + wc * 32 + 8 * fq;
#pragma unroll
        for (int bj = 0; bj < 2; ++bj) { const f32x4 ga = *(const f32x4*)(gffn + c0 + bj * HALF), gb = *(const f32x4*)(gffn + c0 + bj * HALF + 4);
#pragma unroll
            for (int ai = 0; ai < 2; ++ai)
#pragma unroll
                for (int m = 0; m < 4; ++m) { const size_t o = (size_t)(r0 + ai * HALF + m * 16) * DM + c0 + bj * HALF;
                    const f32x4 u0 = *(const f32x4*)(x + o) + acc[ai][bj][m][0], u1 = *(const f32x4*)(x + o + 4) + acc[ai][bj][m][1];
                    *(f32x4*)(out + o) = u0; *(f32x4*)(out + o + 4) = u1; *(u32x4*)(H2U + o) = pack8(u0 * ga, u1 * gb); } }
        return false;
    }
};
template <bool GATHER_> struct MoeSched {
    static constexpr bool GATHER = GATHER_;
    const LAS int* tb; const LAS int* cn; const int* ltok; int seg_lo, seg_hi, G, c;
    __device__ __forceinline__ bool next(int i, Unit& u) const {
        const int t0 = __builtin_amdgcn_readfirstlane(tb[seg_lo]), t1 = __builtin_amdgcn_readfirstlane(tb[seg_hi]);
        const long L = (long)i * G + c; if (L >= (long)(t1 - t0) * 4) return false;
        const int rt = t0 + (int)(L >> 2), pnl = (int)(L & 3); int s = seg_lo;
        while (s + 1 < seg_hi && __builtin_amdgcn_readfirstlane(tb[s + 1]) <= rt) ++s;
        u.pm = rt; u.pn = (s & 31) * 4 + pnl; u.aux = s | ((rt - __builtin_amdgcn_readfirstlane(tb[s])) << 8); return true;
    }
    __device__ __forceinline__ int grow(const Unit& u, int r) const { const int s = u.aux & 255, si = (u.aux >> 8) * 256 + r; return si < cn[s] ? ltok[(size_t)s * LCAP + si] : 0; }
};
struct EpiUp {
    const LAS int* cn; const float* lrs; bf16* HID;
    __device__ __forceinline__ bool operator()(f32x4 (&acc)[2][2][4][2], const Unit& u, int wr, int wc, int fr, int fq) const {
        const int s = u.aux & 255, rtl = u.aux >> 8, cnt = cn[s], pnl = u.pn & 3;
#pragma unroll
        for (int ai = 0; ai < 2; ++ai)
#pragma unroll
            for (int m = 0; m < 4; ++m) { const int r = wr * 64 + fr + ai * HALF + m * 16, si = rtl * 256 + r; const float rs = si < cnt ? lrs[(size_t)s * LCAP + si] : 0.f;
                f32x4 h0, h1;
#pragma unroll
                for (int i = 0; i < 4; ++i) { const float g0 = acc[ai][0][m][0][i] * rs, g1 = acc[ai][0][m][1][i] * rs;
                    h0[i] = g0 * __builtin_amdgcn_rcpf(1.0f + __expf(-g0)) * (acc[ai][1][m][0][i] * rs); h1[i] = g1 * __builtin_amdgcn_rcpf(1.0f + __expf(-g1)) * (acc[ai][1][m][1][i] * rs); }
                *(u32x4*)(HID + (size_t)(u.pm * 256 + r) * DEXP + pnl * 128 + wc * 32 + 8 * fq) = pack8(h0, h1); }
        return false;
    }
};
struct EpiDown {
    const LAS int* cn; const int* ltok; const float* lw; float* out;
    __device__ __forceinline__ bool operator()(f32x4 (&acc)[2][2][4][2], const Unit& u, int wr, int wc, int fr, int fq) const {
        const int s = u.aux & 255, rtl = u.aux >> 8, cnt = cn[s], pnl = u.pn & 3;
#pragma unroll
        for (int ai = 0; ai < 2; ++ai)
#pragma unroll
            for (int m = 0; m < 4; ++m) { const int r = wr * 64 + fr + ai * HALF + m * 16, si = rtl * 256 + r;
                if (si < cnt) { const int tok = ltok[(size_t)s * LCAP + si]; const float w = lw[(size_t)s * LCAP + si];
#pragma unroll
                    for (int bj = 0; bj < 2; ++bj) { float* p = out + (size_t)tok * DM + pnl * 256 + bj * HALF + wc * 32 + 8 * fq;
                        const f32x4 a = *(const f32x4*)p, b = *(const f32x4*)(p + 4); *(f32x4*)p = a + acc[ai][bj][m][0] * w; *(f32x4*)(p + 4) = b + acc[ai][bj][m][1] * w; } } }
        return false;
    }
};
}
constexpr int GP = 144;
typedef LAS unsigned char* ldsp;
__device__ __forceinline__ pg8::bf16x8 ldfrag(ldsp base, int row, int ks, int fq) { return *(const LAS pg8::bf16x8*)(base + row * GP + ks * 64 + fq * 16); }
#define MFMA16(a, b, c) __builtin_amdgcn_mfma_f32_16x16x32_bf16((a), (b), (c), 0, 0, 0)
__device__ __forceinline__ float gla_cumsum(Frame& F, const float* LOGA, int R0, int h, float (&bt)[8], LAS float* part) {
    const int d = F.tid & 63, tq = F.wave; const float* la = LOGA + (size_t)(R0 + 8 * tq) * 256 + h * 64 + d;
    float a[8];
#pragma unroll
    for (int i = 0; i < 8; ++i) a[i] = la[i * 256];
    bt[0] = a[0];
#pragma unroll
    for (int i = 1; i < 8; ++i) bt[i] = bt[i - 1] + a[i];
    part[tq * 64 + d] = bt[7];
    __syncthreads();
    float off = 0.f, tot = 0.f;
#pragma unroll
    for (int j = 0; j < 8; ++j) { const float p = part[j * 64 + d]; tot += p; if (j < tq) off += p; }
#pragma unroll
    for (int i = 0; i < 8; ++i) bt[i] += off;
    return tot;
}
__device__ __forceinline__ void gla_load_vt(Frame& F, const bf16* GV, int R0, int h, ldsp VT) {
#pragma unroll
    for (int j = 0; j < 2; ++j) { const int p = F.tid + 512 * j, s = p >> 4, ec = p & 15; const v4u w = *(const GAS v4u*)(GV + (size_t)(R0 + s) * 512 + h * 128 + ec * 8);
        const unsigned ww[4] = {w.x, w.y, w.z, w.w};
#pragma unroll
        for (int i = 0; i < 4; ++i) { *(LAS bf16*)(VT + (8 * ec + 2 * i) * GP + s * 2) = (bf16)(ww[i] & 0xffffu); *(LAS bf16*)(VT + (8 * ec + 2 * i + 1) * GP + s * 2) = (bf16)(ww[i] >> 16); } }
}
__device__ __forceinline__ void gla_pass1(Frame& F, int unit) {
    const int bh = unit >> 6, c = unit & 63, b = bh >> 2, h = bh & 3, R0 = b * LPB + 64 * c, d = F.tid & 63, tq = F.wave, fr = F.lane & 15, fq = F.lane >> 4;
    LAS float* part = (LAS float*)(F.lds + 0); const ldsp AH = F.lds + 2048, VT = F.lds + 12288;
    float bt[8]; const float tot = gla_cumsum(F, WSP(float, WS_LOGA), R0, h, bt, part);
    const bf16* kp = WSP(bf16, WS_GK) + (size_t)(R0 + 8 * tq) * 256 + h * 64 + d;
    float kh[8];
#pragma unroll
    for (int i = 0; i < 8; ++i) kh[i] = bf2f(kp[i * 256]) * __expf(tot - bt[i]);
    { v4u w; w.x = pk2(kh[0], kh[1]); w.y = pk2(kh[2], kh[3]); w.z = pk2(kh[4], kh[5]); w.w = pk2(kh[6], kh[7]); *(LAS v4u*)(AH + d * GP + tq * 16) = w; }
    gla_load_vt(F, WSP(bf16, WS_GV), R0, h, VT);
    if (tq == 0) WSP(float, WS_DECAY)[(size_t)(bh * 65 + c) * 64 + d] = __expf(tot);
    __syncthreads();
    pg8::f32x4 acc[4];
#pragma unroll
    for (int db = 0; db < 4; ++db) acc[db] = (pg8::f32x4){0.f, 0.f, 0.f, 0.f};
#pragma unroll
    for (int ks = 0; ks < 2; ++ks) { const pg8::bf16x8 bfr = ldfrag(VT, 16 * tq + fr, ks, fq);
#pragma unroll
        for (int db = 0; db < 4; ++db) acc[db] = MFMA16(ldfrag(AH, 16 * db + fr, ks, fq), bfr, acc[db]); }
    float* ds = WSP(float, WS_DS) + ((size_t)(bh * 64 + c) * 128 + 16 * tq + fr) * 64;
#pragma unroll
    for (int db = 0; db < 4; ++db) *(pg8::f32x4*)(ds + 16 * db + 4 * fq) = acc[db];
    __syncthreads();
}
__device__ __forceinline__ void gla_scan(Frame& F) {
    const int gt = (F.vcu * NWAVES + F.wave) * 64 + F.lane, NGT = F.G * NWAVES * 64;
    pg8::f32x4* DS = WSP(pg8::f32x4, WS_DS); const float* DEC = WSP(float, WS_DECAY);
    for (int item = gt; item < 32 * 2048; item += NGT) { const int bh = item >> 11, q = item & 2047, d4 = (q * 4) & 63;
        pg8::f32x4* p = DS + (size_t)bh * 64 * 2048 + q; pg8::f32x4 S = p[0];
        for (int c0 = 1; c0 < 64; c0 += 7) { pg8::f32x4 x[7], dd[7];
#pragma unroll
            for (int j = 0; j < 7; ++j) { x[j] = p[(size_t)(c0 + j) * 2048]; dd[j] = *(const pg8::f32x4*)(DEC + (size_t)(bh * 65 + c0 + j) * 64 + d4); }
#pragma unroll
            for (int j = 0; j < 7; ++j) { S = dd[j] * S + x[j]; p[(size_t)(c0 + j) * 2048] = S; } }
    }
}
__device__ __forceinline__ void gla_pass2(Frame& F, int unit) {
    const int bh = unit >> 6, c = (unit & 63) + 1, b = bh >> 2, h = bh & 3, R0 = b * LPB + 64 * c, d = F.tid & 63, tq = F.wave, fr = F.lane & 15, fq = F.lane >> 4;
    LAS float* part = (LAS float*)(F.lds + 0); const ldsp QT = F.lds + 2048, KT = F.lds + 11264, VT = F.lds + 20480, SB = F.lds + 38912, PP = F.lds + 57344; LAS float* SSQ = (LAS float*)(F.lds + 66560);
    float bt[8]; (void)gla_cumsum(F, WSP(float, WS_LOGA), R0, h, bt, part);
    const bf16* qp = WSP(bf16, WS_GQ) + (size_t)(R0 + 8 * tq) * 256 + h * 64 + d; const bf16* kp = WSP(bf16, WS_GK) + (size_t)(R0 + 8 * tq) * 256 + h * 64 + d;
#pragma unroll
    for (int i = 0; i < 8; ++i) { const float qv = bf2f(qp[i * 256]) * __expf(bt[i]), kv = bf2f(kp[i * 256]) * __expf(fminf(-bt[i], 80.f));
        *(LAS bf16*)(QT + (8 * tq + i) * GP + d * 2) = (bf16)f2bf(qv); *(LAS bf16*)(KT + (8 * tq + i) * GP + d * 2) = (bf16)f2bf(kv); }
    gla_load_vt(F, WSP(bf16, WS_GV), R0, h, VT);
    { const pg8::f32x4* sp = WSP(pg8::f32x4, WS_DS) + (size_t)(bh * 64 + (c - 1)) * 2048;
#pragma unroll
      for (int j = 0; j < 4; ++j) { const int q = F.tid + 512 * j, e = q >> 4, d4 = (q & 15) * 4; const pg8::f32x4 v = sp[q];
          *(LAS unsigned*)(SB + e * GP + d4 * 2) = pk2(v.x, v.y); *(LAS unsigned*)(SB + e * GP + d4 * 2 + 4) = pk2(v.z, v.w); } }
    __syncthreads();
    const int tb = tq >> 1, t0 = 16 * tb, t = t0 + fr;
#pragma unroll
    for (int sbi = 0; sbi < 2; ++sbi) { const int s0 = 16 * (2 * (tq & 1) + sbi); pg8::f32x4 a = {0.f, 0.f, 0.f, 0.f};
#pragma unroll
        for (int ks = 0; ks < 2; ++ks) a = MFMA16(ldfrag(KT, s0 + fr, ks, fq), ldfrag(QT, t0 + fr, ks, fq), a);
        const int s = s0 + 4 * fq;
        const float p0 = (s + 0 <= t) ? a[0] : 0.f, p1 = (s + 1 <= t) ? a[1] : 0.f, p2 = (s + 2 <= t) ? a[2] : 0.f, p3 = (s + 3 <= t) ? a[3] : 0.f;
        *(LAS unsigned*)(PP + t * GP + s * 2) = pk2(p0, p1); *(LAS unsigned*)(PP + t * GP + s * 2 + 4) = pk2(p2, p3); }
    __syncthreads();
    const int eh = tq & 1; pg8::f32x4 o[4];
#pragma unroll
    for (int eb = 0; eb < 4; ++eb) o[eb] = (pg8::f32x4){0.f, 0.f, 0.f, 0.f};
#pragma unroll
    for (int ks = 0; ks < 4; ++ks) { const pg8::bf16x8 bfr = ks < 2 ? ldfrag(PP, t0 + fr, ks, fq) : ldfrag(QT, t0 + fr, ks - 2, fq);
#pragma unroll
        for (int eb = 0; eb < 4; ++eb) { const int e0 = 64 * eh + 16 * eb; o[eb] = MFMA16(ks < 2 ? ldfrag(VT, e0 + fr, ks, fq) : ldfrag(SB, e0 + fr, ks - 2, fq), bfr, o[eb]); } }
    float ss = 0.f;
#pragma unroll
    for (int eb = 0; eb < 4; ++eb) ss += (o[eb][0] * o[eb][0] + o[eb][1] * o[eb][1]) + (o[eb][2] * o[eb][2] + o[eb][3] * o[eb][3]);
    ss += __shfl_xor(ss, 16); ss += __shfl_xor(ss, 32);
    if (fq == 0) SSQ[t * 2 + eh] = ss;
    __syncthreads();
    const float rn = 1.0f / sqrtf((SSQ[t * 2] + SSQ[t * 2 + 1]) * (1.0f / 128.0f) + EPS);
    const bf16* rp = WSP(bf16, WS_GR) + (size_t)(R0 + t) * 512 + h * 128; bf16* op = WSP(bf16, WS_OA) + (size_t)MROWS * 512 + (size_t)(b * SEQ + 64 * (c - 1) + t) * 512 + h * 128; const float* gg = F.in[I_GGLA];
#pragma unroll
    for (int eb = 0; eb < 4; ++eb) { const int e = 64 * eh + 16 * eb + 4 * fq; const unsigned long long rw = *(const GAS unsigned long long*)(rp + e); const pg8::f32x4 g = *(const pg8::f32x4*)(gg + e);
        const float r0 = __uint_as_float((unsigned)rw << 16), r1 = __uint_as_float((unsigned)rw & 0xffff0000u), r2 = __uint_as_float((unsigned)(rw >> 32) << 16), r3 = __uint_as_float((unsigned)(rw >> 32) & 0xffff0000u);
        const float v0 = o[eb][0] * rn * g.x * (r0 * sigmoidf_(r0)), v1 = o[eb][1] * rn * g.y * (r1 * sigmoidf_(r1)), v2 = o[eb][2] * rn * g.z * (r2 * sigmoidf_(r2)), v3 = o[eb][3] * rn * g.w * (r3 * sigmoidf_(r3));
        *(GAS unsigned long long*)(op + e) = (unsigned long long)pk2(v0, v1) | ((unsigned long long)pk2(v2, v3) << 32); }
    __syncthreads();
}
__device__ __forceinline__ void diff_combine(Frame& F) {
    const int gw = F.vcu * NWAVES + F.wave, NGW = F.G * NWAVES, l = F.lane;
    const float s1 = wave_sum(F.in[I_LQ1][l] * F.in[I_LK1][l]), s2 = wave_sum(F.in[I_LQ2][l] * F.in[I_LK2][l]);
    const float lam = expf(s1) - expf(s2) + 0.2f;
    const int h = l >> 4, e8 = (l & 15) * 8; const pg8::f32x4 g0 = *(const pg8::f32x4*)(F.in[I_GSUB] + e8), g1 = *(const pg8::f32x4*)(F.in[I_GSUB] + e8 + 4);
    const bf16* O = WSP(bf16, WS_R1); bf16* OA = WSP(bf16, WS_OA);
    for (int row = gw; row < MROWS; row += NGW) {
        const v4u a = *(const GAS v4u*)(O + (size_t)row * 1024 + (2 * h) * 128 + e8), bb = *(const GAS v4u*)(O + (size_t)row * 1024 + (2 * h + 1) * 128 + e8);
        const unsigned aw[4] = {a.x, a.y, a.z, a.w}, bw[4] = {bb.x, bb.y, bb.z, bb.w}; float dv[8]; float ss = 0.f;
#pragma unroll
        for (int i = 0; i < 4; ++i) { dv[2 * i] = pg8::bf_lo(aw[i]) - lam * pg8::bf_lo(bw[i]); dv[2 * i + 1] = pg8::bf_hi(aw[i]) - lam * pg8::bf_hi(bw[i]); ss += dv[2 * i] * dv[2 * i] + dv[2 * i + 1] * dv[2 * i + 1]; }
        ss += __shfl_xor(ss, 1); ss += __shfl_xor(ss, 2); ss += __shfl_xor(ss, 4); ss += __shfl_xor(ss, 8);
        const float rn = 0.8f / sqrtf(ss * (1.0f / 128.0f) + EPS);
        v4u o; o.x = pk2(dv[0] * rn * g0.x, dv[1] * rn * g0.y); o.y = pk2(dv[2] * rn * g0.z, dv[3] * rn * g0.w); o.z = pk2(dv[4] * rn * g1.x, dv[5] * rn * g1.y); o.w = pk2(dv[6] * rn * g1.z, dv[7] * rn * g1.w);
        *(GAS v4u*)(OA + (size_t)row * 512 + h * 128 + e8) = o;
    }
}
__device__ __forceinline__ void router_phase(Frame& F) {
    LAS float* lg = (LAS float*)(F.lds + F.wave * 4096);
    LAS float* rsd = lg + 16 * 48;
    LAS int* lcnt = (LAS int*)(F.lds + 32768); LAS int* lbase = lcnt + 64;
    const float* U = F.out; const bf16* wh = WSP(bf16, WS_WRH); const bf16* wl = WSP(bf16, WS_WRL);
    int* ltok = WSP(int, WS_LTOK); float* lrs = WSP(float, WS_LRS); float* lw = WSP(float, WS_LW);
    const int fr = F.lane & 15, kg = F.lane >> 4;
    for (int rb = F.vcu; rb < MROWS / 128; rb += F.G) {
        if (F.tid < 64) lcnt[F.tid] = 0;
        __syncthreads();
        const int m0 = rb * 128 + F.wave * 16; const float* urow = U + (size_t)(m0 + fr) * DM + 8 * kg;
        pg8::f32x4 acc[3]; acc[0] = acc[1] = acc[2] = (pg8::f32x4){0.f, 0.f, 0.f, 0.f}; float ss = 0.f;
#pragma unroll 2
        for (int s = 0; s < 32; ++s) {
            const pg8::f32x4 x0 = *(const pg8::f32x4*)(urow + 32 * s), x1 = *(const pg8::f32x4*)(urow + 32 * s + 4);
            ss += (x0[0] * x0[0] + x0[1] * x0[1]) + (x0[2] * x0[2] + x0[3] * x0[3]) + (x1[0] * x1[0] + x1[1] * x1[1]) + (x1[2] * x1[2] + x1[3] * x1[3]);
            const float xv[8] = {x0[0], x0[1], x0[2], x0[3], x1[0], x1[1], x1[2], x1[3]}; unsigned hi[4], lo[4];
#pragma unroll
            for (int i = 0; i < 4; ++i) { const unsigned h0 = f2bf(xv[2 * i]), h1 = f2bf(xv[2 * i + 1]); hi[i] = h0 | (h1 << 16);
                lo[i] = f2bf(xv[2 * i] - __uint_as_float(h0 << 16)) | (f2bf(xv[2 * i + 1] - __uint_as_float(h1 << 16)) << 16); }
            const pg8::bf16x8 ah = __builtin_bit_cast(pg8::bf16x8, (v4u){hi[0], hi[1], hi[2], hi[3]}), al = __builtin_bit_cast(pg8::bf16x8, (v4u){lo[0], lo[1], lo[2], lo[3]});
#pragma unroll
            for (int cb = 0; cb < 3; ++cb) { const size_t wo = (size_t)(16 * cb + fr) * DM + 32 * s + 8 * kg;
                const pg8::bf16x8 bh = *(const pg8::bf16x8*)(wh + wo), bl = *(const pg8::bf16x8*)(wl + wo);
                acc[cb] = MFMA16(ah, bh, acc[cb]); acc[cb] = MFMA16(al, bh, acc[cb]); acc[cb] = MFMA16(ah, bl, acc[cb]); }
        }
        ss += __shfl_xor(ss, 16); ss += __shfl_xor(ss, 32);
        if (kg == 0) rsd[fr] = 1.0f / sqrtf(ss * (1.0f / DM) + EPS);
#pragma unroll
        for (int cb = 0; cb < 3; ++cb)
#pragma unroll
            for (int i = 0; i < 4; ++i) lg[(4 * kg + i) * 48 + 16 * cb + fr] = acc[cb][i];
        LDS_WAIT(); asm volatile("" ::: "memory");
        int seg0 = 0, seg1 = 0, rk0 = 0, rk1 = 0; float w0 = 0.f, w1 = 0.f, rs = 0.f;
        if (F.lane < 16) {
            const LAS float* L = lg + F.lane * 48; rs = rsd[F.lane];
            float gl[4];
#pragma unroll
            for (int j = 0; j < 4; ++j) gl[j] = L[j] * rs + F.in[I_BRG][j];
            int gi = 0; float gm = gl[0];
#pragma unroll
            for (int j = 1; j < 4; ++j) if (gl[j] > gm) { gm = gl[j]; gi = j; }
            float gs = 0.f;
#pragma unroll
            for (int j = 0; j < 4; ++j) gs += expf(gl[j] - gm);
            const float gw_ = 1.0f / gs;
            float v1 = -INFINITY, v2 = -INFINITY; int i1 = 0, i2 = 0;
            for (int j = 0; j < 8; ++j) { const float v = L[4 + gi * 8 + j] * rs + F.in[I_BRE][gi * 8 + j];
                if (v > v1) { v2 = v1; i2 = i1; v1 = v; i1 = j; } else if (v > v2) { v2 = v; i2 = j; } }
            const float e1 = 1.0f / (1.0f + expf(v2 - v1));
            w0 = gw_ * e1; w1 = gw_ * (1.0f - e1); seg0 = gi * 8 + i1; seg1 = 32 + gi * 8 + i2;
            rk0 = atomicAdd((int*)(lcnt + seg0), 1); rk1 = atomicAdd((int*)(lcnt + seg1), 1);
        }
        __syncthreads();
        if (F.tid < 64) { const int n = lcnt[F.tid]; lbase[F.tid] = n ? (int)__hip_atomic_fetch_add((unsigned*)(F.ctl + CW_CNT + F.tid), (unsigned)n, RLX_AGENT) : 0; }
        __syncthreads();
        if (F.lane < 16) { const int tok = m0 + F.lane; const size_t p0 = (size_t)seg0 * LCAP + lbase[seg0] + rk0, p1 = (size_t)seg1 * LCAP + lbase[seg1] + rk1;
            ltok[p0] = tok; lrs[p0] = rs; lw[p0] = w0; ltok[p1] = tok; lrs[p1] = rs; lw[p1] = w1; }
        __syncthreads();
    }
}
#ifndef MK_N_LAUNCHES
#define MK_N_LAUNCHES 1
#endif
constexpr int N_PHASES = 11;
struct Args { const float* in[25]; float* out; unsigned char* ws; int ph_lo, ph_hi; };
__global__ void __launch_bounds__(NWAVES * 64, 2) fwd_kernel(Args args) {
    extern __shared__ __attribute__((aligned(16))) unsigned char lds[];
    Frame F;
    F.lds = (LAS unsigned char*)lds;
    F.MISC = (volatile LAS unsigned*)(F.lds + MISC_OFF);
    F.tid = threadIdx.x; F.lane = F.tid & 63; F.wave = __builtin_amdgcn_readfirstlane(F.tid >> 6);
    F.G = gridDim.x; { const int bx = blockIdx.x; F.vcu = (F.G % 8 == 0) ? (bx % 8) * (F.G / 8) + bx / 8 : bx; }
    F.ws = args.ws; F.out = args.out; F.ctl = (gu32*)(args.ws + WS_CTL);
#pragma unroll
    for (int i = 0; i < 25; ++i) F.in[i] = args.in[i];
    for (int u = F.tid; u < (LDS_BYTES - LDSCTL_OFF) / 4; u += NWAVES * 64) ((LAS unsigned*)(F.lds + LDSCTL_OFF))[u] = 0u;
    __syncthreads();
    XcdBarrier bar; bar.bar = (unsigned*)(F.ctl + CW_BAR); bar.x = 0; bar.st = nullptr;
    if (MK_N_LAUNCHES == 1) bar = xcd_barrier_post((unsigned*)(F.ctl + CW_BAR), F.MISC + 8);
    const int lo = args.ph_lo, hi = args.ph_hi;
#ifndef PH_MASK
#define PH_MASK 0x7ff
#endif
#define IN(k) (((PH_MASK >> (k)) & 1) && lo <= (k) && (k) < hi)
#define SEAM(k) do { if (IN(k) && IN((k) + 1)) xcd_barrier(bar); } while (0)
    const LAS int* tbp = (const LAS int*)(F.lds + TB_OFF); const LAS int* cnp = (const LAS int*)(F.lds + CN_OFF);

    if (IN(0)) { p0_prologue(F); } SEAM(0);
    if (IN(1)) {
        pg8::Gemm g{WSP(pg8::bf16_t, WS_R1), WSP(pg8::bf16_t, WS_WIN), DM}; pg8::StaticOrder S{MZ / 256, NZ / 256, F.G, (int)blockIdx.x};
        epi::EpiZ E{WSP(bf16, WS_Q), WSP(bf16, WS_K), WSP(bf16, WS_V), WSP(bf16, WS_GQ), WSP(bf16, WS_GK), WSP(bf16, WS_GV), WSP(bf16, WS_GR), (bf16*)F.out, (bf16*)F.out + (size_t)MROWS * DM, WSP(float, WS_LOGA),
                    F.in[I_GQN], F.in[I_GKN], F.in[I_BGATE], F.in[I_BMERGE], WSP(float, WS_ROPE), WSP(float, WS_ROPE) + NPOS * 32};
        pg8::gemm_phase(F.lds + RING_OFF, g, S, E);
    } SEAM(1);
    if (IN(2)) {
        const attn_body::AttnTensors AT{(const attn_body::bf16*)WSP(bf16, WS_Q), (const attn_body::bf16*)WSP(bf16, WS_K), (const attn_body::bf16*)WSP(bf16, WS_V), (attn_body::bf16*)WSP(bf16, WS_R1)};
        attn_body::attn_phase<8>((char*)lds + RING_OFF, AT, F.vcu, F.G);
        asm volatile("s_waitcnt vmcnt(0) lgkmcnt(0)" ::: "memory"); __syncthreads();
        for (int un = F.vcu; un < 32 * 64; un += F.G) gla_pass1(F, un);
    } SEAM(2);
    if (IN(3)) { diff_combine(F); gla_scan(F); } SEAM(3);
    if (IN(4)) { for (int un = F.vcu; un < 32 * 64; un += F.G) gla_pass2(F, un); } SEAM(4);
    if (IN(5)) {
        pg8::Gemm g{WSP(pg8::bf16_t, WS_OA), WSP(pg8::bf16_t, WS_WBR), 512}; pg8::PairOrder S{MROWS / 256, DM / 256, F.G, (int)blockIdx.x};
        epi::EpiMerge E{(const bf16*)F.out, (const bf16*)F.out + (size_t)MROWS * DM, WSP(bf16, WS_R1)};
        pg8::gemm_phase(F.lds + RING_OFF, g, S, E);
    } SEAM(5);
    if (IN(6)) {
        pg8::Gemm g{WSP(pg8::bf16_t, WS_R1), WSP(pg8::bf16_t, WS_WOUT), DM}; pg8::StaticOrder S{MROWS / 256, DM / 256, F.G, (int)blockIdx.x};
        epi::EpiOut E{F.in[I_X], F.out, WSP(bf16, WS_H2U), F.in[I_GFFN]};
        pg8::gemm_phase(F.lds + RING_OFF, g, S, E);
    } SEAM(6);
    if (IN(7)) { router_phase(F); } SEAM(7);
    if ((PH_MASK >> 8) && hi > 8) {
        LAS int* tb = (LAS int*)(F.lds + TB_OFF); LAS int* cn = (LAS int*)(F.lds + CN_OFF);
        if (F.tid < 64) cn[F.tid] = (int)__hip_atomic_load(F.ctl + CW_CNT + F.tid, RLX_AGENT);
        __syncthreads();
        if (F.tid == 0) { int a = 0; for (int s = 0; s < 64; ++s) { tb[s] = a; a += (cn[s] + 255) >> 8; } tb[64] = a; }
        __syncthreads();
    }
    if (IN(8)) {
        pg8::Gemm g{WSP(pg8::bf16_t, WS_H2U), WSP(pg8::bf16_t, WS_WGU), DM}; epi::MoeSched<true> S{tbp, cnp, WSP(int, WS_LTOK), 0, 64, F.G, (int)blockIdx.x};
        epi::EpiUp E{cnp, WSP(float, WS_LRS), WSP(bf16, WS_HID)};
        pg8::gemm_phase(F.lds + RING_OFF, g, S, E);
    } SEAM(8);
    if (IN(9)) {
        pg8::Gemm g{WSP(pg8::bf16_t, WS_HID), WSP(pg8::bf16_t, WS_WD), DEXP}; epi::MoeSched<false> S{tbp, cnp, WSP(int, WS_LTOK), 0, 32, F.G, (int)blockIdx.x};
        epi::EpiDown E{cnp, WSP(int, WS_LTOK), WSP(float, WS_LW), F.out};
        pg8::gemm_phase(F.lds + RING_OFF, g, S, E);
    } SEAM(9);
    if (IN(10)) {
        pg8::Gemm g{WSP(pg8::bf16_t, WS_HID), WSP(pg8::bf16_t, WS_WD), DEXP}; epi::MoeSched<false> S{tbp, cnp, WSP(int, WS_LTOK), 32, 64, F.G, (int)blockIdx.x};
        epi::EpiDown E{cnp, WSP(int, WS_LTOK), WSP(float, WS_LW), F.out};
        pg8::gemm_phase(F.lds + RING_OFF, g, S, E);
    }
#undef IN
#undef SEAM
}

extern "C" void kernel_launch(void* const* d_in, const int* in_sizes, int n_in, void* d_out, int out_size, void* d_ws, size_t ws_size, hipStream_t stream) {
    static int grid = 0;
    if (grid == 0) {
        if (n_in != 25 || in_sizes[0] != MROWS * DM || out_size != MROWS * DM || ws_size < WS_END) { fprintf(stderr, "kernel_launch: unexpected shapes (n_in %d, in0 %d, out %d, ws %zu)\n", n_in, n_in > 0 ? in_sizes[0] : -1, out_size, ws_size); grid = -1; return; }
        int dev = 0, cus = 0, per_cu = 0;
        if (hipGetDevice(&dev) != hipSuccess || hipDeviceGetAttribute(&cus, hipDeviceAttributeMultiprocessorCount, dev) != hipSuccess) { grid = -1; return; }
        if (hipFuncSetAttribute((const void*)fwd_kernel, hipFuncAttributeMaxDynamicSharedMemorySize, LDS_BYTES) != hipSuccess) { fprintf(stderr, "kernel_launch: hipFuncSetAttribute failed\n"); grid = -1; return; }
        if (hipOccupancyMaxActiveBlocksPerMultiprocessor(&per_cu, (const void*)fwd_kernel, NWAVES * 64, LDS_BYTES) != hipSuccess || per_cu < 1) { fprintf(stderr, "kernel_launch: occupancy query says %d\n", per_cu); }
        (void)hipGetLastError();
        grid = cus;
    }
    if (grid < 0) return;
    if (hipMemsetAsync((char*)d_ws + WS_CTL, 0, CTL_ZERO_BYTES, stream) != hipSuccess) return;
    Args a{};
    for (int i = 0; i < 25; ++i) a.in[i] = (const float*)d_in[i];
    a.out = (float*)d_out; a.ws = (unsigned char*)d_ws;
    if (MK_N_LAUNCHES == 1) { a.ph_lo = 0; a.ph_hi = N_PHASES; hipLaunchKernelGGL(fwd_kernel, dim3(grid), dim3(NWAVES * 64), LDS_BYTES, stream, a); }
    else for (int p = 0; p < N_PHASES; ++p) { a.ph_lo = p; a.ph_hi = p + 1; hipLaunchKernelGGL(fwd_kernel, dim3(grid), dim3(NWAVES * 64), LDS_BYTES, stream, a); }
}
```

```cpp
#include <hip/hip_runtime.h>
#include <hip/hip_bf16.h>
#include <cstdio>
#include <cstdint>
#include <cmath>

namespace pg8 {
#define PG8_LAS __attribute__((address_space(3)))
typedef unsigned short bf16_t;
typedef short bf16x8 __attribute__((ext_vector_type(8)));
typedef float f32x4 __attribute__((ext_vector_type(4)));
typedef float f32x2 __attribute__((ext_vector_type(2)));
typedef unsigned u32x4 __attribute__((ext_vector_type(4)));
typedef unsigned u32x2 __attribute__((ext_vector_type(2)));
typedef int v8i __attribute__((ext_vector_type(8)));
constexpr int BM = 256, BK = 64, HALF = 128, HTB = HALF * BK * 2, STAGE_BYTES = 8 * HTB, NXCD = 8, WGM = 8;

__host__ __device__ __forceinline__ int lds_byte(int r, int c) { const int st = (r >> 4) * 2 + (c >> 5), rr = r & 15, cc = c & 31, ob = rr * 64 + cc * 2; return st * 1024 + (ob ^ (((ob >> 9) & 1) << 5)); }
__host__ __device__ __forceinline__ void stage_rc(int b, int& R, int& C) { const int st = b / 1024, sb = b % 1024, swz = sb ^ (((sb >> 9) & 1) << 5); R = (st >> 1) * 16 + swz / 64; C = (st & 1) * 32 + (swz % 64) / 2; }
__host__ __device__ __forceinline__ int perm32(int rho) { const int n = rho >> 4, i = rho & 15; return 8 * (i >> 2) + 4 * n + (i & 3); }

struct Unit { int pm, pn, aux, half; };
struct Gemm { const bf16_t* A; const bf16_t* Bt; int K; };

__device__ __forceinline__ void tile_of(int L, int nM, int nN, int& pm, int& pn) {
    const int nwg = nM * nN; int wgid = L;
    { const int q = nwg / NXCD, r = nwg % NXCD, xcd = wgid % NXCD, off = wgid / NXCD; wgid = (xcd < r ? xcd * (q + 1) : r * (q + 1) + (xcd - r) * q) + off; }
    const int nig = WGM * nN, gid = wgid / nig, fm = gid * WGM, gsz = (nM - fm) < WGM ? (nM - fm) : WGM;
    pm = fm + ((wgid % nig) % gsz); pn = (wgid % nig) / gsz;
}
struct StaticOrder {
    static constexpr bool GATHER = false;
    int nM, nN, G, c;
    __device__ __forceinline__ bool next(int i, Unit& u) const { const long L = (long)i * G + c; if (L >= (long)nM * nN) return false; tile_of((int)L, nM, nN, u.pm, u.pn); u.aux = 0; u.half = 0; return true; }
    __device__ __forceinline__ int grow(const Unit&, int) const { return 0; }
};
struct PairOrder {
    static constexpr bool GATHER = false;
    int nM, nN, G, c;
    __device__ __forceinline__ bool next(int i, Unit& u) const { const long L = (long)(i >> 1) * G + c; if (L >= (long)nM * nN) return false; tile_of((int)L, nM, nN, u.pm, u.pn); const int br = i & 1; u.pm += nM * br; u.pn += nN * br; u.aux = br; u.half = 0; return true; }
    __device__ __forceinline__ int grow(const Unit&, int) const { return 0; }
};

__device__ __forceinline__ unsigned cvt_pk_bf16(float lo, float hi) { unsigned r; asm volatile("v_cvt_pk_bf16_f32 %0, %1, %2" : "=v"(r) : "v"(lo), "v"(hi)); return r; }
__device__ __forceinline__ u32x4 pack8(const f32x4 a, const f32x4 b) { u32x4 w; w.x = cvt_pk_bf16(a[0], a[1]); w.y = cvt_pk_bf16(a[2], a[3]); w.z = cvt_pk_bf16(b[0], b[1]); w.w = cvt_pk_bf16(b[2], b[3]); return w; }
__device__ __forceinline__ float bf_lo(unsigned w) { return __uint_as_float(w << 16); }
__device__ __forceinline__ float bf_hi(unsigned w) { return __uint_as_float(w & 0xffff0000u); }

template <class Epi, class Sched, bool F8 = false>
__device__ __forceinline__ void gemm_phase(PG8_LAS unsigned char* lds, const Gemm g, const Sched& S, const Epi& E) {
    constexpr bool GA = Sched::GATHER;
    const int tid = threadIdx.x, wid = __builtin_amdgcn_readfirstlane(tid >> 6), lane = tid & 63, wr = wid >> 2, wc = wid & 3, fr = lane & 15, fq = lane >> 4;
    const int K = g.K, nt = K / BK;
    unsigned voffA[2], voffB[2]; int RA[2], CA[2];
#pragma unroll
    for (int i = 0; i < 2; ++i) { int R, C; stage_rc(tid * 16 + i * 8192, R, C); const int Rb = (R & ~31) + perm32(R & 31);
        voffA[i] = (unsigned)(R * K + C) * 2u; voffB[i] = (unsigned)(Rb * K + C) * 2u; RA[i] = R; CA[i] = C; }
    const size_t kstep = (size_t)(BK * 2);
    const size_t hstep = (size_t)HALF * K * 2;
    const size_t tstep = 2 * hstep;
    const unsigned ldsw = (unsigned)wid * 1024u;
    const int aoff = lds_byte(wr * 64 + fr, F8 ? fq * 16 : fq * 8), boff = lds_byte(wc * 32 + fr, F8 ? fq * 16 : fq * 8);
    unsigned gc[2][2], gn[2][2];
#define PG8_SA(b, h) (((b) * 2 + (h)) * HTB)
#define PG8_SB(b, h) ((4 + (b) * 2 + (h)) * HTB)
#define PG8_GL(src, dstoff) __builtin_amdgcn_global_load_lds((const unsigned*)(src), (PG8_LAS unsigned*)(lds + (dstoff)), 16, 0, 0)
#define PG8_STAGE(bufoff, gbase, voff) do { _Pragma("unroll") for (int _i = 0; _i < 2; ++_i) PG8_GL((const char*)(gbase) + (voff)[_i], (bufoff) + ldsw + _i * 8192); } while (0)
#define PG8_STA(bufoff, kptr, h, NX) do { if constexpr (GA) { _Pragma("unroll") for (int _i = 0; _i < 2; ++_i) { const unsigned _o = (NX) ? gn[h][_i] : gc[h][_i]; PG8_GL((const char*)(kptr) + _o, (bufoff) + ldsw + _i * 8192); } } \
        else { PG8_STAGE(bufoff, (const char*)(kptr) + (h) * hstep, voffA); } } while (0)
#define PG8_GOFF(dst, un) do { _Pragma("unroll") for (int _h = 0; _h < 2; ++_h) _Pragma("unroll") for (int _i = 0; _i < 2; ++_i) dst[_h][_i] = ((unsigned)S.grow(un, _h * HALF + RA[_i]) * (unsigned)K + (unsigned)CA[_i]) * 2u; } while (0)
#define PG8_LDA(dst, b, h) do { _Pragma("unroll") for (int m = 0; m < 4; ++m) _Pragma("unroll") for (int k = 0; k < 2; ++k) dst[m][k] = *(const PG8_LAS bf16x8*)(lds + PG8_SA(b, h) + aoff + m * 2048 + (F8 ? k * 16 : k * 1024)); } while (0)
#define PG8_LDB(dst, b, h) do { _Pragma("unroll") for (int n = 0; n < 2; ++n) _Pragma("unroll") for (int k = 0; k < 2; ++k) dst[n][k] = *(const PG8_LAS bf16x8*)(lds + PG8_SB(b, h) + boff + n * 2048 + (F8 ? k * 16 : k * 1024)); } while (0)
#define PG8_F8V(X) __builtin_shufflevector(__builtin_bit_cast(u32x4, X[0]), __builtin_bit_cast(u32x4, X[1]), 0, 1, 2, 3, 4, 5, 6, 7)
#define PG8_MMA(ai, bj, At, Bt) do { __builtin_amdgcn_s_setprio(1); \
        if constexpr (F8) { _Pragma("unroll") for (int m = 0; m < 4; ++m) _Pragma("unroll") for (int n = 0; n < 2; ++n) \
            acc[ai][bj][m][n] = __builtin_amdgcn_mfma_scale_f32_16x16x128_f8f6f4(__builtin_bit_cast(v8i, PG8_F8V(Bt[n])), __builtin_bit_cast(v8i, PG8_F8V(At[m])), acc[ai][bj][m][n], 0, 0, 0, 0x7f7f7f7f, 0, 0x7f7f7f7f); } \
        else { _Pragma("unroll") for (int m = 0; m < 4; ++m) _Pragma("unroll") for (int n = 0; n < 2; ++n) _Pragma("unroll") for (int k = 0; k < 2; ++k) \
            acc[ai][bj][m][n] = __builtin_amdgcn_mfma_f32_16x16x32_bf16(Bt[n][k], At[m][k], acc[ai][bj][m][n], 0, 0, 0); } __builtin_amdgcn_s_setprio(0); } while (0)
#define PG8_WAIT_V(n) asm volatile("s_waitcnt vmcnt(" #n ")" ::: "memory")
#define PG8_WAIT_L(n) asm volatile("s_waitcnt lgkmcnt(" #n ")" ::: "memory")
#define PG8_BAR __builtin_amdgcn_s_barrier()
#define PG8_SCHED __builtin_amdgcn_sched_barrier(0)
#define PG8_ZERO() do { _Pragma("unroll") for (int a = 0; a < 2; ++a) _Pragma("unroll") for (int b = 0; b < 2; ++b) _Pragma("unroll") for (int m = 0; m < 4; ++m) _Pragma("unroll") for (int n = 0; n < 2; ++n) acc[a][b][m][n] = (f32x4){0.f, 0.f, 0.f, 0.f}; } while (0)
    Unit cur, nxt; int ui = 0;
    if (!S.next(0, cur)) return;
    f32x4 acc[2][2][4][2];
    PG8_ZERO();
    bf16x8 At[4][2], B0[2][2], B1[2][2];
    const char* cA = GA ? (const char*)g.A : (const char*)g.A + (size_t)cur.pm * tstep; const char* cB = (const char*)g.Bt + (size_t)cur.pn * tstep;
    if constexpr (GA) { PG8_GOFF(gc, cur); }
    PG8_STAGE(PG8_SB(0, 0), cB, voffB); PG8_STAGE(PG8_SB(0, 1), cB + hstep, voffB); PG8_STA(PG8_SA(0, 0), cA, 0, false); PG8_STA(PG8_SA(0, 1), cA, 1, false);
    if (wr == 1) PG8_BAR;
    PG8_WAIT_V(2); PG8_BAR;
    PG8_STAGE(PG8_SB(1, 0), cB + kstep, voffB); PG8_STA(PG8_SA(1, 0), cA + kstep, 0, false); PG8_STAGE(PG8_SB(1, 1), cB + hstep + kstep, voffB);
    PG8_WAIT_V(6); PG8_BAR;
    for (;;) {
        const bool has_next = S.next(ui + 1, nxt);
        const char* nA = GA ? (const char*)g.A : (has_next ? (const char*)g.A + (size_t)nxt.pm * tstep : cA); const char* nB = has_next ? (const char*)g.Bt + (size_t)nxt.pn * tstep : cB;
        if constexpr (GA) { if (has_next) { PG8_GOFF(gn, nxt); } else { _Pragma("unroll") for (int _h = 0; _h < 2; ++_h) _Pragma("unroll") for (int _i = 0; _i < 2; ++_i) gn[_h][_i] = gc[_h][_i]; } }
        const bool do0 = cur.half != 2, do1 = cur.half != 1;
        for (int t = 0; t < nt; t += 2) {
            const bool last = (t == nt - 2);
            const char* a1 = cA + (size_t)(t + 1) * kstep;
            const char* a2 = last ? nA : cA + (size_t)(t + 2) * kstep; const char* b2 = last ? nB : cB + (size_t)(t + 2) * kstep;
            const char* a3 = a2 + kstep; const char* b3 = b2 + kstep;
            PG8_LDB(B0, 0, 0); PG8_LDB(B1, 0, 1); PG8_SCHED; PG8_LDA(At, 0, 0); PG8_STA(PG8_SA(1, 1), a1, 1, false);
            PG8_WAIT_V(8); PG8_WAIT_L(0); PG8_BAR; if (do0) { PG8_MMA(0, 0, At, B0); PG8_MMA(0, 1, At, B1); } PG8_BAR; PG8_SCHED;
            PG8_LDA(At, 0, 1); PG8_STAGE(PG8_SB(0, 0), b2, voffB); PG8_STAGE(PG8_SB(0, 1), b2 + hstep, voffB); PG8_STA(PG8_SA(0, 0), a2, 0, last);
            PG8_WAIT_V(8); PG8_WAIT_L(0); PG8_BAR; if (do1) { PG8_MMA(1, 0, At, B0); PG8_MMA(1, 1, At, B1); } PG8_BAR; PG8_SCHED;
            PG8_LDB(B0, 1, 0); PG8_LDB(B1, 1, 1); PG8_SCHED; PG8_LDA(At, 1, 0); PG8_STA(PG8_SA(0, 1), a2, 1, last);
            PG8_WAIT_V(8); PG8_WAIT_L(0); PG8_BAR; if (do0) { PG8_MMA(0, 0, At, B0); PG8_MMA(0, 1, At, B1); } PG8_BAR; PG8_SCHED;
            PG8_LDA(At, 1, 1); PG8_STAGE(PG8_SB(1, 0), b3, voffB); PG8_STAGE(PG8_SB(1, 1), b3 + hstep, voffB); PG8_STA(PG8_SA(1, 0), a3, 0, last);
            PG8_WAIT_V(8); PG8_WAIT_L(0); PG8_BAR; if (do1) { PG8_MMA(1, 0, At, B0); PG8_MMA(1, 1, At, B1); } PG8_BAR; PG8_SCHED;
        }
        if (wr == 0) PG8_BAR;
        const bool keep = E(acc, cur, wr, wc, fr, fq);
        if (!has_next) break;
        if (!keep) { PG8_ZERO(); }
        cur = nxt; cA = nA; cB = nB; ++ui;
        if constexpr (GA) { _Pragma("unroll") for (int _h = 0; _h < 2; ++_h) _Pragma("unroll") for (int _i = 0; _i < 2; ++_i) gc[_h][_i] = gn[_h][_i]; }
        if (wr == 1) PG8_BAR;
    }
    PG8_WAIT_V(0);
    PG8_BAR;
#undef PG8_SA
#undef PG8_SB
#undef PG8_GL
#undef PG8_STAGE
#undef PG8_STA
#undef PG8_GOFF
#undef PG8_LDA
#undef PG8_LDB
#undef PG8_MMA
#undef PG8_F8V
#undef PG8_WAIT_V
#undef PG8_WAIT_L
#undef PG8_BAR
#undef PG8_SCHED
#undef PG8_ZERO
}
}
#include <hip/hip_bf16.h>
#include <cmath>
namespace attn_body {
using bf16=__hip_bfloat16;
using bf16x8=__attribute__((ext_vector_type(8)))short;
using s16x4=__attribute__((ext_vector_type(4)))short;
using f32x16=__attribute__((ext_vector_type(16)))float;
using u32x4=__attribute__((ext_vector_type(4)))unsigned;
constexpr int D=64,QP=512,KP=512,VP=512,OP=1024,QSEQ=4096,KSEQ=4160;
constexpr int NW=8,QBLK=32,QB=QBLK*NW,KVBLK=64,NQB=QSEQ/QB;
constexpr int ATTN_UNIT_ROWS=QB;
__device__ __forceinline__ int crow(int r,int hi){return (r&3)+8*(r>>2)+4*hi;}
#define SBAR() __builtin_amdgcn_sched_barrier(0)
__device__ __forceinline__ void cmask(f32x16&p0,f32x16&p1,int jb,int qrel,int hi){
  const float NEG=-INFINITY; int kb=64*jb+4*hi;
  #pragma unroll
  for(int r=0;r<16;++r){int kv=kb+(r&3)+8*(r>>2); if(kv>qrel)p0[r]=NEG; if(kv+32>qrel)p1[r]=NEG;}
}

constexpr int NSLOT=3, SLOTB=8192;
constexpr int QSTG=4608;
constexpr int LDS_K=0, LDS_V=NSLOT*SLOTB, LDS_WS=LDS_V+NSLOT*2*SLOTB, LDS_OST=LDS_WS+NW*64*4, LDS_BYTES=LDS_OST+NW*QSTG;
constexpr float C2=0.125f*1.4426950408889634f;
__device__ __forceinline__ void glds16(const void*gsrc,unsigned lds_dst){unsigned keep;
  asm volatile("s_mov_b32 %0, m0\n\ts_mov_b32 m0, %2\n\ts_nop 0\n\tglobal_load_lds_dwordx4 %1, off\n\ts_mov_b32 m0, %0":"=&s"(keep):"v"(gsrc),"s"(lds_dst):"memory");}
__device__ __forceinline__ float max3f(float a,float b,float c){float r;asm("v_max3_f32 %0, %1, %2, %3":"=v"(r):"v"(a),"v"(b),"v"(c));return r;}
__device__ __forceinline__ float max2f(float a,float b){float r;asm("v_max_f32_e32 %0, %1, %2":"=v"(r):"v"(a),"v"(b));return r;}
__device__ __forceinline__ float fadd_s(float a,float b){float r;asm("v_add_f32_e32 %0, %1, %2":"=v"(r):"v"(a),"v"(b));return r;}
__device__ __forceinline__ float fsub_s(float a,float b){float r;asm("v_sub_f32_e32 %0, %1, %2":"=v"(r):"v"(a),"v"(b));return r;}
typedef float f32x2_t __attribute__((ext_vector_type(2))); typedef __bf16 bf16x2_t __attribute__((ext_vector_type(2)));
__device__ __forceinline__ unsigned cvtpk_s(float lo,float hi){f32x2_t v={lo,hi};bf16x2_t b=__builtin_convertvector(v,bf16x2_t);return __builtin_bit_cast(unsigned,b);}
#define WAIT_BAR(N) asm volatile("s_waitcnt vmcnt(" #N ") lgkmcnt(0)\n\ts_barrier":::"memory")

__device__ __forceinline__ void qkt(f32x16&p0,f32x16&p1,const char*Kslot,const bf16x8*qr,int r32,int hi){ const f32x16 negm=f32x16{};
  const char*kb=Kslot+hi*1024+r32*16;
  #pragma unroll
  for(int d0=0;d0<4;++d0){
    const bf16x8 b0=*reinterpret_cast<const bf16x8*>(kb+d0*2048);
    const bf16x8 b1=*reinterpret_cast<const bf16x8*>(kb+d0*2048+512);
    if(d0==0){p0=__builtin_amdgcn_mfma_f32_32x32x16_bf16(b0,qr[0],negm,0,0,0);p1=__builtin_amdgcn_mfma_f32_32x32x16_bf16(b1,qr[0],negm,0,0,0);}
    else{p0=__builtin_amdgcn_mfma_f32_32x32x16_bf16(b0,qr[d0],p0,0,0,0);p1=__builtin_amdgcn_mfma_f32_32x32x16_bf16(b1,qr[d0],p1,0,0,0);}}
}
typedef __attribute__((address_space(3))) const char* lds_cptr;
typedef short v4i16_t __attribute__((ext_vector_type(4)));
__device__ __forceinline__ void kload8(bf16x8*kf,lds_cptr kp){
  kf[0]=*(const __attribute__((address_space(3))) bf16x8*)(kp);      kf[1]=*(const __attribute__((address_space(3))) bf16x8*)(kp+512);
  kf[2]=*(const __attribute__((address_space(3))) bf16x8*)(kp+2048); kf[3]=*(const __attribute__((address_space(3))) bf16x8*)(kp+2560);
  kf[4]=*(const __attribute__((address_space(3))) bf16x8*)(kp+4096); kf[5]=*(const __attribute__((address_space(3))) bf16x8*)(kp+4608);
  kf[6]=*(const __attribute__((address_space(3))) bf16x8*)(kp+6144); kf[7]=*(const __attribute__((address_space(3))) bf16x8*)(kp+6656);
}
__device__ __forceinline__ void kload2(bf16x8*kf,lds_cptr kp,int j){ kf[2*j]=*(const __attribute__((address_space(3))) bf16x8*)(kp+j*2048); kf[2*j+1]=*(const __attribute__((address_space(3))) bf16x8*)(kp+j*2048+512); }
__device__ __forceinline__ s16x4 vtr(lds_cptr p){ return __builtin_bit_cast(s16x4,__builtin_amdgcn_ds_read_tr16_b64_v4i16((__attribute__((address_space(3))) v4i16_t*)p)); }
__device__ __forceinline__ float rowmax(const f32x16&p0,const f32x16&p1){
  float a=max3f(p0[0],p0[1],p1[0]),b=max3f(p0[2],p0[3],p1[1]);a=max3f(a,p1[2],p1[3]);
  #pragma unroll
  for(int r=4;r<16;r+=4){a=max3f(a,p0[r],p0[r+1]);b=max3f(b,p0[r+2],p0[r+3]);a=max3f(a,p1[r],p1[r+1]);b=max3f(b,p1[r+2],p1[r+3]);}
  const float m=max2f(a,b);
  auto rr=__builtin_amdgcn_permlane32_swap(__float_as_uint(m),__float_as_uint(m),false,false);
  return max2f(__uint_as_float(rr[0]),__uint_as_float(rr[1]));
}
__device__ __forceinline__ void pv(f32x16*o,int vb,bf16x8 pa0,bf16x8 pa1,bf16x8 pa2,bf16x8 pa3){
  #pragma unroll
  for(int d0=0;d0<4;++d0){s16x4 lo[4],hi[4];
    #pragma unroll
    for(int ks=0;ks<4;++ks){
      asm volatile("ds_read_b64_tr_b16 %0,%1 offset:%c2":"=&v"(lo[ks]):"v"(vb),"i"(d0*4096+ks*1024):"memory");
      asm volatile("ds_read_b64_tr_b16 %0,%1 offset:%c2":"=&v"(hi[ks]):"v"(vb),"i"(d0*4096+ks*1024+512):"memory");}
    asm volatile("s_waitcnt lgkmcnt(0)":::"memory");SBAR();
    #define PK(k) (bf16x8){lo[k][0],lo[k][1],lo[k][2],lo[k][3],hi[k][0],hi[k][1],hi[k][2],hi[k][3]}
    o[d0]=__builtin_amdgcn_mfma_f32_32x32x16_bf16(pa0,PK(0),o[d0],0,0,0);
    o[d0]=__builtin_amdgcn_mfma_f32_32x32x16_bf16(pa1,PK(1),o[d0],0,0,0);
    o[d0]=__builtin_amdgcn_mfma_f32_32x32x16_bf16(pa2,PK(2),o[d0],0,0,0);
    o[d0]=__builtin_amdgcn_mfma_f32_32x32x16_bf16(pa3,PK(3),o[d0],0,0,0);
    #undef PK
  }
}

#ifndef ATTN_STORE16
#define ATTN_STORE16(p,v) (*(u32x4*)(p)=(v))
#endif
template<int THRL,bool FAST> __device__ __forceinline__ void attn_unit(int b,int qcol,int kcol,int vcol,int ocol,int qb,const bf16*Q,const bf16*__restrict__ K,const bf16*__restrict__ V,bf16*O,char*shm,int comb,int o0col,float lam,const float*gsub,bf16*OA,int oacol){
  const int tid=threadIdx.x,lane=tid&63,r32=lane&31,hi=lane>>5; const int wid=__builtin_amdgcn_readfirstlane(tid>>6);
  const long qrow0=(long)b*QSEQ, krow0=(long)b*KSEQ; const int q0=qb*QB;
  const bf16*Qw=Q+(qrow0+q0+wid*QBLK)*QP+qcol;
  const bf16*Kh=K+krow0*KP+kcol,*Vh=V+krow0*VP+vcol;
  const unsigned lds0=(unsigned)(uintptr_t)shm;
  float*wsf=(float*)(shm+LDS_WS)+wid*64;
  const bf16*ksrc=Kh+(long)lane*KP+wid*8;
  const bf16*vsrc=Vh+(long)(16*(wid&3)+(lane>>2))*VP+(wid>>2)*32+(lane&3)*8;
  const unsigned kdst=lds0+LDS_K+wid*1024, vdst=lds0+LDS_V+wid*1024;
  #define DMA_K(t,slot) glds16(ksrc+(long)(t)*KVBLK*KP,(unsigned)__builtin_amdgcn_readfirstlane(kdst+(slot)))
  #define DMA_V(t,slot) do{ glds16(vsrc+(long)(t)*KVBLK*VP,(unsigned)__builtin_amdgcn_readfirstlane(vdst+2*(slot))); glds16(vsrc+64+(long)(t)*KVBLK*VP,(unsigned)__builtin_amdgcn_readfirstlane(vdst+2*(slot)+8192)); }while(0)
  const int vb0=(int)(lds0+LDS_V)+((lane>>4)&1)*32+(lane&3)*8+(4*hi+((lane&15)>>2))*64;
  const char*Kbase=shm+LDS_K; bf16x8 kf[8];
  const lds_cptr shm3=(lds_cptr)shm; const lds_cptr kp0=shm3+LDS_K+hi*1024+r32*16; const lds_cptr vp0=shm3+LDS_V+((lane>>4)&1)*32+(lane&3)*8+(4*hi+((lane&15)>>2))*64;
  const int NT=(q0+QB)/KVBLK+1;
  DMA_K(0,0);DMA_V(0,0);DMA_K(1,SLOTB);
  bf16x8 qr[4];
  #pragma unroll
  for(int d0=0;d0<4;++d0)qr[d0]=*reinterpret_cast<const bf16x8*>(&Qw[(long)r32*QP+d0*16+hi*8]);
  const __attribute__((address_space(3))) char* qsp=(const __attribute__((address_space(3))) char*)shm3+LDS_OST+wid*QSTG+r32*144+hi*16;
  #pragma unroll
  for(int d0=0;d0<4;++d0)*(__attribute__((address_space(3))) bf16x8*)(qsp+d0*32)=qr[d0];
  #define QV(d0) (*(const __attribute__((address_space(3))) bf16x8*)(qsp+(d0)*32))
  float mhat=0.f,l_reg=0.f;f32x16 o[4];o[0]=f32x16{};o[1]=f32x16{};o[2]=f32x16{};o[3]=f32x16{};const f32x16 zero16=f32x16{};
  const int qrel=wid*QBLK+r32;
  #define CMASK(P0,P1,t) do{int jb_=(t)-(NT-4); if(jb_>=0)cmask(P0,P1,jb_,qrel,hi);}while(0)
  bool resc=false;
  #define START(P0,P1) do{ resc=false; if constexpr(FAST){ mhat=0.f; _Pragma("unroll") for(int r=0;r<16;++r)P0[r]=__builtin_amdgcn_exp2f(P0[r]); } \
    else { const float rm=rowmax(P0,P1); mhat=rm; _Pragma("unroll") for(int r=0;r<16;++r)P0[r]=__builtin_amdgcn_exp2f(fsub_s(P0[r],mhat)); } }while(0)
  #define RESC() do{ if(resc){ asm volatile("s_waitcnt lgkmcnt(0)":::"memory"); \
      _Pragma("unroll") for(int d_=0;d_<4;++d_) _Pragma("unroll") for(int r=0;r<16;++r)o[d_][r]*=wsf[crow(r,hi)]; } }while(0)
  f32x16 pA0,pA1,pB0,pB1;
  int sl_prev=0,sl_cur=0,sl_next=SLOTB;
  #define ROT() do{sl_prev=sl_cur;sl_cur=sl_next;sl_next=(sl_next==(NSLOT-1)*SLOTB)?0:sl_next+SLOTB;}while(0)
  DMA_K(2,2*SLOTB);
  WAIT_BAR(3);
  qkt(pA0,pA1,Kbase,qr,r32,hi);asm volatile("s_nop 15\n\ts_nop 7":"+v"(pA0),"+v"(pA1));
  { _Pragma("unroll") for(int r=8;r<16;++r)pA0[r]=-INFINITY; _Pragma("unroll") for(int r=0;r<16;++r)pA1[r]=-INFINITY; }
  START(pA0,pA1);
  if constexpr(FAST){ _Pragma("unroll") for(int r=0;r<16;++r)pA1[r]=__builtin_amdgcn_exp2f(pA1[r]); } else { _Pragma("unroll") for(int r=0;r<16;++r)pA1[r]=__builtin_amdgcn_exp2f(fsub_s(pA1[r],mhat)); }
  WAIT_BAR(0);
  DMA_K(3,0);DMA_V(1,SLOTB);
  ROT();
  kload8(kf,kp0+sl_cur);
  WAIT_BAR(3);
  s16x4 vlo[8],vhi[8]; u32x4 pw0,pw1,pw2,pw3;
  #define PKW(P,B) cvtpk_s(P[B],P[B+1])
  #define PAF(k) __builtin_bit_cast(bf16x8,pw##k)
  #define VFR(i) (bf16x8){vlo[i][0],vlo[i][1],vlo[i][2],vlo[i][3],vhi[i][0],vhi[i][1],vhi[i][2],vhi[i][3]}
  #define PIN(x) asm volatile("":"+v"(x))
  #define MX3(a,b,c) __builtin_fmaxf(__builtin_fmaxf((a),(b)),(c))
  #define GAPA(MF,A0,A1,A2,A3,W0,W1,PW) do{ MF; sacc+=A0; sacc+=A1; sacc+=A2; sacc+=A3; PIN(sacc); W0; W1; PIN(PW); SBAR(); }while(0)
  #define EX(v) __builtin_amdgcn_exp2f(v)
  #define GAPB(MF,X,B) do{ MF; if constexpr(FAST){ X[B]=EX(X[B]); X[B+1]=EX(X[B+1]); } else { X[B]=EX(X[B]-mhat); X[B+1]=EX(X[B+1]-mhat); } PIN(X); SBAR(); }while(0)
  #define VOF(j) ((((j)&3)*4096)+(((j)>>2)*1024))
  #define VRD(sl,j) do{ vlo[sl]=vtr(vp_+VOF(j)); vhi[sl]=vtr(vp_+VOF(j)+512); }while(0)
  #define KRD(G,j) do{ if(G){ kload2(kf,kp0+sl_next,j); SBAR(); } }while(0)
  #define PVM(j) o[(j)&3]=__builtin_amdgcn_mfma_f32_32x32x16_bf16(PAFJ(j),VFR((j)&7),o[(j)&3],0,0,0)
  #define PAFJ(j) (((j)>>2)==0?PAF(0):((j)>>2)==1?PAF(1):((j)>>2)==2?PAF(2):PAF(3))
  #define STEP(C0,C1,P0,P1,t,GK,GV,GL) do{ SBAR(); \
    const lds_cptr vp_=vp0+2*sl_prev; \
    VRD(0,0); SBAR(); float sacc=(P0[0]+P0[1]); \
    GAPA(C0=__builtin_amdgcn_mfma_f32_32x32x16_bf16(kf[0],QV(0),zero16,0,0,0), P0[2],P0[3],P0[4],P0[5],     pw0[0]=PKW(P0,0), pw0[1]=PKW(P0,2), pw0); \
    VRD(1,1); SBAR(); GAPA(C1=__builtin_amdgcn_mfma_f32_32x32x16_bf16(kf[1],QV(0),zero16,0,0,0), P0[6],P0[7],P0[8],P0[9],     pw0[2]=PKW(P0,4), pw0[3]=PKW(P0,6), pw0); \
    VRD(2,2); SBAR(); GAPA(C0=__builtin_amdgcn_mfma_f32_32x32x16_bf16(kf[2],QV(1),C0,0,0,0),   P0[10],P0[11],P0[12],P0[13], pw1[0]=PKW(P0,8), pw1[1]=PKW(P0,10), pw1); \
    VRD(3,3); SBAR(); GAPA(C1=__builtin_amdgcn_mfma_f32_32x32x16_bf16(kf[3],QV(1),C1,0,0,0),   P0[14],P0[15],P1[0],P1[1],   pw1[2]=PKW(P0,12),pw1[3]=PKW(P0,14), pw1); \
    VRD(4,4); SBAR(); GAPA(C0=__builtin_amdgcn_mfma_f32_32x32x16_bf16(kf[4],QV(2),C0,0,0,0),   P1[2],P1[3],P1[4],P1[5],     pw2[0]=PKW(P1,0), pw2[1]=PKW(P1,2), pw2); \
    VRD(5,5); SBAR(); GAPA(C1=__builtin_amdgcn_mfma_f32_32x32x16_bf16(kf[5],QV(2),C1,0,0,0),   P1[6],P1[7],P1[8],P1[9],     pw2[2]=PKW(P1,4), pw2[3]=PKW(P1,6), pw2); \
    VRD(6,6); SBAR(); GAPA(C0=__builtin_amdgcn_mfma_f32_32x32x16_bf16(kf[6],QV(3),C0,0,0,0),   P1[10],P1[11],P1[12],P1[13], pw3[0]=PKW(P1,8), pw3[1]=PKW(P1,10), pw3); \
    VRD(7,7); SBAR(); GAPA(C1=__builtin_amdgcn_mfma_f32_32x32x16_bf16(kf[7],QV(3),C1,0,0,0),   P1[14],P1[15],0.f,0.f,       pw3[2]=PKW(P1,12),pw3[3]=PKW(P1,14), pw3); \
    l_reg+=sacc; \
    if(GK){DMA_K((t)+3,sl_cur);} if(GV){DMA_V((t)+1,sl_next);} \
    CMASK(C0,C1,t); \
    if constexpr(!FAST){ float a=MX3(C0[0],C0[1],C1[0]),b=MX3(C0[2],C0[3],C1[1]); a=MX3(a,C1[2],C1[3]); \
      _Pragma("unroll") for(int r=4;r<16;r+=4){a=MX3(a,C0[r],C0[r+1]);b=MX3(b,C0[r+2],C0[r+3]);a=MX3(a,C1[r],C1[r+1]);b=MX3(b,C1[r+2],C1[r+3]);} \
      float rm=__builtin_fmaxf(a,b); { auto rr=__builtin_amdgcn_permlane32_swap(__float_as_uint(rm),__float_as_uint(rm),false,false); rm=__builtin_fmaxf(__uint_as_float(rr[0]),__uint_as_float(rr[1])); } \
      rm-=mhat; resc=false; \
      if(__builtin_expect(__any(rm>(float)THRL),0)){ const float dl=__builtin_fmaxf(rm,0.f); mhat+=dl; \
        const float f=__builtin_amdgcn_exp2f(-dl); l_reg*=f; if(hi==0)wsf[r32]=f; resc=true; } } \
    SBAR(); \
    GAPB(PVM(0), C0,0); \
    GAPB(PVM(1), C0,2);  VRD(0,8);  SBAR(); \
    GAPB(PVM(2), C0,4);  VRD(1,9);  SBAR(); \
    GAPB(PVM(3), C0,6);  VRD(2,10); SBAR(); \
    GAPB(PVM(4), C0,8);  VRD(3,11); SBAR(); \
    GAPB(PVM(5), C0,10); VRD(4,12); SBAR(); \
    GAPB(PVM(6), C0,12); VRD(5,13); SBAR(); \
    GAPB(PVM(7), C0,14); VRD(6,14); SBAR(); \
    GAPB(PVM(8), C1,0);  VRD(7,15); SBAR(); \
    KRD(GL,0); GAPB(PVM(9),  C1,2); \
    KRD(GL,1); GAPB(PVM(10), C1,4); \
    KRD(GL,2); GAPB(PVM(11), C1,6); \
    KRD(GL,3); GAPB(PVM(12), C1,8); \
    GAPB(PVM(13), C1,10); \
    GAPB(PVM(14), C1,12); \
    GAPB(PVM(15), C1,14); \
    }while(0)
  int t=1;
  #undef CMASK
  #define CMASK(P0,P1,t) do{}while(0)
  for(;t+5<NT;t+=2){
    STEP(pB0,pB1,pA0,pA1,t,true,true,true);     WAIT_BAR(3); RESC(); ROT();
    STEP(pA0,pA1,pB0,pB1,t+1,true,true,true);   WAIT_BAR(3); RESC(); ROT();
  }
  #undef CMASK
  #define CMASK(P0,P1,t) do{int jb_=(t)-(NT-4); if(jb_>=0)cmask(P0,P1,jb_,qrel,hi);}while(0)
  #define ENDW(tt) do{ if((tt)+3<NT){WAIT_BAR(3);} else if((tt)+2<NT){WAIT_BAR(2);} else {WAIT_BAR(0);} }while(0)
  for(;t+1<NT;t+=2){
    STEP(pB0,pB1,pA0,pA1,t,(t+3<NT),(t+1<NT),(t+1<NT));       ENDW(t);   RESC(); ROT();
    STEP(pA0,pA1,pB0,pB1,t+1,(t+4<NT),(t+2<NT),(t+2<NT));     ENDW(t+1); RESC(); ROT();
  }
  { float sacc=pA0[0]+pA0[1]; _Pragma("unroll") for(int r=2;r<16;++r)sacc+=pA0[r]; _Pragma("unroll") for(int r=0;r<16;++r)sacc+=pA1[r]; l_reg+=sacc;
    pw0=(u32x4){PKW(pA0,0),PKW(pA0,2),PKW(pA0,4),PKW(pA0,6)};pw1=(u32x4){PKW(pA0,8),PKW(pA0,10),PKW(pA0,12),PKW(pA0,14)};pw2=(u32x4){PKW(pA1,0),PKW(pA1,2),PKW(pA1,4),PKW(pA1,6)};pw3=(u32x4){PKW(pA1,8),PKW(pA1,10),PKW(pA1,12),PKW(pA1,14)};
    SBAR(); pv(o,vb0+2*sl_prev,PAF(0),PAF(1),PAF(2),PAF(3)); }
  #undef PKW
  #undef PAF
  #undef VFR
  #undef PIN
  #undef MX3
  #undef GAPA
  #undef GAPB
  #undef EX
  #undef VRD
  #undef KRD
  #undef STEP
  #undef VOF
  #undef PVM
  #undef PAFJ
  #undef QV
  #undef ENDW
  {auto rr=__builtin_amdgcn_permlane32_swap(__float_as_uint(l_reg),__float_as_uint(l_reg),false,false);l_reg=__uint_as_float(rr[0])+__uint_as_float(rr[1]);}
  if(hi==0)wsf[32+r32]=l_reg;asm volatile("s_waitcnt lgkmcnt(0)":::"memory");
  float rli[16];
  #pragma unroll
  for(int r=0;r<16;++r)rli[r]=__builtin_amdgcn_rcpf(wsf[32+crow(r,hi)]);
  bf16*Ow=O+(qrow0+q0+wid*QBLK)*OP+ocol;
  { int oz_; asm volatile("v_mov_b32 %0, 0":"=v"(oz_)); const int ln=lane+oz_;
    bf16*stg=(bf16*)(shm+LDS_OST+wid*QSTG);
    if(!comb){
      #pragma unroll
      for(int hh=0;hh<2;++hh){
        #pragma unroll
        for(int r=0;r<16;++r){const int orow=crow(r,hi);
          #pragma unroll
          for(int d0=0;d0<2;++d0)stg[orow*64+d0*32+r32]=__float2bfloat16(o[2*hh+d0][r]*rli[r]);}
        asm volatile("s_waitcnt lgkmcnt(0)":::"memory");
        #pragma unroll
        for(int i=0;i<4;++i){const int row=i*8+(ln>>3),ch=ln&7; const u32x4 v=*(const u32x4*)(stg+row*64+ch*8); ATTN_STORE16(Ow+(long)row*OP+hh*64+ch*8,v);}
        asm volatile("s_waitcnt lgkmcnt(0)":::"memory"); }
    } else {
      const bf16*O0w=O+(qrow0+q0+wid*QBLK)*OP+o0col; bf16*OAw=OA+(qrow0+q0+wid*QBLK)*512+oacol;
      float ssr[4]={0.f,0.f,0.f,0.f};
      #pragma unroll
      for(int pass=0;pass<2;++pass){
        if(pass==1){
          #pragma unroll
          for(int i=0;i<4;++i){ float ss=ssr[i]; ss+=__shfl_xor(ss,1); ss+=__shfl_xor(ss,2); ss+=__shfl_xor(ss,4); ssr[i]=0.8f/sqrtf(ss*(1.0f/128.0f)+1e-6f); } }
        #pragma unroll
        for(int hh=0;hh<2;++hh){
          u32x4 v0[4];
          #pragma unroll
          for(int i=0;i<4;++i){const int row=i*8+(ln>>3),ch=ln&7; v0[i]=*(const u32x4*)(O0w+(long)row*OP+hh*64+ch*8);}
          #pragma unroll
          for(int r=0;r<16;++r){const int orow=crow(r,hi);
            #pragma unroll
            for(int d0=0;d0<2;++d0)stg[orow*64+d0*32+r32]=__float2bfloat16(o[2*hh+d0][r]*rli[r]);}
          asm volatile("s_waitcnt lgkmcnt(0)":::"memory");
          const int ch=ln&7; const float4 g0=*(const float4*)(gsub+hh*64+ch*8), g1=*(const float4*)(gsub+hh*64+ch*8+4); const float gg[8]={g0.x,g0.y,g0.z,g0.w,g1.x,g1.y,g1.z,g1.w};
          #pragma unroll
          for(int i=0;i<4;++i){const int row=i*8+(ln>>3); const u32x4 v1=*(const u32x4*)(stg+row*64+ch*8); const u32x4 a=v0[i];
            const unsigned aw[4]={a.x,a.y,a.z,a.w},bw[4]={v1.x,v1.y,v1.z,v1.w}; float dd[8];
            #pragma unroll
            for(int j=0;j<4;++j){ dd[2*j]=__uint_as_float(aw[j]<<16)-lam*__uint_as_float(bw[j]<<16); dd[2*j+1]=__uint_as_float(aw[j]&0xffff0000u)-lam*__uint_as_float(bw[j]&0xffff0000u); }
            if(pass==0){
              #pragma unroll
              for(int j=0;j<8;++j)ssr[i]+=dd[j]*dd[j]; }
            else { const float rn=ssr[i]; u32x4 w;
              w.x=cvtpk_s(dd[0]*rn*gg[0],dd[1]*rn*gg[1]); w.y=cvtpk_s(dd[2]*rn*gg[2],dd[3]*rn*gg[3]); w.z=cvtpk_s(dd[4]*rn*gg[4],dd[5]*rn*gg[5]); w.w=cvtpk_s(dd[6]*rn*gg[6],dd[7]*rn*gg[7]);
              *(u32x4*)(OAw+(long)row*512+hh*64+ch*8)=w; } }
          asm volatile("s_waitcnt lgkmcnt(0)":::"memory"); } }
    } }
  asm volatile("s_waitcnt lgkmcnt(0)\n\ts_barrier":::"memory");
  #undef DMA_K
  #undef DMA_V
  #undef CMASK
  #undef START
  #undef RESC
  #undef ROT
}
constexpr int ATTN_LDS_BYTES=LDS_BYTES;
struct AttnTensors { const bf16* Q; const bf16* K; const bf16* V; bf16* O; };
#undef SBAR
#undef WAIT_BAR
}
#define GAS __attribute__((address_space(1)))
#define LAS __attribute__((address_space(3)))
typedef unsigned short bf16;
typedef unsigned v4u __attribute__((ext_vector_type(4)));
typedef float f32x4 __attribute__((ext_vector_type(4)));
typedef short bf16x8 __attribute__((ext_vector_type(8)));
typedef GAS unsigned gu32;
typedef GAS unsigned long long gu64;
#define RLX_AGENT __ATOMIC_RELAXED, __HIP_MEMORY_SCOPE_AGENT
#define LDS_WAIT() asm volatile("s_waitcnt lgkmcnt(0)" ::: "memory")
#define VM_WAIT() asm volatile("s_waitcnt vmcnt(0)" ::: "memory")
__device__ __forceinline__ unsigned long long rt() { return __builtin_amdgcn_s_memrealtime(); }
__device__ __forceinline__ unsigned f2bf(float f) { unsigned u = __builtin_bit_cast(unsigned, f); return (u + 0x7fffu + ((u >> 16) & 1u)) >> 16; }
__device__ __forceinline__ unsigned pk2(float lo, float hi) { return f2bf(lo) | (f2bf(hi) << 16); }

#define XB_TMO      128
#define XB_XCNT(j)  (256  + 64 * (j))
#define XB_XSUB(j)  (1280 + 64 * (j))
#define XB_XGEN(j)  (2304 + 64 * (j))
#define XB_TOP      3328
#define XB_TOPGEN   3392
#define XCD_BAR_WORDS 3456
#define XB_SPIN_CAP (1u << 18)

__device__ __forceinline__ unsigned xb_ld(unsigned* p)              { return __hip_atomic_load(p, __ATOMIC_RELAXED, __HIP_MEMORY_SCOPE_AGENT); }
__device__ __forceinline__ unsigned xb_add(unsigned* p, unsigned v) { return __hip_atomic_fetch_add(p, v, __ATOMIC_RELAXED, __HIP_MEMORY_SCOPE_AGENT); }
__device__ __forceinline__ unsigned xb_xcc_id() { return (unsigned)__builtin_amdgcn_s_getreg((3 << 11) | 20) & 0xFu; }
#define XB_SPIN(cond, bar) do { unsigned _sp = 0; while (cond) { __builtin_amdgcn_s_sleep(1); \
    if ((++_sp & 255u) == 0u) { if (xb_ld(&(bar)[XB_TMO])) break; if (_sp > XB_SPIN_CAP) { atomicAdd(&(bar)[XB_TMO], 1u); break; } } } } while (0)

struct XcdBarrier {
    unsigned* bar; unsigned x;
    volatile LAS unsigned* st;
};

__device__ __forceinline__ XcdBarrier xcd_barrier_post(unsigned* bar, volatile LAS unsigned* st) {
    XcdBarrier b; b.bar = bar; b.x = xb_xcc_id(); b.st = st;
    if (threadIdx.x == 0) (void)xb_add(&bar[XB_XCNT(b.x)], 1u);
    return b;
}
__device__ __forceinline__ void xcd_barrier_complete(unsigned* bar, unsigned x, unsigned& nloc, unsigned& nx) {
    const unsigned G = gridDim.x * gridDim.y * gridDim.z;
    unsigned sum, cnt, mine, sp = 0u;
    for (;;) {
        sum = 0u; cnt = 0u; mine = 0u;
#pragma unroll
        for (unsigned j = 0; j < 16; ++j) { const unsigned c = xb_ld(&bar[XB_XCNT(j)]); sum += c; cnt += (c > 0u) ? 1u : 0u; mine = (j == x) ? c : mine; }
        if (sum == G) break;
        __builtin_amdgcn_s_sleep(1);
        if ((++sp & 255u) == 0u) { if (xb_ld(&bar[XB_TMO])) break; if (sp > XB_SPIN_CAP) { atomicAdd(&bar[XB_TMO], 1u); break; } }
    }
    nloc = mine > 0u ? mine : 1u; nx = cnt > 0u ? cnt : 1u;
}

__device__ __forceinline__ void xcd_barrier(const XcdBarrier& b) {
    asm volatile("s_waitcnt vmcnt(0)" ::: "memory");
    __syncthreads();
    if (threadIdx.x == 0) {
        unsigned* bar = b.bar;
        __builtin_amdgcn_s_waitcnt(0);
        unsigned nloc = b.st[0], nx = b.st[1];
        if (nloc == 0u) { xcd_barrier_complete(bar, b.x, nloc, nx); b.st[0] = nloc; b.st[1] = nx; }
        const unsigned old = xb_add(&bar[XB_XSUB(b.x)], 1u);
        const unsigned gen = old / nloc;
        if (old + 1u == (gen + 1u) * nloc) {
            __builtin_amdgcn_fence(__ATOMIC_RELEASE, "agent");
            asm volatile("s_waitcnt vmcnt(0)" ::: "memory");
            const unsigned og = xb_add(&bar[XB_TOP], 1u);
            const unsigned tg = og / nx;
            if (og + 1u == (tg + 1u) * nx) xb_add(&bar[XB_TOPGEN], 1u);
            else XB_SPIN(xb_ld(&bar[XB_TOPGEN]) == tg, bar);
            __builtin_amdgcn_fence(__ATOMIC_ACQUIRE, "agent");
            xb_add(&bar[XB_XGEN(b.x)], 1u);
            asm volatile("s_waitcnt vmcnt(0)" ::: "memory");
        } else {
            XB_SPIN(xb_ld(&bar[XB_XGEN(b.x)]) == gen, bar);
            __builtin_amdgcn_fence(__ATOMIC_ACQUIRE, "agent");
            asm volatile("s_waitcnt vmcnt(0)" ::: "memory");
        }
    }
    __syncthreads();
}
constexpr int NWAVES = 8;
constexpr int DM = 1024, NBATCH = 8, SEQ = 4096, NMETA = 16;
constexpr int MROWS = NBATCH * SEQ;
constexpr int LPB = SEQ + 64;
constexpr int PROWS = NBATCH * LPB + 64;
constexpr int MZ = MROWS + 256;
constexpr int NZ = 5376, DIN = 5136;
constexpr int C_DAQ = 0, C_DAK = 512, C_DAV = 1024, C_GQ = 1536, C_GK = 1792, C_GV = 2048, C_GR = 2560, C_GG = 3072, C_GL = 3088;
constexpr float EPS = 1e-6f;
constexpr int NEXP = 32, DEXP = 512, LCAP = 32768;
constexpr int NPOS = SEQ + NMETA;

constexpr size_t MiB = 1u << 20;
constexpr size_t WS_CTL = 0, CTL_ZERO_BYTES = 1 * MiB, WS_TRASH = 768 * 1024;
constexpr size_t WS_ROPE = 1 * MiB;
constexpr size_t WS_WRH = 3 * MiB, WS_WRL = 3 * MiB + 128 * 1024;
constexpr size_t WS_IG2 = 3 * MiB + 512 * 1024;
constexpr size_t WS_LTOK = 4 * MiB, WS_LRS = 12 * MiB, WS_LW = 20 * MiB;
constexpr size_t WS_WIN = 28 * MiB, WS_WBR = 39 * MiB, WS_WOUT = 41 * MiB, WS_WGU = 43 * MiB, WS_WD = 107 * MiB;
constexpr size_t WS_R1 = 139 * MiB;
constexpr size_t WS_Q = 204 * MiB, WS_K = 236 * MiB, WS_V = 269 * MiB;
constexpr size_t WS_OA = 204 * MiB, WS_H2U = 204 * MiB;
constexpr size_t WS_GQ = 302 * MiB, WS_GK = 319 * MiB, WS_GV = 336 * MiB, WS_GR = 369 * MiB, WS_LOGA = 402 * MiB;
constexpr size_t WS_HID = 302 * MiB;
constexpr size_t WS_H2U8 = 269 * MiB;
constexpr float W8SCALE = 32.0f, H8SCALE = 4.0f;
constexpr size_t WS_DS = 435 * MiB, WS_END = 500 * MiB;
static_assert(WS_R1 + (size_t)MZ * DM * 2 <= WS_Q && WS_K + (size_t)PROWS * 512 * 2 <= WS_V && WS_V + (size_t)PROWS * 512 * 2 <= WS_GQ, "ws map 1");
static_assert(WS_GQ + (size_t)PROWS * 256 * 2 <= WS_GK && WS_GK + (size_t)PROWS * 256 * 2 <= WS_GV && WS_GV + (size_t)PROWS * 512 * 2 <= WS_GR && WS_GR + (size_t)PROWS * 512 * 2 <= WS_LOGA && WS_LOGA + (size_t)PROWS * 256 * 4 <= WS_DS, "ws map 2");
static_assert(WS_HID + (size_t)81920 * 512 * 2 <= WS_DS && WS_DS + (size_t)32 * 64 * 8192 * 4 <= WS_END && WS_WIN + (size_t)NZ * DM * 2 <= WS_WBR && WS_WD + (size_t)32 * 1024 * 512 * 2 <= WS_R1, "ws map 3");
constexpr int CW_TMO = 0, CW_BAR = 4096, CW_CNT = 16384;

constexpr int RING_OFF = 0, RING_BYTES = 131072;
constexpr int LDSCTL_OFF = RING_BYTES, MISC_OFF = LDSCTL_OFF + 320, TB_OFF = LDSCTL_OFF + 1024, CN_OFF = LDSCTL_OFF + 1536;
constexpr int LDS_BYTES = 147456;
struct Frame {
    LAS unsigned char* lds;
    volatile LAS unsigned* MISC;
    gu32* ctl;
    int tid, lane, wave, vcu, G;
    const float* in[25]; float* out; unsigned char* ws;
};
enum { I_X = 0, I_META, I_GMIX, I_WIN, I_GQN, I_GKN, I_LQ1, I_LK1, I_LQ2, I_LK2, I_GSUB, I_WGUP, I_BGATE, I_GGLA, I_WBR, I_BMERGE, I_WOUT, I_GFFN, I_WRG, I_BRG, I_WRE, I_BRE, I_WEG, I_WEU, I_WED };
#define WSP(T, off) ((T*)(F.ws + (off)))

__device__ __forceinline__ float wave_sum(float v) {
#pragma unroll
    for (int o = 1; o < 64; o <<= 1) v += __shfl_xor(v, o);
    return v;
}
__device__ __forceinline__ float bf2f(bf16 v) { return __uint_as_float((unsigned)v << 16); }
__device__ __forceinline__ float sigmoidf_(float x) { return 1.0f / (1.0f + __expf(-x)); }

__device__ __forceinline__ void transpose_tile(const float* src, int Ns, bf16* dst, int Kd, LAS float* scr, int lane) {
    float tv[32];
#pragma unroll
    for (int i = 0; i < 32; ++i) tv[i] = src[(unsigned)((2 * i + (lane >> 5)) * Ns + (lane & 31))];
#pragma unroll
    for (int i = 0; i < 32; ++i) scr[(2 * i + (lane >> 5)) * 33 + (lane & 31)] = tv[i];
    LDS_WAIT(); asm volatile("" ::: "memory");
    const int c = lane & 7;
#pragma unroll
    for (int j = 0; j < 4; ++j) { const int n = (lane >> 3) + 8 * j; const LAS float* s = scr + (8 * c) * 33 + n;
        v4u o; o.x = pk2(s[0 * 33], s[1 * 33]); o.y = pk2(s[2 * 33], s[3 * 33]); o.z = pk2(s[4 * 33], s[5 * 33]); o.w = pk2(s[6 * 33], s[7 * 33]);
        *(GAS v4u*)(dst + (size_t)n * Kd + 8 * c) = o; }
    LDS_WAIT(); asm volatile("" ::: "memory");
}
__device__ __forceinline__ void product_tile(const float* win, const float* wgu, int k0, int n0, bf16* dst, LAS float* scr, int lane) {
    float wg[16];
#pragma unroll
    for (int r = 0; r < 16; ++r) wg[r] = wgu[r * 256 + n0 + (lane & 31)];
    LAS float* gb = scr + 64 * 33;
#pragma unroll
    for (int j = 0; j < 4; ++j) { const int idx = lane + 64 * j, kk = idx >> 2, q = idx & 3; *(LAS f32x4*)(gb + kk * 16 + 4 * q) = *(const GAS f32x4*)(win + (size_t)(k0 + kk) * DIN + C_GG + 4 * q); }
    LDS_WAIT(); asm volatile("" ::: "memory");
#pragma unroll 4
    for (int i = 0; i < 32; ++i) { const int kk = 2 * i + (lane >> 5); const LAS f32x4* g4 = (const LAS f32x4*)(gb + kk * 16); float s = 0.f;
#pragma unroll
        for (int q = 0; q < 4; ++q) { const f32x4 g = g4[q]; s += g.x * wg[4 * q] + g.y * wg[4 * q + 1] + g.z * wg[4 * q + 2] + g.w * wg[4 * q + 3]; }
        scr[kk * 33 + (lane & 31)] = s; }
    LDS_WAIT(); asm volatile("" ::: "memory");
    const int c = lane & 7;
#pragma unroll
    for (int j = 0; j < 4; ++j) { const int n = (lane >> 3) + 8 * j; const LAS float* s = scr + (8 * c) * 33 + n;
        v4u o; o.x = pk2(s[0 * 33], s[1 * 33]); o.y = pk2(s[2 * 33], s[3 * 33]); o.z = pk2(s[4 * 33], s[5 * 33]); o.w = pk2(s[6 * 33], s[7 * 33]);
        *(GAS v4u*)(dst + (size_t)n * DM + 8 * c) = o; }
    LDS_WAIT(); asm volatile("" ::: "memory");
}
__device__ __forceinline__ int win_src_col(int T, int p0) {
    if (T < 4) { const int bj = p0 >> 7, wc = (p0 >> 5) & 3; return (T < 2 ? C_DAQ + 256 * T : C_DAK + 256 * (T - 2)) + 64 * wc + 32 * bj; }
    if (T < 6) return C_DAV + 256 * (T - 4) + p0;
    if (T == 6) return C_GQ + p0;
    if (T == 7) return C_GK + p0;
    if (T < 10) return C_GV + 256 * (T - 8) + p0;
    if (T < 12) return C_GR + 256 * (T - 10) + p0;
    const int t = T - 13; return p0 < 128 ? C_GL + 128 * t + p0 : C_GL + 1024 + 128 * t + (p0 - 128);
}
template <int NR> __device__ __forceinline__ void rms_rows_to_bf16(Frame& F, const float* const (&xrow)[NR], const float* gain, bf16* const (&orow)[NR]) {
    const GAS f32x4* gr = (const GAS f32x4*)gain + F.lane;
    f32x4 v[NR][4];
#pragma unroll
    for (int r = 0; r < NR; ++r) { const GAS f32x4* xr = (const GAS f32x4*)xrow[r] + F.lane;
#pragma unroll
        for (int j = 0; j < 4; ++j) v[r][j] = xr[64 * j]; }
#pragma unroll
    for (int r = 0; r < NR; ++r) { float s = 0.f;
#pragma unroll
        for (int j = 0; j < 4; ++j) s += (v[r][j].x * v[r][j].x + v[r][j].y * v[r][j].y) + (v[r][j].z * v[r][j].z + v[r][j].w * v[r][j].w);
        const float rstd = 1.f / sqrtf(wave_sum(s) * (1.f / DM) + EPS);
        GAS unsigned long long* o8 = (GAS unsigned long long*)orow[r] + F.lane;
#pragma unroll
        for (int j = 0; j < 4; ++j) { const f32x4 g = gr[64 * j]; o8[64 * j] = (unsigned long long)pk2(v[r][j].x * rstd * g.x, v[r][j].y * rstd * g.y) | ((unsigned long long)pk2(v[r][j].z * rstd * g.z, v[r][j].w * rstd * g.w) << 32); } }
}
constexpr int N_EXPERT_ITEMS = NEXP * 256 + NEXP * 128;
__device__ __forceinline__ void expert_conv_desc(Frame& F, int it, const float*& src, unsigned char*& dst, unsigned& Ns, unsigned& Kd) {
    if (it < NEXP * 256) { const int e = it >> 8, q = it & 255, kb = q >> 4, nbp = q & 15, P0 = nbp * 64, pn = P0 >> 8, p = P0 & 255;
        src = (p < 128 ? F.in[I_WEG] : F.in[I_WEU]) + (size_t)e * 1024 * 512 + (size_t)(kb * 64) * 512 + 128 * pn + (p & 127); Ns = 512;
        dst = WSP(unsigned char, WS_WGU) + (size_t)(e * 1024 + P0) * 1024 + kb * 64; Kd = 1024; }
    else { const int r = it - NEXP * 256, e = r >> 7, q = r & 127, kb = q >> 4, nb = q & 15;
        src = F.in[I_WED] + (size_t)e * 512 * 1024 + (size_t)(kb * 64) * 1024 + nb * 64; Ns = 1024; dst = WSP(unsigned char, WS_WD) + (size_t)(e * 1024 + nb * 64) * 512 + kb * 64; Kd = 512; }
}
__device__ __forceinline__ float clamp8(float x) { return fminf(fmaxf(x, -448.0f), 448.0f); }
__device__ __forceinline__ unsigned pk4_fp8(float a, float b, float c, float d) { unsigned w = 0; w = __builtin_amdgcn_cvt_pk_fp8_f32(clamp8(a), clamp8(b), w, false); w = __builtin_amdgcn_cvt_pk_fp8_f32(clamp8(c), clamp8(d), w, true); return w; }
__device__ __forceinline__ void expert_conv_store(unsigned char* dst, unsigned Kd, const float (&v)[64], int lane, LAS unsigned char* stg) {
#pragma unroll
    for (int kg = 0; kg < 4; ++kg) { v4u o;
        o.x = pk4_fp8(v[16 * kg] * W8SCALE, v[16 * kg + 1] * W8SCALE, v[16 * kg + 2] * W8SCALE, v[16 * kg + 3] * W8SCALE); o.y = pk4_fp8(v[16 * kg + 4] * W8SCALE, v[16 * kg + 5] * W8SCALE, v[16 * kg + 6] * W8SCALE, v[16 * kg + 7] * W8SCALE);
        o.z = pk4_fp8(v[16 * kg + 8] * W8SCALE, v[16 * kg + 9] * W8SCALE, v[16 * kg + 10] * W8SCALE, v[16 * kg + 11] * W8SCALE); o.w = pk4_fp8(v[16 * kg + 12] * W8SCALE, v[16 * kg + 13] * W8SCALE, v[16 * kg + 14] * W8SCALE, v[16 * kg + 15] * W8SCALE);
        *(LAS v4u*)(stg + lane * 80 + kg * 16) = o; }
    LDS_WAIT(); asm volatile("" ::: "memory");
#pragma unroll
    for (int i = 0; i < 4; ++i) { const int r = (lane >> 2) + 16 * i, c = lane & 3; const v4u o = *(const LAS v4u*)(stg + r * 80 + c * 16); *(GAS v4u*)(dst + (size_t)r * Kd + 16 * c) = o; }
    LDS_WAIT(); asm volatile("" ::: "memory");
}
__device__ __forceinline__ void expert_conv_range(Frame& F, int first, int me, int nw) {
    const int stride = nw; LAS unsigned char* stg = F.lds + RING_OFF + F.wave * 9216;
    for (int it = first + me; it < N_EXPERT_ITEMS; it += 2 * stride) {
        const float *s0, *s1; unsigned char *d0, *d1; unsigned n0, k0, n1, k1; const bool two = it + stride < N_EXPERT_ITEMS;
        expert_conv_desc(F, it, s0, d0, n0, k0); expert_conv_desc(F, two ? it + stride : it, s1, d1, n1, k1);
        float va[64], vb[64];
#pragma unroll
        for (int k = 0; k < 64; ++k) va[k] = s0[(unsigned)k * n0 + (unsigned)F.lane];
        if (two) {
#pragma unroll
            for (int k = 0; k < 64; ++k) vb[k] = s1[(unsigned)k * n1 + (unsigned)F.lane]; }
        expert_conv_store(d0, k0, va, F.lane, stg);
        if (two) expert_conv_store(d1, k1, vb, F.lane, stg);
    }
    asm volatile("s_waitcnt lgkmcnt(0)" ::: "memory"); __syncthreads();
}
__device__ __forceinline__ void expert_conv_slot(Frame& F, int slot, int nslot, int first) { expert_conv_range(F, first, (slot * F.G + F.vcu) * NWAVES + F.wave, nslot * F.G * NWAVES); }
__device__ __forceinline__ void late_tables(Frame& F, int gt, int NGT) {
    { bf16* wh = WSP(bf16, WS_WRH); bf16* wl = WSP(bf16, WS_WRL);
      for (int i = gt; i < 48 * 1024; i += NGT) { const int n = i >> 10, k = i & 1023; const float v = n < 4 ? F.in[I_WRG][k * 4 + n] : (n < 36 ? F.in[I_WRE][k * 32 + (n - 4)] : 0.f);
          const unsigned h = f2bf(v); const float hf = __uint_as_float(h << 16); wh[i] = (bf16)h; wl[i] = (bf16)f2bf(v - hf); } }
    { float* ig = WSP(float, WS_IG2); for (int i = gt; i < DM; i += NGT) { const float g = F.in[I_GFFN][i]; ig[i] = 1.0f / (g * g); } }
    { unsigned* kz = (unsigned*)(WSP(bf16, WS_K) + (size_t)NBATCH * LPB * 512); unsigned* vz = (unsigned*)(WSP(bf16, WS_V) + (size_t)NBATCH * LPB * 512);
      for (int i = gt; i < 64 * 512 / 2; i += NGT) { kz[i] = 0u; vz[i] = 0u; } }
}
#define P1_EXTRA(G) (((MZ / 256) * (NZ / 256)) % (G))
constexpr int P1_TILES_PER_WAVE = 6;
__device__ __forceinline__ int p1_conv_items(int G) { const int ex = P1_EXTRA(G), n = ex ? (G - ex) * NWAVES * P1_TILES_PER_WAVE : 0; return n < N_EXPERT_ITEMS ? n : N_EXPERT_ITEMS; }
__device__ __forceinline__ void expert_conv_first(Frame& F, int me, int nw, int cnt) {
    LAS unsigned char* stg = F.lds + RING_OFF + F.wave * 9216;
    for (int it = me; it < cnt; it += 2 * nw) {
        const float *s0, *s1; unsigned char *d0, *d1; unsigned n0, k0, n1, k1; const bool two = it + nw < cnt;
        expert_conv_desc(F, it, s0, d0, n0, k0); expert_conv_desc(F, two ? it + nw : it, s1, d1, n1, k1);
        float va[64], vb[64];
#pragma unroll
        for (int k = 0; k < 64; ++k) va[k] = s0[(unsigned)k * n0 + (unsigned)F.lane];
        if (two) {
#pragma unroll
            for (int k = 0; k < 64; ++k) vb[k] = s1[(unsigned)k * n1 + (unsigned)F.lane]; }
        expert_conv_store(d0, k0, va, F.lane, stg);
        if (two) expert_conv_store(d1, k1, vb, F.lane, stg);
    }
}
__device__ __forceinline__ void p0_prologue(Frame& F) {
    LAS float* scr = (LAS float*)(F.lds + RING_OFF + F.wave * 16384);
    const int gw = F.vcu * NWAVES + F.wave, NGW = F.G * NWAVES;
    constexpr int I_A = (NZ / 32) * 16, I_B = 2 * 32 * 8, I_C = 32 * 16, NITEMS = I_A + I_B + I_C;
    bf16* WIN = WSP(bf16, WS_WIN);
    for (int it = gw; it < NITEMS; it += NGW) {
        int r = it; const float* src; bf16* dst; int Ns, Kd;
        if (r < I_A) { const int kb = r / (NZ / 32), nb = r % (NZ / 32), T = nb >> 3, p0 = (nb & 7) * 32; dst = WIN + (size_t)(nb * 32) * DM + kb * 64;
            if (T == 12) { product_tile(F.in[I_WIN], F.in[I_WGUP], kb * 64, p0, dst, scr, F.lane); continue; }
            src = F.in[I_WIN] + (size_t)(kb * 64) * DIN + win_src_col(T, p0); Ns = DIN; Kd = DM; }
        else if ((r -= I_A) < I_B) { const int br = r >> 8, q = r & 255, kb = q >> 5, nb = q & 31;
            src = F.in[I_WBR] + (size_t)br * 512 * 1024 + (size_t)(kb * 64) * 1024 + nb * 32; Ns = 1024; dst = WSP(bf16, WS_WBR) + (size_t)(br * 1024 + nb * 32) * 512 + kb * 64; Kd = 512; }
        else { r -= I_B; const int kb = r >> 5, nb = r & 31;
            src = F.in[I_WOUT] + (size_t)(kb * 64) * 1024 + nb * 32; Ns = 1024; dst = WSP(bf16, WS_WOUT) + (size_t)(nb * 32) * 1024 + kb * 64; Kd = 1024; }
        transpose_tile(src, Ns, dst, Kd, scr, F.lane);
    }
#ifdef PROBE_K
    if (PROBE_K == 100 && blockIdx.x == 0 && F.tid == 0) ((volatile LAS unsigned long long*)(F.lds + LDSCTL_OFF + 2048))[1] = __builtin_amdgcn_s_memrealtime();
#endif
    bf16* XN = WSP(bf16, WS_R1);
    for (int m = gw; m < MROWS; m += 4 * NGW) {
        if (m + 3 * NGW < MROWS) { const float* const xr[4] = {F.in[I_X] + (size_t)m * DM, F.in[I_X] + (size_t)(m + NGW) * DM, F.in[I_X] + (size_t)(m + 2 * NGW) * DM, F.in[I_X] + (size_t)(m + 3 * NGW) * DM};
            bf16* const orr[4] = {XN + (size_t)m * DM, XN + (size_t)(m + NGW) * DM, XN + (size_t)(m + 2 * NGW) * DM, XN + (size_t)(m + 3 * NGW) * DM}; rms_rows_to_bf16<4>(F, xr, F.in[I_GMIX], orr); }
        else for (int k = 0; k < 4; ++k) { const int mm = m + k * NGW; if (mm < MROWS) { const float* const xr[1] = {F.in[I_X] + (size_t)mm * DM}; bf16* const orr[1] = {XN + (size_t)mm * DM}; rms_rows_to_bf16<1>(F, xr, F.in[I_GMIX], orr); } }
    }
    for (int m = MROWS + gw; m < MZ; m += NGW) {
        if (m < MROWS + NMETA) { const float* const xr[1] = {F.in[I_META] + (size_t)(m - MROWS) * DM}; bf16* const orr[1] = {XN + (size_t)m * DM}; rms_rows_to_bf16<1>(F, xr, F.in[I_GMIX], orr); }
        else { GAS v4u* o = (GAS v4u*)(XN + (size_t)m * DM) + F.lane; o[0] = (v4u){0u, 0u, 0u, 0u}; o[64] = (v4u){0u, 0u, 0u, 0u}; }
    }
#ifdef PROBE_K
    if (PROBE_K == 101 && blockIdx.x == 0 && F.tid == 0) ((volatile LAS unsigned long long*)(F.lds + LDSCTL_OFF + 2048))[1] = __builtin_amdgcn_s_memrealtime();
#endif
    const int gt = gw * 64 + F.lane, NGT = NGW * 64;
    { float* rc = WSP(float, WS_ROPE); float* rs = rc + NPOS * 32;
      for (int i = gt; i < NPOS * 32; i += NGT) { const int pos = i >> 5, j = i & 31; const float inv = exp2f(-(float)j * 0.41524101186092029f); const float ang = (float)pos * inv;
          const double rev = (double)ang * 0.15915494309189535; const float x = (float)(rev - rint(rev));
          rc[i] = __builtin_amdgcn_cosf(x); rs[i] = __builtin_amdgcn_sinf(x); } }
}
namespace epi {
using pg8::f32x4; using pg8::u32x4; using pg8::Unit; using pg8::pack8; using pg8::HALF;
__device__ __forceinline__ unsigned pk4_fp8(float a, float b, float c, float d) { unsigned w = 0; w = __builtin_amdgcn_cvt_pk_fp8_f32(clamp8(a), clamp8(b), w, false); w = __builtin_amdgcn_cvt_pk_fp8_f32(clamp8(c), clamp8(d), w, true); return w; }
constexpr float Y8SCALE = 64.0f;
__device__ __forceinline__ float cy8(float y) { return y * Y8SCALE; }
__device__ __forceinline__ f32x4 un4_fp8(unsigned w) { typedef float f2_ __attribute__((ext_vector_type(2))); const f2_ a = __builtin_amdgcn_cvt_pk_f32_fp8(w, false), b = __builtin_amdgcn_cvt_pk_f32_fp8(w, true); return (f32x4){a[0], a[1], b[0], b[1]}; }
__device__ __forceinline__ float c8(float h) { return h * H8SCALE; }
__device__ __forceinline__ float log_sigmoid(float x) { return fminf(x, 0.f) - __logf(1.0f + __expf(-fabsf(x))); }

struct EpiZ {
    bf16 *Q, *K, *V, *GQ, *GK, *GV, *GR, *RATIO, *G1; float* LOGA;
    const float *gq, *gk, *bgate, *bmerge, *ropec, *ropes;
    __device__ __forceinline__ bool operator()(f32x4 (&acc)[2][2][4][2], const Unit& u, int wr, int wc, int fr, int fq) const {
        const int pn = u.pn, pm = u.pm; const bool meta = (pm == MROWS / 256);
        int oz; asm volatile("v_mov_b32 %0, 0" : "=v"(oz));
        const int r0 = wr * 64 + fr + oz, cl = wc * 32 + 8 * fq;
        const int bsh = 64 * ((pm >> 4) + 1);
        if (pn < 4) {
            const bool isq = pn < 2; if (isq && meta) return false;
            const float* gn = isq ? gq : gk;
            const f32x4 ga0 = *(const f32x4*)(gn + 8 * fq), ga1 = *(const f32x4*)(gn + 8 * fq + 4), gb0 = *(const f32x4*)(gn + 32 + 8 * fq), gb1 = *(const f32x4*)(gn + 36 + 8 * fq);
            const int hcol = ((pn & 1) * 4 + wc) * 64 + 8 * fq;
            const float osc = isq ? 0.125f * 1.4426950408889634f : 1.0f;
#pragma unroll
            for (int ai = 0; ai < 2; ++ai)
#pragma unroll
                for (int m = 0; m < 4; ++m) {
                    if (meta && (ai != 0 || wr != 0)) continue;
                    const int r = r0 + ai * HALF + m * 16;
                    const f32x4 x1a = acc[ai][0][m][0], x1b = acc[ai][0][m][1], x2a = acc[ai][1][m][0], x2b = acc[ai][1][m][1];
                    float ss = (x1a[0] * x1a[0] + x1a[1] * x1a[1]) + (x1a[2] * x1a[2] + x1a[3] * x1a[3]) + (x1b[0] * x1b[0] + x1b[1] * x1b[1]) + (x1b[2] * x1b[2] + x1b[3] * x1b[3])
                             + (x2a[0] * x2a[0] + x2a[1] * x2a[1]) + (x2a[2] * x2a[2] + x2a[3] * x2a[3]) + (x2b[0] * x2b[0] + x2b[1] * x2b[1]) + (x2b[2] * x2b[2] + x2b[3] * x2b[3]);
                    ss += __shfl_xor(ss, 16); ss += __shfl_xor(ss, 32);
                    const float rn = 1.0f / sqrtf(ss * (1.0f / 64.0f) + EPS);
                    const int pos = meta ? r : NMETA + ((pm * 256 + r) & (SEQ - 1));
                    const f32x4 c0 = *(const f32x4*)(ropec + pos * 32 + 8 * fq), c1 = *(const f32x4*)(ropec + pos * 32 + 8 * fq + 4), s0 = *(const f32x4*)(ropes + pos * 32 + 8 * fq), s1 = *(const f32x4*)(ropes + pos * 32 + 8 * fq + 4);
                    const f32x4 y1a = x1a * rn * ga0, y1b = x1b * rn * ga1, y2a = x2a * rn * gb0, y2b = x2b * rn * gb1;
                    const f32x4 o1a = (y1a * c0 - y2a * s0) * osc, o1b = (y1b * c1 - y2b * s1) * osc, o2a = (y2a * c0 + y1a * s0) * osc, o2b = (y2b * c1 + y1b * s1) * osc;
                    const u32x4 w1 = pack8(o1a, o1b), w2 = pack8(o2a, o2b);
                    if (isq) { bf16* p = Q + (size_t)(pm * 256 + r) * 512 + hcol; *(u32x4*)p = w1; *(u32x4*)(p + 32) = w2; }
                    else if (!meta) { bf16* p = K + (size_t)(pm * 256 + r + bsh) * 512 + hcol; *(u32x4*)p = w1; *(u32x4*)(p + 32) = w2; }
                    else { for (int b = 0; b < NBATCH; ++b) { bf16* p = K + (size_t)(b * LPB + r) * 512 + hcol; *(u32x4*)p = w1; *(u32x4*)(p + 32) = w2; } }
                    asm volatile("" ::: "memory");
                }
            return false;
        }
        if (pn < 12) {
            bf16* T; int pitch, cb; float sc = 1.0f; bool wmeta = true;
            if (pn < 6) { T = V; pitch = 512; cb = (pn - 4) * 256; }
            else if (pn == 6) { T = GQ; pitch = 256; cb = 0; sc = 0.125f; wmeta = false; }
            else if (pn == 7) { T = GK; pitch = 256; cb = 0; }
            else if (pn < 10) { T = GV; pitch = 512; cb = (pn - 8) * 256; }
            else { T = GR; pitch = 512; cb = (pn - 10) * 256; wmeta = false; }
            if (meta && !wmeta) return false;
#pragma unroll
            for (int ai = 0; ai < 2; ++ai)
#pragma unroll
                for (int m = 0; m < 4; ++m) {
                    if (meta && (ai != 0 || wr != 0)) continue;
                    const int r = r0 + ai * HALF + m * 16;
#pragma unroll
                    for (int bj = 0; bj < 2; ++bj) { const u32x4 w = pack8(acc[ai][bj][m][0] * sc, acc[ai][bj][m][1] * sc); const int col = cb + bj * HALF + cl;
                        if (!meta) *(u32x4*)(T + (size_t)(pm * 256 + r + bsh) * pitch + col) = w;
                        else for (int b = 0; b < NBATCH; ++b) *(u32x4*)(T + (size_t)(b * LPB + r) * pitch + col) = w; }
                    asm volatile("" ::: "memory");
                }
            return false;
        }
        if (pn == 12) {
#pragma unroll
            for (int bj = 0; bj < 2; ++bj) { const int col = bj * HALF + cl; const f32x4 b0 = *(const f32x4*)(bgate + col), b1 = *(const f32x4*)(bgate + col + 4);
#pragma unroll
                for (int ai = 0; ai < 2; ++ai)
#pragma unroll
                    for (int m = 0; m < 4; ++m) {
                        if (meta && (ai != 0 || wr != 0)) continue;
                        const int r = r0 + ai * HALF + m * 16; const f32x4 a0 = acc[ai][bj][m][0] + b0, a1 = acc[ai][bj][m][1] + b1; f32x4 v0, v1;
#pragma unroll
                        for (int i = 0; i < 4; ++i) { v0[i] = log_sigmoid(a0[i]) * (1.0f / 16.0f); v1[i] = log_sigmoid(a1[i]) * (1.0f / 16.0f); }
                        if (!meta) { float* p = LOGA + (size_t)(pm * 256 + r + bsh) * 256 + col; *(f32x4*)p = v0; *(f32x4*)(p + 4) = v1; }
                        else { if (r >= NMETA) { v0 = (f32x4){0.f, 0.f, 0.f, 0.f}; v1 = v0; }
                               for (int b = 0; b < NBATCH; ++b) { float* p = LOGA + (size_t)(b * LPB + r) * 256 + col; *(f32x4*)p = v0; *(f32x4*)(p + 4) = v1; } }
                        asm volatile("" ::: "memory");
                    } }
            return false;
        }
        if (meta) return false;
        { const int d = 128 * (pn - 13) + cl;
          const f32x4 b00 = *(const f32x4*)(bmerge + d), b01 = *(const f32x4*)(bmerge + d + 4), b10 = *(const f32x4*)(bmerge + DM + d), b11 = *(const f32x4*)(bmerge + DM + d + 4);
#pragma unroll
          for (int ai = 0; ai < 2; ++ai)
#pragma unroll
              for (int m = 0; m < 4; ++m) { const int r = r0 + ai * HALF + m * 16;
                  const f32x4 x00 = acc[ai][0][m][0] + b00, x01 = acc[ai][0][m][1] + b01, x10 = acc[ai][1][m][0] + b10, x11 = acc[ai][1][m][1] + b11; f32x4 ra, rb, ga, gb;
#pragma unroll
                  for (int i = 0; i < 4; ++i) { const float e0 = 1.0f + __expf(-x00[i]), e1 = 1.0f + __expf(-x10[i]); ra[i] = e1 * __builtin_amdgcn_rcpf(e0); ga[i] = __builtin_amdgcn_rcpf(e1);
                                                const float f0 = 1.0f + __expf(-x01[i]), f1 = 1.0f + __expf(-x11[i]); rb[i] = f1 * __builtin_amdgcn_rcpf(f0); gb[i] = __builtin_amdgcn_rcpf(f1); }
                  const size_t o = (size_t)(pm * 256 + r) * DM + d; *(u32x4*)(RATIO + o) = pack8(ra, rb); *(u32x4*)(G1 + o) = pack8(ga, gb); asm volatile("" ::: "memory"); } }
        return false;
    }
};
struct EpiMerge {
    const bf16 *RATIO, *G1; bf16* MERGED;
    __device__ __forceinline__ bool operator()(f32x4 (&acc)[2][2][4][2], const Unit& u, int wr, int wc, int fr, int fq) const {
        const int br = u.aux, pm = u.pm - (MROWS / 256) * br, pn = u.pn - 4 * br;
        const int r0 = pm * 256 + wr * 64 + fr, c0 = pn * 256 + wc * 32 + 8 * fq;
        const bf16* src = br ? G1 : RATIO;
#pragma unroll
        for (int ai = 0; ai < 2; ++ai) { u32x4 g[4][2];
#pragma unroll
            for (int m = 0; m < 4; ++m)
#pragma unroll
                for (int bj = 0; bj < 2; ++bj) g[m][bj] = *(const u32x4*)(src + (size_t)(r0 + ai * HALF + m * 16) * DM + c0 + bj * HALF);
#pragma unroll
            for (int m = 0; m < 4; ++m)
#pragma unroll
                for (int bj = 0; bj < 2; ++bj) { const size_t o = (size_t)(r0 + ai * HALF + m * 16) * DM + c0 + bj * HALF; const u32x4 gg = g[m][bj];
                    const f32x4 g0 = {pg8::bf_lo(gg.x), pg8::bf_hi(gg.x), pg8::bf_lo(gg.y), pg8::bf_hi(gg.y)}, g1 = {pg8::bf_lo(gg.z), pg8::bf_hi(gg.z), pg8::bf_lo(gg.w), pg8::bf_hi(gg.w)};
                    const f32x4 v0 = acc[ai][bj][m][0] * g0, v1 = acc[ai][bj][m][1] * g1;
                    if (br) *(u32x4*)(MERGED + o) = pack8(v0, v1); else { acc[ai][bj][m][0] = v0; acc[ai][bj][m][1] = v1; } }
            asm volatile("" ::: "memory"); }
        return br == 0;
    }
};
struct EpiOut {
    const float* x; bf16* H2U; const float* gffn; unsigned char* H2U8;
    __device__ __forceinline__ bool operator()(f32x4 (&acc)[2][2][4][2], const Unit& u, int wr, int wc, int fr, int fq) const {
        const int r0 = u.pm * 256 + wr * 64 + fr, c0 = u.pn * 256 + wc * 32 + 8 * fq;
#pragma unroll
        for (int bj = 0; bj < 2; ++bj) { const f32x4 ga = *(const f32x4*)(gffn + c0 + bj * HALF), gb = *(const f32x4*)(gffn + c0 + bj * HALF + 4);
#pragma unroll
            for (int ai = 0; ai < 2; ++ai) { f32x4 xa[4], xb[4];
#pragma unroll
                for (int m = 0; m < 4; ++m) { const size_t o = (size_t)(r0 + ai * HALF + m * 16) * DM + c0 + bj * HALF; xa[m] = *(const f32x4*)(x + o); xb[m] = *(const f32x4*)(x + o + 4); }
#pragma unroll
                for (int m = 0; m < 4; ++m) { const size_t o = (size_t)(r0 + ai * HALF + m * 16) * DM + c0 + bj * HALF;
                    const f32x4 u0 = xa[m] + acc[ai][bj][m][0], u1 = xb[m] + acc[ai][bj][m][1];
                    const f32x4 h0 = u0 * ga, h1 = u1 * gb; *(u32x4*)(H2U + o) = pack8(h0, h1); *(pg8::u32x2*)(H2U8 + o) = (pg8::u32x2){pk4_fp8(h0[0], h0[1], h0[2], h0[3]), pk4_fp8(h1[0], h1[1], h1[2], h1[3])}; }
                asm volatile("" ::: "memory"); } }
        return false;
    }
};
template <bool GATHER_> struct MoeSched {
    static constexpr bool GATHER = GATHER_;
    const LAS int* tb; const LAS int* cn; const int* ltok; int seg_lo, seg_hi, G, c;
    __device__ __forceinline__ bool next(int i, Unit& u) const {
        const int t0 = __builtin_amdgcn_readfirstlane(tb[seg_lo]), t1 = __builtin_amdgcn_readfirstlane(tb[seg_hi]);
        const int U = (t1 - t0) * 4, R = U / G, r = U - R * G; int L, hf = 0;
        if (i < R) L = i * G + c;
        else if (i > R) return false;
        else if (2 * r <= G) { if (c >= 2 * r) return false; L = R * G + (c >> 1); hf = 1 + (c & 1); }
        else { if (c >= r) return false; L = R * G + c; }
        const int rt = t0 + (L >> 2), pnl = L & 3; int s = seg_lo, hi_ = seg_hi;
        while (hi_ - s > 1) { const int mid = (s + hi_) >> 1; if (__builtin_amdgcn_readfirstlane(tb[mid]) <= rt) s = mid; else hi_ = mid; }
        u.pm = rt; u.pn = (s & 31) * 4 + pnl; u.aux = s | ((rt - __builtin_amdgcn_readfirstlane(tb[s])) << 8); u.half = hf; return true;
    }
    __device__ __forceinline__ int grow(const Unit& u, int r) const { const int s = u.aux & 255, si = (u.aux >> 8) * 256 + r, last = cn[s] - 1; return ltok[(size_t)s * LCAP + (si < last ? si : last)]; }
};
struct EpiUp {
    const LAS int* cn; const float* lrs; unsigned char* HID;
    __device__ __forceinline__ bool operator()(f32x4 (&acc)[2][2][4][2], const Unit& u, int wr, int wc, int fr, int fq) const {
        const int s = u.aux & 255, rtl = u.aux >> 8, last = cn[s] - 1, pnl = u.pn & 3; float rsv[2][4];
#pragma unroll
        for (int ai = 0; ai < 2; ++ai)
#pragma unroll
            for (int m = 0; m < 4; ++m) { if (u.half == 2 - ai) { rsv[ai][m] = 0.f; continue; } const int si = rtl * 256 + wr * 64 + fr + ai * HALF + m * 16; rsv[ai][m] = lrs[(size_t)s * LCAP + (si < last ? si : last)] * (1.0f / W8SCALE); }
#pragma unroll
        for (int ai = 0; ai < 2; ++ai)
#pragma unroll
            for (int m = 0; m < 4; ++m) { if (u.half == 2 - ai) continue; const int r = wr * 64 + fr + ai * HALF + m * 16; const float rs = rsv[ai][m];
                f32x4 h0, h1;
#pragma unroll
                for (int i = 0; i < 4; ++i) { const float g0 = acc[ai][0][m][0][i] * rs, g1 = acc[ai][0][m][1][i] * rs;
                    h0[i] = g0 * __builtin_amdgcn_rcpf(1.0f + __expf(-g0)) * (acc[ai][1][m][0][i] * rs); h1[i] = g1 * __builtin_amdgcn_rcpf(1.0f + __expf(-g1)) * (acc[ai][1][m][1][i] * rs); }
                *(pg8::u32x2*)(HID + (size_t)(u.pm * 256 + r) * DEXP + pnl * 128 + wc * 32 + 8 * fq) = (pg8::u32x2){pk4_fp8(c8(h0[0]), c8(h0[1]), c8(h0[2]), c8(h0[3])), pk4_fp8(c8(h1[0]), c8(h1[1]), c8(h1[2]), c8(h1[3]))}; }
        return false;
    }
};
template <int MODE> struct EpiDown {
    const LAS int* cn; const int* ltok; const float* lw; float* out; unsigned char* Y0; float* trash; const bf16* H2U; const float* gffn;
    __device__ __forceinline__ bool operator()(f32x4 (&acc)[2][2][4][2], const Unit& u, int wr, int wc, int fr, int fq) const {
        const int s = u.aux & 255, rtl = u.aux >> 8, cnt = cn[s], pnl = u.pn & 3; int tok[2][4]; float wv[2][4];
#pragma unroll
        for (int ai = 0; ai < 2; ++ai)
#pragma unroll
            for (int m = 0; m < 4; ++m) { const int si = rtl * 256 + wr * 64 + fr + ai * HALF + m * 16, sc = si < cnt ? si : cnt - 1; tok[ai][m] = ltok[(size_t)s * LCAP + sc]; wv[ai][m] = lw[(size_t)s * LCAP + sc] * (1.0f / (W8SCALE * H8SCALE)); }
        const int cofs = pnl * 256 + wc * 32 + 8 * fq;
        f32x4 ig[2][2];
        if (MODE == 1) {
#pragma unroll
            for (int bj = 0; bj < 2; ++bj)
#pragma unroll
                for (int n = 0; n < 2; ++n) { const f32x4 g = *(const f32x4*)(gffn + cofs + bj * HALF + 4 * n); ig[bj][n] = (f32x4){__builtin_amdgcn_rcpf(g[0]), __builtin_amdgcn_rcpf(g[1]), __builtin_amdgcn_rcpf(g[2]), __builtin_amdgcn_rcpf(g[3])}; } }
#pragma unroll
        for (int ai = 0; ai < 2; ++ai)
#pragma unroll
            for (int mp = 0; mp < 4; mp += 2) { if (u.half == 2 - ai) continue; float* po[2]; unsigned char* py[2]; const bf16* ph[2]; pg8::u32x2 yv[2][2]; u32x4 hv[2][2];
#pragma unroll
                for (int k = 0; k < 2; ++k) { const int m = mp + k, si = rtl * 256 + wr * 64 + fr + ai * HALF + m * 16; const bool ok = si < cnt;
                    po[k] = ok ? out + (size_t)tok[ai][m] * DM + cofs : trash + cofs; py[k] = ok ? Y0 + (size_t)tok[ai][m] * DM + cofs : (unsigned char*)(trash + DM) + cofs; ph[k] = H2U + (size_t)tok[ai][m] * DM + cofs; }
                if (MODE == 1) {
#pragma unroll
                    for (int k = 0; k < 2; ++k)
#pragma unroll
                        for (int bj = 0; bj < 2; ++bj) { yv[k][bj] = *(const pg8::u32x2*)(py[k] + bj * HALF); hv[k][bj] = *(const u32x4*)(ph[k] + bj * HALF); } }
#pragma unroll
                for (int k = 0; k < 2; ++k) { const int m = mp + k; const float w = wv[ai][m];
#pragma unroll
                    for (int bj = 0; bj < 2; ++bj) {
                        if (MODE == 0) { const f32x4 a0 = acc[ai][bj][m][0] * w, a1 = acc[ai][bj][m][1] * w; *(pg8::u32x2*)(py[k] + bj * HALF) = (pg8::u32x2){pk4_fp8(cy8(a0[0]), cy8(a0[1]), cy8(a0[2]), cy8(a0[3])), pk4_fp8(cy8(a1[0]), cy8(a1[1]), cy8(a1[2]), cy8(a1[3]))}; }
                        else { const pg8::u32x2 y = yv[k][bj]; const u32x4 h = hv[k][bj]; float* p = po[k] + bj * HALF;
                            const f32x4 ya = un4_fp8(y.x) * (1.0f / Y8SCALE), yb = un4_fp8(y.y) * (1.0f / Y8SCALE);
                            const f32x4 ha = {pg8::bf_lo(h.x), pg8::bf_hi(h.x), pg8::bf_lo(h.y), pg8::bf_hi(h.y)}, hb = {pg8::bf_lo(h.z), pg8::bf_hi(h.z), pg8::bf_lo(h.w), pg8::bf_hi(h.w)};
                            *(f32x4*)p = (ha * ig[bj][0] + ya) + acc[ai][bj][m][0] * w; *(f32x4*)(p + 4) = (hb * ig[bj][1] + yb) + acc[ai][bj][m][1] * w; } } }
                asm volatile("" ::: "memory"); }
        return false;
    }
};
}
constexpr int GP = 144;
typedef LAS unsigned char* ldsp;
__device__ __forceinline__ pg8::bf16x8 ldfrag(ldsp base, int row, int ks, int fq) { return *(const LAS pg8::bf16x8*)(base + row * GP + ks * 64 + fq * 16); }
#define MFMA16(a, b, c) __builtin_amdgcn_mfma_f32_16x16x32_bf16((a), (b), (c), 0, 0, 0)
constexpr size_t WS_O0 = WS_DS, WS_QD = WS_DS + 32 * MiB, WS_GG = WS_DS + 48 * MiB, WS_GD = WS_DS + 56 * MiB;
__device__ __forceinline__ void gla_x(Frame& F, int unit) {
    const int bh = unit >> 3, g = unit & 7, b = bh >> 2, h = bh & 3, d = F.tid & 63, tq = F.wave, fr = F.lane & 15, fq = F.lane >> 4;
    LAS float* part = (LAS float*)(F.lds + 0); LAS float* TOT = (LAS float*)(F.lds + 2048);
    const ldsp QT = F.lds + 4096, KT = F.lds + 13312, AH = F.lds + 22528, VT = F.lds + 31744, SB = F.lds + 50176, PP = F.lds + 68608;
    for (int i = F.tid; i < 128 * GP / 4; i += NWAVES * 64) ((LAS unsigned*)SB)[i] = 0u;
    pg8::f32x4 accS[4];
#pragma unroll
    for (int db = 0; db < 4; ++db) accS[db] = (pg8::f32x4){0.f, 0.f, 0.f, 0.f};
    float cd = 1.0f;
    const int c_first = g ? 8 * g + 1 : 0, c_last = 8 * g + 8;
    bf16* QD = WSP(bf16, WS_QD); bf16* O0 = WSP(bf16, WS_O0);
    const float* LOGA = WSP(float, WS_LOGA); const bf16* GQ = WSP(bf16, WS_GQ); const bf16* GK = WSP(bf16, WS_GK); const bf16* GV = WSP(bf16, WS_GV);
    float an[8]; bf16 qn[8], kn[8]; v4u vn[2];
#define GX_LOAD(cc) do { const size_t ro_ = (size_t)(b * LPB + 64 * (cc) + 8 * tq) * 256 + h * 64 + d; \
        _Pragma("unroll") for (int i_ = 0; i_ < 8; ++i_) { an[i_] = LOGA[ro_ + i_ * 256]; qn[i_] = GQ[ro_ + i_ * 256]; kn[i_] = GK[ro_ + i_ * 256]; } \
        _Pragma("unroll") for (int j_ = 0; j_ < 2; ++j_) { const int p_ = F.tid + 512 * j_; vn[j_] = *(const GAS v4u*)(GV + (size_t)(b * LPB + 64 * (cc) + (p_ >> 4)) * 512 + h * 128 + (p_ & 15) * 8); } } while (0)
    GX_LOAD(c_first);
    for (int c = c_first; c <= c_last; ++c) {
        const int mrow0 = b * SEQ + 64 * (c - 1);
        float bt[8]; bt[0] = an[0];
#pragma unroll
        for (int i = 1; i < 8; ++i) bt[i] = bt[i - 1] + an[i];
        part[tq * 64 + d] = bt[7];
        __syncthreads();
        float off = 0.f, tot = 0.f;
#pragma unroll
        for (int j = 0; j < 8; ++j) { const float p = part[j * 64 + d]; tot += p; if (j < tq) off += p; }
        if (tq == 0) TOT[d] = tot;
        float kh[8];
#pragma unroll
        for (int i = 0; i < 8; ++i) { const float bti = bt[i] + off; const float kk = bf2f(kn[i]); const float qv = bf2f(qn[i]) * __expf(bti), kv = kk * __expf(fminf(-bti, 80.f)); kh[i] = kk * __expf(tot - bti);
            *(LAS bf16*)(QT + (8 * tq + i) * GP + d * 2) = (bf16)f2bf(qv); *(LAS bf16*)(KT + (8 * tq + i) * GP + d * 2) = (bf16)f2bf(kv);
            if (c >= 1) QD[(size_t)(mrow0 + 8 * tq + i) * 256 + h * 64 + d] = (bf16)f2bf(qv * cd); }
        { v4u w; w.x = pk2(kh[0], kh[1]); w.y = pk2(kh[2], kh[3]); w.z = pk2(kh[4], kh[5]); w.w = pk2(kh[6], kh[7]); *(LAS v4u*)(AH + d * GP + tq * 16) = w; }
        cd *= __expf(tot);
#pragma unroll
        for (int j = 0; j < 2; ++j) { const int p = F.tid + 512 * j, sv = p >> 4, ec = p & 15; const unsigned ww[4] = {vn[j].x, vn[j].y, vn[j].z, vn[j].w};
#pragma unroll
            for (int i = 0; i < 4; ++i) { *(LAS bf16*)(VT + (8 * ec + 2 * i) * GP + sv * 2) = (bf16)(ww[i] & 0xffffu); *(LAS bf16*)(VT + (8 * ec + 2 * i + 1) * GP + sv * 2) = (bf16)(ww[i] >> 16); } }
        if (c < c_last) GX_LOAD(c + 1);
        __syncthreads();
        const int tb = tq >> 1, t0 = 16 * tb, t = t0 + fr;
#pragma unroll
        for (int sbi = 0; sbi < 2; ++sbi) { const int s0 = 16 * (2 * (tq & 1) + sbi); pg8::f32x4 a = {0.f, 0.f, 0.f, 0.f};
#pragma unroll
            for (int ks = 0; ks < 2; ++ks) a = MFMA16(ldfrag(KT, s0 + fr, ks, fq), ldfrag(QT, t0 + fr, ks, fq), a);
            const int s = s0 + 4 * fq;
            const float p0 = (s + 0 <= t) ? a[0] : 0.f, p1 = (s + 1 <= t) ? a[1] : 0.f, p2 = (s + 2 <= t) ? a[2] : 0.f, p3 = (s + 3 <= t) ? a[3] : 0.f;
            *(LAS unsigned*)(PP + t * GP + s * 2) = pk2(p0, p1); *(LAS unsigned*)(PP + t * GP + s * 2 + 4) = pk2(p2, p3); }
#pragma unroll
        for (int db = 0; db < 4; ++db) { const pg8::f32x4 tv = *(const LAS pg8::f32x4*)(TOT + 16 * db + 4 * fq);
            accS[db][0] *= __expf(tv[0]); accS[db][1] *= __expf(tv[1]); accS[db][2] *= __expf(tv[2]); accS[db][3] *= __expf(tv[3]); }
#pragma unroll
        for (int ks = 0; ks < 2; ++ks) { const pg8::bf16x8 bfr = ldfrag(VT, 16 * tq + fr, ks, fq);
#pragma unroll
            for (int db = 0; db < 4; ++db) accS[db] = MFMA16(ldfrag(AH, 16 * db + fr, ks, fq), bfr, accS[db]); }
        __syncthreads();
        if (c >= 1) {
            const int eh = tq & 1; pg8::f32x4 o[4];
#pragma unroll
            for (int eb = 0; eb < 4; ++eb) o[eb] = (pg8::f32x4){0.f, 0.f, 0.f, 0.f};
#pragma unroll
            for (int ks = 0; ks < 4; ++ks) { const pg8::bf16x8 bfr = ks < 2 ? ldfrag(PP, t0 + fr, ks, fq) : ldfrag(QT, t0 + fr, ks - 2, fq);
#pragma unroll
                for (int eb = 0; eb < 4; ++eb) { const int e0 = 64 * eh + 16 * eb; o[eb] = MFMA16(ks < 2 ? ldfrag(VT, e0 + fr, ks, fq) : ldfrag(SB, e0 + fr, ks - 2, fq), bfr, o[eb]); } }
            bf16* op = O0 + (size_t)(mrow0 + t) * 512 + h * 128 + 64 * eh + 4 * fq;
#pragma unroll
            for (int eb = 0; eb < 4; ++eb) *(GAS unsigned long long*)(op + 16 * eb) = (unsigned long long)pk2(o[eb][0], o[eb][1]) | ((unsigned long long)pk2(o[eb][2], o[eb][3]) << 32);
        }
        __syncthreads();
#pragma unroll
        for (int db = 0; db < 4; ++db) { LAS unsigned* sp = (LAS unsigned*)(SB + (16 * tq + fr) * GP + (16 * db + 4 * fq) * 2); sp[0] = pk2(accS[db][0], accS[db][1]); sp[1] = pk2(accS[db][2], accS[db][3]); }
    }
#undef GX_LOAD
    float* gg = WSP(float, WS_GG) + ((size_t)(bh * 8 + g) * 128 + 16 * tq + fr) * 64;
#pragma unroll
    for (int db = 0; db < 4; ++db) *(pg8::f32x4*)(gg + 16 * db + 4 * fq) = accS[db];
    if (tq == 0) WSP(float, WS_GD)[(bh * 8 + g) * 64 + d] = cd;
    __syncthreads();
}
__device__ __forceinline__ void gla_z(Frame& F, int unit) {
    const int bh = unit >> 3, g = unit & 7, b = bh >> 2, h = bh & 3, fr = F.lane & 15, fq = F.lane >> 4;
    const ldsp SB = F.lds + 0;
    { const pg8::f32x4* G4 = WSP(pg8::f32x4, WS_GG); const float* GD = WSP(float, WS_GD);
#pragma unroll
      for (int j = 0; j < 4; ++j) { const int q = F.tid + 512 * j, e = q >> 4, d4 = (q & 15) * 4; pg8::f32x4 S = {0.f, 0.f, 0.f, 0.f}, Gv[7], Dv[7];
#pragma unroll
          for (int gp = 0; gp < 7; ++gp) if (gp < g) { Dv[gp] = *(const pg8::f32x4*)(GD + (bh * 8 + gp) * 64 + d4); Gv[gp] = G4[(size_t)(bh * 8 + gp) * 2048 + q]; }
#pragma unroll
          for (int gp = 0; gp < 7; ++gp) if (gp < g) S = Dv[gp] * S + Gv[gp];
          *(LAS unsigned*)(SB + e * GP + d4 * 2) = pk2(S.x, S.y); *(LAS unsigned*)(SB + e * GP + d4 * 2 + 4) = pk2(S.z, S.w); } }
    __syncthreads();
    const bf16* QD = WSP(bf16, WS_QD); const bf16* O0 = WSP(bf16, WS_O0); const float* gg = F.in[I_GGLA];
    pg8::bf16x8 qf[2]; unsigned long long ow[8], rw[8];
#define GZ_LOAD(itn) do { const int tl_ = 512 * g + 128 * (itn) + 16 * F.wave + fr; const size_t mr_ = (size_t)(b * SEQ + tl_), pr_ = (size_t)(b * LPB + 64 + tl_); \
        _Pragma("unroll") for (int ks_ = 0; ks_ < 2; ++ks_) qf[ks_] = *(const pg8::bf16x8*)(QD + mr_ * 256 + h * 64 + 32 * ks_ + 8 * fq); \
        _Pragma("unroll") for (int eb_ = 0; eb_ < 8; ++eb_) { ow[eb_] = *(const GAS unsigned long long*)(O0 + mr_ * 512 + h * 128 + 16 * eb_ + 4 * fq); rw[eb_] = *(const GAS unsigned long long*)(WSP(bf16, WS_GR) + pr_ * 512 + h * 128 + 16 * eb_ + 4 * fq); } } while (0)
    GZ_LOAD(0);
    for (int it = 0; it < 4; ++it) {
        const int tl = 512 * g + 128 * it + 16 * F.wave + fr, mrow = b * SEQ + tl;
        pg8::f32x4 o[8];
#pragma unroll
        for (int eb = 0; eb < 8; ++eb) o[eb] = (pg8::f32x4){0.f, 0.f, 0.f, 0.f};
#pragma unroll
        for (int ks = 0; ks < 2; ++ks)
#pragma unroll
            for (int eb = 0; eb < 8; ++eb) o[eb] = MFMA16(ldfrag(SB, 16 * eb + fr, ks, fq), qf[ks], o[eb]);
        float ss = 0.f; float sr[8][4];
#pragma unroll
        for (int eb = 0; eb < 8; ++eb) { const unsigned long long w = ow[eb], r = rw[eb];
            o[eb][0] += __uint_as_float((unsigned)w << 16); o[eb][1] += __uint_as_float((unsigned)w & 0xffff0000u); o[eb][2] += __uint_as_float((unsigned)(w >> 32) << 16); o[eb][3] += __uint_as_float((unsigned)(w >> 32) & 0xffff0000u);
            ss += (o[eb][0] * o[eb][0] + o[eb][1] * o[eb][1]) + (o[eb][2] * o[eb][2] + o[eb][3] * o[eb][3]);
            sr[eb][0] = __uint_as_float((unsigned)r << 16); sr[eb][1] = __uint_as_float((unsigned)r & 0xffff0000u); sr[eb][2] = __uint_as_float((unsigned)(r >> 32) << 16); sr[eb][3] = __uint_as_float((unsigned)(r >> 32) & 0xffff0000u); }
        if (it < 3) GZ_LOAD(it + 1);
        ss += __shfl_xor(ss, 16); ss += __shfl_xor(ss, 32);
        const float rn = 1.0f / sqrtf(ss * (1.0f / 128.0f) + EPS);
        bf16* op = WSP(bf16, WS_OA) + (size_t)MROWS * 512 + (size_t)mrow * 512 + h * 128;
#pragma unroll
        for (int eb = 0; eb < 8; ++eb) { const int e = 16 * eb + 4 * fq; const pg8::f32x4 gv = *(const pg8::f32x4*)(gg + e);
            const float v0 = o[eb][0] * rn * gv.x * (sr[eb][0] * sigmoidf_(sr[eb][0])), v1 = o[eb][1] * rn * gv.y * (sr[eb][1] * sigmoidf_(sr[eb][1])), v2 = o[eb][2] * rn * gv.z * (sr[eb][2] * sigmoidf_(sr[eb][2])), v3 = o[eb][3] * rn * gv.w * (sr[eb][3] * sigmoidf_(sr[eb][3]));
            *(GAS unsigned long long*)(op + e) = (unsigned long long)pk2(v0, v1) | ((unsigned long long)pk2(v2, v3) << 32); }
    }
#undef GZ_LOAD
    __syncthreads();
}
__device__ __forceinline__ void router_phase(Frame& F) {
    LAS float* lgp = (LAS float*)(F.lds + 0);
    LAS float* ssp = (LAS float*)(F.lds + 49152);
    LAS int* lcnt = (LAS int*)(F.lds + 51200); LAS int* lbase = lcnt + 64;
    const bf16* H = WSP(bf16, WS_H2U); const bf16* wh = WSP(bf16, WS_WRH); const bf16* wl = WSP(bf16, WS_WRL);
    int* ltok = WSP(int, WS_LTOK); float* lrs = WSP(float, WS_LRS); float* lw = WSP(float, WS_LW);
    const int fr = F.lane & 15, kg = F.lane >> 4, rbk = F.wave & 3, kh = F.wave >> 2;
    for (int rb = F.vcu; rb < MROWS / 128; rb += F.G) {
        if (F.tid < 64) lcnt[F.tid] = 0;
        const bf16* h0 = H + (size_t)(rb * 128 + rbk * 32 + fr) * DM + kh * 512 + 8 * kg; const bf16* h1 = h0 + 16 * DM;
        const bf16* whp = wh + (size_t)fr * DM + kh * 512 + 8 * kg; const bf16* wlp = wl + (size_t)fr * DM + kh * 512 + 8 * kg;
        pg8::f32x4 acc[2][3];
#pragma unroll
        for (int a = 0; a < 2; ++a)
#pragma unroll
            for (int cb = 0; cb < 3; ++cb) acc[a][cb] = (pg8::f32x4){0.f, 0.f, 0.f, 0.f};
        float ss0 = 0.f, ss1 = 0.f; const float* ig2 = WSP(float, WS_IG2) + kh * 512 + 8 * kg;
#pragma unroll 4
        for (int s = 0; s < 16; ++s) {
            const pg8::bf16x8 a0 = *(const pg8::bf16x8*)(h0 + 32 * s), a1 = *(const pg8::bf16x8*)(h1 + 32 * s);
            { const pg8::f32x4 ia = *(const pg8::f32x4*)(ig2 + 32 * s), ib = *(const pg8::f32x4*)(ig2 + 32 * s + 4); const float iv[8] = {ia[0], ia[1], ia[2], ia[3], ib[0], ib[1], ib[2], ib[3]};
#pragma unroll
              for (int j = 0; j < 8; ++j) { const float x0 = __uint_as_float((unsigned)(unsigned short)a0[j] << 16), x1 = __uint_as_float((unsigned)(unsigned short)a1[j] << 16); ss0 += x0 * x0 * iv[j]; ss1 += x1 * x1 * iv[j]; } }
#pragma unroll
            for (int cb = 0; cb < 3; ++cb) { const pg8::bf16x8 bh = *(const pg8::bf16x8*)(whp + (size_t)(16 * cb) * DM + 32 * s), bl = *(const pg8::bf16x8*)(wlp + (size_t)(16 * cb) * DM + 32 * s);
                acc[0][cb] = MFMA16(a0, bh, acc[0][cb]); acc[0][cb] = MFMA16(a0, bl, acc[0][cb]); acc[1][cb] = MFMA16(a1, bh, acc[1][cb]); acc[1][cb] = MFMA16(a1, bl, acc[1][cb]); }
        }
#pragma unroll
        for (int a = 0; a < 2; ++a)
#pragma unroll
            for (int cb = 0; cb < 3; ++cb)
#pragma unroll
                for (int i = 0; i < 4; ++i) lgp[(kh * 128 + rbk * 32 + a * 16 + 4 * kg + i) * 48 + 16 * cb + fr] = acc[a][cb][i];
        ss0 += __shfl_xor(ss0, 16); ss0 += __shfl_xor(ss0, 32); ss1 += __shfl_xor(ss1, 16); ss1 += __shfl_xor(ss1, 32);
        if (kg == 0) { ssp[kh * 128 + rbk * 32 + fr] = ss0; ssp[kh * 128 + rbk * 32 + 16 + fr] = ss1; }
        __syncthreads();
        int seg0 = 0, seg1 = 0, rk0 = 0, rk1 = 0; float w0 = 0.f, w1 = 0.f, rs = 0.f;
        if (F.tid < 128) {
            const LAS float* L0 = lgp + F.tid * 48; const LAS float* L1 = L0 + 128 * 48; rs = 1.0f / sqrtf((ssp[F.tid] + ssp[128 + F.tid]) * (1.0f / DM) + EPS);
            float gl[4];
#pragma unroll
            for (int j = 0; j < 4; ++j) gl[j] = (L0[j] + L1[j]) * rs + F.in[I_BRG][j];
            int gi = 0; float gm = gl[0];
#pragma unroll
            for (int j = 1; j < 4; ++j) if (gl[j] > gm) { gm = gl[j]; gi = j; }
            float gs = 0.f;
#pragma unroll
            for (int j = 0; j < 4; ++j) gs += expf(gl[j] - gm);
            const float gw_ = 1.0f / gs;
            float v1 = -INFINITY, v2 = -INFINITY; int i1 = 0, i2 = 0;
            for (int j = 0; j < 8; ++j) { const float v = (L0[4 + gi * 8 + j] + L1[4 + gi * 8 + j]) * rs + F.in[I_BRE][gi * 8 + j];
                if (v > v1) { v2 = v1; i2 = i1; v1 = v; i1 = j; } else if (v > v2) { v2 = v; i2 = j; } }
            const float e1 = 1.0f / (1.0f + expf(v2 - v1));
            w0 = gw_ * e1; w1 = gw_ * (1.0f - e1); seg0 = gi * 8 + i1; seg1 = 32 + gi * 8 + i2;
            rk0 = atomicAdd((int*)(lcnt + seg0), 1); rk1 = atomicAdd((int*)(lcnt + seg1), 1);
        }
        __syncthreads();
        if (F.tid < 64) { const int n = lcnt[F.tid]; lbase[F.tid] = n ? (int)__hip_atomic_fetch_add((unsigned*)(F.ctl + CW_CNT + F.tid), (unsigned)n, RLX_AGENT) : 0; }
        __syncthreads();
        if (F.tid < 128) { const int tok = rb * 128 + F.tid; const size_t p0 = (size_t)seg0 * LCAP + lbase[seg0] + rk0, p1 = (size_t)seg1 * LCAP + lbase[seg1] + rk1;
            ltok[p0] = tok; lrs[p0] = rs; lw[p0] = w0; ltok[p1] = tok; lrs[p1] = rs; lw[p1] = w1; }
        __syncthreads();
    }
}
#ifndef MK_N_LAUNCHES
#define MK_N_LAUNCHES 1
#endif
constexpr int N_PHASES = 10;
struct Args { const float* in[25]; float* out; unsigned char* ws; int ph_lo, ph_hi; };
__global__ void __launch_bounds__(NWAVES * 64, 2) fwd_kernel(Args args) {
    extern __shared__ __attribute__((aligned(16))) unsigned char lds[];
    Frame F;
    F.lds = (LAS unsigned char*)lds;
    F.MISC = (volatile LAS unsigned*)(F.lds + MISC_OFF);
    F.tid = threadIdx.x; F.lane = F.tid & 63; F.wave = __builtin_amdgcn_readfirstlane(F.tid >> 6);
    F.G = gridDim.x; { const int bx = blockIdx.x; F.vcu = (F.G % 8 == 0) ? (bx % 8) * (F.G / 8) + bx / 8 : bx; }
    F.ws = args.ws; F.out = args.out; F.ctl = (gu32*)(args.ws + WS_CTL);
#pragma unroll
    for (int i = 0; i < 25; ++i) F.in[i] = args.in[i];
    for (int u = F.tid; u < (LDS_BYTES - LDSCTL_OFF) / 4; u += NWAVES * 64) ((LAS unsigned*)(F.lds + LDSCTL_OFF))[u] = 0u;
    __syncthreads();
    XcdBarrier bar; bar.bar = (unsigned*)(F.ctl + CW_BAR); bar.x = 0; bar.st = nullptr;
    if (MK_N_LAUNCHES == 1) bar = xcd_barrier_post((unsigned*)(F.ctl + CW_BAR), F.MISC + 8);
    const int lo = args.ph_lo, hi = args.ph_hi;
#ifdef PROBE_K
    volatile LAS unsigned long long* prb = (volatile LAS unsigned long long*)(F.lds + LDSCTL_OFF + 2048); if (blockIdx.x == 0 && F.tid == 0) prb[0] = __builtin_amdgcn_s_memrealtime();
#define PROBE_AT(k) do { if ((k) == PROBE_K && blockIdx.x == 0 && F.tid == 0) prb[1] = __builtin_amdgcn_s_memrealtime(); } while (0)
#else
#define PROBE_AT(k) do {} while (0)
#endif
#ifndef PH_MASK
#define PH_MASK 0x3ff
#endif
#define IN(k) (((PH_MASK >> (k)) & 1) && lo <= (k) && (k) < hi)
#define SEAM(k) do { if (IN(k) && IN((k) + 1)) xcd_barrier(bar); PROBE_AT(k); } while (0)
    const LAS int* tbp = (const LAS int*)(F.lds + TB_OFF); const LAS int* cnp = (const LAS int*)(F.lds + CN_OFF);

    if (IN(0)) { p0_prologue(F); } SEAM(0);
    if (IN(1)) {
#ifdef SKEW_US
        { const unsigned long long t0_ = __builtin_amdgcn_s_memrealtime(), dl_ = (unsigned long long)(F.vcu & 7) * (SKEW_US * 100 / 8); while (__builtin_amdgcn_s_memrealtime() - t0_ < dl_) __builtin_amdgcn_s_sleep(8); }
#endif
        pg8::Gemm g{WSP(pg8::bf16_t, WS_R1), WSP(pg8::bf16_t, WS_WIN), DM}; pg8::StaticOrder S{MZ / 256, NZ / 256, F.G, (int)blockIdx.x};
        epi::EpiZ E{WSP(bf16, WS_Q), WSP(bf16, WS_K), WSP(bf16, WS_V), WSP(bf16, WS_GQ), WSP(bf16, WS_GK), WSP(bf16, WS_GV), WSP(bf16, WS_GR), (bf16*)F.out, (bf16*)F.out + (size_t)MROWS * DM, WSP(float, WS_LOGA),
                    F.in[I_GQN], F.in[I_GKN], F.in[I_BGATE], F.in[I_BMERGE], WSP(float, WS_ROPE), WSP(float, WS_ROPE) + NPOS * 32};
        pg8::gemm_phase(F.lds + RING_OFF, g, S, E);
        if ((int)blockIdx.x >= P1_EXTRA(F.G)) { const int nidle = F.G - P1_EXTRA(F.G), j = (int)blockIdx.x - P1_EXTRA(F.G), nw = nidle * NWAVES, me = j * NWAVES + F.wave, cnt = p1_conv_items(F.G);
            late_tables(F, me * 64 + F.lane, nw * 64); expert_conv_first(F, me, nw, cnt); }
    } SEAM(1);
    if (IN(2)) {
        const attn_body::AttnTensors AT{(const attn_body::bf16*)WSP(bf16, WS_Q), (const attn_body::bf16*)WSP(bf16, WS_K), (const attn_body::bf16*)WSP(bf16, WS_V), (attn_body::bf16*)WSP(bf16, WS_R1)};
        { const float lam = expf(wave_sum(F.in[I_LQ1][F.lane] * F.in[I_LK1][F.lane])) - expf(wave_sum(F.in[I_LQ2][F.lane] * F.in[I_LK2][F.lane])) + 0.2f;
          float gqm = fabsf(F.in[I_GQN][F.lane]), gkm = fabsf(F.in[I_GKN][F.lane]);
#pragma unroll
          for (int o_ = 1; o_ < 64; o_ <<= 1) { gqm = fmaxf(gqm, __shfl_xor(gqm, o_)); gkm = fmaxf(gkm, __shfl_xor(gkm, o_)); }
          const bool fastsm = __builtin_amdgcn_readfirstlane((0.125f * 1.4426950408889634f * 64.0f) * gqm * gkm < 48.0f ? 1 : 0) != 0;
          const int nslot = 2 * ((256 + F.G - 1) / F.G);
          int i = 0;
#define ATTN_LOOP(FASTSM) for (;; ++i) { const int p = (i >> 2) * F.G + F.vcu; if (p >= 256) break; \
              if ((i & 3) == 1 || (i & 3) == 3) expert_conv_slot(F, (i >> 2) * 2 + ((i & 3) >> 1), nslot, p1_conv_items(F.G)); \
              const int bh = p >> 3, s = p & 7, b = bh >> 2, h = bh & 3, mp = i & 1, qb = (i & 2) ? 15 - s : s, hm = 2 * h + mp; \
              attn_body::attn_unit<8, FASTSM>(b, hm * 64, hm * 64, h * 128, hm * 128, qb, AT.Q, AT.K, AT.V, AT.O, (char*)lds + RING_OFF, mp, 2 * h * 128, lam, F.in[I_GSUB], (attn_body::bf16*)WSP(bf16, WS_OA), h * 128); }
          if (fastsm) { ATTN_LOOP(true) } else { ATTN_LOOP(false) }
#undef ATTN_LOOP
          for (int sl = (i >> 2) * 2 + (((i & 3) + 1) >> 1 > 2 ? 2 : ((i & 3) + 1) >> 1); sl < nslot; ++sl) expert_conv_slot(F, sl, nslot, p1_conv_items(F.G)); }
        asm volatile("s_waitcnt vmcnt(0) lgkmcnt(0)" ::: "memory"); __syncthreads();
        for (int un = F.vcu; un < 32 * 8; un += F.G) gla_x(F, un);
    } SEAM(2);
    if (IN(3)) { for (int un = F.vcu; un < 32 * 8; un += F.G) gla_z(F, un); } SEAM(3);
    if (IN(4)) {
        pg8::Gemm g{WSP(pg8::bf16_t, WS_OA), WSP(pg8::bf16_t, WS_WBR), 512}; pg8::PairOrder S{MROWS / 256, DM / 256, F.G, (int)blockIdx.x};
        epi::EpiMerge E{(const bf16*)F.out, (const bf16*)F.out + (size_t)MROWS * DM, WSP(bf16, WS_R1)};
        pg8::gemm_phase(F.lds + RING_OFF, g, S, E);
    } SEAM(4);
    if (IN(5)) {
        pg8::Gemm g{WSP(pg8::bf16_t, WS_R1), WSP(pg8::bf16_t, WS_WOUT), DM}; pg8::StaticOrder S{MROWS / 256, DM / 256, F.G, (int)blockIdx.x};
        epi::EpiOut E{F.in[I_X], WSP(bf16, WS_H2U), F.in[I_GFFN], WSP(unsigned char, WS_H2U8)};
        pg8::gemm_phase(F.lds + RING_OFF, g, S, E);
    } SEAM(5);
    if (IN(6)) { router_phase(F); } SEAM(6);
    if ((PH_MASK >> 7) && hi > 7) {
        LAS int* tb = (LAS int*)(F.lds + TB_OFF); LAS int* cn = (LAS int*)(F.lds + CN_OFF);
        if (F.tid < 64) { const int c = (int)__hip_atomic_load(F.ctl + CW_CNT + F.tid, RLX_AGENT); cn[F.tid] = c;
            const int t = (c + 255) >> 8; int incl = t;
#pragma unroll
            for (int o = 1; o < 64; o <<= 1) { const int v = __shfl_up(incl, o); if (F.lane >= o) incl += v; }
            tb[F.tid] = incl - t; if (F.tid == 63) tb[64] = incl; }
        __syncthreads();
    }
    if (IN(7)) {
        pg8::Gemm g{WSP(pg8::bf16_t, WS_H2U8), WSP(pg8::bf16_t, WS_WGU), DM / 2}; epi::MoeSched<true> S{tbp, cnp, WSP(int, WS_LTOK), 0, 64, F.G, F.vcu};
        epi::EpiUp E{cnp, WSP(float, WS_LRS), WSP(unsigned char, WS_HID)};
        pg8::gemm_phase<epi::EpiUp, epi::MoeSched<true>, true>(F.lds + RING_OFF, g, S, E);
    } SEAM(7);
    if (IN(8)) {
        pg8::Gemm g{WSP(pg8::bf16_t, WS_HID), WSP(pg8::bf16_t, WS_WD), DEXP / 2}; epi::MoeSched<false> S{tbp, cnp, WSP(int, WS_LTOK), 0, 32, F.G, F.vcu};
        epi::EpiDown<0> E{cnp, WSP(int, WS_LTOK), WSP(float, WS_LW), F.out, WSP(unsigned char, WS_R1), WSP(float, WS_TRASH), WSP(bf16, WS_H2U), F.in[I_GFFN]};
        pg8::gemm_phase<epi::EpiDown<0>, epi::MoeSched<false>, true>(F.lds + RING_OFF, g, S, E);
    } SEAM(8);
    if (IN(9)) {
        pg8::Gemm g{WSP(pg8::bf16_t, WS_HID), WSP(pg8::bf16_t, WS_WD), DEXP / 2}; epi::MoeSched<false> S{tbp, cnp, WSP(int, WS_LTOK), 32, 64, F.G, F.vcu};
        epi::EpiDown<1> E{cnp, WSP(int, WS_LTOK), WSP(float, WS_LW), F.out, WSP(unsigned char, WS_R1), WSP(float, WS_TRASH), WSP(bf16, WS_H2U), F.in[I_GFFN]};
        pg8::gemm_phase<epi::EpiDown<1>, epi::MoeSched<false>, true>(F.lds + RING_OFF, g, S, E);
    }
#ifdef PROBE_K
    PROBE_AT(9);
    if (blockIdx.x == 0 && F.tid == 0) { const unsigned long long t1 = __builtin_amdgcn_s_memrealtime(), tgt = t1 + (unsigned long long)PROBE_MULT * (prb[1] - prb[0]);
        for (unsigned sp = 0; sp < 4000000u && __builtin_amdgcn_s_memrealtime() < tgt; ++sp) __builtin_amdgcn_s_sleep(16); }
#endif
#undef IN
#undef SEAM
}

extern "C" void kernel_launch(void* const* d_in, const int* in_sizes, int n_in, void* d_out, int out_size, void* d_ws, size_t ws_size, hipStream_t stream) {
    static int grid = 0;
    if (grid == 0) {
        if (n_in != 25 || in_sizes[0] != MROWS * DM || out_size != MROWS * DM || ws_size < WS_END) { fprintf(stderr, "kernel_launch: unexpected shapes (n_in %d, in0 %d, out %d, ws %zu)\n", n_in, n_in > 0 ? in_sizes[0] : -1, out_size, ws_size); grid = -1; return; }
        int dev = 0, cus = 0, per_cu = 0;
        if (hipGetDevice(&dev) != hipSuccess || hipDeviceGetAttribute(&cus, hipDeviceAttributeMultiprocessorCount, dev) != hipSuccess) { grid = -1; return; }
        if (hipFuncSetAttribute((const void*)fwd_kernel, hipFuncAttributeMaxDynamicSharedMemorySize, LDS_BYTES) != hipSuccess) { fprintf(stderr, "kernel_launch: hipFuncSetAttribute failed\n"); grid = -1; return; }
        if (hipOccupancyMaxActiveBlocksPerMultiprocessor(&per_cu, (const void*)fwd_kernel, NWAVES * 64, LDS_BYTES) != hipSuccess || per_cu < 1) { fprintf(stderr, "kernel_launch: occupancy query says %d\n", per_cu); }
        (void)hipGetLastError();
        grid = cus;
    }
    if (grid < 0) return;
    if (hipMemsetAsync((char*)d_ws + WS_CTL, 0, CTL_ZERO_BYTES, stream) != hipSuccess) return;
    Args a{};
    for (int i = 0; i < 25; ++i) a.in[i] = (const float*)d_in[i];
    a.out = (float*)d_out; a.ws = (unsigned char*)d_ws;
    if (MK_N_LAUNCHES == 1) { a.ph_lo = 0; a.ph_hi = N_PHASES; hipLaunchKernelGGL(fwd_kernel, dim3(grid), dim3(NWAVES * 64), LDS_BYTES, stream, a); }
    else for (int p = 0; p < N_PHASES; ++p) { a.ph_lo = p; a.ph_hi = p + 1; hipLaunchKernelGGL(fwd_kernel, dim3(grid), dim3(NWAVES * 64), LDS_BYTES, stream, a); }
}
```

```cpp
#include <hip/hip_runtime.h>
#include <hip/hip_bf16.h>
#include <cstdio>
#include <cstdint>
#include <cmath>

namespace pg8 {
#define PG8_LAS __attribute__((address_space(3)))
typedef unsigned short bf16_t;
typedef short bf16x8 __attribute__((ext_vector_type(8)));
typedef float f32x4 __attribute__((ext_vector_type(4)));
typedef float f32x2 __attribute__((ext_vector_type(2)));
typedef unsigned u32x4 __attribute__((ext_vector_type(4)));
typedef unsigned u32x2 __attribute__((ext_vector_type(2)));
typedef int v8i __attribute__((ext_vector_type(8)));
constexpr int BM = 256, BK = 64, HALF = 128, HTB = HALF * BK * 2, STAGE_BYTES = 8 * HTB, NXCD = 8, WGM = 8;

__host__ __device__ __forceinline__ int lds_byte(int r, int c) { const int st = (r >> 4) * 2 + (c >> 5), rr = r & 15, cc = c & 31, ob = rr * 64 + cc * 2; return st * 1024 + (ob ^ (((ob >> 9) & 1) << 5)); }
__host__ __device__ __forceinline__ void stage_rc(int b, int& R, int& C) { const int st = b / 1024, sb = b % 1024, swz = sb ^ (((sb >> 9) & 1) << 5); R = (st >> 1) * 16 + swz / 64; C = (st & 1) * 32 + (swz % 64) / 2; }
__host__ __device__ __forceinline__ int perm32(int rho) { const int n = rho >> 4, i = rho & 15; return 8 * (i >> 2) + 4 * n + (i & 3); }

struct Unit { int pm, pn, aux, half; };
struct Gemm { const bf16_t* A; const bf16_t* Bt; int K; };

__device__ __forceinline__ void tile_of(int L, int nM, int nN, int& pm, int& pn) {
    const int nwg = nM * nN; int wgid = L;
    { const int q = nwg / NXCD, r = nwg % NXCD, xcd = wgid % NXCD, off = wgid / NXCD; wgid = (xcd < r ? xcd * (q + 1) : r * (q + 1) + (xcd - r) * q) + off; }
    const int nig = WGM * nN, gid = wgid / nig, fm = gid * WGM, gsz = (nM - fm) < WGM ? (nM - fm) : WGM;
    pm = fm + ((wgid % nig) % gsz); pn = (wgid % nig) / gsz;
}
struct StaticOrder {
    static constexpr bool GATHER = false;
    int nM, nN, G, c;
    __device__ __forceinline__ bool next(int i, Unit& u) const { const long L = (long)i * G + c; if (L >= (long)nM * nN) return false; tile_of((int)L, nM, nN, u.pm, u.pn); u.aux = 0; u.half = 0; return true; }
    __device__ __forceinline__ int grow(const Unit&, int) const { return 0; }
};
struct PairOrder {
    static constexpr bool GATHER = false;
    int nM, nN, G, c;
    __device__ __forceinline__ bool next(int i, Unit& u) const { const long L = (long)(i >> 1) * G + c; if (L >= (long)nM * nN) return false; tile_of((int)L, nM, nN, u.pm, u.pn); const int br = i & 1; u.pm += nM * br; u.pn += nN * br; u.aux = br; u.half = 0; return true; }
    __device__ __forceinline__ int grow(const Unit&, int) const { return 0; }
};

__device__ __forceinline__ unsigned cvt_pk_bf16(float lo, float hi) { unsigned r; asm volatile("v_cvt_pk_bf16_f32 %0, %1, %2" : "=v"(r) : "v"(lo), "v"(hi)); return r; }
__device__ __forceinline__ u32x4 pack8(const f32x4 a, const f32x4 b) { u32x4 w; w.x = cvt_pk_bf16(a[0], a[1]); w.y = cvt_pk_bf16(a[2], a[3]); w.z = cvt_pk_bf16(b[0], b[1]); w.w = cvt_pk_bf16(b[2], b[3]); return w; }
__device__ __forceinline__ float bf_lo(unsigned w) { return __uint_as_float(w << 16); }
__device__ __forceinline__ float bf_hi(unsigned w) { return __uint_as_float(w & 0xffff0000u); }

template <class Epi, class Sched, bool F8 = false>
__device__ __forceinline__ void gemm_phase(PG8_LAS unsigned char* lds, const Gemm g, const Sched& S, const Epi& E) {
    constexpr bool GA = Sched::GATHER;
    const int tid = threadIdx.x, wid = __builtin_amdgcn_readfirstlane(tid >> 6), lane = tid & 63, wr = wid >> 2, wc = wid & 3, fr = lane & 15, fq = lane >> 4;
    const int K = g.K, nt = K / BK;
    unsigned voffA[2], voffB[2]; int RA[2], CA[2];
#pragma unroll
    for (int i = 0; i < 2; ++i) { int R, C; stage_rc(tid * 16 + i * 8192, R, C); const int Rb = (R & ~31) + perm32(R & 31);
        voffA[i] = (unsigned)(R * K + C) * 2u; voffB[i] = (unsigned)(Rb * K + C) * 2u; RA[i] = R; CA[i] = C; }
    const size_t kstep = (size_t)(BK * 2);
    const size_t hstep = (size_t)HALF * K * 2;
    const size_t tstep = 2 * hstep;
    const unsigned ldsw = (unsigned)wid * 1024u;
    const int aoff = lds_byte(wr * 64 + fr, F8 ? fq * 16 : fq * 8), boff = lds_byte(wc * 32 + fr, F8 ? fq * 16 : fq * 8);
    unsigned gc[2][2], gn[2][2];
#define PG8_SA(b, h) (((b) * 2 + (h)) * HTB)
#define PG8_SB(b, h) ((4 + (b) * 2 + (h)) * HTB)
#define PG8_GL(src, dstoff) __builtin_amdgcn_global_load_lds((const unsigned*)(src), (PG8_LAS unsigned*)(lds + (dstoff)), 16, 0, 0)
#define PG8_STAGE(bufoff, gbase, voff) do { _Pragma("unroll") for (int _i = 0; _i < 2; ++_i) PG8_GL((const char*)(gbase) + (voff)[_i], (bufoff) + ldsw + _i * 8192); } while (0)
#define PG8_STA(bufoff, kptr, h, NX) do { if constexpr (GA) { _Pragma("unroll") for (int _i = 0; _i < 2; ++_i) { const unsigned _o = (NX) ? gn[h][_i] : gc[h][_i]; PG8_GL((const char*)(kptr) + _o, (bufoff) + ldsw + _i * 8192); } } \
        else { PG8_STAGE(bufoff, (const char*)(kptr) + (h) * hstep, voffA); } } while (0)
#define PG8_GOFF(dst, un) do { _Pragma("unroll") for (int _h = 0; _h < 2; ++_h) _Pragma("unroll") for (int _i = 0; _i < 2; ++_i) dst[_h][_i] = ((unsigned)S.grow(un, _h * HALF + RA[_i]) * (unsigned)K + (unsigned)CA[_i]) * 2u; } while (0)
#define PG8_LDA(dst, b, h) do { _Pragma("unroll") for (int m = 0; m < 4; ++m) _Pragma("unroll") for (int k = 0; k < 2; ++k) dst[m][k] = *(const PG8_LAS bf16x8*)(lds + PG8_SA(b, h) + aoff + m * 2048 + (F8 ? k * 16 : k * 1024)); } while (0)
#define PG8_LDB(dst, b, h) do { _Pragma("unroll") for (int n = 0; n < 2; ++n) _Pragma("unroll") for (int k = 0; k < 2; ++k) dst[n][k] = *(const PG8_LAS bf16x8*)(lds + PG8_SB(b, h) + boff + n * 2048 + (F8 ? k * 16 : k * 1024)); } while (0)
#define PG8_F8V(X) __builtin_shufflevector(__builtin_bit_cast(u32x4, X[0]), __builtin_bit_cast(u32x4, X[1]), 0, 1, 2, 3, 4, 5, 6, 7)
#define PG8_MMA(ai, bj, At, Bt) do { __builtin_amdgcn_s_setprio(1); \
        if constexpr (F8) { _Pragma("unroll") for (int m = 0; m < 4; ++m) _Pragma("unroll") for (int n = 0; n < 2; ++n) \
            acc[ai][bj][m][n] = __builtin_amdgcn_mfma_scale_f32_16x16x128_f8f6f4(__builtin_bit_cast(v8i, PG8_F8V(Bt[n])), __builtin_bit_cast(v8i, PG8_F8V(At[m])), acc[ai][bj][m][n], 0, 0, 0, 0x7f7f7f7f, 0, 0x7f7f7f7f); } \
        else { _Pragma("unroll") for (int m = 0; m < 4; ++m) _Pragma("unroll") for (int n = 0; n < 2; ++n) _Pragma("unroll") for (int k = 0; k < 2; ++k) \
            acc[ai][bj][m][n] = __builtin_amdgcn_mfma_f32_16x16x32_bf16(Bt[n][k], At[m][k], acc[ai][bj][m][n], 0, 0, 0); } __builtin_amdgcn_s_setprio(0); } while (0)
#define PG8_WAIT_V(n) asm volatile("s_waitcnt vmcnt(" #n ")" ::: "memory")
#define PG8_WAIT_L(n) asm volatile("s_waitcnt lgkmcnt(" #n ")" ::: "memory")
#define PG8_BAR __builtin_amdgcn_s_barrier()
#define PG8_SCHED __builtin_amdgcn_sched_barrier(0)
#define PG8_ZERO() do { _Pragma("unroll") for (int a = 0; a < 2; ++a) _Pragma("unroll") for (int b = 0; b < 2; ++b) _Pragma("unroll") for (int m = 0; m < 4; ++m) _Pragma("unroll") for (int n = 0; n < 2; ++n) acc[a][b][m][n] = (f32x4){0.f, 0.f, 0.f, 0.f}; } while (0)
    Unit cur, nxt; int ui = 0;
    if (!S.next(0, cur)) return;
    f32x4 acc[2][2][4][2];
    PG8_ZERO();
    bf16x8 At[4][2], B0[2][2], B1[2][2];
    const char* cA = GA ? (const char*)g.A : (const char*)g.A + (size_t)cur.pm * tstep; const char* cB = (const char*)g.Bt + (size_t)cur.pn * tstep;
    if constexpr (GA) { PG8_GOFF(gc, cur); }
    PG8_STAGE(PG8_SB(0, 0), cB, voffB); PG8_STAGE(PG8_SB(0, 1), cB + hstep, voffB); PG8_STA(PG8_SA(0, 0), cA, 0, false); PG8_STA(PG8_SA(0, 1), cA, 1, false);
    if (wr == 1) PG8_BAR;
    PG8_WAIT_V(2); PG8_BAR;
    PG8_STAGE(PG8_SB(1, 0), cB + kstep, voffB); PG8_STA(PG8_SA(1, 0), cA + kstep, 0, false); PG8_STAGE(PG8_SB(1, 1), cB + hstep + kstep, voffB);
    PG8_WAIT_V(6); PG8_BAR;
    for (;;) {
        const bool has_next = S.next(ui + 1, nxt);
        const char* nA = GA ? (const char*)g.A : (has_next ? (const char*)g.A + (size_t)nxt.pm * tstep : cA); const char* nB = has_next ? (const char*)g.Bt + (size_t)nxt.pn * tstep : cB;
        if constexpr (GA) { if (has_next) { PG8_GOFF(gn, nxt); } else { _Pragma("unroll") for (int _h = 0; _h < 2; ++_h) _Pragma("unroll") for (int _i = 0; _i < 2; ++_i) gn[_h][_i] = gc[_h][_i]; } }
        const bool do0 = cur.half != 2, do1 = cur.half != 1;
        for (int t = 0; t < nt; t += 2) {
            const bool last = (t == nt - 2);
            const char* a1 = cA + (size_t)(t + 1) * kstep;
            const char* a2 = last ? nA : cA + (size_t)(t + 2) * kstep; const char* b2 = last ? nB : cB + (size_t)(t + 2) * kstep;
            const char* a3 = a2 + kstep; const char* b3 = b2 + kstep;
            PG8_LDB(B0, 0, 0); PG8_LDB(B1, 0, 1); PG8_SCHED; PG8_LDA(At, 0, 0); PG8_STA(PG8_SA(1, 1), a1, 1, false);
            PG8_WAIT_V(8); PG8_WAIT_L(0); PG8_BAR; if (do0) { PG8_MMA(0, 0, At, B0); PG8_MMA(0, 1, At, B1); } PG8_BAR; PG8_SCHED;
            PG8_LDA(At, 0, 1); PG8_STAGE(PG8_SB(0, 0), b2, voffB); PG8_STAGE(PG8_SB(0, 1), b2 + hstep, voffB); PG8_STA(PG8_SA(0, 0), a2, 0, last);
            PG8_WAIT_V(8); PG8_WAIT_L(0); PG8_BAR; if (do1) { PG8_MMA(1, 0, At, B0); PG8_MMA(1, 1, At, B1); } PG8_BAR; PG8_SCHED;
            PG8_LDB(B0, 1, 0); PG8_LDB(B1, 1, 1); PG8_SCHED; PG8_LDA(At, 1, 0); PG8_STA(PG8_SA(0, 1), a2, 1, last);
            PG8_WAIT_V(8); PG8_WAIT_L(0); PG8_BAR; if (do0) { PG8_MMA(0, 0, At, B0); PG8_MMA(0, 1, At, B1); } PG8_BAR; PG8_SCHED;
            PG8_LDA(At, 1, 1); PG8_STAGE(PG8_SB(1, 0), b3, voffB); PG8_STAGE(PG8_SB(1, 1), b3 + hstep, voffB); PG8_STA(PG8_SA(1, 0), a3, 0, last);
            PG8_WAIT_V(8); PG8_WAIT_L(0); PG8_BAR; if (do1) { PG8_MMA(1, 0, At, B0); PG8_MMA(1, 1, At, B1); } PG8_BAR; PG8_SCHED;
        }
        if (wr == 0) PG8_BAR;
        const bool keep = E(acc, cur, wr, wc, fr, fq);
        if (!has_next) break;
        if (!keep) { PG8_ZERO(); }
        cur = nxt; cA = nA; cB = nB; ++ui;
        if constexpr (GA) { _Pragma("unroll") for (int _h = 0; _h < 2; ++_h) _Pragma("unroll") for (int _i = 0; _i < 2; ++_i) gc[_h][_i] = gn[_h][_i]; }
        if (wr == 1) PG8_BAR;
    }
    PG8_WAIT_V(0);
    PG8_BAR;
#undef PG8_SA
#undef PG8_SB
#undef PG8_GL
#undef PG8_STAGE
#undef PG8_STA
#undef PG8_GOFF
#undef PG8_LDA
#undef PG8_LDB
#undef PG8_MMA
#undef PG8_F8V
#undef PG8_WAIT_V
#undef PG8_WAIT_L
#undef PG8_BAR
#undef PG8_SCHED
#undef PG8_ZERO
}
}
#include <hip/hip_bf16.h>
#include <cmath>
namespace attn_body {
using bf16=__hip_bfloat16;
using bf16x8=__attribute__((ext_vector_type(8)))short;
using s16x4=__attribute__((ext_vector_type(4)))short;
using f32x16=__attribute__((ext_vector_type(16)))float;
using u32x4=__attribute__((ext_vector_type(4)))unsigned;
constexpr int D=64,QP=512,KP=512,VP=512,OP=1024,QSEQ=4096,KSEQ=4160;
constexpr int NW=8,QBLK=32,QB=QBLK*NW,KVBLK=64,NQB=QSEQ/QB;
constexpr int ATTN_UNIT_ROWS=QB;
__device__ __forceinline__ int crow(int r,int hi){return (r&3)+8*(r>>2)+4*hi;}
#define SBAR() __builtin_amdgcn_sched_barrier(0)
__device__ __forceinline__ void cmask(f32x16&p0,f32x16&p1,int jb,int qrel,int hi){
  const float NEG=-INFINITY; int kb=64*jb+4*hi;
  #pragma unroll
  for(int r=0;r<16;++r){int kv=kb+(r&3)+8*(r>>2); if(kv>qrel)p0[r]=NEG; if(kv+32>qrel)p1[r]=NEG;}
}

constexpr int NSLOT=3, SLOTB=8192;
constexpr int QSTG=4608;
constexpr int LDS_K=0, LDS_V=NSLOT*SLOTB, LDS_WS=LDS_V+NSLOT*2*SLOTB, LDS_OST=LDS_WS+NW*64*4, LDS_BYTES=LDS_OST+NW*QSTG;
constexpr float C2=0.125f*1.4426950408889634f;
__device__ __forceinline__ void glds16(const void*gsrc,unsigned lds_dst){unsigned keep;
  asm volatile("s_mov_b32 %0, m0\n\ts_mov_b32 m0, %2\n\ts_nop 0\n\tglobal_load_lds_dwordx4 %1, off\n\ts_mov_b32 m0, %0":"=&s"(keep):"v"(gsrc),"s"(lds_dst):"memory");}
__device__ __forceinline__ float max3f(float a,float b,float c){float r;asm("v_max3_f32 %0, %1, %2, %3":"=v"(r):"v"(a),"v"(b),"v"(c));return r;}
__device__ __forceinline__ float max2f(float a,float b){float r;asm("v_max_f32_e32 %0, %1, %2":"=v"(r):"v"(a),"v"(b));return r;}
__device__ __forceinline__ float fadd_s(float a,float b){float r;asm("v_add_f32_e32 %0, %1, %2":"=v"(r):"v"(a),"v"(b));return r;}
__device__ __forceinline__ float fsub_s(float a,float b){float r;asm("v_sub_f32_e32 %0, %1, %2":"=v"(r):"v"(a),"v"(b));return r;}
typedef float f32x2_t __attribute__((ext_vector_type(2))); typedef __bf16 bf16x2_t __attribute__((ext_vector_type(2)));
__device__ __forceinline__ unsigned cvtpk_s(float lo,float hi){f32x2_t v={lo,hi};bf16x2_t b=__builtin_convertvector(v,bf16x2_t);return __builtin_bit_cast(unsigned,b);}
#define WAIT_BAR(N) asm volatile("s_waitcnt vmcnt(" #N ") lgkmcnt(0)\n\ts_barrier":::"memory")

__device__ __forceinline__ void qkt(f32x16&p0,f32x16&p1,const char*Kslot,const bf16x8*qr,int r32,int hi){ const f32x16 negm=f32x16{};
  const char*kb=Kslot+hi*1024+r32*16;
  #pragma unroll
  for(int d0=0;d0<4;++d0){
    const bf16x8 b0=*reinterpret_cast<const bf16x8*>(kb+d0*2048);
    const bf16x8 b1=*reinterpret_cast<const bf16x8*>(kb+d0*2048+512);
    if(d0==0){p0=__builtin_amdgcn_mfma_f32_32x32x16_bf16(b0,qr[0],negm,0,0,0);p1=__builtin_amdgcn_mfma_f32_32x32x16_bf16(b1,qr[0],negm,0,0,0);}
    else{p0=__builtin_amdgcn_mfma_f32_32x32x16_bf16(b0,qr[d0],p0,0,0,0);p1=__builtin_amdgcn_mfma_f32_32x32x16_bf16(b1,qr[d0],p1,0,0,0);}}
}
typedef __attribute__((address_space(3))) const char* lds_cptr;
typedef short v4i16_t __attribute__((ext_vector_type(4)));
__device__ __forceinline__ void kload8(bf16x8*kf,lds_cptr kp){
  kf[0]=*(const __attribute__((address_space(3))) bf16x8*)(kp);      kf[1]=*(const __attribute__((address_space(3))) bf16x8*)(kp+512);
  kf[2]=*(const __attribute__((address_space(3))) bf16x8*)(kp+2048); kf[3]=*(const __attribute__((address_space(3))) bf16x8*)(kp+2560);
  kf[4]=*(const __attribute__((address_space(3))) bf16x8*)(kp+4096); kf[5]=*(const __attribute__((address_space(3))) bf16x8*)(kp+4608);
  kf[6]=*(const __attribute__((address_space(3))) bf16x8*)(kp+6144); kf[7]=*(const __attribute__((address_space(3))) bf16x8*)(kp+6656);
}
__device__ __forceinline__ void kload2(bf16x8*kf,lds_cptr kp,int j){ kf[2*j]=*(const __attribute__((address_space(3))) bf16x8*)(kp+j*2048); kf[2*j+1]=*(const __attribute__((address_space(3))) bf16x8*)(kp+j*2048+512); }
__device__ __forceinline__ s16x4 vtr(lds_cptr p){ return __builtin_bit_cast(s16x4,__builtin_amdgcn_ds_read_tr16_b64_v4i16((__attribute__((address_space(3))) v4i16_t*)p)); }
__device__ __forceinline__ float rowmax(const f32x16&p0,const f32x16&p1){
  float a=max3f(p0[0],p0[1],p1[0]),b=max3f(p0[2],p0[3],p1[1]);a=max3f(a,p1[2],p1[3]);
  #pragma unroll
  for(int r=4;r<16;r+=4){a=max3f(a,p0[r],p0[r+1]);b=max3f(b,p0[r+2],p0[r+3]);a=max3f(a,p1[r],p1[r+1]);b=max3f(b,p1[r+2],p1[r+3]);}
  const float m=max2f(a,b);
  auto rr=__builtin_amdgcn_permlane32_swap(__float_as_uint(m),__float_as_uint(m),false,false);
  return max2f(__uint_as_float(rr[0]),__uint_as_float(rr[1]));
}
__device__ __forceinline__ void pv(f32x16*o,int vb,bf16x8 pa0,bf16x8 pa1,bf16x8 pa2,bf16x8 pa3){
  #pragma unroll
  for(int d0=0;d0<4;++d0){s16x4 lo[4],hi[4];
    #pragma unroll
    for(int ks=0;ks<4;++ks){
      asm volatile("ds_read_b64_tr_b16 %0,%1 offset:%c2":"=&v"(lo[ks]):"v"(vb),"i"(d0*4096+ks*1024):"memory");
      asm volatile("ds_read_b64_tr_b16 %0,%1 offset:%c2":"=&v"(hi[ks]):"v"(vb),"i"(d0*4096+ks*1024+512):"memory");}
    asm volatile("s_waitcnt lgkmcnt(0)":::"memory");SBAR();
    #define PK(k) (bf16x8){lo[k][0],lo[k][1],lo[k][2],lo[k][3],hi[k][0],hi[k][1],hi[k][2],hi[k][3]}
    o[d0]=__builtin_amdgcn_mfma_f32_32x32x16_bf16(pa0,PK(0),o[d0],0,0,0);
    o[d0]=__builtin_amdgcn_mfma_f32_32x32x16_bf16(pa1,PK(1),o[d0],0,0,0);
    o[d0]=__builtin_amdgcn_mfma_f32_32x32x16_bf16(pa2,PK(2),o[d0],0,0,0);
    o[d0]=__builtin_amdgcn_mfma_f32_32x32x16_bf16(pa3,PK(3),o[d0],0,0,0);
    #undef PK
  }
}

#ifndef ATTN_STORE16
#define ATTN_STORE16(p,v) (*(u32x4*)(p)=(v))
#endif
template<int THRL,bool FAST> __device__ __forceinline__ void attn_unit(int b,int qcol,int kcol,int vcol,int ocol,int qb,const bf16*Q,const bf16*__restrict__ K,const bf16*__restrict__ V,bf16*O,char*shm,int comb,int o0col,float lam,const float*gsub,bf16*OA,int oacol){
  const int tid=threadIdx.x,lane=tid&63,r32=lane&31,hi=lane>>5; const int wid=__builtin_amdgcn_readfirstlane(tid>>6);
  const long qrow0=(long)b*QSEQ, krow0=(long)b*KSEQ; const int q0=qb*QB;
  const bf16*Qw=Q+(qrow0+q0+wid*QBLK)*QP+qcol;
  const bf16*Kh=K+krow0*KP+kcol,*Vh=V+krow0*VP+vcol;
  const unsigned lds0=(unsigned)(uintptr_t)shm;
  float*wsf=(float*)(shm+LDS_WS)+wid*64;
  const bf16*ksrc=Kh+(long)lane*KP+wid*8;
  const bf16*vsrc=Vh+(long)(16*(wid&3)+(lane>>2))*VP+(wid>>2)*32+(lane&3)*8;
  const unsigned kdst=lds0+LDS_K+wid*1024, vdst=lds0+LDS_V+wid*1024;
  #define DMA_K(t,slot) glds16(ksrc+(long)(t)*KVBLK*KP,(unsigned)__builtin_amdgcn_readfirstlane(kdst+(slot)))
  #define DMA_V(t,slot) do{ glds16(vsrc+(long)(t)*KVBLK*VP,(unsigned)__builtin_amdgcn_readfirstlane(vdst+2*(slot))); glds16(vsrc+64+(long)(t)*KVBLK*VP,(unsigned)__builtin_amdgcn_readfirstlane(vdst+2*(slot)+8192)); }while(0)
  const int vb0=(int)(lds0+LDS_V)+((lane>>4)&1)*32+(lane&3)*8+(4*hi+((lane&15)>>2))*64;
  const char*Kbase=shm+LDS_K; bf16x8 kf[8];
  const lds_cptr shm3=(lds_cptr)shm; const lds_cptr kp0=shm3+LDS_K+hi*1024+r32*16; const lds_cptr vp0=shm3+LDS_V+((lane>>4)&1)*32+(lane&3)*8+(4*hi+((lane&15)>>2))*64;
  const int NT=(q0+QB)/KVBLK+1;
  DMA_K(0,0);DMA_V(0,0);DMA_K(1,SLOTB);
  bf16x8 qr[4];
  #pragma unroll
  for(int d0=0;d0<4;++d0)qr[d0]=*reinterpret_cast<const bf16x8*>(&Qw[(long)r32*QP+d0*16+hi*8]);
  const __attribute__((address_space(3))) char* qsp=(const __attribute__((address_space(3))) char*)shm3+LDS_OST+wid*QSTG+r32*144+hi*16;
  #pragma unroll
  for(int d0=0;d0<4;++d0)*(__attribute__((address_space(3))) bf16x8*)(qsp+d0*32)=qr[d0];
  #define QV(d0) (*(const __attribute__((address_space(3))) bf16x8*)(qsp+(d0)*32))
  float mhat=0.f,l_reg=0.f;f32x16 o[4];o[0]=f32x16{};o[1]=f32x16{};o[2]=f32x16{};o[3]=f32x16{};const f32x16 zero16=f32x16{};
  const int qrel=wid*QBLK+r32;
  #define CMASK(P0,P1,t) do{int jb_=(t)-(NT-4); if(jb_>=0)cmask(P0,P1,jb_,qrel,hi);}while(0)
  bool resc=false;
  #define START(P0,P1) do{ resc=false; if constexpr(FAST){ mhat=0.f; _Pragma("unroll") for(int r=0;r<16;++r)P0[r]=__builtin_amdgcn_exp2f(P0[r]); } \
    else { const float rm=rowmax(P0,P1); mhat=rm; _Pragma("unroll") for(int r=0;r<16;++r)P0[r]=__builtin_amdgcn_exp2f(fsub_s(P0[r],mhat)); } }while(0)
  #define RESC() do{ if(resc){ asm volatile("s_waitcnt lgkmcnt(0)":::"memory"); \
      _Pragma("unroll") for(int d_=0;d_<4;++d_) _Pragma("unroll") for(int r=0;r<16;++r)o[d_][r]*=wsf[crow(r,hi)]; } }while(0)
  f32x16 pA0,pA1,pB0,pB1;
  int sl_prev=0,sl_cur=0,sl_next=SLOTB;
  #define ROT() do{sl_prev=sl_cur;sl_cur=sl_next;sl_next=(sl_next==(NSLOT-1)*SLOTB)?0:sl_next+SLOTB;}while(0)
  DMA_K(2,2*SLOTB);
  WAIT_BAR(3);
  qkt(pA0,pA1,Kbase,qr,r32,hi);asm volatile("s_nop 15\n\ts_nop 7":"+v"(pA0),"+v"(pA1));
  { _Pragma("unroll") for(int r=8;r<16;++r)pA0[r]=-INFINITY; _Pragma("unroll") for(int r=0;r<16;++r)pA1[r]=-INFINITY; }
  START(pA0,pA1);
  if constexpr(FAST){ _Pragma("unroll") for(int r=0;r<16;++r)pA1[r]=__builtin_amdgcn_exp2f(pA1[r]); } else { _Pragma("unroll") for(int r=0;r<16;++r)pA1[r]=__builtin_amdgcn_exp2f(fsub_s(pA1[r],mhat)); }
  WAIT_BAR(0);
  DMA_K(3,0);DMA_V(1,SLOTB);
  ROT();
  kload8(kf,kp0+sl_cur);
  WAIT_BAR(3);
  s16x4 vlo[8],vhi[8]; u32x4 pw0,pw1,pw2,pw3;
  #define PKW(P,B) cvtpk_s(P[B],P[B+1])
  #define PAF(k) __builtin_bit_cast(bf16x8,pw##k)
  #define VFR(i) (bf16x8){vlo[i][0],vlo[i][1],vlo[i][2],vlo[i][3],vhi[i][0],vhi[i][1],vhi[i][2],vhi[i][3]}
  #define PIN(x) asm volatile("":"+v"(x))
  #define MX3(a,b,c) __builtin_fmaxf(__builtin_fmaxf((a),(b)),(c))
  #define GAPA(MF,A0,A1,A2,A3,W0,W1,PW) do{ MF; sacc+=A0; sacc+=A1; sacc+=A2; sacc+=A3; PIN(sacc); W0; W1; PIN(PW); SBAR(); }while(0)
  #define EX(v) __builtin_amdgcn_exp2f(v)
  #define GAPB(MF,X,B) do{ MF; if constexpr(FAST){ X[B]=EX(X[B]); X[B+1]=EX(X[B+1]); } else { X[B]=EX(X[B]-mhat); X[B+1]=EX(X[B+1]-mhat); } PIN(X); SBAR(); }while(0)
  #define VOF(j) ((((j)&3)*4096)+(((j)>>2)*1024))
  #define VRD(sl,j) do{ vlo[sl]=vtr(vp_+VOF(j)); vhi[sl]=vtr(vp_+VOF(j)+512); }while(0)
  #define KRD(G,j) do{ if(G){ kload2(kf,kp0+sl_next,j); SBAR(); } }while(0)
  #define PVM(j) o[(j)&3]=__builtin_amdgcn_mfma_f32_32x32x16_bf16(PAFJ(j),VFR((j)&7),o[(j)&3],0,0,0)
  #define PAFJ(j) (((j)>>2)==0?PAF(0):((j)>>2)==1?PAF(1):((j)>>2)==2?PAF(2):PAF(3))
  #define STEP(C0,C1,P0,P1,t,GK,GV,GL) do{ SBAR(); \
    const lds_cptr vp_=vp0+2*sl_prev; \
    VRD(0,0); SBAR(); float sacc=(P0[0]+P0[1]); \
    GAPA(C0=__builtin_amdgcn_mfma_f32_32x32x16_bf16(kf[0],QV(0),zero16,0,0,0), P0[2],P0[3],P0[4],P0[5],     pw0[0]=PKW(P0,0), pw0[1]=PKW(P0,2), pw0); \
    VRD(1,1); SBAR(); GAPA(C1=__builtin_amdgcn_mfma_f32_32x32x16_bf16(kf[1],QV(0),zero16,0,0,0), P0[6],P0[7],P0[8],P0[9],     pw0[2]=PKW(P0,4), pw0[3]=PKW(P0,6), pw0); \
    VRD(2,2); SBAR(); GAPA(C0=__builtin_amdgcn_mfma_f32_32x32x16_bf16(kf[2],QV(1),C0,0,0,0),   P0[10],P0[11],P0[12],P0[13], pw1[0]=PKW(P0,8), pw1[1]=PKW(P0,10), pw1); \
    VRD(3,3); SBAR(); GAPA(C1=__builtin_amdgcn_mfma_f32_32x32x16_bf16(kf[3],QV(1),C1,0,0,0),   P0[14],P0[15],P1[0],P1[1],   pw1[2]=PKW(P0,12),pw1[3]=PKW(P0,14), pw1); \
    VRD(4,4); SBAR(); GAPA(C0=__builtin_amdgcn_mfma_f32_32x32x16_bf16(kf[4],QV(2),C0,0,0,0),   P1[2],P1[3],P1[4],P1[5],     pw2[0]=PKW(P1,0), pw2[1]=PKW(P1,2), pw2); \
    VRD(5,5); SBAR(); GAPA(C1=__builtin_amdgcn_mfma_f32_32x32x16_bf16(kf[5],QV(2),C1,0,0,0),   P1[6],P1[7],P1[8],P1[9],     pw2[2]=PKW(P1,4), pw2[3]=PKW(P1,6), pw2); \
    VRD(6,6); SBAR(); GAPA(C0=__builtin_amdgcn_mfma_f32_32x32x16_bf16(kf[6],QV(3),C0,0,0,0),   P1[10],P1[11],P1[12],P1[13], pw3[0]=PKW(P1,8), pw3[1]=PKW(P1,10), pw3); \
    VRD(7,7); SBAR(); GAPA(C1=__builtin_amdgcn_mfma_f32_32x32x16_bf16(kf[7],QV(3),C1,0,0,0),   P1[14],P1[15],0.f,0.f,       pw3[2]=PKW(P1,12),pw3[3]=PKW(P1,14), pw3); \
    l_reg+=sacc; \
    if(GK){DMA_K((t)+3,sl_cur);} if(GV){DMA_V((t)+1,sl_next);} \
    CMASK(C0,C1,t); \
    if constexpr(!FAST){ float a=MX3(C0[0],C0[1],C1[0]),b=MX3(C0[2],C0[3],C1[1]); a=MX3(a,C1[2],C1[3]); \
      _Pragma("unroll") for(int r=4;r<16;r+=4){a=MX3(a,C0[r],C0[r+1]);b=MX3(b,C0[r+2],C0[r+3]);a=MX3(a,C1[r],C1[r+1]);b=MX3(b,C1[r+2],C1[r+3]);} \
      float rm=__builtin_fmaxf(a,b); { auto rr=__builtin_amdgcn_permlane32_swap(__float_as_uint(rm),__float_as_uint(rm),false,false); rm=__builtin_fmaxf(__uint_as_float(rr[0]),__uint_as_float(rr[1])); } \
      rm-=mhat; resc=false; \
      if(__builtin_expect(__any(rm>(float)THRL),0)){ const float dl=__builtin_fmaxf(rm,0.f); mhat+=dl; \
        const float f=__builtin_amdgcn_exp2f(-dl); l_reg*=f; if(hi==0)wsf[r32]=f; resc=true; } } \
    SBAR(); \
    GAPB(PVM(0), C0,0); \
    GAPB(PVM(1), C0,2);  VRD(0,8);  SBAR(); \
    GAPB(PVM(2), C0,4);  VRD(1,9);  SBAR(); \
    GAPB(PVM(3), C0,6);  VRD(2,10); SBAR(); \
    GAPB(PVM(4), C0,8);  VRD(3,11); SBAR(); \
    GAPB(PVM(5), C0,10); VRD(4,12); SBAR(); \
    GAPB(PVM(6), C0,12); VRD(5,13); SBAR(); \
    GAPB(PVM(7), C0,14); VRD(6,14); SBAR(); \
    GAPB(PVM(8), C1,0);  VRD(7,15); SBAR(); \
    KRD(GL,0); GAPB(PVM(9),  C1,2); \
    KRD(GL,1); GAPB(PVM(10), C1,4); \
    KRD(GL,2); GAPB(PVM(11), C1,6); \
    KRD(GL,3); GAPB(PVM(12), C1,8); \
    GAPB(PVM(13), C1,10); \
    GAPB(PVM(14), C1,12); \
    GAPB(PVM(15), C1,14); \
    }while(0)
  int t=1;
  #undef CMASK
  #define CMASK(P0,P1,t) do{}while(0)
  for(;t+5<NT;t+=2){
    STEP(pB0,pB1,pA0,pA1,t,true,true,true);     WAIT_BAR(3); RESC(); ROT();
    STEP(pA0,pA1,pB0,pB1,t+1,true,true,true);   WAIT_BAR(3); RESC(); ROT();
  }
  #undef CMASK
  #define CMASK(P0,P1,t) do{int jb_=(t)-(NT-4); if(jb_>=0)cmask(P0,P1,jb_,qrel,hi);}while(0)
  #define ENDW(tt) do{ if((tt)+3<NT){WAIT_BAR(3);} else if((tt)+2<NT){WAIT_BAR(2);} else {WAIT_BAR(0);} }while(0)
  for(;t+1<NT;t+=2){
    STEP(pB0,pB1,pA0,pA1,t,(t+3<NT),(t+1<NT),(t+1<NT));       ENDW(t);   RESC(); ROT();
    STEP(pA0,pA1,pB0,pB1,t+1,(t+4<NT),(t+2<NT),(t+2<NT));     ENDW(t+1); RESC(); ROT();
  }
  { float sacc=pA0[0]+pA0[1]; _Pragma("unroll") for(int r=2;r<16;++r)sacc+=pA0[r]; _Pragma("unroll") for(int r=0;r<16;++r)sacc+=pA1[r]; l_reg+=sacc;
    pw0=(u32x4){PKW(pA0,0),PKW(pA0,2),PKW(pA0,4),PKW(pA0,6)};pw1=(u32x4){PKW(pA0,8),PKW(pA0,10),PKW(pA0,12),PKW(pA0,14)};pw2=(u32x4){PKW(pA1,0),PKW(pA1,2),PKW(pA1,4),PKW(pA1,6)};pw3=(u32x4){PKW(pA1,8),PKW(pA1,10),PKW(pA1,12),PKW(pA1,14)};
    SBAR(); pv(o,vb0+2*sl_prev,PAF(0),PAF(1),PAF(2),PAF(3)); }
  #undef PKW
  #undef PAF
  #undef VFR
  #undef PIN
  #undef MX3
  #undef GAPA
  #undef GAPB
  #undef EX
  #undef VRD
  #undef KRD
  #undef STEP
  #undef VOF
  #undef PVM
  #undef PAFJ
  #undef QV
  #undef ENDW
  {auto rr=__builtin_amdgcn_permlane32_swap(__float_as_uint(l_reg),__float_as_uint(l_reg),false,false);l_reg=__uint_as_float(rr[0])+__uint_as_float(rr[1]);}
  if(hi==0)wsf[32+r32]=l_reg;asm volatile("s_waitcnt lgkmcnt(0)":::"memory");
  float rli[16];
  #pragma unroll
  for(int r=0;r<16;++r)rli[r]=__builtin_amdgcn_rcpf(wsf[32+crow(r,hi)]);
  bf16*Ow=O+(qrow0+q0+wid*QBLK)*OP+ocol;
  { int oz_; asm volatile("v_mov_b32 %0, 0":"=v"(oz_)); const int ln=lane+oz_;
    bf16*stg=(bf16*)(shm+LDS_OST+wid*QSTG);
    if(!comb){
      #pragma unroll
      for(int hh=0;hh<2;++hh){
        #pragma unroll
        for(int r=0;r<16;++r){const int orow=crow(r,hi);
          #pragma unroll
          for(int d0=0;d0<2;++d0)stg[orow*64+d0*32+r32]=__float2bfloat16(o[2*hh+d0][r]*rli[r]);}
        asm volatile("s_waitcnt lgkmcnt(0)":::"memory");
        #pragma unroll
        for(int i=0;i<4;++i){const int row=i*8+(ln>>3),ch=ln&7; const u32x4 v=*(const u32x4*)(stg+row*64+ch*8); ATTN_STORE16(Ow+(long)row*OP+hh*64+ch*8,v);}
        asm volatile("s_waitcnt lgkmcnt(0)":::"memory"); }
    } else {
      const bf16*O0w=O+(qrow0+q0+wid*QBLK)*OP+o0col; bf16*OAw=OA+(qrow0+q0+wid*QBLK)*512+oacol;
      float ssr[4]={0.f,0.f,0.f,0.f};
      #pragma unroll
      for(int pass=0;pass<2;++pass){
        if(pass==1){
          #pragma unroll
          for(int i=0;i<4;++i){ float ss=ssr[i]; ss+=__shfl_xor(ss,1); ss+=__shfl_xor(ss,2); ss+=__shfl_xor(ss,4); ssr[i]=0.8f/sqrtf(ss*(1.0f/128.0f)+1e-6f); } }
        #pragma unroll
        for(int hh=0;hh<2;++hh){
          u32x4 v0[4];
          #pragma unroll
          for(int i=0;i<4;++i){const int row=i*8+(ln>>3),ch=ln&7; v0[i]=*(const u32x4*)(O0w+(long)row*OP+hh*64+ch*8);}
          #pragma unroll
          for(int r=0;r<16;++r){const int orow=crow(r,hi);
            #pragma unroll
            for(int d0=0;d0<2;++d0)stg[orow*64+d0*32+r32]=__float2bfloat16(o[2*hh+d0][r]*rli[r]);}
          asm volatile("s_waitcnt lgkmcnt(0)":::"memory");
          const int ch=ln&7; const float4 g0=*(const float4*)(gsub+hh*64+ch*8), g1=*(const float4*)(gsub+hh*64+ch*8+4); const float gg[8]={g0.x,g0.y,g0.z,g0.w,g1.x,g1.y,g1.z,g1.w};
          #pragma unroll
          for(int i=0;i<4;++i){const int row=i*8+(ln>>3); const u32x4 v1=*(const u32x4*)(stg+row*64+ch*8); const u32x4 a=v0[i];
            const unsigned aw[4]={a.x,a.y,a.z,a.w},bw[4]={v1.x,v1.y,v1.z,v1.w}; float dd[8];
            #pragma unroll
            for(int j=0;j<4;++j){ dd[2*j]=__uint_as_float(aw[j]<<16)-lam*__uint_as_float(bw[j]<<16); dd[2*j+1]=__uint_as_float(aw[j]&0xffff0000u)-lam*__uint_as_float(bw[j]&0xffff0000u); }
            if(pass==0){
              #pragma unroll
              for(int j=0;j<8;++j)ssr[i]+=dd[j]*dd[j]; }
            else { const float rn=ssr[i]; u32x4 w;
              w.x=cvtpk_s(dd[0]*rn*gg[0],dd[1]*rn*gg[1]); w.y=cvtpk_s(dd[2]*rn*gg[2],dd[3]*rn*gg[3]); w.z=cvtpk_s(dd[4]*rn*gg[4],dd[5]*rn*gg[5]); w.w=cvtpk_s(dd[6]*rn*gg[6],dd[7]*rn*gg[7]);
              *(u32x4*)(OAw+(long)row*512+hh*64+ch*8)=w; } }
          asm volatile("s_waitcnt lgkmcnt(0)":::"memory"); } }
    } }
  asm volatile("s_waitcnt lgkmcnt(0)\n\ts_barrier":::"memory");
  #undef DMA_K
  #undef DMA_V
  #undef CMASK
  #undef START
  #undef RESC
  #undef ROT
}
constexpr int ATTN_LDS_BYTES=LDS_BYTES;
struct AttnTensors { const bf16* Q; const bf16* K; const bf16* V; bf16* O; };
#undef SBAR
#undef WAIT_BAR
}
#define GAS __attribute__((address_space(1)))
#define LAS __attribute__((address_space(3)))
typedef unsigned short bf16;
typedef unsigned v4u __attribute__((ext_vector_type(4)));
typedef float f32x4 __attribute__((ext_vector_type(4)));
typedef short bf16x8 __attribute__((ext_vector_type(8)));
typedef GAS unsigned gu32;
typedef GAS unsigned long long gu64;
#define RLX_AGENT __ATOMIC_RELAXED, __HIP_MEMORY_SCOPE_AGENT
#define LDS_WAIT() asm volatile("s_waitcnt lgkmcnt(0)" ::: "memory")
#define VM_WAIT() asm volatile("s_waitcnt vmcnt(0)" ::: "memory")
__device__ __forceinline__ unsigned long long rt() { return __builtin_amdgcn_s_memrealtime(); }
__device__ __forceinline__ unsigned f2bf(float f) { unsigned u = __builtin_bit_cast(unsigned, f); return (u + 0x7fffu + ((u >> 16) & 1u)) >> 16; }
__device__ __forceinline__ unsigned pk2(float lo, float hi) { return f2bf(lo) | (f2bf(hi) << 16); }

#define XB_TMO      128
#define XB_XCNT(j)  (256  + 64 * (j))
#define XB_XSUB(j)  (1280 + 64 * (j))
#define XB_XGEN(j)  (2304 + 64 * (j))
#define XB_TOP      3328
#define XB_TOPGEN   3392
#define XCD_BAR_WORDS 3456
#define XB_SPIN_CAP (1u << 18)

__device__ __forceinline__ unsigned xb_ld(unsigned* p)              { return __hip_atomic_load(p, __ATOMIC_RELAXED, __HIP_MEMORY_SCOPE_AGENT); }
__device__ __forceinline__ unsigned xb_add(unsigned* p, unsigned v) { return __hip_atomic_fetch_add(p, v, __ATOMIC_RELAXED, __HIP_MEMORY_SCOPE_AGENT); }
__device__ __forceinline__ unsigned xb_xcc_id() { return (unsigned)__builtin_amdgcn_s_getreg((3 << 11) | 20) & 0xFu; }
#define XB_SPIN(cond, bar) do { unsigned _sp = 0; while (cond) { __builtin_amdgcn_s_sleep(1); \
    if ((++_sp & 255u) == 0u) { if (xb_ld(&(bar)[XB_TMO])) break; if (_sp > XB_SPIN_CAP) { atomicAdd(&(bar)[XB_TMO], 1u); break; } } } } while (0)

struct XcdBarrier {
    unsigned* bar; unsigned x;
    volatile LAS unsigned* st;
};

__device__ __forceinline__ XcdBarrier xcd_barrier_post(unsigned* bar, volatile LAS unsigned* st) {
    XcdBarrier b; b.bar = bar; b.x = xb_xcc_id(); b.st = st;
    if (threadIdx.x == 0) (void)xb_add(&bar[XB_XCNT(b.x)], 1u);
    return b;
}
__device__ __forceinline__ void xcd_barrier_complete(unsigned* bar, unsigned x, unsigned& nloc, unsigned& nx) {
    const unsigned G = gridDim.x * gridDim.y * gridDim.z;
    unsigned sum, cnt, mine, sp = 0u;
    for (;;) {
        sum = 0u; cnt = 0u; mine = 0u;
#pragma unroll
        for (unsigned j = 0; j < 16; ++j) { const unsigned c = xb_ld(&bar[XB_XCNT(j)]); sum += c; cnt += (c > 0u) ? 1u : 0u; mine = (j == x) ? c : mine; }
        if (sum == G) break;
        __builtin_amdgcn_s_sleep(1);
        if ((++sp & 255u) == 0u) { if (xb_ld(&bar[XB_TMO])) break; if (sp > XB_SPIN_CAP) { atomicAdd(&bar[XB_TMO], 1u); break; } }
    }
    nloc = mine > 0u ? mine : 1u; nx = cnt > 0u ? cnt : 1u;
}

__device__ __forceinline__ void xcd_barrier(const XcdBarrier& b) {
    asm volatile("s_waitcnt vmcnt(0)" ::: "memory");
    __syncthreads();
    if (threadIdx.x == 0) {
        unsigned* bar = b.bar;
        __builtin_amdgcn_s_waitcnt(0);
        unsigned nloc = b.st[0], nx = b.st[1];
        if (nloc == 0u) { xcd_barrier_complete(bar, b.x, nloc, nx); b.st[0] = nloc; b.st[1] = nx; }
        const unsigned old = xb_add(&bar[XB_XSUB(b.x)], 1u);
        const unsigned gen = old / nloc;
        if (old + 1u == (gen + 1u) * nloc) {
            __builtin_amdgcn_fence(__ATOMIC_RELEASE, "agent");
            asm volatile("s_waitcnt vmcnt(0)" ::: "memory");
            const unsigned og = xb_add(&bar[XB_TOP], 1u);
            const unsigned tg = og / nx;
            if (og + 1u == (tg + 1u) * nx) xb_add(&bar[XB_TOPGEN], 1u);
            else XB_SPIN(xb_ld(&bar[XB_TOPGEN]) == tg, bar);
            __builtin_amdgcn_fence(__ATOMIC_ACQUIRE, "agent");
            xb_add(&bar[XB_XGEN(b.x)], 1u);
            asm volatile("s_waitcnt vmcnt(0)" ::: "memory");
        } else {
            XB_SPIN(xb_ld(&bar[XB_XGEN(b.x)]) == gen, bar);
            __builtin_amdgcn_fence(__ATOMIC_ACQUIRE, "agent");
            asm volatile("s_waitcnt vmcnt(0)" ::: "memory");
        }
    }
    __syncthreads();
}
constexpr int NWAVES = 8;
constexpr int DM = 1024, NBATCH = 8, SEQ = 4096, NMETA = 16;
constexpr int MROWS = NBATCH * SEQ;
constexpr int LPB = SEQ + 64;
constexpr int PROWS = NBATCH * LPB + 64;
constexpr int MZ = MROWS + 256;
constexpr int NZ = 5376, DIN = 5136;
constexpr int C_DAQ = 0, C_DAK = 512, C_DAV = 1024, C_GQ = 1536, C_GK = 1792, C_GV = 2048, C_GR = 2560, C_GG = 3072, C_GL = 3088;
constexpr float EPS = 1e-6f;
constexpr int NEXP = 32, DEXP = 512, LCAP = 32768;
constexpr int NPOS = SEQ + NMETA;

constexpr size_t MiB = 1u << 20;
constexpr size_t WS_CTL = 0, CTL_ZERO_BYTES = 1 * MiB, WS_TRASH = 768 * 1024;
constexpr size_t WS_ROPE = 1 * MiB;
constexpr size_t WS_WRH = 3 * MiB, WS_WRL = 3 * MiB + 128 * 1024;
constexpr size_t WS_IG2 = 3 * MiB + 512 * 1024;
constexpr size_t WS_LTOK = 4 * MiB, WS_LRS = 12 * MiB, WS_LW = 20 * MiB;
constexpr size_t WS_WIN = 28 * MiB, WS_WBR = 39 * MiB, WS_WOUT = 41 * MiB, WS_WGU = 43 * MiB, WS_WD = 107 * MiB;
constexpr size_t WS_R1 = 139 * MiB;
constexpr size_t WS_Q = 204 * MiB, WS_K = 236 * MiB, WS_V = 269 * MiB;
constexpr size_t WS_OA = 204 * MiB, WS_H2U = 204 * MiB;
constexpr size_t WS_GQ = 302 * MiB, WS_GK = 319 * MiB, WS_GV = 336 * MiB, WS_GR = 369 * MiB, WS_LOGA = 402 * MiB;
constexpr size_t WS_HID = 302 * MiB;
constexpr size_t WS_H2U8 = 269 * MiB;
constexpr float W8SCALE = 32.0f, H8SCALE = 4.0f;
constexpr size_t WS_DS = 435 * MiB, WS_END = 500 * MiB;
static_assert(WS_R1 + (size_t)MZ * DM * 2 <= WS_Q && WS_K + (size_t)PROWS * 512 * 2 <= WS_V && WS_V + (size_t)PROWS * 512 * 2 <= WS_GQ, "ws map 1");
static_assert(WS_GQ + (size_t)PROWS * 256 * 2 <= WS_GK && WS_GK + (size_t)PROWS * 256 * 2 <= WS_GV && WS_GV + (size_t)PROWS * 512 * 2 <= WS_GR && WS_GR + (size_t)PROWS * 512 * 2 <= WS_LOGA && WS_LOGA + (size_t)PROWS * 256 * 4 <= WS_DS, "ws map 2");
static_assert(WS_HID + (size_t)81920 * 512 * 2 <= WS_DS && WS_DS + (size_t)32 * 64 * 8192 * 4 <= WS_END && WS_WIN + (size_t)NZ * DM * 2 <= WS_WBR && WS_WD + (size_t)32 * 1024 * 512 * 2 <= WS_R1, "ws map 3");
constexpr int CW_TMO = 0, CW_BAR = 4096, CW_CNT = 16384;

constexpr int RING_OFF = 0, RING_BYTES = 131072;
constexpr int LDSCTL_OFF = RING_BYTES, MISC_OFF = LDSCTL_OFF + 320, TB_OFF = LDSCTL_OFF + 1024, CN_OFF = LDSCTL_OFF + 1536;
constexpr int LDS_BYTES = 147456;
struct Frame {
    LAS unsigned char* lds;
    volatile LAS unsigned* MISC;
    gu32* ctl;
    int tid, lane, wave, vcu, G;
    const float* in[25]; float* out; unsigned char* ws;
};
enum { I_X = 0, I_META, I_GMIX, I_WIN, I_GQN, I_GKN, I_LQ1, I_LK1, I_LQ2, I_LK2, I_GSUB, I_WGUP, I_BGATE, I_GGLA, I_WBR, I_BMERGE, I_WOUT, I_GFFN, I_WRG, I_BRG, I_WRE, I_BRE, I_WEG, I_WEU, I_WED };
#define WSP(T, off) ((T*)(F.ws + (off)))

__device__ __forceinline__ float wave_sum(float v) {
#pragma unroll
    for (int o = 1; o < 64; o <<= 1) v += __shfl_xor(v, o);
    return v;
}
__device__ __forceinline__ float bf2f(bf16 v) { return __uint_as_float((unsigned)v << 16); }
__device__ __forceinline__ float sigmoidf_(float x) { return 1.0f / (1.0f + __expf(-x)); }

__device__ __forceinline__ void transpose_tile(const float* src, int Ns, bf16* dst, int Kd, LAS float* scr, int lane) {
    float tv[32];
#pragma unroll
    for (int i = 0; i < 32; ++i) tv[i] = src[(unsigned)((2 * i + (lane >> 5)) * Ns + (lane & 31))];
#pragma unroll
    for (int i = 0; i < 32; ++i) scr[(2 * i + (lane >> 5)) * 33 + (lane & 31)] = tv[i];
    LDS_WAIT(); asm volatile("" ::: "memory");
    const int c = lane & 7;
#pragma unroll
    for (int j = 0; j < 4; ++j) { const int n = (lane >> 3) + 8 * j; const LAS float* s = scr + (8 * c) * 33 + n;
        v4u o; o.x = pk2(s[0 * 33], s[1 * 33]); o.y = pk2(s[2 * 33], s[3 * 33]); o.z = pk2(s[4 * 33], s[5 * 33]); o.w = pk2(s[6 * 33], s[7 * 33]);
        *(GAS v4u*)(dst + (size_t)n * Kd + 8 * c) = o; }
    LDS_WAIT(); asm volatile("" ::: "memory");
}
__device__ __forceinline__ void product_tile(const float* win, const float* wgu, int k0, int n0, bf16* dst, LAS float* scr, int lane) {
    float wg[16];
#pragma unroll
    for (int r = 0; r < 16; ++r) wg[r] = wgu[r * 256 + n0 + (lane & 31)];
    LAS float* gb = scr + 64 * 33;
#pragma unroll
    for (int j = 0; j < 4; ++j) { const int idx = lane + 64 * j, kk = idx >> 2, q = idx & 3; *(LAS f32x4*)(gb + kk * 16 + 4 * q) = *(const GAS f32x4*)(win + (size_t)(k0 + kk) * DIN + C_GG + 4 * q); }
    LDS_WAIT(); asm volatile("" ::: "memory");
#pragma unroll 4
    for (int i = 0; i < 32; ++i) { const int kk = 2 * i + (lane >> 5); const LAS f32x4* g4 = (const LAS f32x4*)(gb + kk * 16); float s = 0.f;
#pragma unroll
        for (int q = 0; q < 4; ++q) { const f32x4 g = g4[q]; s += g.x * wg[4 * q] + g.y * wg[4 * q + 1] + g.z * wg[4 * q + 2] + g.w * wg[4 * q + 3]; }
        scr[kk * 33 + (lane & 31)] = s; }
    LDS_WAIT(); asm volatile("" ::: "memory");
    const int c = lane & 7;
#pragma unroll
    for (int j = 0; j < 4; ++j) { const int n = (lane >> 3) + 8 * j; const LAS float* s = scr + (8 * c) * 33 + n;
        v4u o; o.x = pk2(s[0 * 33], s[1 * 33]); o.y = pk2(s[2 * 33], s[3 * 33]); o.z = pk2(s[4 * 33], s[5 * 33]); o.w = pk2(s[6 * 33], s[7 * 33]);
        *(GAS v4u*)(dst + (size_t)n * DM + 8 * c) = o; }
    LDS_WAIT(); asm volatile("" ::: "memory");
}
__device__ __forceinline__ int win_src_col(int T, int p0) {
    if (T < 4) { const int bj = p0 >> 7, wc = (p0 >> 5) & 3; return (T < 2 ? C_DAQ + 256 * T : C_DAK + 256 * (T - 2)) + 64 * wc + 32 * bj; }
    if (T < 6) return C_DAV + 256 * (T - 4) + p0;
    if (T == 6) return C_GQ + p0;
    if (T == 7) return C_GK + p0;
    if (T < 10) return C_GV + 256 * (T - 8) + p0;
    if (T < 12) return C_GR + 256 * (T - 10) + p0;
    const int t = T - 13; return p0 < 128 ? C_GL + 128 * t + p0 : C_GL + 1024 + 128 * t + (p0 - 128);
}
template <int NR> __device__ __forceinline__ void rms_rows_to_bf16(Frame& F, const float* const (&xrow)[NR], const float* gain, bf16* const (&orow)[NR]) {
    const GAS f32x4* gr = (const GAS f32x4*)gain + F.lane;
    f32x4 v[NR][4];
#pragma unroll
    for (int r = 0; r < NR; ++r) { const GAS f32x4* xr = (const GAS f32x4*)xrow[r] + F.lane;
#pragma unroll
        for (int j = 0; j < 4; ++j) v[r][j] = xr[64 * j]; }
#pragma unroll
    for (int r = 0; r < NR; ++r) { float s = 0.f;
#pragma unroll
        for (int j = 0; j < 4; ++j) s += (v[r][j].x * v[r][j].x + v[r][j].y * v[r][j].y) + (v[r][j].z * v[r][j].z + v[r][j].w * v[r][j].w);
        const float rstd = 1.f / sqrtf(wave_sum(s) * (1.f / DM) + EPS);
        GAS unsigned long long* o8 = (GAS unsigned long long*)orow[r] + F.lane;
#pragma unroll
        for (int j = 0; j < 4; ++j) { const f32x4 g = gr[64 * j]; o8[64 * j] = (unsigned long long)pk2(v[r][j].x * rstd * g.x, v[r][j].y * rstd * g.y) | ((unsigned long long)pk2(v[r][j].z * rstd * g.z, v[r][j].w * rstd * g.w) << 32); } }
}
constexpr int N_EXPERT_ITEMS = NEXP * 256 + NEXP * 128;
__device__ __forceinline__ void expert_conv_desc(Frame& F, int it, const float*& src, unsigned char*& dst, unsigned& Ns, unsigned& Kd) {
    if (it < NEXP * 256) { const int e = it >> 8, q = it & 255, kb = q >> 4, nbp = q & 15, P0 = nbp * 64, pn = P0 >> 8, p = P0 & 255;
        src = (p < 128 ? F.in[I_WEG] : F.in[I_WEU]) + (size_t)e * 1024 * 512 + (size_t)(kb * 64) * 512 + 128 * pn + (p & 127); Ns = 512;
        dst = WSP(unsigned char, WS_WGU) + (size_t)(e * 1024 + P0) * 1024 + kb * 64; Kd = 1024; }
    else { const int r = it - NEXP * 256, e = r >> 7, q = r & 127, kb = q >> 4, nb = q & 15;
        src = F.in[I_WED] + (size_t)e * 512 * 1024 + (size_t)(kb * 64) * 1024 + nb * 64; Ns = 1024; dst = WSP(unsigned char, WS_WD) + (size_t)(e * 1024 + nb * 64) * 512 + kb * 64; Kd = 512; }
}
__device__ __forceinline__ float clamp8(float x) { return fminf(fmaxf(x, -448.0f), 448.0f); }
__device__ __forceinline__ unsigned pk4_fp8(float a, float b, float c, float d) { unsigned w = 0; w = __builtin_amdgcn_cvt_pk_fp8_f32(clamp8(a), clamp8(b), w, false); w = __builtin_amdgcn_cvt_pk_fp8_f32(clamp8(c), clamp8(d), w, true); return w; }
__device__ __forceinline__ void expert_conv_store(unsigned char* dst, unsigned Kd, const float (&v)[64], int lane, LAS unsigned char* stg) {
#pragma unroll
    for (int kg = 0; kg < 4; ++kg) { v4u o;
        o.x = pk4_fp8(v[16 * kg] * W8SCALE, v[16 * kg + 1] * W8SCALE, v[16 * kg + 2] * W8SCALE, v[16 * kg + 3] * W8SCALE); o.y = pk4_fp8(v[16 * kg + 4] * W8SCALE, v[16 * kg + 5] * W8SCALE, v[16 * kg + 6] * W8SCALE, v[16 * kg + 7] * W8SCALE);
        o.z = pk4_fp8(v[16 * kg + 8] * W8SCALE, v[16 * kg + 9] * W8SCALE, v[16 * kg + 10] * W8SCALE, v[16 * kg + 11] * W8SCALE); o.w = pk4_fp8(v[16 * kg + 12] * W8SCALE, v[16 * kg + 13] * W8SCALE, v[16 * kg + 14] * W8SCALE, v[16 * kg + 15] * W8SCALE);
        *(LAS v4u*)(stg + lane * 80 + kg * 16) = o; }
    LDS_WAIT(); asm volatile("" ::: "memory");
#pragma unroll
    for (int i = 0; i < 4; ++i) { const int r = (lane >> 2) + 16 * i, c = lane & 3; const v4u o = *(const LAS v4u*)(stg + r * 80 + c * 16); *(GAS v4u*)(dst + (size_t)r * Kd + 16 * c) = o; }
    LDS_WAIT(); asm volatile("" ::: "memory");
}
__device__ __forceinline__ void expert_conv_range(Frame& F, int first, int me, int nw) {
    const int stride = nw; LAS unsigned char* stg = F.lds + RING_OFF + F.wave * 9216;
    for (int it = first + me; it < N_EXPERT_ITEMS; it += 2 * stride) {
        const float *s0, *s1; unsigned char *d0, *d1; unsigned n0, k0, n1, k1; const bool two = it + stride < N_EXPERT_ITEMS;
        expert_conv_desc(F, it, s0, d0, n0, k0); expert_conv_desc(F, two ? it + stride : it, s1, d1, n1, k1);
        float va[64], vb[64];
#pragma unroll
        for (int k = 0; k < 64; ++k) va[k] = s0[(unsigned)k * n0 + (unsigned)F.lane];
        if (two) {
#pragma unroll
            for (int k = 0; k < 64; ++k) vb[k] = s1[(unsigned)k * n1 + (unsigned)F.lane]; }
        expert_conv_store(d0, k0, va, F.lane, stg);
        if (two) expert_conv_store(d1, k1, vb, F.lane, stg);
    }
    asm volatile("s_waitcnt lgkmcnt(0)" ::: "memory"); __syncthreads();
}
__device__ __forceinline__ void expert_conv_slot(Frame& F, int slot, int nslot, int first) { expert_conv_range(F, first, (slot * F.G + F.vcu) * NWAVES + F.wave, nslot * F.G * NWAVES); }
__device__ __forceinline__ void late_tables(Frame& F, int gt, int NGT) {
    { bf16* wh = WSP(bf16, WS_WRH); bf16* wl = WSP(bf16, WS_WRL);
      for (int i = gt; i < 48 * 1024; i += NGT) { const int n = i >> 10, k = i & 1023; const float v = n < 4 ? F.in[I_WRG][k * 4 + n] : (n < 36 ? F.in[I_WRE][k * 32 + (n - 4)] : 0.f);
          const unsigned h = f2bf(v); const float hf = __uint_as_float(h << 16); wh[i] = (bf16)h; wl[i] = (bf16)f2bf(v - hf); } }
    { float* ig = WSP(float, WS_IG2); for (int i = gt; i < DM; i += NGT) { const float g = F.in[I_GFFN][i]; ig[i] = 1.0f / (g * g); } }
    { unsigned* kz = (unsigned*)(WSP(bf16, WS_K) + (size_t)NBATCH * LPB * 512); unsigned* vz = (unsigned*)(WSP(bf16, WS_V) + (size_t)NBATCH * LPB * 512);
      for (int i = gt; i < 64 * 512 / 2; i += NGT) { kz[i] = 0u; vz[i] = 0u; } }
}
#define P1_EXTRA(G) (((MZ / 256) * (NZ / 256)) % (G))
constexpr int P1_TILES_PER_WAVE = 6;
__device__ __forceinline__ int p1_conv_items(int G) { const int ex = P1_EXTRA(G), n = ex ? (G - ex) * NWAVES * P1_TILES_PER_WAVE : 0; return n < N_EXPERT_ITEMS ? n : N_EXPERT_ITEMS; }
__device__ __forceinline__ void expert_conv_first(Frame& F, int me, int nw, int cnt) {
    LAS unsigned char* stg = F.lds + RING_OFF + F.wave * 9216;
    for (int it = me; it < cnt; it += 2 * nw) {
        const float *s0, *s1; unsigned char *d0, *d1; unsigned n0, k0, n1, k1; const bool two = it + nw < cnt;
        expert_conv_desc(F, it, s0, d0, n0, k0); expert_conv_desc(F, two ? it + nw : it, s1, d1, n1, k1);
        float va[64], vb[64];
#pragma unroll
        for (int k = 0; k < 64; ++k) va[k] = s0[(unsigned)k * n0 + (unsigned)F.lane];
        if (two) {
#pragma unroll
            for (int k = 0; k < 64; ++k) vb[k] = s1[(unsigned)k * n1 + (unsigned)F.lane]; }
        expert_conv_store(d0, k0, va, F.lane, stg);
        if (two) expert_conv_store(d1, k1, vb, F.lane, stg);
    }
}
__device__ __forceinline__ void p0_prologue(Frame& F) {
    LAS float* scr = (LAS float*)(F.lds + RING_OFF + F.wave * 16384);
    const int gw = F.vcu * NWAVES + F.wave, NGW = F.G * NWAVES;
    constexpr int I_A = (NZ / 32) * 16, I_B = 2 * 32 * 8, I_C = 32 * 16, NITEMS = I_A + I_B + I_C;
    bf16* WIN = WSP(bf16, WS_WIN); bf16* XN = WSP(bf16, WS_R1);
    for (int pass = 0; pass < 2; ++pass) {
    if ((pass == 0) == ((gw & 1) == 0)) {
    for (int it = gw; it < NITEMS; it += NGW) {
        int r = it; const float* src; bf16* dst; int Ns, Kd;
        if (r < I_A) { const int kb = r / (NZ / 32), nb = r % (NZ / 32), T = nb >> 3, p0 = (nb & 7) * 32; dst = WIN + (size_t)(nb * 32) * DM + kb * 64;
            if (T == 12) { product_tile(F.in[I_WIN], F.in[I_WGUP], kb * 64, p0, dst, scr, F.lane); continue; }
            src = F.in[I_WIN] + (size_t)(kb * 64) * DIN + win_src_col(T, p0); Ns = DIN; Kd = DM; }
        else if ((r -= I_A) < I_B) { const int br = r >> 8, q = r & 255, kb = q >> 5, nb = q & 31;
            src = F.in[I_WBR] + (size_t)br * 512 * 1024 + (size_t)(kb * 64) * 1024 + nb * 32; Ns = 1024; dst = WSP(bf16, WS_WBR) + (size_t)(br * 1024 + nb * 32) * 512 + kb * 64; Kd = 512; }
        else { r -= I_B; const int kb = r >> 5, nb = r & 31;
            src = F.in[I_WOUT] + (size_t)(kb * 64) * 1024 + nb * 32; Ns = 1024; dst = WSP(bf16, WS_WOUT) + (size_t)(nb * 32) * 1024 + kb * 64; Kd = 1024; }
        transpose_tile(src, Ns, dst, Kd, scr, F.lane);
    }
    } else {
    for (int m = gw; m < MROWS; m += 4 * NGW) {
        if (m + 3 * NGW < MROWS) { const float* const xr[4] = {F.in[I_X] + (size_t)m * DM, F.in[I_X] + (size_t)(m + NGW) * DM, F.in[I_X] + (size_t)(m + 2 * NGW) * DM, F.in[I_X] + (size_t)(m + 3 * NGW) * DM};
            bf16* const orr[4] = {XN + (size_t)m * DM, XN + (size_t)(m + NGW) * DM, XN + (size_t)(m + 2 * NGW) * DM, XN + (size_t)(m + 3 * NGW) * DM}; rms_rows_to_bf16<4>(F, xr, F.in[I_GMIX], orr); }
        else for (int k = 0; k < 4; ++k) { const int mm = m + k * NGW; if (mm < MROWS) { const float* const xr[1] = {F.in[I_X] + (size_t)mm * DM}; bf16* const orr[1] = {XN + (size_t)mm * DM}; rms_rows_to_bf16<1>(F, xr, F.in[I_GMIX], orr); } }
    }
    for (int m = MROWS + gw; m < MZ; m += NGW) {
        if (m < MROWS + NMETA) { const float* const xr[1] = {F.in[I_META] + (size_t)(m - MROWS) * DM}; bf16* const orr[1] = {XN + (size_t)m * DM}; rms_rows_to_bf16<1>(F, xr, F.in[I_GMIX], orr); }
        else { GAS v4u* o = (GAS v4u*)(XN + (size_t)m * DM) + F.lane; o[0] = (v4u){0u, 0u, 0u, 0u}; o[64] = (v4u){0u, 0u, 0u, 0u}; }
    }
    } }
    const int gt = gw * 64 + F.lane, NGT = NGW * 64;
    { float* rc = WSP(float, WS_ROPE); float* rs = rc + NPOS * 32;
      for (int i = gt; i < NPOS * 32; i += NGT) { const int pos = i >> 5, j = i & 31; const float inv = exp2f(-(float)j * 0.41524101186092029f); const float ang = (float)pos * inv;
          const double rev = (double)ang * 0.15915494309189535; const float x = (float)(rev - rint(rev));
          rc[i] = __builtin_amdgcn_cosf(x); rs[i] = __builtin_amdgcn_sinf(x); } }
}
namespace epi {
using pg8::f32x4; using pg8::u32x4; using pg8::Unit; using pg8::pack8; using pg8::HALF;
__device__ __forceinline__ unsigned pk4_fp8(float a, float b, float c, float d) { unsigned w = 0; w = __builtin_amdgcn_cvt_pk_fp8_f32(clamp8(a), clamp8(b), w, false); w = __builtin_amdgcn_cvt_pk_fp8_f32(clamp8(c), clamp8(d), w, true); return w; }
constexpr float Y8SCALE = 64.0f;
__device__ __forceinline__ float cy8(float y) { return y * Y8SCALE; }
__device__ __forceinline__ f32x4 un4_fp8(unsigned w) { typedef float f2_ __attribute__((ext_vector_type(2))); const f2_ a = __builtin_amdgcn_cvt_pk_f32_fp8(w, false), b = __builtin_amdgcn_cvt_pk_f32_fp8(w, true); return (f32x4){a[0], a[1], b[0], b[1]}; }
__device__ __forceinline__ float c8(float h) { return h * H8SCALE; }
__device__ __forceinline__ float log_sigmoid(float x) { return fminf(x, 0.f) - __logf(1.0f + __expf(-fabsf(x))); }

struct EpiZ {
    bf16 *Q, *K, *V, *GQ, *GK, *GV, *GR, *RATIO, *G1; float* LOGA;
    const float *gq, *gk, *bgate, *bmerge, *ropec, *ropes;
    __device__ __forceinline__ bool operator()(f32x4 (&acc)[2][2][4][2], const Unit& u, int wr, int wc, int fr, int fq) const {
        const int pn = u.pn, pm = u.pm; const bool meta = (pm == MROWS / 256);
        int oz; asm volatile("v_mov_b32 %0, 0" : "=v"(oz));
        const int r0 = wr * 64 + fr + oz, cl = wc * 32 + 8 * fq;
        const int bsh = 64 * ((pm >> 4) + 1);
        if (pn < 4) {
            const bool isq = pn < 2; if (isq && meta) return false;
            const float* gn = isq ? gq : gk;
            const f32x4 ga0 = *(const f32x4*)(gn + 8 * fq), ga1 = *(const f32x4*)(gn + 8 * fq + 4), gb0 = *(const f32x4*)(gn + 32 + 8 * fq), gb1 = *(const f32x4*)(gn + 36 + 8 * fq);
            const int hcol = ((pn & 1) * 4 + wc) * 64 + 8 * fq;
            const float osc = isq ? 0.125f * 1.4426950408889634f : 1.0f;
#pragma unroll
            for (int ai = 0; ai < 2; ++ai)
#pragma unroll
                for (int m = 0; m < 4; ++m) {
                    if (meta && (ai != 0 || wr != 0)) continue;
                    const int r = r0 + ai * HALF + m * 16;
                    const f32x4 x1a = acc[ai][0][m][0], x1b = acc[ai][0][m][1], x2a = acc[ai][1][m][0], x2b = acc[ai][1][m][1];
                    float ss = (x1a[0] * x1a[0] + x1a[1] * x1a[1]) + (x1a[2] * x1a[2] + x1a[3] * x1a[3]) + (x1b[0] * x1b[0] + x1b[1] * x1b[1]) + (x1b[2] * x1b[2] + x1b[3] * x1b[3])
                             + (x2a[0] * x2a[0] + x2a[1] * x2a[1]) + (x2a[2] * x2a[2] + x2a[3] * x2a[3]) + (x2b[0] * x2b[0] + x2b[1] * x2b[1]) + (x2b[2] * x2b[2] + x2b[3] * x2b[3]);
                    ss += __shfl_xor(ss, 16); ss += __shfl_xor(ss, 32);
                    const float rn = 1.0f / sqrtf(ss * (1.0f / 64.0f) + EPS);
                    const int pos = meta ? r : NMETA + ((pm * 256 + r) & (SEQ - 1));
                    const f32x4 c0 = *(const f32x4*)(ropec + pos * 32 + 8 * fq), c1 = *(const f32x4*)(ropec + pos * 32 + 8 * fq + 4), s0 = *(const f32x4*)(ropes + pos * 32 + 8 * fq), s1 = *(const f32x4*)(ropes + pos * 32 + 8 * fq + 4);
                    const f32x4 y1a = x1a * rn * ga0, y1b = x1b * rn * ga1, y2a = x2a * rn * gb0, y2b = x2b * rn * gb1;
                    const f32x4 o1a = (y1a * c0 - y2a * s0) * osc, o1b = (y1b * c1 - y2b * s1) * osc, o2a = (y2a * c0 + y1a * s0) * osc, o2b = (y2b * c1 + y1b * s1) * osc;
                    const u32x4 w1 = pack8(o1a, o1b), w2 = pack8(o2a, o2b);
                    if (isq) { bf16* p = Q + (size_t)(pm * 256 + r) * 512 + hcol; *(u32x4*)p = w1; *(u32x4*)(p + 32) = w2; }
                    else if (!meta) { bf16* p = K + (size_t)(pm * 256 + r + bsh) * 512 + hcol; *(u32x4*)p = w1; *(u32x4*)(p + 32) = w2; }
                    else { for (int b = 0; b < NBATCH; ++b) { bf16* p = K + (size_t)(b * LPB + r) * 512 + hcol; *(u32x4*)p = w1; *(u32x4*)(p + 32) = w2; } }
                    asm volatile("" ::: "memory");
                }
            return false;
        }
        if (pn < 12) {
            bf16* T; int pitch, cb; float sc = 1.0f; bool wmeta = true;
            if (pn < 6) { T = V; pitch = 512; cb = (pn - 4) * 256; }
            else if (pn == 6) { T = GQ; pitch = 256; cb = 0; sc = 0.125f; wmeta = false; }
            else if (pn == 7) { T = GK; pitch = 256; cb = 0; }
            else if (pn < 10) { T = GV; pitch = 512; cb = (pn - 8) * 256; }
            else { T = GR; pitch = 512; cb = (pn - 10) * 256; wmeta = false; }
            if (meta && !wmeta) return false;
#pragma unroll
            for (int ai = 0; ai < 2; ++ai)
#pragma unroll
                for (int m = 0; m < 4; ++m) {
                    if (meta && (ai != 0 || wr != 0)) continue;
                    const int r = r0 + ai * HALF + m * 16;
#pragma unroll
                    for (int bj = 0; bj < 2; ++bj) { const u32x4 w = pack8(acc[ai][bj][m][0] * sc, acc[ai][bj][m][1] * sc); const int col = cb + bj * HALF + cl;
                        if (!meta) *(u32x4*)(T + (size_t)(pm * 256 + r + bsh) * pitch + col) = w;
                        else for (int b = 0; b < NBATCH; ++b) *(u32x4*)(T + (size_t)(b * LPB + r) * pitch + col) = w; }
                    asm volatile("" ::: "memory");
                }
            return false;
        }
        if (pn == 12) {
#pragma unroll
            for (int bj = 0; bj < 2; ++bj) { const int col = bj * HALF + cl; const f32x4 b0 = *(const f32x4*)(bgate + col), b1 = *(const f32x4*)(bgate + col + 4);
#pragma unroll
                for (int ai = 0; ai < 2; ++ai)
#pragma unroll
                    for (int m = 0; m < 4; ++m) {
                        if (meta && (ai != 0 || wr != 0)) continue;
                        const int r = r0 + ai * HALF + m * 16; const f32x4 a0 = acc[ai][bj][m][0] + b0, a1 = acc[ai][bj][m][1] + b1; f32x4 v0, v1;
#pragma unroll
                        for (int i = 0; i < 4; ++i) { v0[i] = log_sigmoid(a0[i]) * (1.0f / 16.0f); v1[i] = log_sigmoid(a1[i]) * (1.0f / 16.0f); }
                        if (!meta) { float* p = LOGA + (size_t)(pm * 256 + r + bsh) * 256 + col; *(f32x4*)p = v0; *(f32x4*)(p + 4) = v1; }
                        else { if (r >= NMETA) { v0 = (f32x4){0.f, 0.f, 0.f, 0.f}; v1 = v0; }
                               for (int b = 0; b < NBATCH; ++b) { float* p = LOGA + (size_t)(b * LPB + r) * 256 + col; *(f32x4*)p = v0; *(f32x4*)(p + 4) = v1; } }
                        asm volatile("" ::: "memory");
                    } }
            return false;
        }
        if (meta) return false;
        { const int d = 128 * (pn - 13) + cl;
          const f32x4 b00 = *(const f32x4*)(bmerge + d), b01 = *(const f32x4*)(bmerge + d + 4), b10 = *(const f32x4*)(bmerge + DM + d), b11 = *(const f32x4*)(bmerge + DM + d + 4);
#pragma unroll
          for (int ai = 0; ai < 2; ++ai)
#pragma unroll
              for (int m = 0; m < 4; ++m) { const int r = r0 + ai * HALF + m * 16;
                  const f32x4 x00 = acc[ai][0][m][0] + b00, x01 = acc[ai][0][m][1] + b01, x10 = acc[ai][1][m][0] + b10, x11 = acc[ai][1][m][1] + b11; f32x4 ra, rb, ga, gb;
#pragma unroll
                  for (int i = 0; i < 4; ++i) { const float e0 = 1.0f + __expf(-x00[i]), e1 = 1.0f + __expf(-x10[i]); ra[i] = e1 * __builtin_amdgcn_rcpf(e0); ga[i] = __builtin_amdgcn_rcpf(e1);
                                                const float f0 = 1.0f + __expf(-x01[i]), f1 = 1.0f + __expf(-x11[i]); rb[i] = f1 * __builtin_amdgcn_rcpf(f0); gb[i] = __builtin_amdgcn_rcpf(f1); }
                  const size_t o = (size_t)(pm * 256 + r) * DM + d; *(u32x4*)(RATIO + o) = pack8(ra, rb); *(u32x4*)(G1 + o) = pack8(ga, gb); asm volatile("" ::: "memory"); } }
        return false;
    }
};
struct EpiMerge {
    const bf16 *RATIO, *G1; bf16* MERGED;
    __device__ __forceinline__ bool operator()(f32x4 (&acc)[2][2][4][2], const Unit& u, int wr, int wc, int fr, int fq) const {
        const int br = u.aux, pm = u.pm - (MROWS / 256) * br, pn = u.pn - 4 * br;
        const int r0 = pm * 256 + wr * 64 + fr, c0 = pn * 256 + wc * 32 + 8 * fq;
        const bf16* src = br ? G1 : RATIO;
#pragma unroll
        for (int ai = 0; ai < 2; ++ai) { u32x4 g[4][2];
#pragma unroll
            for (int m = 0; m < 4; ++m)
#pragma unroll
                for (int bj = 0; bj < 2; ++bj) g[m][bj] = *(const u32x4*)(src + (size_t)(r0 + ai * HALF + m * 16) * DM + c0 + bj * HALF);
#pragma unroll
            for (int m = 0; m < 4; ++m)
#pragma unroll
                for (int bj = 0; bj < 2; ++bj) { const size_t o = (size_t)(r0 + ai * HALF + m * 16) * DM + c0 + bj * HALF; const u32x4 gg = g[m][bj];
                    const f32x4 g0 = {pg8::bf_lo(gg.x), pg8::bf_hi(gg.x), pg8::bf_lo(gg.y), pg8::bf_hi(gg.y)}, g1 = {pg8::bf_lo(gg.z), pg8::bf_hi(gg.z), pg8::bf_lo(gg.w), pg8::bf_hi(gg.w)};
                    const f32x4 v0 = acc[ai][bj][m][0] * g0, v1 = acc[ai][bj][m][1] * g1;
                    if (br) *(u32x4*)(MERGED + o) = pack8(v0, v1); else { acc[ai][bj][m][0] = v0; acc[ai][bj][m][1] = v1; } }
            asm volatile("" ::: "memory"); }
        return br == 0;
    }
};
struct EpiOut {
    const float* x; bf16* H2U; const float* gffn; unsigned char* H2U8;
    __device__ __forceinline__ bool operator()(f32x4 (&acc)[2][2][4][2], const Unit& u, int wr, int wc, int fr, int fq) const {
        const int r0 = u.pm * 256 + wr * 64 + fr, c0 = u.pn * 256 + wc * 32 + 8 * fq;
#pragma unroll
        for (int bj = 0; bj < 2; ++bj) { const f32x4 ga = *(const f32x4*)(gffn + c0 + bj * HALF), gb = *(const f32x4*)(gffn + c0 + bj * HALF + 4);
#pragma unroll
            for (int ai = 0; ai < 2; ++ai) { f32x4 xa[4], xb[4];
#pragma unroll
                for (int m = 0; m < 4; ++m) { const size_t o = (size_t)(r0 + ai * HALF + m * 16) * DM + c0 + bj * HALF; xa[m] = *(const f32x4*)(x + o); xb[m] = *(const f32x4*)(x + o + 4); }
#pragma unroll
                for (int m = 0; m < 4; ++m) { const size_t o = (size_t)(r0 + ai * HALF + m * 16) * DM + c0 + bj * HALF;
                    const f32x4 u0 = xa[m] + acc[ai][bj][m][0], u1 = xb[m] + acc[ai][bj][m][1];
                    const f32x4 h0 = u0 * ga, h1 = u1 * gb; *(u32x4*)(H2U + o) = pack8(h0, h1); *(pg8::u32x2*)(H2U8 + o) = (pg8::u32x2){pk4_fp8(h0[0], h0[1], h0[2], h0[3]), pk4_fp8(h1[0], h1[1], h1[2], h1[3])}; }
                asm volatile("" ::: "memory"); } }
        return false;
    }
};
template <bool GATHER_> struct MoeSched {
    static constexpr bool GATHER = GATHER_;
    const LAS int* tb; const LAS int* cn; const int* ltok; int seg_lo, seg_hi, G, c;
    __device__ __forceinline__ bool next(int i, Unit& u) const {
        const int t0 = __builtin_amdgcn_readfirstlane(tb[seg_lo]), t1 = __builtin_amdgcn_readfirstlane(tb[seg_hi]);
        const int U = (t1 - t0) * 4, R = U / G, r = U - R * G; int L, hf = 0;
        if (i < R) L = i * G + c;
        else if (i > R) return false;
        else if (2 * r <= G) { if (c >= 2 * r) return false; L = R * G + (c >> 1); hf = 1 + (c & 1); }
        else { if (c >= r) return false; L = R * G + c; }
        const int rt = t0 + (L >> 2), pnl = L & 3; int s = seg_lo, hi_ = seg_hi;
        while (hi_ - s > 1) { const int mid = (s + hi_) >> 1; if (__builtin_amdgcn_readfirstlane(tb[mid]) <= rt) s = mid; else hi_ = mid; }
        u.pm = rt; u.pn = (s & 31) * 4 + pnl; u.aux = s | ((rt - __builtin_amdgcn_readfirstlane(tb[s])) << 8); u.half = hf; return true;
    }
    __device__ __forceinline__ int grow(const Unit& u, int r) const { const int s = u.aux & 255, si = (u.aux >> 8) * 256 + r, last = cn[s] - 1; return ltok[(size_t)s * LCAP + (si < last ? si : last)]; }
};
struct EpiUp {
    const LAS int* cn; const float* lrs; unsigned char* HID;
    __device__ __forceinline__ bool operator()(f32x4 (&acc)[2][2][4][2], const Unit& u, int wr, int wc, int fr, int fq) const {
        const int s = u.aux & 255, rtl = u.aux >> 8, last = cn[s] - 1, pnl = u.pn & 3; float rsv[2][4];
#pragma unroll
        for (int ai = 0; ai < 2; ++ai)
#pragma unroll
            for (int m = 0; m < 4; ++m) { if (u.half == 2 - ai) { rsv[ai][m] = 0.f; continue; } const int si = rtl * 256 + wr * 64 + fr + ai * HALF + m * 16; rsv[ai][m] = lrs[(size_t)s * LCAP + (si < last ? si : last)] * (1.0f / W8SCALE); }
#pragma unroll
        for (int ai = 0; ai < 2; ++ai)
#pragma unroll
            for (int m = 0; m < 4; ++m) { if (u.half == 2 - ai) continue; const int r = wr * 64 + fr + ai * HALF + m * 16; const float rs = rsv[ai][m];
                f32x4 h0, h1;
#pragma unroll
                for (int i = 0; i < 4; ++i) { const float g0 = acc[ai][0][m][0][i] * rs, g1 = acc[ai][0][m][1][i] * rs;
                    h0[i] = g0 * __builtin_amdgcn_rcpf(1.0f + __expf(-g0)) * (acc[ai][1][m][0][i] * rs); h1[i] = g1 * __builtin_amdgcn_rcpf(1.0f + __expf(-g1)) * (acc[ai][1][m][1][i] * rs); }
                *(pg8::u32x2*)(HID + (size_t)(u.pm * 256 + r) * DEXP + pnl * 128 + wc * 32 + 8 * fq) = (pg8::u32x2){pk4_fp8(c8(h0[0]), c8(h0[1]), c8(h0[2]), c8(h0[3])), pk4_fp8(c8(h1[0]), c8(h1[1]), c8(h1[2]), c8(h1[3]))}; }
        return false;
    }
};
template <int MODE> struct EpiDown {
    const LAS int* cn; const int* ltok; const float* lw; float* out; unsigned char* Y0; float* trash; const bf16* H2U; const float* gffn;
    __device__ __forceinline__ bool operator()(f32x4 (&acc)[2][2][4][2], const Unit& u, int wr, int wc, int fr, int fq) const {
        const int s = u.aux & 255, rtl = u.aux >> 8, cnt = cn[s], pnl = u.pn & 3; int tok[2][4]; float wv[2][4];
#pragma unroll
        for (int ai = 0; ai < 2; ++ai)
#pragma unroll
            for (int m = 0; m < 4; ++m) { const int si = rtl * 256 + wr * 64 + fr + ai * HALF + m * 16, sc = si < cnt ? si : cnt - 1; tok[ai][m] = ltok[(size_t)s * LCAP + sc]; wv[ai][m] = lw[(size_t)s * LCAP + sc] * (1.0f / (W8SCALE * H8SCALE)); }
        const int cofs = pnl * 256 + wc * 32 + 8 * fq;
        f32x4 ig[2][2];
        if (MODE == 1) {
#pragma unroll
            for (int bj = 0; bj < 2; ++bj)
#pragma unroll
                for (int n = 0; n < 2; ++n) { const f32x4 g = *(const f32x4*)(gffn + cofs + bj * HALF + 4 * n); ig[bj][n] = (f32x4){__builtin_amdgcn_rcpf(g[0]), __builtin_amdgcn_rcpf(g[1]), __builtin_amdgcn_rcpf(g[2]), __builtin_amdgcn_rcpf(g[3])}; } }
#pragma unroll
        for (int ai = 0; ai < 2; ++ai)
#pragma unroll
            for (int mp = 0; mp < 4; mp += 2) { if (u.half == 2 - ai) continue; float* po[2]; unsigned char* py[2]; const bf16* ph[2]; pg8::u32x2 yv[2][2]; u32x4 hv[2][2];
#pragma unroll
                for (int k = 0; k < 2; ++k) { const int m = mp + k, si = rtl * 256 + wr * 64 + fr + ai * HALF + m * 16; const bool ok = si < cnt;
                    po[k] = ok ? out + (size_t)tok[ai][m] * DM + cofs : trash + cofs; py[k] = ok ? Y0 + (size_t)tok[ai][m] * DM + cofs : (unsigned char*)(trash + DM) + cofs; ph[k] = H2U + (size_t)tok[ai][m] * DM + cofs; }
                if (MODE == 1) {
#pragma unroll
                    for (int k = 0; k < 2; ++k)
#pragma unroll
                        for (int bj = 0; bj < 2; ++bj) { yv[k][bj] = *(const pg8::u32x2*)(py[k] + bj * HALF); hv[k][bj] = *(const u32x4*)(ph[k] + bj * HALF); } }
#pragma unroll
                for (int k = 0; k < 2; ++k) { const int m = mp + k; const float w = wv[ai][m];
#pragma unroll
                    for (int bj = 0; bj < 2; ++bj) {
                        if (MODE == 0) { const f32x4 a0 = acc[ai][bj][m][0] * w, a1 = acc[ai][bj][m][1] * w; *(pg8::u32x2*)(py[k] + bj * HALF) = (pg8::u32x2){pk4_fp8(cy8(a0[0]), cy8(a0[1]), cy8(a0[2]), cy8(a0[3])), pk4_fp8(cy8(a1[0]), cy8(a1[1]), cy8(a1[2]), cy8(a1[3]))}; }
                        else { const pg8::u32x2 y = yv[k][bj]; const u32x4 h = hv[k][bj]; float* p = po[k] + bj * HALF;
                            const f32x4 ya = un4_fp8(y.x) * (1.0f / Y8SCALE), yb = un4_fp8(y.y) * (1.0f / Y8SCALE);
                            const f32x4 ha = {pg8::bf_lo(h.x), pg8::bf_hi(h.x), pg8::bf_lo(h.y), pg8::bf_hi(h.y)}, hb = {pg8::bf_lo(h.z), pg8::bf_hi(h.z), pg8::bf_lo(h.w), pg8::bf_hi(h.w)};
                            *(f32x4*)p = (ha * ig[bj][0] + ya) + acc[ai][bj][m][0] * w; *(f32x4*)(p + 4) = (hb * ig[bj][1] + yb) + acc[ai][bj][m][1] * w; } } }
                asm volatile("" ::: "memory"); }
        return false;
    }
};
}
constexpr int GP = 144;
typedef LAS unsigned char* ldsp;
__device__ __forceinline__ pg8::bf16x8 ldfrag(ldsp base, int row, int ks, int fq) { return *(const LAS pg8::bf16x8*)(base + row * GP + ks * 64 + fq * 16); }
#define MFMA16(a, b, c) __builtin_amdgcn_mfma_f32_16x16x32_bf16((a), (b), (c), 0, 0, 0)
constexpr size_t WS_O0 = WS_DS, WS_QD = WS_DS + 32 * MiB, WS_GG = WS_DS + 48 * MiB, WS_GD = WS_DS + 56 * MiB;
__device__ __forceinline__ void gla_x(Frame& F, int unit) {
    const int bh = unit >> 3, g = unit & 7, b = bh >> 2, h = bh & 3, d = F.tid & 63, tq = F.wave, fr = F.lane & 15, fq = F.lane >> 4;
    LAS float* part = (LAS float*)(F.lds + 0); LAS float* TOT = (LAS float*)(F.lds + 2048);
    const ldsp QT = F.lds + 4096, KT = F.lds + 13312, AH = F.lds + 22528, VT = F.lds + 31744, SB = F.lds + 50176, PP = F.lds + 68608;
    for (int i = F.tid; i < 128 * GP / 4; i += NWAVES * 64) ((LAS unsigned*)SB)[i] = 0u;
    pg8::f32x4 accS[4];
#pragma unroll
    for (int db = 0; db < 4; ++db) accS[db] = (pg8::f32x4){0.f, 0.f, 0.f, 0.f};
    float cd = 1.0f;
    const int c_first = g ? 8 * g + 1 : 0, c_last = 8 * g + 8;
    bf16* QD = WSP(bf16, WS_QD); bf16* O0 = WSP(bf16, WS_O0);
    const float* LOGA = WSP(float, WS_LOGA); const bf16* GQ = WSP(bf16, WS_GQ); const bf16* GK = WSP(bf16, WS_GK); const bf16* GV = WSP(bf16, WS_GV);
    float an[8]; bf16 qn[8], kn[8]; v4u vn[2];
#define GX_LOAD(cc) do { const size_t ro_ = (size_t)(b * LPB + 64 * (cc) + 8 * tq) * 256 + h * 64 + d; \
        _Pragma("unroll") for (int i_ = 0; i_ < 8; ++i_) { an[i_] = LOGA[ro_ + i_ * 256]; qn[i_] = GQ[ro_ + i_ * 256]; kn[i_] = GK[ro_ + i_ * 256]; } \
        _Pragma("unroll") for (int j_ = 0; j_ < 2; ++j_) { const int p_ = F.tid + 512 * j_; vn[j_] = *(const GAS v4u*)(GV + (size_t)(b * LPB + 64 * (cc) + (p_ >> 4)) * 512 + h * 128 + (p_ & 15) * 8); } } while (0)
    GX_LOAD(c_first);
    for (int c = c_first; c <= c_last; ++c) {
        const int mrow0 = b * SEQ + 64 * (c - 1);
        float bt[8]; bt[0] = an[0];
#pragma unroll
        for (int i = 1; i < 8; ++i) bt[i] = bt[i - 1] + an[i];
        part[tq * 64 + d] = bt[7];
        __syncthreads();
        float off = 0.f, tot = 0.f;
#pragma unroll
        for (int j = 0; j < 8; ++j) { const float p = part[j * 64 + d]; tot += p; if (j < tq) off += p; }
        if (tq == 0) TOT[d] = tot;
        float kh[8];
#pragma unroll
        for (int i = 0; i < 8; ++i) { const float bti = bt[i] + off; const float kk = bf2f(kn[i]); const float qv = bf2f(qn[i]) * __expf(bti), kv = kk * __expf(fminf(-bti, 80.f)); kh[i] = kk * __expf(tot - bti);
            *(LAS bf16*)(QT + (8 * tq + i) * GP + d * 2) = (bf16)f2bf(qv); *(LAS bf16*)(KT + (8 * tq + i) * GP + d * 2) = (bf16)f2bf(kv);
            if (c >= 1) QD[(size_t)(mrow0 + 8 * tq + i) * 256 + h * 64 + d] = (bf16)f2bf(qv * cd); }
        { v4u w; w.x = pk2(kh[0], kh[1]); w.y = pk2(kh[2], kh[3]); w.z = pk2(kh[4], kh[5]); w.w = pk2(kh[6], kh[7]); *(LAS v4u*)(AH + d * GP + tq * 16) = w; }
        cd *= __expf(tot);
#pragma unroll
        for (int j = 0; j < 2; ++j) { const int p = F.tid + 512 * j, sv = p >> 4, ec = p & 15; const unsigned ww[4] = {vn[j].x, vn[j].y, vn[j].z, vn[j].w};
#pragma unroll
            for (int i = 0; i < 4; ++i) { *(LAS bf16*)(VT + (8 * ec + 2 * i) * GP + sv * 2) = (bf16)(ww[i] & 0xffffu); *(LAS bf16*)(VT + (8 * ec + 2 * i + 1) * GP + sv * 2) = (bf16)(ww[i] >> 16); } }
        if (c < c_last) GX_LOAD(c + 1);
        __syncthreads();
        const int tb = tq >> 1, t0 = 16 * tb, t = t0 + fr;
#pragma unroll
        for (int sbi = 0; sbi < 2; ++sbi) { const int s0 = 16 * (2 * (tq & 1) + sbi); pg8::f32x4 a = {0.f, 0.f, 0.f, 0.f};
#pragma unroll
            for (int ks = 0; ks < 2; ++ks) a = MFMA16(ldfrag(KT, s0 + fr, ks, fq), ldfrag(QT, t0 + fr, ks, fq), a);
            const int s = s0 + 4 * fq;
            const float p0 = (s + 0 <= t) ? a[0] : 0.f, p1 = (s + 1 <= t) ? a[1] : 0.f, p2 = (s + 2 <= t) ? a[2] : 0.f, p3 = (s + 3 <= t) ? a[3] : 0.f;
            *(LAS unsigned*)(PP + t * GP + s * 2) = pk2(p0, p1); *(LAS unsigned*)(PP + t * GP + s * 2 + 4) = pk2(p2, p3); }
#pragma unroll
        for (int db = 0; db < 4; ++db) { const pg8::f32x4 tv = *(const LAS pg8::f32x4*)(TOT + 16 * db + 4 * fq);
            accS[db][0] *= __expf(tv[0]); accS[db][1] *= __expf(tv[1]); accS[db][2] *= __expf(tv[2]); accS[db][3] *= __expf(tv[3]); }
#pragma unroll
        for (int ks = 0; ks < 2; ++ks) { const pg8::bf16x8 bfr = ldfrag(VT, 16 * tq + fr, ks, fq);
#pragma unroll
            for (int db = 0; db < 4; ++db) accS[db] = MFMA16(ldfrag(AH, 16 * db + fr, ks, fq), bfr, accS[db]); }
        __syncthreads();
        if (c >= 1) {
            const int eh = tq & 1; pg8::f32x4 o[4];
#pragma unroll
            for (int eb = 0; eb < 4; ++eb) o[eb] = (pg8::f32x4){0.f, 0.f, 0.f, 0.f};
#pragma unroll
            for (int ks = 0; ks < 4; ++ks) { const pg8::bf16x8 bfr = ks < 2 ? ldfrag(PP, t0 + fr, ks, fq) : ldfrag(QT, t0 + fr, ks - 2, fq);
#pragma unroll
                for (int eb = 0; eb < 4; ++eb) { const int e0 = 64 * eh + 16 * eb; o[eb] = MFMA16(ks < 2 ? ldfrag(VT, e0 + fr, ks, fq) : ldfrag(SB, e0 + fr, ks - 2, fq), bfr, o[eb]); } }
            bf16* op = O0 + (size_t)(mrow0 + t) * 512 + h * 128 + 64 * eh + 4 * fq;
#pragma unroll
            for (int eb = 0; eb < 4; ++eb) *(GAS unsigned long long*)(op + 16 * eb) = (unsigned long long)pk2(o[eb][0], o[eb][1]) | ((unsigned long long)pk2(o[eb][2], o[eb][3]) << 32);
        }
        __syncthreads();
#pragma unroll
        for (int db = 0; db < 4; ++db) { LAS unsigned* sp = (LAS unsigned*)(SB + (16 * tq + fr) * GP + (16 * db + 4 * fq) * 2); sp[0] = pk2(accS[db][0], accS[db][1]); sp[1] = pk2(accS[db][2], accS[db][3]); }
    }
#undef GX_LOAD
    float* gg = WSP(float, WS_GG) + ((size_t)(bh * 8 + g) * 128 + 16 * tq + fr) * 64;
#pragma unroll
    for (int db = 0; db < 4; ++db) *(pg8::f32x4*)(gg + 16 * db + 4 * fq) = accS[db];
    if (tq == 0) WSP(float, WS_GD)[(bh * 8 + g) * 64 + d] = cd;
    __syncthreads();
}
__device__ __forceinline__ void gla_z(Frame& F, int unit) {
    const int bh = unit >> 3, g = unit & 7, b = bh >> 2, h = bh & 3, fr = F.lane & 15, fq = F.lane >> 4;
    const ldsp SB = F.lds + 0;
    { const pg8::f32x4* G4 = WSP(pg8::f32x4, WS_GG); const float* GD = WSP(float, WS_GD);
#pragma unroll
      for (int j = 0; j < 4; ++j) { const int q = F.tid + 512 * j, e = q >> 4, d4 = (q & 15) * 4; pg8::f32x4 S = {0.f, 0.f, 0.f, 0.f}, Gv[7], Dv[7];
#pragma unroll
          for (int gp = 0; gp < 7; ++gp) if (gp < g) { Dv[gp] = *(const pg8::f32x4*)(GD + (bh * 8 + gp) * 64 + d4); Gv[gp] = G4[(size_t)(bh * 8 + gp) * 2048 + q]; }
#pragma unroll
          for (int gp = 0; gp < 7; ++gp) if (gp < g) S = Dv[gp] * S + Gv[gp];
          *(LAS unsigned*)(SB + e * GP + d4 * 2) = pk2(S.x, S.y); *(LAS unsigned*)(SB + e * GP + d4 * 2 + 4) = pk2(S.z, S.w); } }
    __syncthreads();
    const bf16* QD = WSP(bf16, WS_QD); const bf16* O0 = WSP(bf16, WS_O0); const float* gg = F.in[I_GGLA];
    pg8::bf16x8 qf[2]; unsigned long long ow[8], rw[8];
#define GZ_LOAD(itn) do { const int tl_ = 512 * g + 128 * (itn) + 16 * F.wave + fr; const size_t mr_ = (size_t)(b * SEQ + tl_), pr_ = (size_t)(b * LPB + 64 + tl_); \
        _Pragma("unroll") for (int ks_ = 0; ks_ < 2; ++ks_) qf[ks_] = *(const pg8::bf16x8*)(QD + mr_ * 256 + h * 64 + 32 * ks_ + 8 * fq); \
        _Pragma("unroll") for (int eb_ = 0; eb_ < 8; ++eb_) { ow[eb_] = *(const GAS unsigned long long*)(O0 + mr_ * 512 + h * 128 + 16 * eb_ + 4 * fq); rw[eb_] = *(const GAS unsigned long long*)(WSP(bf16, WS_GR) + pr_ * 512 + h * 128 + 16 * eb_ + 4 * fq); } } while (0)
    GZ_LOAD(0);
    for (int it = 0; it < 4; ++it) {
        const int tl = 512 * g + 128 * it + 16 * F.wave + fr, mrow = b * SEQ + tl;
        pg8::f32x4 o[8];
#pragma unroll
        for (int eb = 0; eb < 8; ++eb) o[eb] = (pg8::f32x4){0.f, 0.f, 0.f, 0.f};
#pragma unroll
        for (int ks = 0; ks < 2; ++ks)
#pragma unroll
            for (int eb = 0; eb < 8; ++eb) o[eb] = MFMA16(ldfrag(SB, 16 * eb + fr, ks, fq), qf[ks], o[eb]);
        float ss = 0.f; float sr[8][4];
#pragma unroll
        for (int eb = 0; eb < 8; ++eb) { const unsigned long long w = ow[eb], r = rw[eb];
            o[eb][0] += __uint_as_float((unsigned)w << 16); o[eb][1] += __uint_as_float((unsigned)w & 0xffff0000u); o[eb][2] += __uint_as_float((unsigned)(w >> 32) << 16); o[eb][3] += __uint_as_float((unsigned)(w >> 32) & 0xffff0000u);
            ss += (o[eb][0] * o[eb][0] + o[eb][1] * o[eb][1]) + (o[eb][2] * o[eb][2] + o[eb][3] * o[eb][3]);
            sr[eb][0] = __uint_as_float((unsigned)r << 16); sr[eb][1] = __uint_as_float((unsigned)r & 0xffff0000u); sr[eb][2] = __uint_as_float((unsigned)(r >> 32) << 16); sr[eb][3] = __uint_as_float((unsigned)(r >> 32) & 0xffff0000u); }
        if (it < 3) GZ_LOAD(it + 1);
        ss += __shfl_xor(ss, 16); ss += __shfl_xor(ss, 32);
        const float rn = 1.0f / sqrtf(ss * (1.0f / 128.0f) + EPS);
        bf16* op = WSP(bf16, WS_OA) + (size_t)MROWS * 512 + (size_t)mrow * 512 + h * 128;
#pragma unroll
        for (int eb = 0; eb < 8; ++eb) { const int e = 16 * eb + 4 * fq; const pg8::f32x4 gv = *(const pg8::f32x4*)(gg + e);
            const float v0 = o[eb][0] * rn * gv.x * (sr[eb][0] * sigmoidf_(sr[eb][0])), v1 = o[eb][1] * rn * gv.y * (sr[eb][1] * sigmoidf_(sr[eb][1])), v2 = o[eb][2] * rn * gv.z * (sr[eb][2] * sigmoidf_(sr[eb][2])), v3 = o[eb][3] * rn * gv.w * (sr[eb][3] * sigmoidf_(sr[eb][3]));
            *(GAS unsigned long long*)(op + e) = (unsigned long long)pk2(v0, v1) | ((unsigned long long)pk2(v2, v3) << 32); }
    }
#undef GZ_LOAD
    __syncthreads();
}
__device__ __forceinline__ void router_phase(Frame& F) {
    LAS float* lgp = (LAS float*)(F.lds + 0);
    LAS float* ssp = (LAS float*)(F.lds + 49152);
    LAS int* lcnt = (LAS int*)(F.lds + 51200); LAS int* lbase = lcnt + 64;
    const bf16* H = WSP(bf16, WS_H2U); const bf16* wh = WSP(bf16, WS_WRH); const bf16* wl = WSP(bf16, WS_WRL);
    int* ltok = WSP(int, WS_LTOK); float* lrs = WSP(float, WS_LRS); float* lw = WSP(float, WS_LW);
    const int fr = F.lane & 15, kg = F.lane >> 4, rbk = F.wave & 3, kh = F.wave >> 2;
    for (int rb = F.vcu; rb < MROWS / 128; rb += F.G) {
        if (F.tid < 64) lcnt[F.tid] = 0;
        const bf16* h0 = H + (size_t)(rb * 128 + rbk * 32 + fr) * DM + kh * 512 + 8 * kg; const bf16* h1 = h0 + 16 * DM;
        const bf16* whp = wh + (size_t)fr * DM + kh * 512 + 8 * kg; const bf16* wlp = wl + (size_t)fr * DM + kh * 512 + 8 * kg;
        pg8::f32x4 acc[2][3];
#pragma unroll
        for (int a = 0; a < 2; ++a)
#pragma unroll
            for (int cb = 0; cb < 3; ++cb) acc[a][cb] = (pg8::f32x4){0.f, 0.f, 0.f, 0.f};
        float ss0 = 0.f, ss1 = 0.f; const float* ig2 = WSP(float, WS_IG2) + kh * 512 + 8 * kg;
#pragma unroll 4
        for (int s = 0; s < 16; ++s) {
            const pg8::bf16x8 a0 = *(const pg8::bf16x8*)(h0 + 32 * s), a1 = *(const pg8::bf16x8*)(h1 + 32 * s);
            { const pg8::f32x4 ia = *(const pg8::f32x4*)(ig2 + 32 * s), ib = *(const pg8::f32x4*)(ig2 + 32 * s + 4); const float iv[8] = {ia[0], ia[1], ia[2], ia[3], ib[0], ib[1], ib[2], ib[3]};
#pragma unroll
              for (int j = 0; j < 8; ++j) { const float x0 = __uint_as_float((unsigned)(unsigned short)a0[j] << 16), x1 = __uint_as_float((unsigned)(unsigned short)a1[j] << 16); ss0 += x0 * x0 * iv[j]; ss1 += x1 * x1 * iv[j]; } }
#pragma unroll
            for (int cb = 0; cb < 3; ++cb) { const pg8::bf16x8 bh = *(const pg8::bf16x8*)(whp + (size_t)(16 * cb) * DM + 32 * s), bl = *(const pg8::bf16x8*)(wlp + (size_t)(16 * cb) * DM + 32 * s);
                acc[0][cb] = MFMA16(a0, bh, acc[0][cb]); acc[0][cb] = MFMA16(a0, bl, acc[0][cb]); acc[1][cb] = MFMA16(a1, bh, acc[1][cb]); acc[1][cb] = MFMA16(a1, bl, acc[1][cb]); }
        }
#pragma unroll
        for (int a = 0; a < 2; ++a)
#pragma unroll
            for (int cb = 0; cb < 3; ++cb)
#pragma unroll
                for (int i = 0; i < 4; ++i) lgp[(kh * 128 + rbk * 32 + a * 16 + 4 * kg + i) * 48 + 16 * cb + fr] = acc[a][cb][i];
        ss0 += __shfl_xor(ss0, 16); ss0 += __shfl_xor(ss0, 32); ss1 += __shfl_xor(ss1, 16); ss1 += __shfl_xor(ss1, 32);
        if (kg == 0) { ssp[kh * 128 + rbk * 32 + fr] = ss0; ssp[kh * 128 + rbk * 32 + 16 + fr] = ss1; }
        __syncthreads();
        int seg0 = 0, seg1 = 0, rk0 = 0, rk1 = 0; float w0 = 0.f, w1 = 0.f, rs = 0.f;
        if (F.tid < 128) {
            const LAS float* L0 = lgp + F.tid * 48; const LAS float* L1 = L0 + 128 * 48; rs = 1.0f / sqrtf((ssp[F.tid] + ssp[128 + F.tid]) * (1.0f / DM) + EPS);
            float gl[4];
#pragma unroll
            for (int j = 0; j < 4; ++j) gl[j] = (L0[j] + L1[j]) * rs + F.in[I_BRG][j];
            int gi = 0; float gm = gl[0];
#pragma unroll
            for (int j = 1; j < 4; ++j) if (gl[j] > gm) { gm = gl[j]; gi = j; }
            float gs = 0.f;
#pragma unroll
            for (int j = 0; j < 4; ++j) gs += expf(gl[j] - gm);
            const float gw_ = 1.0f / gs;
            float v1 = -INFINITY, v2 = -INFINITY; int i1 = 0, i2 = 0;
            for (int j = 0; j < 8; ++j) { const float v = (L0[4 + gi * 8 + j] + L1[4 + gi * 8 + j]) * rs + F.in[I_BRE][gi * 8 + j];
                if (v > v1) { v2 = v1; i2 = i1; v1 = v; i1 = j; } else if (v > v2) { v2 = v; i2 = j; } }
            const float e1 = 1.0f / (1.0f + expf(v2 - v1));
            w0 = gw_ * e1; w1 = gw_ * (1.0f - e1); seg0 = gi * 8 + i1; seg1 = 32 + gi * 8 + i2;
            rk0 = atomicAdd((int*)(lcnt + seg0), 1); rk1 = atomicAdd((int*)(lcnt + seg1), 1);
        }
        __syncthreads();
        if (F.tid < 64) { const int n = lcnt[F.tid]; lbase[F.tid] = n ? (int)__hip_atomic_fetch_add((unsigned*)(F.ctl + CW_CNT + F.tid), (unsigned)n, RLX_AGENT) : 0; }
        __syncthreads();
        if (F.tid < 128) { const int tok = rb * 128 + F.tid; const size_t p0 = (size_t)seg0 * LCAP + lbase[seg0] + rk0, p1 = (size_t)seg1 * LCAP + lbase[seg1] + rk1;
            ltok[p0] = tok; lrs[p0] = rs; lw[p0] = w0; ltok[p1] = tok; lrs[p1] = rs; lw[p1] = w1; }
        __syncthreads();
    }
}
#ifndef MK_N_LAUNCHES
#define MK_N_LAUNCHES 1
#endif
constexpr int N_PHASES = 10;
struct Args { const float* in[25]; float* out; unsigned char* ws; int ph_lo, ph_hi; };
__global__ void __launch_bounds__(NWAVES * 64, 2) fwd_kernel(Args args) {
    extern __shared__ __attribute__((aligned(16))) unsigned char lds[];
    Frame F;
    F.lds = (LAS unsigned char*)lds;
    F.MISC = (volatile LAS unsigned*)(F.lds + MISC_OFF);
    F.tid = threadIdx.x; F.lane = F.tid & 63; F.wave = __builtin_amdgcn_readfirstlane(F.tid >> 6);
    F.G = gridDim.x; { const int bx = blockIdx.x; F.vcu = (F.G % 8 == 0) ? (bx % 8) * (F.G / 8) + bx / 8 : bx; }
    F.ws = args.ws; F.out = args.out; F.ctl = (gu32*)(args.ws + WS_CTL);
#pragma unroll
    for (int i = 0; i < 25; ++i) F.in[i] = args.in[i];
    for (int u = F.tid; u < (LDS_BYTES - LDSCTL_OFF) / 4; u += NWAVES * 64) ((LAS unsigned*)(F.lds + LDSCTL_OFF))[u] = 0u;
    __syncthreads();
    XcdBarrier bar; bar.bar = (unsigned*)(F.ctl + CW_BAR); bar.x = 0; bar.st = nullptr;
    if (MK_N_LAUNCHES == 1) bar = xcd_barrier_post((unsigned*)(F.ctl + CW_BAR), F.MISC + 8);
    const int lo = args.ph_lo, hi = args.ph_hi;
#ifdef PROBE_K
    volatile LAS unsigned long long* prb = (volatile LAS unsigned long long*)(F.lds + LDSCTL_OFF + 2048); if (blockIdx.x == 0 && F.tid == 0) prb[0] = __builtin_amdgcn_s_memrealtime();
#define PROBE_AT(k) do { if ((k) == PROBE_K && blockIdx.x == 0 && F.tid == 0) prb[1] = __builtin_amdgcn_s_memrealtime(); } while (0)
#else
#define PROBE_AT(k) do {} while (0)
#endif
#ifndef PH_MASK
#define PH_MASK 0x3ff
#endif
#define IN(k) (((PH_MASK >> (k)) & 1) && lo <= (k) && (k) < hi)
#define SEAM(k) do { if (IN(k) && IN((k) + 1)) xcd_barrier(bar); PROBE_AT(k); } while (0)
    const LAS int* tbp = (const LAS int*)(F.lds + TB_OFF); const LAS int* cnp = (const LAS int*)(F.lds + CN_OFF);

    if (IN(0)) { p0_prologue(F); } SEAM(0);
    if (IN(1)) {
#ifdef SKEW_US
        { const unsigned long long t0_ = __builtin_amdgcn_s_memrealtime(), dl_ = (unsigned long long)(F.vcu & 7) * (SKEW_US * 100 / 8); while (__builtin_amdgcn_s_memrealtime() - t0_ < dl_) __builtin_amdgcn_s_sleep(8); }
#endif
        pg8::Gemm g{WSP(pg8::bf16_t, WS_R1), WSP(pg8::bf16_t, WS_WIN), DM}; pg8::StaticOrder S{MZ / 256, NZ / 256, F.G, (int)blockIdx.x};
        epi::EpiZ E{WSP(bf16, WS_Q), WSP(bf16, WS_K), WSP(bf16, WS_V), WSP(bf16, WS_GQ), WSP(bf16, WS_GK), WSP(bf16, WS_GV), WSP(bf16, WS_GR), (bf16*)F.out, (bf16*)F.out + (size_t)MROWS * DM, WSP(float, WS_LOGA),
                    F.in[I_GQN], F.in[I_GKN], F.in[I_BGATE], F.in[I_BMERGE], WSP(float, WS_ROPE), WSP(float, WS_ROPE) + NPOS * 32};
        pg8::gemm_phase(F.lds + RING_OFF, g, S, E);
        if ((int)blockIdx.x >= P1_EXTRA(F.G)) { const int nidle = F.G - P1_EXTRA(F.G), j = (int)blockIdx.x - P1_EXTRA(F.G), nw = nidle * NWAVES, me = j * NWAVES + F.wave, cnt = p1_conv_items(F.G);
            late_tables(F, me * 64 + F.lane, nw * 64); expert_conv_first(F, me, nw, cnt); }
    } SEAM(1);
    if (IN(2)) {
        const attn_body::AttnTensors AT{(const attn_body::bf16*)WSP(bf16, WS_Q), (const attn_body::bf16*)WSP(bf16, WS_K), (const attn_body::bf16*)WSP(bf16, WS_V), (attn_body::bf16*)WSP(bf16, WS_R1)};
        { const float lam = expf(wave_sum(F.in[I_LQ1][F.lane] * F.in[I_LK1][F.lane])) - expf(wave_sum(F.in[I_LQ2][F.lane] * F.in[I_LK2][F.lane])) + 0.2f;
          float gqm = fabsf(F.in[I_GQN][F.lane]), gkm = fabsf(F.in[I_GKN][F.lane]);
#pragma unroll
          for (int o_ = 1; o_ < 64; o_ <<= 1) { gqm = fmaxf(gqm, __shfl_xor(gqm, o_)); gkm = fmaxf(gkm, __shfl_xor(gkm, o_)); }
          const bool fastsm = __builtin_amdgcn_readfirstlane((0.125f * 1.4426950408889634f * 64.0f) * gqm * gkm < 48.0f ? 1 : 0) != 0;
          const int nslot = 2 * ((256 + F.G - 1) / F.G);
          int i = 0;
#define ATTN_LOOP(FASTSM) for (;; ++i) { const int p = (i >> 2) * F.G + F.vcu; if (p >= 256) break; \
              if ((i & 3) == 1 || (i & 3) == 3) expert_conv_slot(F, (i >> 2) * 2 + ((i & 3) >> 1), nslot, p1_conv_items(F.G)); \
              const int bh = p >> 3, s = p & 7, b = bh >> 2, h = bh & 3, mp = i & 1, qb = (i & 2) ? 15 - s : s, hm = 2 * h + mp; \
              attn_body::attn_unit<8, FASTSM>(b, hm * 64, hm * 64, h * 128, hm * 128, qb, AT.Q, AT.K, AT.V, AT.O, (char*)lds + RING_OFF, mp, 2 * h * 128, lam, F.in[I_GSUB], (attn_body::bf16*)WSP(bf16, WS_OA), h * 128); }
          if (fastsm) { ATTN_LOOP(true) } else { ATTN_LOOP(false) }
#undef ATTN_LOOP
          for (int sl = (i >> 2) * 2 + (((i & 3) + 1) >> 1 > 2 ? 2 : ((i & 3) + 1) >> 1); sl < nslot; ++sl) expert_conv_slot(F, sl, nslot, p1_conv_items(F.G)); }
        asm volatile("s_waitcnt vmcnt(0) lgkmcnt(0)" ::: "memory"); __syncthreads();
        for (int un = F.vcu; un < 32 * 8; un += F.G) gla_x(F, un);
    } SEAM(2);
    if (IN(3)) { for (int un = F.vcu; un < 32 * 8; un += F.G) gla_z(F, un); } SEAM(3);
    if (IN(4)) {
        pg8::Gemm g{WSP(pg8::bf16_t, WS_OA), WSP(pg8::bf16_t, WS_WBR), 512}; pg8::PairOrder S{MROWS / 256, DM / 256, F.G, (int)blockIdx.x};
        epi::EpiMerge E{(const bf16*)F.out, (const bf16*)F.out + (size_t)MROWS * DM, WSP(bf16, WS_R1)};
        pg8::gemm_phase(F.lds + RING_OFF, g, S, E);
    } SEAM(4);
    if (IN(5)) {
        pg8::Gemm g{WSP(pg8::bf16_t, WS_R1), WSP(pg8::bf16_t, WS_WOUT), DM}; pg8::StaticOrder S{MROWS / 256, DM / 256, F.G, (int)blockIdx.x};
        epi::EpiOut E{F.in[I_X], WSP(bf16, WS_H2U), F.in[I_GFFN], WSP(unsigned char, WS_H2U8)};
        pg8::gemm_phase(F.lds + RING_OFF, g, S, E);
    } SEAM(5);
    if (IN(6)) { router_phase(F); } SEAM(6);
    if ((PH_MASK >> 7) && hi > 7) {
        LAS int* tb = (LAS int*)(F.lds + TB_OFF); LAS int* cn = (LAS int*)(F.lds + CN_OFF);
        if (F.tid < 64) { const int c = (int)__hip_atomic_load(F.ctl + CW_CNT + F.tid, RLX_AGENT); cn[F.tid] = c;
            const int t = (c + 255) >> 8; int incl = t;
#pragma unroll
            for (int o = 1; o < 64; o <<= 1) { const int v = __shfl_up(incl, o); if (F.lane >= o) incl += v; }
            tb[F.tid] = incl - t; if (F.tid == 63) tb[64] = incl; }
        __syncthreads();
    }
    if (IN(7)) {
        pg8::Gemm g{WSP(pg8::bf16_t, WS_H2U8), WSP(pg8::bf16_t, WS_WGU), DM / 2}; epi::MoeSched<true> S{tbp, cnp, WSP(int, WS_LTOK), 0, 64, F.G, F.vcu};
        epi::EpiUp E{cnp, WSP(float, WS_LRS), WSP(unsigned char, WS_HID)};
        pg8::gemm_phase<epi::EpiUp, epi::MoeSched<true>, true>(F.lds + RING_OFF, g, S, E);
    } SEAM(7);
    if (IN(8)) {
        pg8::Gemm g{WSP(pg8::bf16_t, WS_HID), WSP(pg8::bf16_t, WS_WD), DEXP / 2}; epi::MoeSched<false> S{tbp, cnp, WSP(int, WS_LTOK), 0, 32, F.G, F.vcu};
        epi::EpiDown<0> E{cnp, WSP(int, WS_LTOK), WSP(float, WS_LW), F.out, WSP(unsigned char, WS_R1), WSP(float, WS_TRASH), WSP(bf16, WS_H2U), F.in[I_GFFN]};
        pg8::gemm_phase<epi::EpiDown<0>, epi::MoeSched<false>, true>(F.lds + RING_OFF, g, S, E);
    } SEAM(8);
    if (IN(9)) {
        pg8::Gemm g{WSP(pg8::bf16_t, WS_HID), WSP(pg8::bf16_t, WS_WD), DEXP / 2}; epi::MoeSched<false> S{tbp, cnp, WSP(int, WS_LTOK), 32, 64, F.G, F.vcu};
        epi::EpiDown<1> E{cnp, WSP(int, WS_LTOK), WSP(float, WS_LW), F.out, WSP(unsigned char, WS_R1), WSP(float, WS_TRASH), WSP(bf16, WS_H2U), F.in[I_GFFN]};
        pg8::gemm_phase<epi::EpiDown<1>, epi::MoeSched<false>, true>(F.lds + RING_OFF, g, S, E);
    }
#ifdef PROBE_K
    PROBE_AT(9);
    if (blockIdx.x == 0 && F.tid == 0) { const unsigned long long t1 = __builtin_amdgcn_s_memrealtime(), tgt = t1 + (unsigned long long)PROBE_MULT * (prb[1] - prb[0]);
        for (unsigned sp = 0; sp < 4000000u && __builtin_amdgcn_s_memrealtime() < tgt; ++sp) __builtin_amdgcn_s_sleep(16); }
#endif
#undef IN
#undef SEAM
}

extern "C" void kernel_launch(void* const* d_in, const int* in_sizes, int n_in, void* d_out, int out_size, void* d_ws, size_t ws_size, hipStream_t stream) {
    static int grid = 0;
    if (grid == 0) {
        if (n_in != 25 || in_sizes[0] != MROWS * DM || out_size != MROWS * DM || ws_size < WS_END) { fprintf(stderr, "kernel_launch: unexpected shapes (n_in %d, in0 %d, out %d, ws %zu)\n", n_in, n_in > 0 ? in_sizes[0] : -1, out_size, ws_size); grid = -1; return; }
        int dev = 0, cus = 0, per_cu = 0;
        if (hipGetDevice(&dev) != hipSuccess || hipDeviceGetAttribute(&cus, hipDeviceAttributeMultiprocessorCount, dev) != hipSuccess) { grid = -1; return; }
        if (hipFuncSetAttribute((const void*)fwd_kernel, hipFuncAttributeMaxDynamicSharedMemorySize, LDS_BYTES) != hipSuccess) { fprintf(stderr, "kernel_launch: hipFuncSetAttribute failed\n"); grid = -1; return; }
        if (hipOccupancyMaxActiveBlocksPerMultiprocessor(&per_cu, (const void*)fwd_kernel, NWAVES * 64, LDS_BYTES) != hipSuccess || per_cu < 1) { fprintf(stderr, "kernel_launch: occupancy query says %d\n", per_cu); }
        (void)hipGetLastError();
        grid = cus;
    }
    if (grid < 0) return;
    if (hipMemsetAsync((char*)d_ws + WS_CTL, 0, CTL_ZERO_BYTES, stream) != hipSuccess) return;
    Args a{};
    for (int i = 0; i < 25; ++i) a.in[i] = (const float*)d_in[i];
    a.out = (float*)d_out; a.ws = (unsigned char*)d_ws;
    if (MK_N_LAUNCHES == 1) { a.ph_lo = 0; a.ph_hi = N_PHASES; hipLaunchKernelGGL(fwd_kernel, dim3(grid), dim3(NWAVES * 64), LDS_BYTES, stream, a); }
    else for (int p = 0; p < N_PHASES; ++p) { a.ph_lo = p; a.ph_hi = p + 1; hipLaunchKernelGGL(fwd_kernel, dim3(grid), dim3(NWAVES * 64), LDS_BYTES, stream, a); }
}
```

```cpp
#include <hip/hip_runtime.h>
#include <hip/hip_bf16.h>
#include <cstdio>
#include <cstdint>
#include <cmath>

namespace pg8 {
#define PG8_LAS __attribute__((address_space(3)))
typedef unsigned short bf16_t;
typedef short bf16x8 __attribute__((ext_vector_type(8)));
typedef float f32x4 __attribute__((ext_vector_type(4)));
typedef float f32x2 __attribute__((ext_vector_type(2)));
typedef unsigned u32x4 __attribute__((ext_vector_type(4)));
typedef unsigned u32x2 __attribute__((ext_vector_type(2)));
typedef int v8i __attribute__((ext_vector_type(8)));
constexpr int BM = 256, BK = 64, HALF = 128, HTB = HALF * BK * 2, STAGE_BYTES = 8 * HTB, NXCD = 8, WGM = 8;

__host__ __device__ __forceinline__ int lds_byte(int r, int c) { const int st = (r >> 4) * 2 + (c >> 5), rr = r & 15, cc = c & 31, ob = rr * 64 + cc * 2; return st * 1024 + (ob ^ (((ob >> 9) & 1) << 5)); }
__host__ __device__ __forceinline__ void stage_rc(int b, int& R, int& C) { const int st = b / 1024, sb = b % 1024, swz = sb ^ (((sb >> 9) & 1) << 5); R = (st >> 1) * 16 + swz / 64; C = (st & 1) * 32 + (swz % 64) / 2; }
__host__ __device__ __forceinline__ int perm32(int rho) { const int n = rho >> 4, i = rho & 15; return 8 * (i >> 2) + 4 * n + (i & 3); }

struct Unit { int pm, pn, aux, half; };
struct Gemm { const bf16_t* A; const bf16_t* Bt; int K; };

__device__ __forceinline__ void tile_of(int L, int nM, int nN, int& pm, int& pn) {
    const int nwg = nM * nN; int wgid = L;
    { const int q = nwg / NXCD, r = nwg % NXCD, xcd = wgid % NXCD, off = wgid / NXCD; wgid = (xcd < r ? xcd * (q + 1) : r * (q + 1) + (xcd - r) * q) + off; }
    const int nig = WGM * nN, gid = wgid / nig, fm = gid * WGM, gsz = (nM - fm) < WGM ? (nM - fm) : WGM;
    pm = fm + ((wgid % nig) % gsz); pn = (wgid % nig) / gsz;
}
struct StaticOrder {
    static constexpr bool GATHER = false;
    int nM, nN, G, c;
    __device__ __forceinline__ bool next(int i, Unit& u) const { const long L = (long)i * G + c; if (L >= (long)nM * nN) return false; tile_of((int)L, nM, nN, u.pm, u.pn); u.aux = 0; u.half = 0; return true; }
    __device__ __forceinline__ int grow(const Unit&, int) const { return 0; }
};
struct PairOrder {
    static constexpr bool GATHER = false;
    int nM, nN, G, c;
    __device__ __forceinline__ bool next(int i, Unit& u) const { const long L = (long)(i >> 1) * G + c; if (L >= (long)nM * nN) return false; tile_of((int)L, nM, nN, u.pm, u.pn); const int br = i & 1; u.pm += nM * br; u.pn += nN * br; u.aux = br; u.half = 0; return true; }
    __device__ __forceinline__ int grow(const Unit&, int) const { return 0; }
};

__device__ __forceinline__ unsigned cvt_pk_bf16(float lo, float hi) { unsigned r; asm volatile("v_cvt_pk_bf16_f32 %0, %1, %2" : "=v"(r) : "v"(lo), "v"(hi)); return r; }
__device__ __forceinline__ u32x4 pack8(const f32x4 a, const f32x4 b) { u32x4 w; w.x = cvt_pk_bf16(a[0], a[1]); w.y = cvt_pk_bf16(a[2], a[3]); w.z = cvt_pk_bf16(b[0], b[1]); w.w = cvt_pk_bf16(b[2], b[3]); return w; }
__device__ __forceinline__ float bf_lo(unsigned w) { return __uint_as_float(w << 16); }
__device__ __forceinline__ float bf_hi(unsigned w) { return __uint_as_float(w & 0xffff0000u); }

template <class Epi, class Sched, bool F8 = false>
__device__ __forceinline__ void gemm_phase(PG8_LAS unsigned char* lds, const Gemm g, const Sched& S, const Epi& E) {
    constexpr bool GA = Sched::GATHER;
    const int tid = threadIdx.x, wid = __builtin_amdgcn_readfirstlane(tid >> 6), lane = tid & 63, wr = wid >> 2, wc = wid & 3, fr = lane & 15, fq = lane >> 4;
    const int K = g.K, nt = K / BK;
    unsigned voffA[2], voffB[2]; int RA[2], CA[2];
#pragma unroll
    for (int i = 0; i < 2; ++i) { int R, C; stage_rc(tid * 16 + i * 8192, R, C); const int Rb = (R & ~31) + perm32(R & 31);
        voffA[i] = (unsigned)(R * K + C) * 2u; voffB[i] = (unsigned)(Rb * K + C) * 2u; RA[i] = R; CA[i] = C; }
    const size_t kstep = (size_t)(BK * 2);
    const size_t hstep = (size_t)HALF * K * 2;
    const size_t tstep = 2 * hstep;
    const unsigned ldsw = (unsigned)wid * 1024u;
    const int aoff = lds_byte(wr * 64 + fr, F8 ? fq * 16 : fq * 8), boff = lds_byte(wc * 32 + fr, F8 ? fq * 16 : fq * 8);
    unsigned gc[2][2], gn[2][2];
#define PG8_SA(b, h) (((b) * 2 + (h)) * HTB)
#define PG8_SB(b, h) ((4 + (b) * 2 + (h)) * HTB)
#define PG8_GL(src, dstoff) __builtin_amdgcn_global_load_lds((const unsigned*)(src), (PG8_LAS unsigned*)(lds + (dstoff)), 16, 0, 0)
#define PG8_STAGE(bufoff, gbase, voff) do { _Pragma("unroll") for (int _i = 0; _i < 2; ++_i) PG8_GL((const char*)(gbase) + (voff)[_i], (bufoff) + ldsw + _i * 8192); } while (0)
#define PG8_STA(bufoff, kptr, h, NX) do { if constexpr (GA) { _Pragma("unroll") for (int _i = 0; _i < 2; ++_i) { const unsigned _o = (NX) ? gn[h][_i] : gc[h][_i]; PG8_GL((const char*)(kptr) + _o, (bufoff) + ldsw + _i * 8192); } } \
        else { PG8_STAGE(bufoff, (const char*)(kptr) + (h) * hstep, voffA); } } while (0)
#define PG8_GOFF(dst, un) do { _Pragma("unroll") for (int _h = 0; _h < 2; ++_h) _Pragma("unroll") for (int _i = 0; _i < 2; ++_i) dst[_h][_i] = ((unsigned)S.grow(un, _h * HALF + RA[_i]) * (unsigned)K + (unsigned)CA[_i]) * 2u; } while (0)
#define PG8_LDA(dst, b, h) do { _Pragma("unroll") for (int m = 0; m < 4; ++m) _Pragma("unroll") for (int k = 0; k < 2; ++k) dst[m][k] = *(const PG8_LAS bf16x8*)(lds + PG8_SA(b, h) + aoff + m * 2048 + (F8 ? k * 16 : k * 1024)); } while (0)
#define PG8_LDB(dst, b, h) do { _Pragma("unroll") for (int n = 0; n < 2; ++n) _Pragma("unroll") for (int k = 0; k < 2; ++k) dst[n][k] = *(const PG8_LAS bf16x8*)(lds + PG8_SB(b, h) + boff + n * 2048 + (F8 ? k * 16 : k * 1024)); } while (0)
#define PG8_F8V(X) __builtin_shufflevector(__builtin_bit_cast(u32x4, X[0]), __builtin_bit_cast(u32x4, X[1]), 0, 1, 2, 3, 4, 5, 6, 7)
#define PG8_MMA(ai, bj, At, Bt) do { __builtin_amdgcn_s_setprio(1); \
        if constexpr (F8) { _Pragma("unroll") for (int m = 0; m < 4; ++m) _Pragma("unroll") for (int n = 0; n < 2; ++n) \
            acc[ai][bj][m][n] = __builtin_amdgcn_mfma_scale_f32_16x16x128_f8f6f4(__builtin_bit_cast(v8i, PG8_F8V(Bt[n])), __builtin_bit_cast(v8i, PG8_F8V(At[m])), acc[ai][bj][m][n], 0, 0, 0, 0x7f7f7f7f, 0, 0x7f7f7f7f); } \
        else { _Pragma("unroll") for (int m = 0; m < 4; ++m) _Pragma("unroll") for (int n = 0; n < 2; ++n) _Pragma("unroll") for (int k = 0; k < 2; ++k) \
            acc[ai][bj][m][n] = __builtin_amdgcn_mfma_f32_16x16x32_bf16(Bt[n][k], At[m][k], acc[ai][bj][m][n], 0, 0, 0); } __builtin_amdgcn_s_setprio(0); } while (0)
#define PG8_WAIT_V(n) asm volatile("s_waitcnt vmcnt(" #n ")" ::: "memory")
#define PG8_WAIT_L(n) asm volatile("s_waitcnt lgkmcnt(" #n ")" ::: "memory")
#define PG8_BAR __builtin_amdgcn_s_barrier()
#define PG8_SCHED __builtin_amdgcn_sched_barrier(0)
#define PG8_ZERO() do { _Pragma("unroll") for (int a = 0; a < 2; ++a) _Pragma("unroll") for (int b = 0; b < 2; ++b) _Pragma("unroll") for (int m = 0; m < 4; ++m) _Pragma("unroll") for (int n = 0; n < 2; ++n) acc[a][b][m][n] = (f32x4){0.f, 0.f, 0.f, 0.f}; } while (0)
    Unit cur, nxt; int ui = 0;
    if (!S.next(0, cur)) return;
    f32x4 acc[2][2][4][2];
    PG8_ZERO();
    bf16x8 At[4][2], B0[2][2], B1[2][2];
    const char* cA = GA ? (const char*)g.A : (const char*)g.A + (size_t)cur.pm * tstep; const char* cB = (const char*)g.Bt + (size_t)cur.pn * tstep;
    if constexpr (GA) { PG8_GOFF(gc, cur); }
    PG8_STAGE(PG8_SB(0, 0), cB, voffB); PG8_STAGE(PG8_SB(0, 1), cB + hstep, voffB); PG8_STA(PG8_SA(0, 0), cA, 0, false); PG8_STA(PG8_SA(0, 1), cA, 1, false);
    if (wr == 1) PG8_BAR;
    PG8_WAIT_V(2); PG8_BAR;
    PG8_STAGE(PG8_SB(1, 0), cB + kstep, voffB); PG8_STA(PG8_SA(1, 0), cA + kstep, 0, false); PG8_STAGE(PG8_SB(1, 1), cB + hstep + kstep, voffB);
    PG8_WAIT_V(6); PG8_BAR;
    for (;;) {
        const bool has_next = S.next(ui + 1, nxt);
        const char* nA = GA ? (const char*)g.A : (has_next ? (const char*)g.A + (size_t)nxt.pm * tstep : cA); const char* nB = has_next ? (const char*)g.Bt + (size_t)nxt.pn * tstep : cB;
        if constexpr (GA) { if (has_next) { PG8_GOFF(gn, nxt); } else { _Pragma("unroll") for (int _h = 0; _h < 2; ++_h) _Pragma("unroll") for (int _i = 0; _i < 2; ++_i) gn[_h][_i] = gc[_h][_i]; } }
        const bool do0 = cur.half != 2, do1 = cur.half != 1;
        for (int t = 0; t < nt; t += 2) {
            const bool last = (t == nt - 2);
            const char* a1 = cA + (size_t)(t + 1) * kstep;
            const char* a2 = last ? nA : cA + (size_t)(t + 2) * kstep; const char* b2 = last ? nB : cB + (size_t)(t + 2) * kstep;
            const char* a3 = a2 + kstep; const char* b3 = b2 + kstep;
            PG8_LDB(B0, 0, 0); PG8_LDB(B1, 0, 1); PG8_SCHED; PG8_LDA(At, 0, 0); PG8_STA(PG8_SA(1, 1), a1, 1, false);
            PG8_WAIT_V(8); PG8_WAIT_L(0); PG8_BAR; if (do0) { PG8_MMA(0, 0, At, B0); PG8_MMA(0, 1, At, B1); } PG8_BAR; PG8_SCHED;
            PG8_LDA(At, 0, 1); PG8_STAGE(PG8_SB(0, 0), b2, voffB); PG8_STAGE(PG8_SB(0, 1), b2 + hstep, voffB); PG8_STA(PG8_SA(0, 0), a2, 0, last);
            PG8_WAIT_V(8); PG8_WAIT_L(0); PG8_BAR; if (do1) { PG8_MMA(1, 0, At, B0); PG8_MMA(1, 1, At, B1); } PG8_BAR; PG8_SCHED;
            PG8_LDB(B0, 1, 0); PG8_LDB(B1, 1, 1); PG8_SCHED; PG8_LDA(At, 1, 0); PG8_STA(PG8_SA(0, 1), a2, 1, last);
            PG8_WAIT_V(8); PG8_WAIT_L(0); PG8_BAR; if (do0) { PG8_MMA(0, 0, At, B0); PG8_MMA(0, 1, At, B1); } PG8_BAR; PG8_SCHED;
            PG8_LDA(At, 1, 1); PG8_STAGE(PG8_SB(1, 0), b3, voffB); PG8_STAGE(PG8_SB(1, 1), b3 + hstep, voffB); PG8_STA(PG8_SA(1, 0), a3, 0, last);
            PG8_WAIT_V(8); PG8_WAIT_L(0); PG8_BAR; if (do1) { PG8_MMA(1, 0, At, B0); PG8_MMA(1, 1, At, B1); } PG8_BAR; PG8_SCHED;
        }
        if (wr == 0) PG8_BAR;
        const bool keep = E(acc, cur, wr, wc, fr, fq);
        if (!has_next) break;
        if (!keep) { PG8_ZERO(); }
        cur = nxt; cA = nA; cB = nB; ++ui;
        if constexpr (GA) { _Pragma("unroll") for (int _h = 0; _h < 2; ++_h) _Pragma("unroll") for (int _i = 0; _i < 2; ++_i) gc[_h][_i] = gn[_h][_i]; }
        if (wr == 1) PG8_BAR;
    }
    PG8_WAIT_V(0);
    PG8_BAR;
#undef PG8_SA
#undef PG8_SB
#undef PG8_GL
#undef PG8_STAGE
#undef PG8_STA
#undef PG8_GOFF
#undef PG8_LDA
#undef PG8_LDB
#undef PG8_MMA
#undef PG8_F8V
#undef PG8_WAIT_V
#undef PG8_WAIT_L
#undef PG8_BAR
#undef PG8_SCHED
#undef PG8_ZERO
}
}
#include <hip/hip_bf16.h>
#include <cmath>
namespace attn_body {
using bf16=__hip_bfloat16;
using bf16x8=__attribute__((ext_vector_type(8)))short;
using s16x4=__attribute__((ext_vector_type(4)))short;
using f32x16=__attribute__((ext_vector_type(16)))float;
using u32x4=__attribute__((ext_vector_type(4)))unsigned;
constexpr int D=64,QP=512,KP=512,VP=512,OP=1024,QSEQ=4096,KSEQ=4160;
constexpr int NW=8,QBLK=32,QB=QBLK*NW,KVBLK=64,NQB=QSEQ/QB;
constexpr int ATTN_UNIT_ROWS=QB;
__device__ __forceinline__ int crow(int r,int hi){return (r&3)+8*(r>>2)+4*hi;}
#define SBAR() __builtin_amdgcn_sched_barrier(0)
__device__ __forceinline__ void cmask(f32x16&p0,f32x16&p1,int jb,int qrel,int hi){
  const float NEG=-INFINITY; int kb=64*jb+4*hi;
  #pragma unroll
  for(int r=0;r<16;++r){int kv=kb+(r&3)+8*(r>>2); if(kv>qrel)p0[r]=NEG; if(kv+32>qrel)p1[r]=NEG;}
}

constexpr int NSLOT=3, SLOTB=8192;
constexpr int QSTG=4608;
constexpr int LDS_K=0, LDS_V=NSLOT*SLOTB, LDS_WS=LDS_V+NSLOT*2*SLOTB, LDS_OST=LDS_WS+NW*64*4, LDS_BYTES=LDS_OST+NW*QSTG;
constexpr float C2=0.125f*1.4426950408889634f;
__device__ __forceinline__ void glds16(const void*gsrc,unsigned lds_dst){unsigned keep;
  asm volatile("s_mov_b32 %0, m0\n\ts_mov_b32 m0, %2\n\ts_nop 0\n\tglobal_load_lds_dwordx4 %1, off\n\ts_mov_b32 m0, %0":"=&s"(keep):"v"(gsrc),"s"(lds_dst):"memory");}
__device__ __forceinline__ float max3f(float a,float b,float c){float r;asm("v_max3_f32 %0, %1, %2, %3":"=v"(r):"v"(a),"v"(b),"v"(c));return r;}
__device__ __forceinline__ float max2f(float a,float b){float r;asm("v_max_f32_e32 %0, %1, %2":"=v"(r):"v"(a),"v"(b));return r;}
__device__ __forceinline__ float fadd_s(float a,float b){float r;asm("v_add_f32_e32 %0, %1, %2":"=v"(r):"v"(a),"v"(b));return r;}
__device__ __forceinline__ float fsub_s(float a,float b){float r;asm("v_sub_f32_e32 %0, %1, %2":"=v"(r):"v"(a),"v"(b));return r;}
typedef float f32x2_t __attribute__((ext_vector_type(2))); typedef __bf16 bf16x2_t __attribute__((ext_vector_type(2)));
__device__ __forceinline__ unsigned cvtpk_s(float lo,float hi){f32x2_t v={lo,hi};bf16x2_t b=__builtin_convertvector(v,bf16x2_t);return __builtin_bit_cast(unsigned,b);}
#define WAIT_BAR(N) asm volatile("s_waitcnt vmcnt(" #N ") lgkmcnt(0)\n\ts_barrier":::"memory")

__device__ __forceinline__ void qkt(f32x16&p0,f32x16&p1,const char*Kslot,const bf16x8*qr,int r32,int hi){ const f32x16 negm=f32x16{};
  const char*kb=Kslot+hi*1024+r32*16;
  #pragma unroll
  for(int d0=0;d0<4;++d0){
    const bf16x8 b0=*reinterpret_cast<const bf16x8*>(kb+d0*2048);
    const bf16x8 b1=*reinterpret_cast<const bf16x8*>(kb+d0*2048+512);
    if(d0==0){p0=__builtin_amdgcn_mfma_f32_32x32x16_bf16(b0,qr[0],negm,0,0,0);p1=__builtin_amdgcn_mfma_f32_32x32x16_bf16(b1,qr[0],negm,0,0,0);}
    else{p0=__builtin_amdgcn_mfma_f32_32x32x16_bf16(b0,qr[d0],p0,0,0,0);p1=__builtin_amdgcn_mfma_f32_32x32x16_bf16(b1,qr[d0],p1,0,0,0);}}
}
typedef __attribute__((address_space(3))) const char* lds_cptr;
typedef short v4i16_t __attribute__((ext_vector_type(4)));
__device__ __forceinline__ void kload8(bf16x8*kf,lds_cptr kp){
  kf[0]=*(const __attribute__((address_space(3))) bf16x8*)(kp);      kf[1]=*(const __attribute__((address_space(3))) bf16x8*)(kp+512);
  kf[2]=*(const __attribute__((address_space(3))) bf16x8*)(kp+2048); kf[3]=*(const __attribute__((address_space(3))) bf16x8*)(kp+2560);
  kf[4]=*(const __attribute__((address_space(3))) bf16x8*)(kp+4096); kf[5]=*(const __attribute__((address_space(3))) bf16x8*)(kp+4608);
  kf[6]=*(const __attribute__((address_space(3))) bf16x8*)(kp+6144); kf[7]=*(const __attribute__((address_space(3))) bf16x8*)(kp+6656);
}
__device__ __forceinline__ void kload2(bf16x8*kf,lds_cptr kp,int j){ kf[2*j]=*(const __attribute__((address_space(3))) bf16x8*)(kp+j*2048); kf[2*j+1]=*(const __attribute__((address_space(3))) bf16x8*)(kp+j*2048+512); }
__device__ __forceinline__ s16x4 vtr(lds_cptr p){ return __builtin_bit_cast(s16x4,__builtin_amdgcn_ds_read_tr16_b64_v4i16((__attribute__((address_space(3))) v4i16_t*)p)); }
__device__ __forceinline__ float rowmax(const f32x16&p0,const f32x16&p1){
  float a=max3f(p0[0],p0[1],p1[0]),b=max3f(p0[2],p0[3],p1[1]);a=max3f(a,p1[2],p1[3]);
  #pragma unroll
  for(int r=4;r<16;r+=4){a=max3f(a,p0[r],p0[r+1]);b=max3f(b,p0[r+2],p0[r+3]);a=max3f(a,p1[r],p1[r+1]);b=max3f(b,p1[r+2],p1[r+3]);}
  const float m=max2f(a,b);
  auto rr=__builtin_amdgcn_permlane32_swap(__float_as_uint(m),__float_as_uint(m),false,false);
  return max2f(__uint_as_float(rr[0]),__uint_as_float(rr[1]));
}
__device__ __forceinline__ void pv(f32x16*o,int vb,bf16x8 pa0,bf16x8 pa1,bf16x8 pa2,bf16x8 pa3){
  #pragma unroll
  for(int d0=0;d0<4;++d0){s16x4 lo[4],hi[4];
    #pragma unroll
    for(int ks=0;ks<4;++ks){
      asm volatile("ds_read_b64_tr_b16 %0,%1 offset:%c2":"=&v"(lo[ks]):"v"(vb),"i"(d0*4096+ks*1024):"memory");
      asm volatile("ds_read_b64_tr_b16 %0,%1 offset:%c2":"=&v"(hi[ks]):"v"(vb),"i"(d0*4096+ks*1024+512):"memory");}
    asm volatile("s_waitcnt lgkmcnt(0)":::"memory");SBAR();
    #define PK(k) (bf16x8){lo[k][0],lo[k][1],lo[k][2],lo[k][3],hi[k][0],hi[k][1],hi[k][2],hi[k][3]}
    o[d0]=__builtin_amdgcn_mfma_f32_32x32x16_bf16(pa0,PK(0),o[d0],0,0,0);
    o[d0]=__builtin_amdgcn_mfma_f32_32x32x16_bf16(pa1,PK(1),o[d0],0,0,0);
    o[d0]=__builtin_amdgcn_mfma_f32_32x32x16_bf16(pa2,PK(2),o[d0],0,0,0);
    o[d0]=__builtin_amdgcn_mfma_f32_32x32x16_bf16(pa3,PK(3),o[d0],0,0,0);
    #undef PK
  }
}

#ifndef ATTN_STORE16
#define ATTN_STORE16(p,v) (*(u32x4*)(p)=(v))
#endif
template<int THRL,bool FAST> __device__ __forceinline__ void attn_unit(int b,int qcol,int kcol,int vcol,int ocol,int qb,const bf16*Q,const bf16*__restrict__ K,const bf16*__restrict__ V,bf16*O,char*shm,int comb,int o0col,float lam,const float*gsub,bf16*OA,int oacol){
  const int tid=threadIdx.x,lane=tid&63,r32=lane&31,hi=lane>>5; const int wid=__builtin_amdgcn_readfirstlane(tid>>6);
  const long qrow0=(long)b*QSEQ, krow0=(long)b*KSEQ; const int q0=qb*QB;
  const bf16*Qw=Q+(qrow0+q0+wid*QBLK)*QP+qcol;
  const bf16*Kh=K+krow0*KP+kcol,*Vh=V+krow0*VP+vcol;
  const unsigned lds0=(unsigned)(uintptr_t)shm;
  float*wsf=(float*)(shm+LDS_WS)+wid*64;
  const bf16*ksrc=Kh+(long)lane*KP+wid*8;
  const bf16*vsrc=Vh+(long)(16*(wid&3)+(lane>>2))*VP+(wid>>2)*32+(lane&3)*8;
  const unsigned kdst=lds0+LDS_K+wid*1024, vdst=lds0+LDS_V+wid*1024;
  #define DMA_K(t,slot) glds16(ksrc+(long)(t)*KVBLK*KP,(unsigned)__builtin_amdgcn_readfirstlane(kdst+(slot)))
  #define DMA_V(t,slot) do{ glds16(vsrc+(long)(t)*KVBLK*VP,(unsigned)__builtin_amdgcn_readfirstlane(vdst+2*(slot))); glds16(vsrc+64+(long)(t)*KVBLK*VP,(unsigned)__builtin_amdgcn_readfirstlane(vdst+2*(slot)+8192)); }while(0)
  const int vb0=(int)(lds0+LDS_V)+((lane>>4)&1)*32+(lane&3)*8+(4*hi+((lane&15)>>2))*64;
  const char*Kbase=shm+LDS_K; bf16x8 kf[8];
  const lds_cptr shm3=(lds_cptr)shm; const lds_cptr kp0=shm3+LDS_K+hi*1024+r32*16; const lds_cptr vp0=shm3+LDS_V+((lane>>4)&1)*32+(lane&3)*8+(4*hi+((lane&15)>>2))*64;
  const int NT=(q0+QB)/KVBLK+1;
  DMA_K(0,0);DMA_V(0,0);DMA_K(1,SLOTB);
  bf16x8 qr[4];
  #pragma unroll
  for(int d0=0;d0<4;++d0)qr[d0]=*reinterpret_cast<const bf16x8*>(&Qw[(long)r32*QP+d0*16+hi*8]);
  const __attribute__((address_space(3))) char* qsp=(const __attribute__((address_space(3))) char*)shm3+LDS_OST+wid*QSTG+r32*144+hi*16;
  #pragma unroll
  for(int d0=0;d0<4;++d0)*(__attribute__((address_space(3))) bf16x8*)(qsp+d0*32)=qr[d0];
  #define QV(d0) (*(const __attribute__((address_space(3))) bf16x8*)(qsp+(d0)*32))
  float mhat=0.f,l_reg=0.f;f32x16 o[4];o[0]=f32x16{};o[1]=f32x16{};o[2]=f32x16{};o[3]=f32x16{};const f32x16 zero16=f32x16{};
  const int qrel=wid*QBLK+r32;
  #define CMASK(P0,P1,t) do{int jb_=(t)-(NT-4); if(jb_>=0)cmask(P0,P1,jb_,qrel,hi);}while(0)
  bool resc=false;
  #define START(P0,P1) do{ resc=false; if constexpr(FAST){ mhat=0.f; _Pragma("unroll") for(int r=0;r<16;++r)P0[r]=__builtin_amdgcn_exp2f(P0[r]); } \
    else { const float rm=rowmax(P0,P1); mhat=rm; _Pragma("unroll") for(int r=0;r<16;++r)P0[r]=__builtin_amdgcn_exp2f(fsub_s(P0[r],mhat)); } }while(0)
  #define RESC() do{ if(resc){ asm volatile("s_waitcnt lgkmcnt(0)":::"memory"); \
      _Pragma("unroll") for(int d_=0;d_<4;++d_) _Pragma("unroll") for(int r=0;r<16;++r)o[d_][r]*=wsf[crow(r,hi)]; } }while(0)
  f32x16 pA0,pA1,pB0,pB1;
  int sl_prev=0,sl_cur=0,sl_next=SLOTB;
  #define ROT() do{sl_prev=sl_cur;sl_cur=sl_next;sl_next=(sl_next==(NSLOT-1)*SLOTB)?0:sl_next+SLOTB;}while(0)
  DMA_K(2,2*SLOTB);
  WAIT_BAR(3);
  qkt(pA0,pA1,Kbase,qr,r32,hi);asm volatile("s_nop 15\n\ts_nop 7":"+v"(pA0),"+v"(pA1));
  { _Pragma("unroll") for(int r=8;r<16;++r)pA0[r]=-INFINITY; _Pragma("unroll") for(int r=0;r<16;++r)pA1[r]=-INFINITY; }
  START(pA0,pA1);
  if constexpr(FAST){ _Pragma("unroll") for(int r=0;r<16;++r)pA1[r]=__builtin_amdgcn_exp2f(pA1[r]); } else { _Pragma("unroll") for(int r=0;r<16;++r)pA1[r]=__builtin_amdgcn_exp2f(fsub_s(pA1[r],mhat)); }
  WAIT_BAR(0);
  DMA_K(3,0);DMA_V(1,SLOTB);
  ROT();
  kload8(kf,kp0+sl_cur);
  WAIT_BAR(3);
  s16x4 vlo[8],vhi[8]; u32x4 pw0,pw1,pw2,pw3;
  #define PKW(P,B) cvtpk_s(P[B],P[B+1])
  #define PAF(k) __builtin_bit_cast(bf16x8,pw##k)
  #define VFR(i) (bf16x8){vlo[i][0],vlo[i][1],vlo[i][2],vlo[i][3],vhi[i][0],vhi[i][1],vhi[i][2],vhi[i][3]}
  #define PIN(x) asm volatile("":"+v"(x))
  #define MX3(a,b,c) __builtin_fmaxf(__builtin_fmaxf((a),(b)),(c))
  #define GAPA(MF,A0,A1,A2,A3,W0,W1,PW) do{ MF; sacc+=A0; sacc+=A1; sacc+=A2; sacc+=A3; PIN(sacc); W0; W1; PIN(PW); SBAR(); }while(0)
  #define EX(v) __builtin_amdgcn_exp2f(v)
  #define GAPB(MF,X,B) do{ MF; if constexpr(FAST){ X[B]=EX(X[B]); X[B+1]=EX(X[B+1]); } else { X[B]=EX(X[B]-mhat); X[B+1]=EX(X[B+1]-mhat); } PIN(X); SBAR(); }while(0)
  #define VOF(j) ((((j)&3)*4096)+(((j)>>2)*1024))
  #define VRD(sl,j) do{ vlo[sl]=vtr(vp_+VOF(j)); vhi[sl]=vtr(vp_+VOF(j)+512); }while(0)
  #define KRD(G,j) do{ if(G){ kload2(kf,kp0+sl_next,j); SBAR(); } }while(0)
  #define PVM(j) o[(j)&3]=__builtin_amdgcn_mfma_f32_32x32x16_bf16(PAFJ(j),VFR((j)&7),o[(j)&3],0,0,0)
  #define PAFJ(j) (((j)>>2)==0?PAF(0):((j)>>2)==1?PAF(1):((j)>>2)==2?PAF(2):PAF(3))
  #define STEP(C0,C1,P0,P1,t,GK,GV,GL) do{ SBAR(); \
    const lds_cptr vp_=vp0+2*sl_prev; \
    VRD(0,0); SBAR(); float sacc=(P0[0]+P0[1]); \
    GAPA(C0=__builtin_amdgcn_mfma_f32_32x32x16_bf16(kf[0],QV(0),zero16,0,0,0), P0[2],P0[3],P0[4],P0[5],     pw0[0]=PKW(P0,0), pw0[1]=PKW(P0,2), pw0); \
    VRD(1,1); SBAR(); GAPA(C1=__builtin_amdgcn_mfma_f32_32x32x16_bf16(kf[1],QV(0),zero16,0,0,0), P0[6],P0[7],P0[8],P0[9],     pw0[2]=PKW(P0,4), pw0[3]=PKW(P0,6), pw0); \
    VRD(2,2); SBAR(); GAPA(C0=__builtin_amdgcn_mfma_f32_32x32x16_bf16(kf[2],QV(1),C0,0,0,0),   P0[10],P0[11],P0[12],P0[13], pw1[0]=PKW(P0,8), pw1[1]=PKW(P0,10), pw1); \
    VRD(3,3); SBAR(); GAPA(C1=__builtin_amdgcn_mfma_f32_32x32x16_bf16(kf[3],QV(1),C1,0,0,0),   P0[14],P0[15],P1[0],P1[1],   pw1[2]=PKW(P0,12),pw1[3]=PKW(P0,14), pw1); \
    VRD(4,4); SBAR(); GAPA(C0=__builtin_amdgcn_mfma_f32_32x32x16_bf16(kf[4],QV(2),C0,0,0,0),   P1[2],P1[3],P1[4],P1[5],     pw2[0]=PKW(P1,0), pw2[1]=PKW(P1,2), pw2); \
    VRD(5,5); SBAR(); GAPA(C1=__builtin_amdgcn_mfma_f32_32x32x16_bf16(kf[5],QV(2),C1,0,0,0),   P1[6],P1[7],P1[8],P1[9],     pw2[2]=PKW(P1,4), pw2[3]=PKW(P1,6), pw2); \
    VRD(6,6); SBAR(); GAPA(C0=__builtin_amdgcn_mfma_f32_32x32x16_bf16(kf[6],QV(3),C0,0,0,0),   P1[10],P1[11],P1[12],P1[13], pw3[0]=PKW(P1,8), pw3[1]=PKW(P1,10), pw3); \
    VRD(7,7); SBAR(); GAPA(C1=__builtin_amdgcn_mfma_f32_32x32x16_bf16(kf[7],QV(3),C1,0,0,0),   P1[14],P1[15],0.f,0.f,       pw3[2]=PKW(P1,12),pw3[3]=PKW(P1,14), pw3); \
    l_reg+=sacc; \
    if(GK){DMA_K((t)+3,sl_cur);} if(GV){DMA_V((t)+1,sl_next);} \
    CMASK(C0,C1,t); \
    if constexpr(!FAST){ float a=MX3(C0[0],C0[1],C1[0]),b=MX3(C0[2],C0[3],C1[1]); a=MX3(a,C1[2],C1[3]); \
      _Pragma("unroll") for(int r=4;r<16;r+=4){a=MX3(a,C0[r],C0[r+1]);b=MX3(b,C0[r+2],C0[r+3]);a=MX3(a,C1[r],C1[r+1]);b=MX3(b,C1[r+2],C1[r+3]);} \
      float rm=__builtin_fmaxf(a,b); { auto rr=__builtin_amdgcn_permlane32_swap(__float_as_uint(rm),__float_as_uint(rm),false,false); rm=__builtin_fmaxf(__uint_as_float(rr[0]),__uint_as_float(rr[1])); } \
      rm-=mhat; resc=false; \
      if(__builtin_expect(__any(rm>(float)THRL),0)){ const float dl=__builtin_fmaxf(rm,0.f); mhat+=dl; \
        const float f=__builtin_amdgcn_exp2f(-dl); l_reg*=f; if(hi==0)wsf[r32]=f; resc=true; } } \
    SBAR(); \
    GAPB(PVM(0), C0,0); \
    GAPB(PVM(1), C0,2);  VRD(0,8);  SBAR(); \
    GAPB(PVM(2), C0,4);  VRD(1,9);  SBAR(); \
    GAPB(PVM(3), C0,6);  VRD(2,10); SBAR(); \
    GAPB(PVM(4), C0,8);  VRD(3,11); SBAR(); \
    GAPB(PVM(5), C0,10); VRD(4,12); SBAR(); \
    GAPB(PVM(6), C0,12); VRD(5,13); SBAR(); \
    GAPB(PVM(7), C0,14); VRD(6,14); SBAR(); \
    GAPB(PVM(8), C1,0);  VRD(7,15); SBAR(); \
    KRD(GL,0); GAPB(PVM(9),  C1,2); \
    KRD(GL,1); GAPB(PVM(10), C1,4); \
    KRD(GL,2); GAPB(PVM(11), C1,6); \
    KRD(GL,3); GAPB(PVM(12), C1,8); \
    GAPB(PVM(13), C1,10); \
    GAPB(PVM(14), C1,12); \
    GAPB(PVM(15), C1,14); \
    }while(0)
  int t=1;
  #undef CMASK
  #define CMASK(P0,P1,t) do{}while(0)
  for(;t+5<NT;t+=2){
    STEP(pB0,pB1,pA0,pA1,t,true,true,true);     WAIT_BAR(3); RESC(); ROT();
    STEP(pA0,pA1,pB0,pB1,t+1,true,true,true);   WAIT_BAR(3); RESC(); ROT();
  }
  #undef CMASK
  #define CMASK(P0,P1,t) do{int jb_=(t)-(NT-4); if(jb_>=0)cmask(P0,P1,jb_,qrel,hi);}while(0)
  #define ENDW(tt) do{ if((tt)+3<NT){WAIT_BAR(3);} else if((tt)+2<NT){WAIT_BAR(2);} else {WAIT_BAR(0);} }while(0)
  for(;t+1<NT;t+=2){
    STEP(pB0,pB1,pA0,pA1,t,(t+3<NT),(t+1<NT),(t+1<NT));       ENDW(t);   RESC(); ROT();
    STEP(pA0,pA1,pB0,pB1,t+1,(t+4<NT),(t+2<NT),(t+2<NT));     ENDW(t+1); RESC(); ROT();
  }
  { float sacc=pA0[0]+pA0[1]; _Pragma("unroll") for(int r=2;r<16;++r)sacc+=pA0[r]; _Pragma("unroll") for(int r=0;r<16;++r)sacc+=pA1[r]; l_reg+=sacc;
    pw0=(u32x4){PKW(pA0,0),PKW(pA0,2),PKW(pA0,4),PKW(pA0,6)};pw1=(u32x4){PKW(pA0,8),PKW(pA0,10),PKW(pA0,12),PKW(pA0,14)};pw2=(u32x4){PKW(pA1,0),PKW(pA1,2),PKW(pA1,4),PKW(pA1,6)};pw3=(u32x4){PKW(pA1,8),PKW(pA1,10),PKW(pA1,12),PKW(pA1,14)};
    SBAR(); pv(o,vb0+2*sl_prev,PAF(0),PAF(1),PAF(2),PAF(3)); }
  #undef PKW
  #undef PAF
  #undef VFR
  #undef PIN
  #undef MX3
  #undef GAPA
  #undef GAPB
  #undef EX
  #undef VRD
  #undef KRD
  #undef STEP
  #undef VOF
  #undef PVM
  #undef PAFJ
  #undef QV
  #undef ENDW
  {auto rr=__builtin_amdgcn_permlane32_swap(__float_as_uint(l_reg),__float_as_uint(l_reg),false,false);l_reg=__uint_as_float(rr[0])+__uint_as_float(rr[1]);}
  if(hi==0)wsf[32+r32]=l_reg;asm volatile("s_waitcnt lgkmcnt(0)":::"memory");
  float rli[16];
  #pragma unroll
  for(int r=0;r<16;++r)rli[r]=__builtin_amdgcn_rcpf(wsf[32+crow(r,hi)]);
  bf16*Ow=O+(qrow0+q0+wid*QBLK)*OP+ocol;
  { int oz_; asm volatile("v_mov_b32 %0, 0":"=v"(oz_)); const int ln=lane+oz_;
    bf16*stg=(bf16*)(shm+LDS_OST+wid*QSTG);
    if(!comb){
      #pragma unroll
      for(int hh=0;hh<2;++hh){
        #pragma unroll
        for(int r=0;r<16;++r){const int orow=crow(r,hi);
          #pragma unroll
          for(int d0=0;d0<2;++d0)stg[orow*64+d0*32+r32]=__float2bfloat16(o[2*hh+d0][r]*rli[r]);}
        asm volatile("s_waitcnt lgkmcnt(0)":::"memory");
        #pragma unroll
        for(int i=0;i<4;++i){const int row=i*8+(ln>>3),ch=ln&7; const u32x4 v=*(const u32x4*)(stg+row*64+ch*8); ATTN_STORE16(Ow+(long)row*OP+hh*64+ch*8,v);}
        asm volatile("s_waitcnt lgkmcnt(0)":::"memory"); }
    } else {
      const bf16*O0w=O+(qrow0+q0+wid*QBLK)*OP+o0col; bf16*OAw=OA+(qrow0+q0+wid*QBLK)*512+oacol;
      float ssr[4]={0.f,0.f,0.f,0.f};
      #pragma unroll
      for(int pass=0;pass<2;++pass){
        if(pass==1){
          #pragma unroll
          for(int i=0;i<4;++i){ float ss=ssr[i]; ss+=__shfl_xor(ss,1); ss+=__shfl_xor(ss,2); ss+=__shfl_xor(ss,4); ssr[i]=0.8f/sqrtf(ss*(1.0f/128.0f)+1e-6f); } }
        #pragma unroll
        for(int hh=0;hh<2;++hh){
          u32x4 v0[4];
          #pragma unroll
          for(int i=0;i<4;++i){const int row=i*8+(ln>>3),ch=ln&7; v0[i]=*(const u32x4*)(O0w+(long)row*OP+hh*64+ch*8);}
          #pragma unroll
          for(int r=0;r<16;++r){const int orow=crow(r,hi);
            #pragma unroll
            for(int d0=0;d0<2;++d0)stg[orow*64+d0*32+r32]=__float2bfloat16(o[2*hh+d0][r]*rli[r]);}
          asm volatile("s_waitcnt lgkmcnt(0)":::"memory");
          const int ch=ln&7; const float4 g0=*(const float4*)(gsub+hh*64+ch*8), g1=*(const float4*)(gsub+hh*64+ch*8+4); const float gg[8]={g0.x,g0.y,g0.z,g0.w,g1.x,g1.y,g1.z,g1.w};
          #pragma unroll
          for(int i=0;i<4;++i){const int row=i*8+(ln>>3); const u32x4 v1=*(const u32x4*)(stg+row*64+ch*8); const u32x4 a=v0[i];
            const unsigned aw[4]={a.x,a.y,a.z,a.w},bw[4]={v1.x,v1.y,v1.z,v1.w}; float dd[8];
            #pragma unroll
            for(int j=0;j<4;++j){ dd[2*j]=__uint_as_float(aw[j]<<16)-lam*__uint_as_float(bw[j]<<16); dd[2*j+1]=__uint_as_float(aw[j]&0xffff0000u)-lam*__uint_as_float(bw[j]&0xffff0000u); }
            if(pass==0){
              #pragma unroll
              for(int j=0;j<8;++j)ssr[i]+=dd[j]*dd[j]; }
            else { const float rn=ssr[i]; u32x4 w;
              w.x=cvtpk_s(dd[0]*rn*gg[0],dd[1]*rn*gg[1]); w.y=cvtpk_s(dd[2]*rn*gg[2],dd[3]*rn*gg[3]); w.z=cvtpk_s(dd[4]*rn*gg[4],dd[5]*rn*gg[5]); w.w=cvtpk_s(dd[6]*rn*gg[6],dd[7]*rn*gg[7]);
              *(u32x4*)(OAw+(long)row*512+hh*64+ch*8)=w; } }
          asm volatile("s_waitcnt lgkmcnt(0)":::"memory"); } }
    } }
  asm volatile("s_waitcnt lgkmcnt(0)\n\ts_barrier":::"memory");
  #undef DMA_K
  #undef DMA_V
  #undef CMASK
  #undef START
  #undef RESC
  #undef ROT
}
constexpr int ATTN_LDS_BYTES=LDS_BYTES;
struct AttnTensors { const bf16* Q; const bf16* K; const bf16* V; bf16* O; };
#undef SBAR
#undef WAIT_BAR
}
#define GAS __attribute__((address_space(1)))
#define LAS __attribute__((address_space(3)))
typedef unsigned short bf16;
typedef unsigned v4u __attribute__((ext_vector_type(4)));
typedef float f32x4 __attribute__((ext_vector_type(4)));
typedef short bf16x8 __attribute__((ext_vector_type(8)));
typedef GAS unsigned gu32;
typedef GAS unsigned long long gu64;
#define RLX_AGENT __ATOMIC_RELAXED, __HIP_MEMORY_SCOPE_AGENT
#define LDS_WAIT() asm volatile("s_waitcnt lgkmcnt(0)" ::: "memory")
#define VM_WAIT() asm volatile("s_waitcnt vmcnt(0)" ::: "memory")
__device__ __forceinline__ unsigned long long rt() { return __builtin_amdgcn_s_memrealtime(); }
__device__ __forceinline__ unsigned f2bf(float f) { unsigned u = __builtin_bit_cast(unsigned, f); return (u + 0x7fffu + ((u >> 16) & 1u)) >> 16; }
__device__ __forceinline__ unsigned pk2(float lo, float hi) { return f2bf(lo) | (f2bf(hi) << 16); }

#define XB_TMO      128
#define XB_XCNT(j)  (256  + 64 * (j))
#define XB_XSUB(j)  (1280 + 64 * (j))
#define XB_XGEN(j)  (2304 + 64 * (j))
#define XB_TOP      3328
#define XB_TOPGEN   3392
#define XCD_BAR_WORDS 3456
#define XB_SPIN_CAP (1u << 18)

__device__ __forceinline__ unsigned xb_ld(unsigned* p)              { return __hip_atomic_load(p, __ATOMIC_RELAXED, __HIP_MEMORY_SCOPE_AGENT); }
__device__ __forceinline__ unsigned xb_add(unsigned* p, unsigned v) { return __hip_atomic_fetch_add(p, v, __ATOMIC_RELAXED, __HIP_MEMORY_SCOPE_AGENT); }
__device__ __forceinline__ unsigned xb_xcc_id() { return (unsigned)__builtin_amdgcn_s_getreg((3 << 11) | 20) & 0xFu; }
#define XB_SPIN(cond, bar) do { unsigned _sp = 0; while (cond) { __builtin_amdgcn_s_sleep(1); \
    if ((++_sp & 255u) == 0u) { if (xb_ld(&(bar)[XB_TMO])) break; if (_sp > XB_SPIN_CAP) { atomicAdd(&(bar)[XB_TMO], 1u); break; } } } } while (0)

struct XcdBarrier {
    unsigned* bar; unsigned x;
    volatile LAS unsigned* st;
};

__device__ __forceinline__ XcdBarrier xcd_barrier_post(unsigned* bar, volatile LAS unsigned* st) {
    XcdBarrier b; b.bar = bar; b.x = xb_xcc_id(); b.st = st;
    if (threadIdx.x == 0) (void)xb_add(&bar[XB_XCNT(b.x)], 1u);
    return b;
}
__device__ __forceinline__ void xcd_barrier_complete(unsigned* bar, unsigned x, unsigned& nloc, unsigned& nx) {
    const unsigned G = gridDim.x * gridDim.y * gridDim.z;
    unsigned sum, cnt, mine, sp = 0u;
    for (;;) {
        sum = 0u; cnt = 0u; mine = 0u;
#pragma unroll
        for (unsigned j = 0; j < 16; ++j) { const unsigned c = xb_ld(&bar[XB_XCNT(j)]); sum += c; cnt += (c > 0u) ? 1u : 0u; mine = (j == x) ? c : mine; }
        if (sum == G) break;
        __builtin_amdgcn_s_sleep(1);
        if ((++sp & 255u) == 0u) { if (xb_ld(&bar[XB_TMO])) break; if (sp > XB_SPIN_CAP) { atomicAdd(&bar[XB_TMO], 1u); break; } }
    }
    nloc = mine > 0u ? mine : 1u; nx = cnt > 0u ? cnt : 1u;
}

__device__ __forceinline__ void xcd_barrier(const XcdBarrier& b) {
    asm volatile("s_waitcnt vmcnt(0)" ::: "memory");
    __syncthreads();
    if (threadIdx.x == 0) {
        unsigned* bar = b.bar;
        __builtin_amdgcn_s_waitcnt(0);
        unsigned nloc = b.st[0], nx = b.st[1];
        if (nloc == 0u) { xcd_barrier_complete(bar, b.x, nloc, nx); b.st[0] = nloc; b.st[1] = nx; }
        const unsigned old = xb_add(&bar[XB_XSUB(b.x)], 1u);
        const unsigned gen = old / nloc;
        if (old + 1u == (gen + 1u) * nloc) {
            __builtin_amdgcn_fence(__ATOMIC_RELEASE, "agent");
            asm volatile("s_waitcnt vmcnt(0)" ::: "memory");
            const unsigned og = xb_add(&bar[XB_TOP], 1u);
            const unsigned tg = og / nx;
            if (og + 1u == (tg + 1u) * nx) xb_add(&bar[XB_TOPGEN], 1u);
            else XB_SPIN(xb_ld(&bar[XB_TOPGEN]) == tg, bar);
            __builtin_amdgcn_fence(__ATOMIC_ACQUIRE, "agent");
            xb_add(&bar[XB_XGEN(b.x)], 1u);
            asm volatile("s_waitcnt vmcnt(0)" ::: "memory");
        } else {
            XB_SPIN(xb_ld(&bar[XB_XGEN(b.x)]) == gen, bar);
            __builtin_amdgcn_fence(__ATOMIC_ACQUIRE, "agent");
            asm volatile("s_waitcnt vmcnt(0)" ::: "memory");
        }
    }
    __syncthreads();
}
constexpr int NWAVES = 8;
constexpr int DM = 1024, NBATCH = 8, SEQ = 4096, NMETA = 16;
constexpr int MROWS = NBATCH * SEQ;
constexpr int LPB = SEQ + 64;
constexpr int PROWS = NBATCH * LPB + 64;
constexpr int MZ = MROWS + 256;
constexpr int NZ = 5376, DIN = 5136;
constexpr int C_DAQ = 0, C_DAK = 512, C_DAV = 1024, C_GQ = 1536, C_GK = 1792, C_GV = 2048, C_GR = 2560, C_GG = 3072, C_GL = 3088;
constexpr float EPS = 1e-6f;
constexpr int NEXP = 32, DEXP = 512, LCAP = 32768;
constexpr int NPOS = SEQ + NMETA;

constexpr size_t MiB = 1u << 20;
constexpr size_t WS_CTL = 0, CTL_ZERO_BYTES = 1 * MiB, WS_TRASH = 768 * 1024;
constexpr size_t WS_ROPE = 1 * MiB;
constexpr size_t WS_WRH = 3 * MiB, WS_WRL = 3 * MiB + 128 * 1024;
constexpr size_t WS_IG2 = 3 * MiB + 512 * 1024;
constexpr size_t WS_LTOK = 4 * MiB, WS_LRS = 12 * MiB, WS_LW = 20 * MiB;
constexpr size_t WS_WIN = 28 * MiB, WS_WBR = 39 * MiB, WS_WOUT = 41 * MiB, WS_WGU = 43 * MiB, WS_WD = 107 * MiB;
constexpr size_t WS_R1 = 139 * MiB;
constexpr size_t WS_Q = 204 * MiB, WS_K = 236 * MiB, WS_V = 269 * MiB;
constexpr size_t WS_OA = 204 * MiB, WS_H2U = 204 * MiB;
constexpr size_t WS_GQ = 302 * MiB, WS_GK = 319 * MiB, WS_GV = 336 * MiB, WS_GR = 369 * MiB, WS_LOGA = 402 * MiB;
constexpr size_t WS_HID = 302 * MiB;
constexpr size_t WS_H2U8 = 269 * MiB;
constexpr float W8SCALE = 32.0f, H8SCALE = 4.0f;
constexpr size_t WS_DS = 435 * MiB, WS_END = 500 * MiB;
static_assert(WS_R1 + (size_t)MZ * DM * 2 <= WS_Q && WS_K + (size_t)PROWS * 512 * 2 <= WS_V && WS_V + (size_t)PROWS * 512 * 2 <= WS_GQ, "ws map 1");
static_assert(WS_GQ + (size_t)PROWS * 256 * 2 <= WS_GK && WS_GK + (size_t)PROWS * 256 * 2 <= WS_GV && WS_GV + (size_t)PROWS * 512 * 2 <= WS_GR && WS_GR + (size_t)PROWS * 512 * 2 <= WS_LOGA && WS_LOGA + (size_t)PROWS * 256 * 4 <= WS_DS, "ws map 2");
static_assert(WS_HID + (size_t)81920 * 512 * 2 <= WS_DS && WS_DS + (size_t)32 * 64 * 8192 * 4 <= WS_END && WS_WIN + (size_t)NZ * DM * 2 <= WS_WBR && WS_WD + (size_t)32 * 1024 * 512 * 2 <= WS_R1, "ws map 3");
constexpr int CW_TMO = 0, CW_BAR = 4096, CW_CNT = 16384;

constexpr int RING_OFF = 0, RING_BYTES = 131072;
constexpr int LDSCTL_OFF = RING_BYTES, MISC_OFF = LDSCTL_OFF + 320, TB_OFF = LDSCTL_OFF + 1024, CN_OFF = LDSCTL_OFF + 1536;
constexpr int INTAB_OFF = LDSCTL_OFF + 3072;
constexpr int LDS_BYTES = 147456;
struct Frame {
    LAS unsigned char* lds;
    volatile LAS unsigned* MISC;
    gu32* ctl;
    int tid, lane, wave, vcu, G;
    float* out; unsigned char* ws;
    __device__ __forceinline__ const float* inp(int i) const { const unsigned long long v = ((const LAS unsigned long long*)(lds + INTAB_OFF))[i];
        return (const float*)(((unsigned long long)(unsigned)__builtin_amdgcn_readfirstlane((int)(v >> 32)) << 32) | (unsigned)__builtin_amdgcn_readfirstlane((int)v)); }
};
enum { I_X = 0, I_META, I_GMIX, I_WIN, I_GQN, I_GKN, I_LQ1, I_LK1, I_LQ2, I_LK2, I_GSUB, I_WGUP, I_BGATE, I_GGLA, I_WBR, I_BMERGE, I_WOUT, I_GFFN, I_WRG, I_BRG, I_WRE, I_BRE, I_WEG, I_WEU, I_WED };
#define WSP(T, off) ((T*)(F.ws + (off)))

__device__ __forceinline__ float wave_sum(float v) {
#pragma unroll
    for (int o = 1; o < 64; o <<= 1) v += __shfl_xor(v, o);
    return v;
}
__device__ __forceinline__ float bf2f(bf16 v) { return __uint_as_float((unsigned)v << 16); }
__device__ __forceinline__ float sigmoidf_(float x) { return 1.0f / (1.0f + __expf(-x)); }

__device__ __forceinline__ void transpose_tile(const float* src, int Ns, bf16* dst, int Kd, LAS float* scr, int lane) {
    float tv[32];
#pragma unroll
    for (int i = 0; i < 32; ++i) tv[i] = src[(unsigned)((2 * i + (lane >> 5)) * Ns + (lane & 31))];
#pragma unroll
    for (int i = 0; i < 32; ++i) scr[(2 * i + (lane >> 5)) * 33 + (lane & 31)] = tv[i];
    LDS_WAIT(); asm volatile("" ::: "memory");
    const int c = lane & 7;
#pragma unroll
    for (int j = 0; j < 4; ++j) { const int n = (lane >> 3) + 8 * j; const LAS float* s = scr + (8 * c) * 33 + n;
        v4u o; o.x = pk2(s[0 * 33], s[1 * 33]); o.y = pk2(s[2 * 33], s[3 * 33]); o.z = pk2(s[4 * 33], s[5 * 33]); o.w = pk2(s[6 * 33], s[7 * 33]);
        *(GAS v4u*)(dst + (size_t)n * Kd + 8 * c) = o; }
    LDS_WAIT(); asm volatile("" ::: "memory");
}
__device__ __forceinline__ void product_tile(const float* win, const float* wgu, int k0, int n0, bf16* dst, LAS float* scr, int lane) {
    float wg[16];
#pragma unroll
    for (int r = 0; r < 16; ++r) wg[r] = wgu[r * 256 + n0 + (lane & 31)];
    LAS float* gb = scr + 64 * 33;
#pragma unroll
    for (int j = 0; j < 4; ++j) { const int idx = lane + 64 * j, kk = idx >> 2, q = idx & 3; *(LAS f32x4*)(gb + kk * 16 + 4 * q) = *(const GAS f32x4*)(win + (size_t)(k0 + kk) * DIN + C_GG + 4 * q); }
    LDS_WAIT(); asm volatile("" ::: "memory");
#pragma unroll 4
    for (int i = 0; i < 32; ++i) { const int kk = 2 * i + (lane >> 5); const LAS f32x4* g4 = (const LAS f32x4*)(gb + kk * 16); float s = 0.f;
#pragma unroll
        for (int q = 0; q < 4; ++q) { const f32x4 g = g4[q]; s += g.x * wg[4 * q] + g.y * wg[4 * q + 1] + g.z * wg[4 * q + 2] + g.w * wg[4 * q + 3]; }
        scr[kk * 33 + (lane & 31)] = s; }
    LDS_WAIT(); asm volatile("" ::: "memory");
    const int c = lane & 7;
#pragma unroll
    for (int j = 0; j < 4; ++j) { const int n = (lane >> 3) + 8 * j; const LAS float* s = scr + (8 * c) * 33 + n;
        v4u o; o.x = pk2(s[0 * 33], s[1 * 33]); o.y = pk2(s[2 * 33], s[3 * 33]); o.z = pk2(s[4 * 33], s[5 * 33]); o.w = pk2(s[6 * 33], s[7 * 33]);
        *(GAS v4u*)(dst + (size_t)n * DM + 8 * c) = o; }
    LDS_WAIT(); asm volatile("" ::: "memory");
}
__device__ __forceinline__ int win_src_col(int T, int p0) {
    if (T < 4) { const int bj = p0 >> 7, wc = (p0 >> 5) & 3; return (T < 2 ? C_DAQ + 256 * T : C_DAK + 256 * (T - 2)) + 64 * wc + 32 * bj; }
    if (T < 6) return C_DAV + 256 * (T - 4) + p0;
    if (T == 6) return C_GQ + p0;
    if (T == 7) return C_GK + p0;
    if (T < 10) return C_GV + 256 * (T - 8) + p0;
    if (T < 12) return C_GR + 256 * (T - 10) + p0;
    const int t = T - 13; return p0 < 128 ? C_GL + 128 * t + p0 : C_GL + 1024 + 128 * t + (p0 - 128);
}
template <int NR> __device__ __forceinline__ void rms_rows_to_bf16(Frame& F, const float* const (&xrow)[NR], const float* gain, bf16* const (&orow)[NR]) {
    const GAS f32x4* gr = (const GAS f32x4*)gain + F.lane;
    f32x4 v[NR][4];
#pragma unroll
    for (int r = 0; r < NR; ++r) { const GAS f32x4* xr = (const GAS f32x4*)xrow[r] + F.lane;
#pragma unroll
        for (int j = 0; j < 4; ++j) v[r][j] = xr[64 * j]; }
#pragma unroll
    for (int r = 0; r < NR; ++r) { float s = 0.f;
#pragma unroll
        for (int j = 0; j < 4; ++j) s += (v[r][j].x * v[r][j].x + v[r][j].y * v[r][j].y) + (v[r][j].z * v[r][j].z + v[r][j].w * v[r][j].w);
        const float rstd = 1.f / sqrtf(wave_sum(s) * (1.f / DM) + EPS);
        GAS unsigned long long* o8 = (GAS unsigned long long*)orow[r] + F.lane;
#pragma unroll
        for (int j = 0; j < 4; ++j) { const f32x4 g = gr[64 * j]; o8[64 * j] = (unsigned long long)pk2(v[r][j].x * rstd * g.x, v[r][j].y * rstd * g.y) | ((unsigned long long)pk2(v[r][j].z * rstd * g.z, v[r][j].w * rstd * g.w) << 32); } }
}
constexpr int N_EXPERT_ITEMS = NEXP * 256 + NEXP * 128;
__device__ __forceinline__ void expert_conv_desc(Frame& F, int it, const float*& src, unsigned char*& dst, unsigned& Ns, unsigned& Kd) {
    if (it < NEXP * 256) { const int e = it >> 8, q = it & 255, kb = q >> 4, nbp = q & 15, P0 = nbp * 64, pn = P0 >> 8, p = P0 & 255;
        src = (p < 128 ? F.inp(I_WEG) : F.inp(I_WEU)) + (size_t)e * 1024 * 512 + (size_t)(kb * 64) * 512 + 128 * pn + (p & 127); Ns = 512;
        dst = WSP(unsigned char, WS_WGU) + (size_t)(e * 1024 + P0) * 1024 + kb * 64; Kd = 1024; }
    else { const int r = it - NEXP * 256, e = r >> 7, q = r & 127, kb = q >> 4, nb = q & 15;
        src = F.inp(I_WED) + (size_t)e * 512 * 1024 + (size_t)(kb * 64) * 1024 + nb * 64; Ns = 1024; dst = WSP(unsigned char, WS_WD) + (size_t)(e * 1024 + nb * 64) * 512 + kb * 64; Kd = 512; }
}
__device__ __forceinline__ float clamp8(float x) { return fminf(fmaxf(x, -448.0f), 448.0f); }
__device__ __forceinline__ unsigned pk4_fp8(float a, float b, float c, float d) { unsigned w = 0; w = __builtin_amdgcn_cvt_pk_fp8_f32(clamp8(a), clamp8(b), w, false); w = __builtin_amdgcn_cvt_pk_fp8_f32(clamp8(c), clamp8(d), w, true); return w; }
__device__ __forceinline__ void expert_conv_store(unsigned char* dst, unsigned Kd, const float (&v)[64], int lane, LAS unsigned char* stg) {
#pragma unroll
    for (int kg = 0; kg < 4; ++kg) { v4u o;
        o.x = pk4_fp8(v[16 * kg] * W8SCALE, v[16 * kg + 1] * W8SCALE, v[16 * kg + 2] * W8SCALE, v[16 * kg + 3] * W8SCALE); o.y = pk4_fp8(v[16 * kg + 4] * W8SCALE, v[16 * kg + 5] * W8SCALE, v[16 * kg + 6] * W8SCALE, v[16 * kg + 7] * W8SCALE);
        o.z = pk4_fp8(v[16 * kg + 8] * W8SCALE, v[16 * kg + 9] * W8SCALE, v[16 * kg + 10] * W8SCALE, v[16 * kg + 11] * W8SCALE); o.w = pk4_fp8(v[16 * kg + 12] * W8SCALE, v[16 * kg + 13] * W8SCALE, v[16 * kg + 14] * W8SCALE, v[16 * kg + 15] * W8SCALE);
        *(LAS v4u*)(stg + lane * 80 + kg * 16) = o; }
    LDS_WAIT(); asm volatile("" ::: "memory");
#pragma unroll
    for (int i = 0; i < 4; ++i) { const int r = (lane >> 2) + 16 * i, c = lane & 3; const v4u o = *(const LAS v4u*)(stg + r * 80 + c * 16); *(GAS v4u*)(dst + (size_t)r * Kd + 16 * c) = o; }
    LDS_WAIT(); asm volatile("" ::: "memory");
}
__device__ __forceinline__ void expert_conv_range(Frame& F, int first, int me, int nw) {
    const int stride = nw; LAS unsigned char* stg = F.lds + RING_OFF + F.wave * 9216;
    for (int it = first + me; it < N_EXPERT_ITEMS; it += 2 * stride) {
        const float *s0, *s1; unsigned char *d0, *d1; unsigned n0, k0, n1, k1; const bool two = it + stride < N_EXPERT_ITEMS;
        expert_conv_desc(F, it, s0, d0, n0, k0); expert_conv_desc(F, two ? it + stride : it, s1, d1, n1, k1);
        float va[64], vb[64];
#pragma unroll
        for (int k = 0; k < 64; ++k) va[k] = s0[(unsigned)k * n0 + (unsigned)F.lane];
        if (two) {
#pragma unroll
            for (int k = 0; k < 64; ++k) vb[k] = s1[(unsigned)k * n1 + (unsigned)F.lane]; }
        expert_conv_store(d0, k0, va, F.lane, stg);
        if (two) expert_conv_store(d1, k1, vb, F.lane, stg);
    }
    asm volatile("s_waitcnt lgkmcnt(0)" ::: "memory"); __syncthreads();
}
__device__ __forceinline__ void expert_conv_slot(Frame& F, int slot, int nslot, int first) { expert_conv_range(F, first, (slot * F.G + F.vcu) * NWAVES + F.wave, nslot * F.G * NWAVES); }
__device__ __forceinline__ void late_tables(Frame& F, int gt, int NGT) {
    { bf16* wh = WSP(bf16, WS_WRH); bf16* wl = WSP(bf16, WS_WRL);
      for (int i = gt; i < 48 * 1024; i += NGT) { const int n = i >> 10, k = i & 1023; const float v = n < 4 ? F.inp(I_WRG)[k * 4 + n] : (n < 36 ? F.inp(I_WRE)[k * 32 + (n - 4)] : 0.f);
          const unsigned h = f2bf(v); const float hf = __uint_as_float(h << 16); wh[i] = (bf16)h; wl[i] = (bf16)f2bf(v - hf); } }
    { float* ig = WSP(float, WS_IG2); for (int i = gt; i < DM; i += NGT) { const float g = F.inp(I_GFFN)[i]; ig[i] = 1.0f / (g * g); } }
    { unsigned* kz = (unsigned*)(WSP(bf16, WS_K) + (size_t)NBATCH * LPB * 512); unsigned* vz = (unsigned*)(WSP(bf16, WS_V) + (size_t)NBATCH * LPB * 512);
      for (int i = gt; i < 64 * 512 / 2; i += NGT) { kz[i] = 0u; vz[i] = 0u; } }
}
#define P1_EXTRA(G) (((MZ / 256) * (NZ / 256)) % (G))
constexpr int P1_TILES_PER_WAVE = 6;
__device__ __forceinline__ int p1_conv_items(int G) { const int ex = P1_EXTRA(G), n = ex ? (G - ex) * NWAVES * P1_TILES_PER_WAVE : 0; return n < N_EXPERT_ITEMS ? n : N_EXPERT_ITEMS; }
__device__ __forceinline__ void expert_conv_first(Frame& F, int me, int nw, int cnt) {
    LAS unsigned char* stg = F.lds + RING_OFF + F.wave * 9216;
    for (int it = me; it < cnt; it += 2 * nw) {
        const float *s0, *s1; unsigned char *d0, *d1; unsigned n0, k0, n1, k1; const bool two = it + nw < cnt;
        expert_conv_desc(F, it, s0, d0, n0, k0); expert_conv_desc(F, two ? it + nw : it, s1, d1, n1, k1);
        float va[64], vb[64];
#pragma unroll
        for (int k = 0; k < 64; ++k) va[k] = s0[(unsigned)k * n0 + (unsigned)F.lane];
        if (two) {
#pragma unroll
            for (int k = 0; k < 64; ++k) vb[k] = s1[(unsigned)k * n1 + (unsigned)F.lane]; }
        expert_conv_store(d0, k0, va, F.lane, stg);
        if (two) expert_conv_store(d1, k1, vb, F.lane, stg);
    }
}
__device__ __forceinline__ void p0_prologue(Frame& F) {
    LAS float* scr = (LAS float*)(F.lds + RING_OFF + F.wave * 16384);
    const int gw = F.vcu * NWAVES + F.wave, NGW = F.G * NWAVES;
    constexpr int I_A = (NZ / 32) * 16, I_B = 2 * 32 * 8, I_C = 32 * 16, NITEMS = I_A + I_B + I_C;
    bf16* WIN = WSP(bf16, WS_WIN);
    for (int it = gw; it < NITEMS; it += NGW) {
        int r = it; const float* src; bf16* dst; int Ns, Kd;
        if (r < I_A) { const int kb = r / (NZ / 32), nb = r % (NZ / 32), T = nb >> 3, p0 = (nb & 7) * 32; dst = WIN + (size_t)(nb * 32) * DM + kb * 64;
            if (T == 12) { product_tile(F.inp(I_WIN), F.inp(I_WGUP), kb * 64, p0, dst, scr, F.lane); continue; }
            src = F.inp(I_WIN) + (size_t)(kb * 64) * DIN + win_src_col(T, p0); Ns = DIN; Kd = DM; }
        else if ((r -= I_A) < I_B) { const int br = r >> 8, q = r & 255, kb = q >> 5, nb = q & 31;
            src = F.inp(I_WBR) + (size_t)br * 512 * 1024 + (size_t)(kb * 64) * 1024 + nb * 32; Ns = 1024; dst = WSP(bf16, WS_WBR) + (size_t)(br * 1024 + nb * 32) * 512 + kb * 64; Kd = 512; }
        else { r -= I_B; const int kb = r >> 5, nb = r & 31;
            src = F.inp(I_WOUT) + (size_t)(kb * 64) * 1024 + nb * 32; Ns = 1024; dst = WSP(bf16, WS_WOUT) + (size_t)(nb * 32) * 1024 + kb * 64; Kd = 1024; }
        transpose_tile(src, Ns, dst, Kd, scr, F.lane);
    }
#ifdef PROBE_K
    if (PROBE_K == 100 && blockIdx.x == 0 && F.tid == 0) ((volatile LAS unsigned long long*)(F.lds + LDSCTL_OFF + 2048))[1] = __builtin_amdgcn_s_memrealtime();
#endif
    bf16* XN = WSP(bf16, WS_R1);
    for (int m = gw; m < MROWS; m += 4 * NGW) {
        if (m + 3 * NGW < MROWS) { const float* const xr[4] = {F.inp(I_X) + (size_t)m * DM, F.inp(I_X) + (size_t)(m + NGW) * DM, F.inp(I_X) + (size_t)(m + 2 * NGW) * DM, F.inp(I_X) + (size_t)(m + 3 * NGW) * DM};
            bf16* const orr[4] = {XN + (size_t)m * DM, XN + (size_t)(m + NGW) * DM, XN + (size_t)(m + 2 * NGW) * DM, XN + (size_t)(m + 3 * NGW) * DM}; rms_rows_to_bf16<4>(F, xr, F.inp(I_GMIX), orr); }
        else for (int k = 0; k < 4; ++k) { const int mm = m + k * NGW; if (mm < MROWS) { const float* const xr[1] = {F.inp(I_X) + (size_t)mm * DM}; bf16* const orr[1] = {XN + (size_t)mm * DM}; rms_rows_to_bf16<1>(F, xr, F.inp(I_GMIX), orr); } }
    }
    for (int m = MROWS + gw; m < MZ; m += NGW) {
        if (m < MROWS + NMETA) { const float* const xr[1] = {F.inp(I_META) + (size_t)(m - MROWS) * DM}; bf16* const orr[1] = {XN + (size_t)m * DM}; rms_rows_to_bf16<1>(F, xr, F.inp(I_GMIX), orr); }
        else { GAS v4u* o = (GAS v4u*)(XN + (size_t)m * DM) + F.lane; o[0] = (v4u){0u, 0u, 0u, 0u}; o[64] = (v4u){0u, 0u, 0u, 0u}; }
    }
#ifdef PROBE_K
    if (PROBE_K == 101 && blockIdx.x == 0 && F.tid == 0) ((volatile LAS unsigned long long*)(F.lds + LDSCTL_OFF + 2048))[1] = __builtin_amdgcn_s_memrealtime();
#endif
    const int gt = gw * 64 + F.lane, NGT = NGW * 64;
    { float* rc = WSP(float, WS_ROPE); float* rs = rc + NPOS * 32;
      for (int i = gt; i < NPOS * 32; i += NGT) { const int pos = i >> 5, j = i & 31; const float inv = exp2f(-(float)j * 0.41524101186092029f); const float ang = (float)pos * inv;
          const double rev = (double)ang * 0.15915494309189535; const float x = (float)(rev - rint(rev));
          rc[i] = __builtin_amdgcn_cosf(x); rs[i] = __builtin_amdgcn_sinf(x); } }
}
namespace epi {
using pg8::f32x4; using pg8::u32x4; using pg8::Unit; using pg8::pack8; using pg8::HALF;
__device__ __forceinline__ unsigned pk4_fp8(float a, float b, float c, float d) { unsigned w = 0; w = __builtin_amdgcn_cvt_pk_fp8_f32(clamp8(a), clamp8(b), w, false); w = __builtin_amdgcn_cvt_pk_fp8_f32(clamp8(c), clamp8(d), w, true); return w; }
constexpr float Y8SCALE = 64.0f;
__device__ __forceinline__ float cy8(float y) { return y * Y8SCALE; }
__device__ __forceinline__ f32x4 un4_fp8(unsigned w) { typedef float f2_ __attribute__((ext_vector_type(2))); const f2_ a = __builtin_amdgcn_cvt_pk_f32_fp8(w, false), b = __builtin_amdgcn_cvt_pk_f32_fp8(w, true); return (f32x4){a[0], a[1], b[0], b[1]}; }
__device__ __forceinline__ float c8(float h) { return h * H8SCALE; }
__device__ __forceinline__ float log_sigmoid(float x) { return fminf(x, 0.f) - __logf(1.0f + __expf(-fabsf(x))); }

struct EpiZ {
    bf16 *Q, *K, *V, *GQ, *GK, *GV, *GR, *RATIO, *G1; float* LOGA;
    const float *gq, *gk, *bgate, *bmerge, *ropec, *ropes;
    __device__ __forceinline__ bool operator()(f32x4 (&acc)[2][2][4][2], const Unit& u, int wr, int wc, int fr, int fq) const {
        const int pn = u.pn, pm = u.pm; const bool meta = (pm == MROWS / 256);
        int oz; asm volatile("v_mov_b32 %0, 0" : "=v"(oz));
        const int r0 = wr * 64 + fr + oz, cl = wc * 32 + 8 * fq;
        const int bsh = 64 * ((pm >> 4) + 1);
        if (pn < 4) {
            const bool isq = pn < 2; if (isq && meta) return false;
            const float* gn = isq ? gq : gk;
            const f32x4 ga0 = *(const f32x4*)(gn + 8 * fq), ga1 = *(const f32x4*)(gn + 8 * fq + 4), gb0 = *(const f32x4*)(gn + 32 + 8 * fq), gb1 = *(const f32x4*)(gn + 36 + 8 * fq);
            const int hcol = ((pn & 1) * 4 + wc) * 64 + 8 * fq;
            const float osc = isq ? 0.125f * 1.4426950408889634f : 1.0f;
#pragma unroll
            for (int ai = 0; ai < 2; ++ai)
#pragma unroll
                for (int m = 0; m < 4; ++m) {
                    if (meta && (ai != 0 || wr != 0)) continue;
                    const int r = r0 + ai * HALF + m * 16;
                    const f32x4 x1a = acc[ai][0][m][0], x1b = acc[ai][0][m][1], x2a = acc[ai][1][m][0], x2b = acc[ai][1][m][1];
                    float ss = (x1a[0] * x1a[0] + x1a[1] * x1a[1]) + (x1a[2] * x1a[2] + x1a[3] * x1a[3]) + (x1b[0] * x1b[0] + x1b[1] * x1b[1]) + (x1b[2] * x1b[2] + x1b[3] * x1b[3])
                             + (x2a[0] * x2a[0] + x2a[1] * x2a[1]) + (x2a[2] * x2a[2] + x2a[3] * x2a[3]) + (x2b[0] * x2b[0] + x2b[1] * x2b[1]) + (x2b[2] * x2b[2] + x2b[3] * x2b[3]);
                    ss += __shfl_xor(ss, 16); ss += __shfl_xor(ss, 32);
                    const float rn = 1.0f / sqrtf(ss * (1.0f / 64.0f) + EPS);
                    const int pos = meta ? r : NMETA + ((pm * 256 + r) & (SEQ - 1));
                    const f32x4 c0 = *(const f32x4*)(ropec + pos * 32 + 8 * fq), c1 = *(const f32x4*)(ropec + pos * 32 + 8 * fq + 4), s0 = *(const f32x4*)(ropes + pos * 32 + 8 * fq), s1 = *(const f32x4*)(ropes + pos * 32 + 8 * fq + 4);
                    const f32x4 y1a = x1a * rn * ga0, y1b = x1b * rn * ga1, y2a = x2a * rn * gb0, y2b = x2b * rn * gb1;
                    const f32x4 o1a = (y1a * c0 - y2a * s0) * osc, o1b = (y1b * c1 - y2b * s1) * osc, o2a = (y2a * c0 + y1a * s0) * osc, o2b = (y2b * c1 + y1b * s1) * osc;
                    const u32x4 w1 = pack8(o1a, o1b), w2 = pack8(o2a, o2b);
                    if (isq) { bf16* p = Q + (size_t)(pm * 256 + r) * 512 + hcol; *(u32x4*)p = w1; *(u32x4*)(p + 32) = w2; }
                    else if (!meta) { bf16* p = K + (size_t)(pm * 256 + r + bsh) * 512 + hcol; *(u32x4*)p = w1; *(u32x4*)(p + 32) = w2; }
                    else { for (int b = 0; b < NBATCH; ++b) { bf16* p = K + (size_t)(b * LPB + r) * 512 + hcol; *(u32x4*)p = w1; *(u32x4*)(p + 32) = w2; } }
                    asm volatile("" ::: "memory");
                }
            return false;
        }
        if (pn < 12) {
            bf16* T; int pitch, cb; float sc = 1.0f; bool wmeta = true;
            if (pn < 6) { T = V; pitch = 512; cb = (pn - 4) * 256; }
            else if (pn == 6) { T = GQ; pitch = 256; cb = 0; sc = 0.125f; wmeta = false; }
            else if (pn == 7) { T = GK; pitch = 256; cb = 0; }
            else if (pn < 10) { T = GV; pitch = 512; cb = (pn - 8) * 256; }
            else { T = GR; pitch = 512; cb = (pn - 10) * 256; wmeta = false; }
            if (meta && !wmeta) return false;
#pragma unroll
            for (int ai = 0; ai < 2; ++ai)
#pragma unroll
                for (int m = 0; m < 4; ++m) {
                    if (meta && (ai != 0 || wr != 0)) continue;
                    const int r = r0 + ai * HALF + m * 16;
#pragma unroll
                    for (int bj = 0; bj < 2; ++bj) { const u32x4 w = pack8(acc[ai][bj][m][0] * sc, acc[ai][bj][m][1] * sc); const int col = cb + bj * HALF + cl;
                        if (!meta) *(u32x4*)(T + (size_t)(pm * 256 + r + bsh) * pitch + col) = w;
                        else for (int b = 0; b < NBATCH; ++b) *(u32x4*)(T + (size_t)(b * LPB + r) * pitch + col) = w; }
                    asm volatile("" ::: "memory");
                }
            return false;
        }
        if (pn == 12) {
#pragma unroll
            for (int bj = 0; bj < 2; ++bj) { const int col = bj * HALF + cl; const f32x4 b0 = *(const f32x4*)(bgate + col), b1 = *(const f32x4*)(bgate + col + 4);
#pragma unroll
                for (int ai = 0; ai < 2; ++ai)
#pragma unroll
                    for (int m = 0; m < 4; ++m) {
                        if (meta && (ai != 0 || wr != 0)) continue;
                        const int r = r0 + ai * HALF + m * 16; const f32x4 a0 = acc[ai][bj][m][0] + b0, a1 = acc[ai][bj][m][1] + b1; f32x4 v0, v1;
#pragma unroll
                        for (int i = 0; i < 4; ++i) { v0[i] = log_sigmoid(a0[i]) * (1.0f / 16.0f); v1[i] = log_sigmoid(a1[i]) * (1.0f / 16.0f); }
                        if (!meta) { float* p = LOGA + (size_t)(pm * 256 + r + bsh) * 256 + col; *(f32x4*)p = v0; *(f32x4*)(p + 4) = v1; }
                        else { if (r >= NMETA) { v0 = (f32x4){0.f, 0.f, 0.f, 0.f}; v1 = v0; }
                               for (int b = 0; b < NBATCH; ++b) { float* p = LOGA + (size_t)(b * LPB + r) * 256 + col; *(f32x4*)p = v0; *(f32x4*)(p + 4) = v1; } }
                        asm volatile("" ::: "memory");
                    } }
            return false;
        }
        if (meta) return false;
        { const int d = 128 * (pn - 13) + cl;
          const f32x4 b00 = *(const f32x4*)(bmerge + d), b01 = *(const f32x4*)(bmerge + d + 4), b10 = *(const f32x4*)(bmerge + DM + d), b11 = *(const f32x4*)(bmerge + DM + d + 4);
#pragma unroll
          for (int ai = 0; ai < 2; ++ai)
#pragma unroll
              for (int m = 0; m < 4; ++m) { const int r = r0 + ai * HALF + m * 16;
                  const f32x4 x00 = acc[ai][0][m][0] + b00, x01 = acc[ai][0][m][1] + b01, x10 = acc[ai][1][m][0] + b10, x11 = acc[ai][1][m][1] + b11; f32x4 ra, rb, ga, gb;
#pragma unroll
                  for (int i = 0; i < 4; ++i) { const float e0 = 1.0f + __expf(-x00[i]), e1 = 1.0f + __expf(-x10[i]); ra[i] = e1 * __builtin_amdgcn_rcpf(e0); ga[i] = __builtin_amdgcn_rcpf(e1);
                                                const float f0 = 1.0f + __expf(-x01[i]), f1 = 1.0f + __expf(-x11[i]); rb[i] = f1 * __builtin_amdgcn_rcpf(f0); gb[i] = __builtin_amdgcn_rcpf(f1); }
                  const size_t o = (size_t)(pm * 256 + r) * DM + d; *(u32x4*)(RATIO + o) = pack8(ra, rb); *(u32x4*)(G1 + o) = pack8(ga, gb); asm volatile("" ::: "memory"); } }
        return false;
    }
};
struct EpiMerge {
    const bf16 *RATIO, *G1; bf16* MERGED;
    __device__ __forceinline__ bool operator()(f32x4 (&acc)[2][2][4][2], const Unit& u, int wr, int wc, int fr, int fq) const {
        const int br = u.aux, pm = u.pm - (MROWS / 256) * br, pn = u.pn - 4 * br;
        const int r0 = pm * 256 + wr * 64 + fr, c0 = pn * 256 + wc * 32 + 8 * fq;
        const bf16* src = br ? G1 : RATIO;
#pragma unroll
        for (int ai = 0; ai < 2; ++ai) { u32x4 g[4][2];
#pragma unroll
            for (int m = 0; m < 4; ++m)
#pragma unroll
                for (int bj = 0; bj < 2; ++bj) g[m][bj] = *(const u32x4*)(src + (size_t)(r0 + ai * HALF + m * 16) * DM + c0 + bj * HALF);
#pragma unroll
            for (int m = 0; m < 4; ++m)
#pragma unroll
                for (int bj = 0; bj < 2; ++bj) { const size_t o = (size_t)(r0 + ai * HALF + m * 16) * DM + c0 + bj * HALF; const u32x4 gg = g[m][bj];
                    const f32x4 g0 = {pg8::bf_lo(gg.x), pg8::bf_hi(gg.x), pg8::bf_lo(gg.y), pg8::bf_hi(gg.y)}, g1 = {pg8::bf_lo(gg.z), pg8::bf_hi(gg.z), pg8::bf_lo(gg.w), pg8::bf_hi(gg.w)};
                    const f32x4 v0 = acc[ai][bj][m][0] * g0, v1 = acc[ai][bj][m][1] * g1;
                    if (br) *(u32x4*)(MERGED + o) = pack8(v0, v1); else { acc[ai][bj][m][0] = v0; acc[ai][bj][m][1] = v1; } }
            asm volatile("" ::: "memory"); }
        return br == 0;
    }
};
struct EpiOut {
    const float* x; bf16* H2U; const float* gffn; unsigned char* H2U8;
    __device__ __forceinline__ bool operator()(f32x4 (&acc)[2][2][4][2], const Unit& u, int wr, int wc, int fr, int fq) const {
        const int r0 = u.pm * 256 + wr * 64 + fr, c0 = u.pn * 256 + wc * 32 + 8 * fq;
#pragma unroll
        for (int bj = 0; bj < 2; ++bj) { const f32x4 ga = *(const f32x4*)(gffn + c0 + bj * HALF), gb = *(const f32x4*)(gffn + c0 + bj * HALF + 4);
#pragma unroll
            for (int ai = 0; ai < 2; ++ai) { f32x4 xa[4], xb[4];
#pragma unroll
                for (int m = 0; m < 4; ++m) { const size_t o = (size_t)(r0 + ai * HALF + m * 16) * DM + c0 + bj * HALF; xa[m] = *(const f32x4*)(x + o); xb[m] = *(const f32x4*)(x + o + 4); }
#pragma unroll
                for (int m = 0; m < 4; ++m) { const size_t o = (size_t)(r0 + ai * HALF + m * 16) * DM + c0 + bj * HALF;
                    const f32x4 u0 = xa[m] + acc[ai][bj][m][0], u1 = xb[m] + acc[ai][bj][m][1];
                    const f32x4 h0 = u0 * ga, h1 = u1 * gb; *(u32x4*)(H2U + o) = pack8(h0, h1); *(pg8::u32x2*)(H2U8 + o) = (pg8::u32x2){pk4_fp8(h0[0], h0[1], h0[2], h0[3]), pk4_fp8(h1[0], h1[1], h1[2], h1[3])}; }
                asm volatile("" ::: "memory"); } }
        return false;
    }
};
template <bool GATHER_> struct MoeSched {
    static constexpr bool GATHER = GATHER_;
    const LAS int* tb; const LAS int* cn; const int* ltok; int seg_lo, seg_hi, G, c;
    __device__ __forceinline__ bool next(int i, Unit& u) const {
        const int t0 = __builtin_amdgcn_readfirstlane(tb[seg_lo]), t1 = __builtin_amdgcn_readfirstlane(tb[seg_hi]);
        const int U = (t1 - t0) * 4, R = U / G, r = U - R * G; int L, hf = 0;
        if (i < R) L = i * G + c;
        else if (i > R) return false;
        else if (2 * r <= G) { if (c >= 2 * r) return false; L = R * G + (c >> 1); hf = 1 + (c & 1); }
        else { if (c >= r) return false; L = R * G + c; }
        const int rt = t0 + (L >> 2), pnl = L & 3; int s = seg_lo, hi_ = seg_hi;
        while (hi_ - s > 1) { const int mid = (s + hi_) >> 1; if (__builtin_amdgcn_readfirstlane(tb[mid]) <= rt) s = mid; else hi_ = mid; }
        u.pm = rt; u.pn = (s & 31) * 4 + pnl; u.aux = s | ((rt - __builtin_amdgcn_readfirstlane(tb[s])) << 8); u.half = hf; return true;
    }
    __device__ __forceinline__ int grow(const Unit& u, int r) const { const int s = u.aux & 255, si = (u.aux >> 8) * 256 + r, last = cn[s] - 1; return ltok[(size_t)s * LCAP + (si < last ? si : last)]; }
};
struct EpiUp {
    const LAS int* cn; const float* lrs; unsigned char* HID;
    __device__ __forceinline__ bool operator()(f32x4 (&acc)[2][2][4][2], const Unit& u, int wr, int wc, int fr, int fq) const {
        const int s = u.aux & 255, rtl = u.aux >> 8, last = cn[s] - 1, pnl = u.pn & 3; float rsv[2][4];
#pragma unroll
        for (int ai = 0; ai < 2; ++ai)
#pragma unroll
            for (int m = 0; m < 4; ++m) { if (u.half == 2 - ai) { rsv[ai][m] = 0.f; continue; } const int si = rtl * 256 + wr * 64 + fr + ai * HALF + m * 16; rsv[ai][m] = lrs[(size_t)s * LCAP + (si < last ? si : last)] * (1.0f / W8SCALE); }
#pragma unroll
        for (int ai = 0; ai < 2; ++ai)
#pragma unroll
            for (int m = 0; m < 4; ++m) { if (u.half == 2 - ai) continue; const int r = wr * 64 + fr + ai * HALF + m * 16; const float rs = rsv[ai][m];
                f32x4 h0, h1;
#pragma unroll
                for (int i = 0; i < 4; ++i) { const float g0 = acc[ai][0][m][0][i] * rs, g1 = acc[ai][0][m][1][i] * rs;
                    h0[i] = g0 * __builtin_amdgcn_rcpf(1.0f + __expf(-g0)) * (acc[ai][1][m][0][i] * rs); h1[i] = g1 * __builtin_amdgcn_rcpf(1.0f + __expf(-g1)) * (acc[ai][1][m][1][i] * rs); }
                *(pg8::u32x2*)(HID + (size_t)(u.pm * 256 + r) * DEXP + pnl * 128 + wc * 32 + 8 * fq) = (pg8::u32x2){pk4_fp8(c8(h0[0]), c8(h0[1]), c8(h0[2]), c8(h0[3])), pk4_fp8(c8(h1[0]), c8(h1[1]), c8(h1[2]), c8(h1[3]))}; }
        return false;
    }
};
template <int MODE> struct EpiDown {
    const LAS int* cn; const int* ltok; const float* lw; float* out; unsigned char* Y0; float* trash; const bf16* H2U; const float* gffn;
    __device__ __forceinline__ bool operator()(f32x4 (&acc)[2][2][4][2], const Unit& u, int wr, int wc, int fr, int fq) const {
        const int s = u.aux & 255, rtl = u.aux >> 8, cnt = cn[s], pnl = u.pn & 3; int tok[2][4]; float wv[2][4];
#pragma unroll
        for (int ai = 0; ai < 2; ++ai)
#pragma unroll
            for (int m = 0; m < 4; ++m) { const int si = rtl * 256 + wr * 64 + fr + ai * HALF + m * 16, sc = si < cnt ? si : cnt - 1; tok[ai][m] = ltok[(size_t)s * LCAP + sc]; wv[ai][m] = lw[(size_t)s * LCAP + sc] * (1.0f / (W8SCALE * H8SCALE)); }
        const int cofs = pnl * 256 + wc * 32 + 8 * fq;
        f32x4 ig[2][2];
        if (MODE == 1) {
#pragma unroll
            for (int bj = 0; bj < 2; ++bj)
#pragma unroll
                for (int n = 0; n < 2; ++n) { const f32x4 g = *(const f32x4*)(gffn + cofs + bj * HALF + 4 * n); ig[bj][n] = (f32x4){__builtin_amdgcn_rcpf(g[0]), __builtin_amdgcn_rcpf(g[1]), __builtin_amdgcn_rcpf(g[2]), __builtin_amdgcn_rcpf(g[3])}; } }
#pragma unroll
        for (int ai = 0; ai < 2; ++ai)
#pragma unroll
            for (int mp = 0; mp < 4; mp += 2) { if (u.half == 2 - ai) continue; float* po[2]; unsigned char* py[2]; const bf16* ph[2]; pg8::u32x2 yv[2][2]; u32x4 hv[2][2];
#pragma unroll
                for (int k = 0; k < 2; ++k) { const int m = mp + k, si = rtl * 256 + wr * 64 + fr + ai * HALF + m * 16; const bool ok = si < cnt;
                    po[k] = ok ? out + (size_t)tok[ai][m] * DM + cofs : trash + cofs; py[k] = ok ? Y0 + (size_t)tok[ai][m] * DM + cofs : (unsigned char*)(trash + DM) + cofs; ph[k] = H2U + (size_t)tok[ai][m] * DM + cofs; }
                if (MODE == 1) {
#pragma unroll
                    for (int k = 0; k < 2; ++k)
#pragma unroll
                        for (int bj = 0; bj < 2; ++bj) { yv[k][bj] = *(const pg8::u32x2*)(py[k] + bj * HALF); hv[k][bj] = *(const u32x4*)(ph[k] + bj * HALF); } }
#pragma unroll
                for (int k = 0; k < 2; ++k) { const int m = mp + k; const float w = wv[ai][m];
#pragma unroll
                    for (int bj = 0; bj < 2; ++bj) {
                        if (MODE == 0) { const f32x4 a0 = acc[ai][bj][m][0] * w, a1 = acc[ai][bj][m][1] * w; *(pg8::u32x2*)(py[k] + bj * HALF) = (pg8::u32x2){pk4_fp8(cy8(a0[0]), cy8(a0[1]), cy8(a0[2]), cy8(a0[3])), pk4_fp8(cy8(a1[0]), cy8(a1[1]), cy8(a1[2]), cy8(a1[3]))}; }
                        else { const pg8::u32x2 y = yv[k][bj]; const u32x4 h = hv[k][bj]; float* p = po[k] + bj * HALF;
                            const f32x4 ya = un4_fp8(y.x) * (1.0f / Y8SCALE), yb = un4_fp8(y.y) * (1.0f / Y8SCALE);
                            const f32x4 ha = {pg8::bf_lo(h.x), pg8::bf_hi(h.x), pg8::bf_lo(h.y), pg8::bf_hi(h.y)}, hb = {pg8::bf_lo(h.z), pg8::bf_hi(h.z), pg8::bf_lo(h.w), pg8::bf_hi(h.w)};
                            *(f32x4*)p = (ha * ig[bj][0] + ya) + acc[ai][bj][m][0] * w; *(f32x4*)(p + 4) = (hb * ig[bj][1] + yb) + acc[ai][bj][m][1] * w; } } }
                asm volatile("" ::: "memory"); }
        return false;
    }
};
}
constexpr int GP = 144;
typedef LAS unsigned char* ldsp;
__device__ __forceinline__ pg8::bf16x8 ldfrag(ldsp base, int row, int ks, int fq) { return *(const LAS pg8::bf16x8*)(base + row * GP + ks * 64 + fq * 16); }
#define MFMA16(a, b, c) __builtin_amdgcn_mfma_f32_16x16x32_bf16((a), (b), (c), 0, 0, 0)
constexpr size_t WS_O0 = WS_DS, WS_QD = WS_DS + 32 * MiB, WS_GG = WS_DS + 48 * MiB, WS_GD = WS_DS + 56 * MiB;
__device__ __forceinline__ void gla_x(Frame& F, int unit) {
    const int bh = unit >> 3, g = unit & 7, b = bh >> 2, h = bh & 3, d = F.tid & 63, tq = F.wave, fr = F.lane & 15, fq = F.lane >> 4;
    LAS float* part = (LAS float*)(F.lds + 0); LAS float* TOT = (LAS float*)(F.lds + 2048);
    const ldsp QT = F.lds + 4096, KT = F.lds + 13312, AH = F.lds + 22528, VT = F.lds + 31744, SB = F.lds + 50176, PP = F.lds + 68608;
    for (int i = F.tid; i < 128 * GP / 4; i += NWAVES * 64) ((LAS unsigned*)SB)[i] = 0u;
    pg8::f32x4 accS[4];
#pragma unroll
    for (int db = 0; db < 4; ++db) accS[db] = (pg8::f32x4){0.f, 0.f, 0.f, 0.f};
    float cd = 1.0f;
    const int c_first = g ? 8 * g + 1 : 0, c_last = 8 * g + 8;
    bf16* QD = WSP(bf16, WS_QD); bf16* O0 = WSP(bf16, WS_O0);
    const float* LOGA = WSP(float, WS_LOGA); const bf16* GQ = WSP(bf16, WS_GQ); const bf16* GK = WSP(bf16, WS_GK); const bf16* GV = WSP(bf16, WS_GV);
    float an[8]; bf16 qn[8], kn[8]; v4u vn[2];
#define GX_LOAD(cc) do { const size_t ro_ = (size_t)(b * LPB + 64 * (cc) + 8 * tq) * 256 + h * 64 + d; \
        _Pragma("unroll") for (int i_ = 0; i_ < 8; ++i_) { an[i_] = LOGA[ro_ + i_ * 256]; qn[i_] = GQ[ro_ + i_ * 256]; kn[i_] = GK[ro_ + i_ * 256]; } \
        _Pragma("unroll") for (int j_ = 0; j_ < 2; ++j_) { const int p_ = F.tid + 512 * j_; vn[j_] = *(const GAS v4u*)(GV + (size_t)(b * LPB + 64 * (cc) + (p_ >> 4)) * 512 + h * 128 + (p_ & 15) * 8); } } while (0)
    GX_LOAD(c_first);
    for (int c = c_first; c <= c_last; ++c) {
        const int mrow0 = b * SEQ + 64 * (c - 1);
        float bt[8]; bt[0] = an[0];
#pragma unroll
        for (int i = 1; i < 8; ++i) bt[i] = bt[i - 1] + an[i];
        part[tq * 64 + d] = bt[7];
        __syncthreads();
        float off = 0.f, tot = 0.f;
#pragma unroll
        for (int j = 0; j < 8; ++j) { const float p = part[j * 64 + d]; tot += p; if (j < tq) off += p; }
        if (tq == 0) TOT[d] = tot;
        float kh[8];
#pragma unroll
        for (int i = 0; i < 8; ++i) { const float bti = bt[i] + off; const float kk = bf2f(kn[i]); const float qv = bf2f(qn[i]) * __expf(bti), kv = kk * __expf(fminf(-bti, 80.f)); kh[i] = kk * __expf(tot - bti);
            *(LAS bf16*)(QT + (8 * tq + i) * GP + d * 2) = (bf16)f2bf(qv); *(LAS bf16*)(KT + (8 * tq + i) * GP + d * 2) = (bf16)f2bf(kv);
            if (c >= 1) QD[(size_t)(mrow0 + 8 * tq + i) * 256 + h * 64 + d] = (bf16)f2bf(qv * cd); }
        { v4u w; w.x = pk2(kh[0], kh[1]); w.y = pk2(kh[2], kh[3]); w.z = pk2(kh[4], kh[5]); w.w = pk2(kh[6], kh[7]); *(LAS v4u*)(AH + d * GP + tq * 16) = w; }
        cd *= __expf(tot);
#pragma unroll
        for (int j = 0; j < 2; ++j) { const int p = F.tid + 512 * j, sv = p >> 4, ec = p & 15; const unsigned ww[4] = {vn[j].x, vn[j].y, vn[j].z, vn[j].w};
#pragma unroll
            for (int i = 0; i < 4; ++i) { *(LAS bf16*)(VT + (8 * ec + 2 * i) * GP + sv * 2) = (bf16)(ww[i] & 0xffffu); *(LAS bf16*)(VT + (8 * ec + 2 * i + 1) * GP + sv * 2) = (bf16)(ww[i] >> 16); } }
        if (c < c_last) GX_LOAD(c + 1);
        __syncthreads();
        const int tb = tq >> 1, t0 = 16 * tb, t = t0 + fr;
#pragma unroll
        for (int sbi = 0; sbi < 2; ++sbi) { const int s0 = 16 * (2 * (tq & 1) + sbi); pg8::f32x4 a = {0.f, 0.f, 0.f, 0.f};
#pragma unroll
            for (int ks = 0; ks < 2; ++ks) a = MFMA16(ldfrag(KT, s0 + fr, ks, fq), ldfrag(QT, t0 + fr, ks, fq), a);
            const int s = s0 + 4 * fq;
            const float p0 = (s + 0 <= t) ? a[0] : 0.f, p1 = (s + 1 <= t) ? a[1] : 0.f, p2 = (s + 2 <= t) ? a[2] : 0.f, p3 = (s + 3 <= t) ? a[3] : 0.f;
            *(LAS unsigned*)(PP + t * GP + s * 2) = pk2(p0, p1); *(LAS unsigned*)(PP + t * GP + s * 2 + 4) = pk2(p2, p3); }
#pragma unroll
        for (int db = 0; db < 4; ++db) { const pg8::f32x4 tv = *(const LAS pg8::f32x4*)(TOT + 16 * db + 4 * fq);
            accS[db][0] *= __expf(tv[0]); accS[db][1] *= __expf(tv[1]); accS[db][2] *= __expf(tv[2]); accS[db][3] *= __expf(tv[3]); }
#pragma unroll
        for (int ks = 0; ks < 2; ++ks) { const pg8::bf16x8 bfr = ldfrag(VT, 16 * tq + fr, ks, fq);
#pragma unroll
            for (int db = 0; db < 4; ++db) accS[db] = MFMA16(ldfrag(AH, 16 * db + fr, ks, fq), bfr, accS[db]); }
        __syncthreads();
        if (c >= 1) {
            const int eh = tq & 1; pg8::f32x4 o[4];
#pragma unroll
            for (int eb = 0; eb < 4; ++eb) o[eb] = (pg8::f32x4){0.f, 0.f, 0.f, 0.f};
#pragma unroll
            for (int ks = 0; ks < 4; ++ks) { const pg8::bf16x8 bfr = ks < 2 ? ldfrag(PP, t0 + fr, ks, fq) : ldfrag(QT, t0 + fr, ks - 2, fq);
#pragma unroll
                for (int eb = 0; eb < 4; ++eb) { const int e0 = 64 * eh + 16 * eb; o[eb] = MFMA16(ks < 2 ? ldfrag(VT, e0 + fr, ks, fq) : ldfrag(SB, e0 + fr, ks - 2, fq), bfr, o[eb]); } }
            bf16* op = O0 + (size_t)(mrow0 + t) * 512 + h * 128 + 64 * eh + 4 * fq;
#pragma unroll
            for (int eb = 0; eb < 4; ++eb) *(GAS unsigned long long*)(op + 16 * eb) = (unsigned long long)pk2(o[eb][0], o[eb][1]) | ((unsigned long long)pk2(o[eb][2], o[eb][3]) << 32);
        }
        __syncthreads();
#pragma unroll
        for (int db = 0; db < 4; ++db) { LAS unsigned* sp = (LAS unsigned*)(SB + (16 * tq + fr) * GP + (16 * db + 4 * fq) * 2); sp[0] = pk2(accS[db][0], accS[db][1]); sp[1] = pk2(accS[db][2], accS[db][3]); }
    }
#undef GX_LOAD
    float* gg = WSP(float, WS_GG) + ((size_t)(bh * 8 + g) * 128 + 16 * tq + fr) * 64;
#pragma unroll
    for (int db = 0; db < 4; ++db) *(pg8::f32x4*)(gg + 16 * db + 4 * fq) = accS[db];
    if (tq == 0) WSP(float, WS_GD)[(bh * 8 + g) * 64 + d] = cd;
    __syncthreads();
}
__device__ __forceinline__ void gla_z(Frame& F, int unit) {
    const int bh = unit >> 3, g = unit & 7, b = bh >> 2, h = bh & 3, fr = F.lane & 15, fq = F.lane >> 4;
    const ldsp SB = F.lds + 0;
    { const pg8::f32x4* G4 = WSP(pg8::f32x4, WS_GG); const float* GD = WSP(float, WS_GD);
#pragma unroll
      for (int j = 0; j < 4; ++j) { const int q = F.tid + 512 * j, e = q >> 4, d4 = (q & 15) * 4; pg8::f32x4 S = {0.f, 0.f, 0.f, 0.f}, Gv[7], Dv[7];
#pragma unroll
          for (int gp = 0; gp < 7; ++gp) if (gp < g) { Dv[gp] = *(const pg8::f32x4*)(GD + (bh * 8 + gp) * 64 + d4); Gv[gp] = G4[(size_t)(bh * 8 + gp) * 2048 + q]; }
#pragma unroll
          for (int gp = 0; gp < 7; ++gp) if (gp < g) S = Dv[gp] * S + Gv[gp];
          *(LAS unsigned*)(SB + e * GP + d4 * 2) = pk2(S.x, S.y); *(LAS unsigned*)(SB + e * GP + d4 * 2 + 4) = pk2(S.z, S.w); } }
    __syncthreads();
    const bf16* QD = WSP(bf16, WS_QD); const bf16* O0 = WSP(bf16, WS_O0); const float* gg = F.inp(I_GGLA);
    pg8::bf16x8 qf[2]; unsigned long long ow[8], rw[8];
#define GZ_LOAD(itn) do { const int tl_ = 512 * g + 128 * (itn) + 16 * F.wave + fr; const size_t mr_ = (size_t)(b * SEQ + tl_), pr_ = (size_t)(b * LPB + 64 + tl_); \
        _Pragma("unroll") for (int ks_ = 0; ks_ < 2; ++ks_) qf[ks_] = *(const pg8::bf16x8*)(QD + mr_ * 256 + h * 64 + 32 * ks_ + 8 * fq); \
        _Pragma("unroll") for (int eb_ = 0; eb_ < 8; ++eb_) { ow[eb_] = *(const GAS unsigned long long*)(O0 + mr_ * 512 + h * 128 + 16 * eb_ + 4 * fq); rw[eb_] = *(const GAS unsigned long long*)(WSP(bf16, WS_GR) + pr_ * 512 + h * 128 + 16 * eb_ + 4 * fq); } } while (0)
    GZ_LOAD(0);
    for (int it = 0; it < 4; ++it) {
        const int tl = 512 * g + 128 * it + 16 * F.wave + fr, mrow = b * SEQ + tl;
        pg8::f32x4 o[8];
#pragma unroll
        for (int eb = 0; eb < 8; ++eb) o[eb] = (pg8::f32x4){0.f, 0.f, 0.f, 0.f};
#pragma unroll
        for (int ks = 0; ks < 2; ++ks)
#pragma unroll
            for (int eb = 0; eb < 8; ++eb) o[eb] = MFMA16(ldfrag(SB, 16 * eb + fr, ks, fq), qf[ks], o[eb]);
        float ss = 0.f; float sr[8][4];
#pragma unroll
        for (int eb = 0; eb < 8; ++eb) { const unsigned long long w = ow[eb], r = rw[eb];
            o[eb][0] += __uint_as_float((unsigned)w << 16); o[eb][1] += __uint_as_float((unsigned)w & 0xffff0000u); o[eb][2] += __uint_as_float((unsigned)(w >> 32) << 16); o[eb][3] += __uint_as_float((unsigned)(w >> 32) & 0xffff0000u);
            ss += (o[eb][0] * o[eb][0] + o[eb][1] * o[eb][1]) + (o[eb][2] * o[eb][2] + o[eb][3] * o[eb][3]);
            sr[eb][0] = __uint_as_float((unsigned)r << 16); sr[eb][1] = __uint_as_float((unsigned)r & 0xffff0000u); sr[eb][2] = __uint_as_float((unsigned)(r >> 32) << 16); sr[eb][3] = __uint_as_float((unsigned)(r >> 32) & 0xffff0000u); }
        if (it < 3) GZ_LOAD(it + 1);
        ss += __shfl_xor(ss, 16); ss += __shfl_xor(ss, 32);
        const float rn = 1.0f / sqrtf(ss * (1.0f / 128.0f) + EPS);
        bf16* op = WSP(bf16, WS_OA) + (size_t)MROWS * 512 + (size_t)mrow * 512 + h * 128;
#pragma unroll
        for (int eb = 0; eb < 8; ++eb) { const int e = 16 * eb + 4 * fq; const pg8::f32x4 gv = *(const pg8::f32x4*)(gg + e);
            const float v0 = o[eb][0] * rn * gv.x * (sr[eb][0] * sigmoidf_(sr[eb][0])), v1 = o[eb][1] * rn * gv.y * (sr[eb][1] * sigmoidf_(sr[eb][1])), v2 = o[eb][2] * rn * gv.z * (sr[eb][2] * sigmoidf_(sr[eb][2])), v3 = o[eb][3] * rn * gv.w * (sr[eb][3] * sigmoidf_(sr[eb][3]));
            *(GAS unsigned long long*)(op + e) = (unsigned long long)pk2(v0, v1) | ((unsigned long long)pk2(v2, v3) << 32); }
    }
#undef GZ_LOAD
    __syncthreads();
}
__device__ __forceinline__ void router_phase(Frame& F) {
    LAS float* lgp = (LAS float*)(F.lds + 0);
    LAS float* ssp = (LAS float*)(F.lds + 49152);
    LAS int* lcnt = (LAS int*)(F.lds + 51200); LAS int* lbase = lcnt + 64;
    const bf16* H = WSP(bf16, WS_H2U); const bf16* wh = WSP(bf16, WS_WRH); const bf16* wl = WSP(bf16, WS_WRL);
    int* ltok = WSP(int, WS_LTOK); float* lrs = WSP(float, WS_LRS); float* lw = WSP(float, WS_LW);
    const int fr = F.lane & 15, kg = F.lane >> 4, rbk = F.wave & 3, kh = F.wave >> 2;
    for (int rb = F.vcu; rb < MROWS / 128; rb += F.G) {
        if (F.tid < 64) lcnt[F.tid] = 0;
        const bf16* h0 = H + (size_t)(rb * 128 + rbk * 32 + fr) * DM + kh * 512 + 8 * kg; const bf16* h1 = h0 + 16 * DM;
        const bf16* whp = wh + (size_t)fr * DM + kh * 512 + 8 * kg; const bf16* wlp = wl + (size_t)fr * DM + kh * 512 + 8 * kg;
        pg8::f32x4 acc[2][3];
#pragma unroll
        for (int a = 0; a < 2; ++a)
#pragma unroll
            for (int cb = 0; cb < 3; ++cb) acc[a][cb] = (pg8::f32x4){0.f, 0.f, 0.f, 0.f};
        float ss0 = 0.f, ss1 = 0.f; const float* ig2 = WSP(float, WS_IG2) + kh * 512 + 8 * kg;
#pragma unroll 4
        for (int s = 0; s < 16; ++s) {
            const pg8::bf16x8 a0 = *(const pg8::bf16x8*)(h0 + 32 * s), a1 = *(const pg8::bf16x8*)(h1 + 32 * s);
            { const pg8::f32x4 ia = *(const pg8::f32x4*)(ig2 + 32 * s), ib = *(const pg8::f32x4*)(ig2 + 32 * s + 4); const float iv[8] = {ia[0], ia[1], ia[2], ia[3], ib[0], ib[1], ib[2], ib[3]};
#pragma unroll
              for (int j = 0; j < 8; ++j) { const float x0 = __uint_as_float((unsigned)(unsigned short)a0[j] << 16), x1 = __uint_as_float((unsigned)(unsigned short)a1[j] << 16); ss0 += x0 * x0 * iv[j]; ss1 += x1 * x1 * iv[j]; } }
#pragma unroll
            for (int cb = 0; cb < 3; ++cb) { const pg8::bf16x8 bh = *(const pg8::bf16x8*)(whp + (size_t)(16 * cb) * DM + 32 * s), bl = *(const pg8::bf16x8*)(wlp + (size_t)(16 * cb) * DM + 32 * s);
                acc[0][cb] = MFMA16(a0, bh, acc[0][cb]); acc[0][cb] = MFMA16(a0, bl, acc[0][cb]); acc[1][cb] = MFMA16(a1, bh, acc[1][cb]); acc[1][cb] = MFMA16(a1, bl, acc[1][cb]); }
        }
#pragma unroll
        for (int a = 0; a < 2; ++a)
#pragma unroll
            for (int cb = 0; cb < 3; ++cb)
#pragma unroll
                for (int i = 0; i < 4; ++i) lgp[(kh * 128 + rbk * 32 + a * 16 + 4 * kg + i) * 48 + 16 * cb + fr] = acc[a][cb][i];
        ss0 += __shfl_xor(ss0, 16); ss0 += __shfl_xor(ss0, 32); ss1 += __shfl_xor(ss1, 16); ss1 += __shfl_xor(ss1, 32);
        if (kg == 0) { ssp[kh * 128 + rbk * 32 + fr] = ss0; ssp[kh * 128 + rbk * 32 + 16 + fr] = ss1; }
        __syncthreads();
        int seg0 = 0, seg1 = 0, rk0 = 0, rk1 = 0; float w0 = 0.f, w1 = 0.f, rs = 0.f;
        if (F.tid < 128) {
            const LAS float* L0 = lgp + F.tid * 48; const LAS float* L1 = L0 + 128 * 48; rs = 1.0f / sqrtf((ssp[F.tid] + ssp[128 + F.tid]) * (1.0f / DM) + EPS);
            float gl[4];
#pragma unroll
            for (int j = 0; j < 4; ++j) gl[j] = (L0[j] + L1[j]) * rs + F.inp(I_BRG)[j];
            int gi = 0; float gm = gl[0];
#pragma unroll
            for (int j = 1; j < 4; ++j) if (gl[j] > gm) { gm = gl[j]; gi = j; }
            float gs = 0.f;
#pragma unroll
            for (int j = 0; j < 4; ++j) gs += expf(gl[j] - gm);
            const float gw_ = 1.0f / gs;
            float v1 = -INFINITY, v2 = -INFINITY; int i1 = 0, i2 = 0;
            for (int j = 0; j < 8; ++j) { const float v = (L0[4 + gi * 8 + j] + L1[4 + gi * 8 + j]) * rs + F.inp(I_BRE)[gi * 8 + j];
                if (v > v1) { v2 = v1; i2 = i1; v1 = v; i1 = j; } else if (v > v2) { v2 = v; i2 = j; } }
            const float e1 = 1.0f / (1.0f + expf(v2 - v1));
            w0 = gw_ * e1; w1 = gw_ * (1.0f - e1); seg0 = gi * 8 + i1; seg1 = 32 + gi * 8 + i2;
            rk0 = atomicAdd((int*)(lcnt + seg0), 1); rk1 = atomicAdd((int*)(lcnt + seg1), 1);
        }
        __syncthreads();
        if (F.tid < 64) { const int n = lcnt[F.tid]; lbase[F.tid] = n ? (int)__hip_atomic_fetch_add((unsigned*)(F.ctl + CW_CNT + F.tid), (unsigned)n, RLX_AGENT) : 0; }
        __syncthreads();
        if (F.tid < 128) { const int tok = rb * 128 + F.tid; const size_t p0 = (size_t)seg0 * LCAP + lbase[seg0] + rk0, p1 = (size_t)seg1 * LCAP + lbase[seg1] + rk1;
            ltok[p0] = tok; lrs[p0] = rs; lw[p0] = w0; ltok[p1] = tok; lrs[p1] = rs; lw[p1] = w1; }
        __syncthreads();
    }
}
#ifndef MK_N_LAUNCHES
#define MK_N_LAUNCHES 1
#endif
constexpr int N_PHASES = 10;
struct Args { const float* in[25]; float* out; unsigned char* ws; int ph_lo, ph_hi; };
__global__ void __launch_bounds__(NWAVES * 64, 2) fwd_kernel(Args args) {
    extern __shared__ __attribute__((aligned(16))) unsigned char lds[];
    Frame F;
    F.lds = (LAS unsigned char*)lds;
    F.MISC = (volatile LAS unsigned*)(F.lds + MISC_OFF);
    F.tid = threadIdx.x; F.lane = F.tid & 63; F.wave = __builtin_amdgcn_readfirstlane(F.tid >> 6);
    F.G = gridDim.x; { const int bx = blockIdx.x; F.vcu = (F.G % 8 == 0) ? (bx % 8) * (F.G / 8) + bx / 8 : bx; }
    F.ws = args.ws; F.out = args.out; F.ctl = (gu32*)(args.ws + WS_CTL);
    for (int u = F.tid; u < (LDS_BYTES - LDSCTL_OFF) / 4; u += NWAVES * 64) ((LAS unsigned*)(F.lds + LDSCTL_OFF))[u] = 0u;
    __syncthreads();
    if (F.tid < 25) ((LAS unsigned long long*)(F.lds + INTAB_OFF))[F.tid] = (unsigned long long)args.in[F.tid];
    __syncthreads();
    XcdBarrier bar; bar.bar = (unsigned*)(F.ctl + CW_BAR); bar.x = 0; bar.st = nullptr;
    if (MK_N_LAUNCHES == 1) bar = xcd_barrier_post((unsigned*)(F.ctl + CW_BAR), F.MISC + 8);
    const int lo = args.ph_lo, hi = args.ph_hi;
#ifdef PROBE_K
    volatile LAS unsigned long long* prb = (volatile LAS unsigned long long*)(F.lds + LDSCTL_OFF + 2048); if (blockIdx.x == 0 && F.tid == 0) prb[0] = __builtin_amdgcn_s_memrealtime();
#define PROBE_AT(k) do { if ((k) == PROBE_K && blockIdx.x == 0 && F.tid == 0) prb[1] = __builtin_amdgcn_s_memrealtime(); } while (0)
#else
#define PROBE_AT(k) do {} while (0)
#endif
#ifndef PH_MASK
#define PH_MASK 0x3ff
#endif
#define IN(k) (((PH_MASK >> (k)) & 1) && lo <= (k) && (k) < hi)
#define SEAM(k) do { if (IN(k) && IN((k) + 1)) xcd_barrier(bar); PROBE_AT(k); } while (0)
    const LAS int* tbp = (const LAS int*)(F.lds + TB_OFF); const LAS int* cnp = (const LAS int*)(F.lds + CN_OFF);

    if (IN(0)) { p0_prologue(F); } SEAM(0);
    if (IN(1)) {
#ifdef SKEW_US
        { const unsigned long long t0_ = __builtin_amdgcn_s_memrealtime(), dl_ = (unsigned long long)(F.vcu & 7) * (SKEW_US * 100 / 8); while (__builtin_amdgcn_s_memrealtime() - t0_ < dl_) __builtin_amdgcn_s_sleep(8); }
#endif
        pg8::Gemm g{WSP(pg8::bf16_t, WS_R1), WSP(pg8::bf16_t, WS_WIN), DM}; pg8::StaticOrder S{MZ / 256, NZ / 256, F.G, (int)blockIdx.x};
        epi::EpiZ E{WSP(bf16, WS_Q), WSP(bf16, WS_K), WSP(bf16, WS_V), WSP(bf16, WS_GQ), WSP(bf16, WS_GK), WSP(bf16, WS_GV), WSP(bf16, WS_GR), (bf16*)F.out, (bf16*)F.out + (size_t)MROWS * DM, WSP(float, WS_LOGA),
                    F.inp(I_GQN), F.inp(I_GKN), F.inp(I_BGATE), F.inp(I_BMERGE), WSP(float, WS_ROPE), WSP(float, WS_ROPE) + NPOS * 32};
        pg8::gemm_phase(F.lds + RING_OFF, g, S, E);
        if ((int)blockIdx.x >= P1_EXTRA(F.G)) { const int nidle = F.G - P1_EXTRA(F.G), j = (int)blockIdx.x - P1_EXTRA(F.G), nw = nidle * NWAVES, me = j * NWAVES + F.wave, cnt = p1_conv_items(F.G);
            late_tables(F, me * 64 + F.lane, nw * 64); expert_conv_first(F, me, nw, cnt); }
    } SEAM(1);
    if (IN(2)) {
        const attn_body::AttnTensors AT{(const attn_body::bf16*)WSP(bf16, WS_Q), (const attn_body::bf16*)WSP(bf16, WS_K), (const attn_body::bf16*)WSP(bf16, WS_V), (attn_body::bf16*)WSP(bf16, WS_R1)};
        { const float lam = expf(wave_sum(F.inp(I_LQ1)[F.lane] * F.inp(I_LK1)[F.lane])) - expf(wave_sum(F.inp(I_LQ2)[F.lane] * F.inp(I_LK2)[F.lane])) + 0.2f;
          float gqm = fabsf(F.inp(I_GQN)[F.lane]), gkm = fabsf(F.inp(I_GKN)[F.lane]);
#pragma unroll
          for (int o_ = 1; o_ < 64; o_ <<= 1) { gqm = fmaxf(gqm, __shfl_xor(gqm, o_)); gkm = fmaxf(gkm, __shfl_xor(gkm, o_)); }
          const bool fastsm = __builtin_amdgcn_readfirstlane((0.125f * 1.4426950408889634f * 64.0f) * gqm * gkm < 48.0f ? 1 : 0) != 0;
          const int nslot = 2 * ((256 + F.G - 1) / F.G);
          int i = 0;
#define ATTN_LOOP(FASTSM) for (;; ++i) { const int p = (i >> 2) * F.G + F.vcu; if (p >= 256) break; \
              if ((i & 3) == 1 || (i & 3) == 3) expert_conv_slot(F, (i >> 2) * 2 + ((i & 3) >> 1), nslot, p1_conv_items(F.G)); \
              const int bh = p >> 3, s = p & 7, b = bh >> 2, h = bh & 3, mp = i & 1, qb = (i & 2) ? 15 - s : s, hm = 2 * h + mp; \
              attn_body::attn_unit<8, FASTSM>(b, hm * 64, hm * 64, h * 128, hm * 128, qb, AT.Q, AT.K, AT.V, AT.O, (char*)lds + RING_OFF, mp, 2 * h * 128, lam, F.inp(I_GSUB), (attn_body::bf16*)WSP(bf16, WS_OA), h * 128); }
          if (fastsm) { ATTN_LOOP(true) } else { ATTN_LOOP(false) }
#undef ATTN_LOOP
          for (int sl = (i >> 2) * 2 + (((i & 3) + 1) >> 1 > 2 ? 2 : ((i & 3) + 1) >> 1); sl < nslot; ++sl) expert_conv_slot(F, sl, nslot, p1_conv_items(F.G)); }
        asm volatile("s_waitcnt vmcnt(0) lgkmcnt(0)" ::: "memory"); __syncthreads();
        for (int un = F.vcu; un < 32 * 8; un += F.G) gla_x(F, un);
    } SEAM(2);
    if (IN(3)) { for (int un = F.vcu; un < 32 * 8; un += F.G) gla_z(F, un); } SEAM(3);
    if (IN(4)) {
        pg8::Gemm g{WSP(pg8::bf16_t, WS_OA), WSP(pg8::bf16_t, WS_WBR), 512}; pg8::PairOrder S{MROWS / 256, DM / 256, F.G, (int)blockIdx.x};
        epi::EpiMerge E{(const bf16*)F.out, (const bf16*)F.out + (size_t)MROWS * DM, WSP(bf16, WS_R1)};
        pg8::gemm_phase(F.lds + RING_OFF, g, S, E);
    } SEAM(4);
    if (IN(5)) {
        pg8::Gemm g{WSP(pg8::bf16_t, WS_R1), WSP(pg8::bf16_t, WS_WOUT), DM}; pg8::StaticOrder S{MROWS / 256, DM / 256, F.G, (int)blockIdx.x};
        epi::EpiOut E{F.inp(I_X), WSP(bf16, WS_H2U), F.inp(I_GFFN), WSP(unsigned char, WS_H2U8)};
        pg8::gemm_phase(F.lds + RING_OFF, g, S, E);
    } SEAM(5);
    if (IN(6)) { router_phase(F); } SEAM(6);
    if ((PH_MASK >> 7) && hi > 7) {
        LAS int* tb = (LAS int*)(F.lds + TB_OFF); LAS int* cn = (LAS int*)(F.lds + CN_OFF);
        if (F.tid < 64) { const int c = (int)__hip_atomic_load(F.ctl + CW_CNT + F.tid, RLX_AGENT); cn[F.tid] = c;
            const int t = (c + 255) >> 8; int incl = t;
#pragma unroll
            for (int o = 1; o < 64; o <<= 1) { const int v = __shfl_up(incl, o); if (F.lane >= o) incl += v; }
            tb[F.tid] = incl - t; if (F.tid == 63) tb[64] = incl; }
        __syncthreads();
    }
    if (IN(7)) {
        pg8::Gemm g{WSP(pg8::bf16_t, WS_H2U8), WSP(pg8::bf16_t, WS_WGU), DM / 2}; epi::MoeSched<true> S{tbp, cnp, WSP(int, WS_LTOK), 0, 64, F.G, F.vcu};
        epi::EpiUp E{cnp, WSP(float, WS_LRS), WSP(unsigned char, WS_HID)};
        pg8::gemm_phase<epi::EpiUp, epi::MoeSched<true>, true>(F.lds + RING_OFF, g, S, E);
    } SEAM(7);
    if (IN(8)) {
        pg8::Gemm g{WSP(pg8::bf16_t, WS_HID), WSP(pg8::bf16_t, WS_WD), DEXP / 2}; epi::MoeSched<false> S{tbp, cnp, WSP(int, WS_LTOK), 0, 32, F.G, F.vcu};
        epi::EpiDown<0> E{cnp, WSP(int, WS_LTOK), WSP(float, WS_LW), F.out, WSP(unsigned char, WS_R1), WSP(float, WS_TRASH), WSP(bf16, WS_H2U), F.inp(I_GFFN)};
        pg8::gemm_phase<epi::EpiDown<0>, epi::MoeSched<false>, true>(F.lds + RING_OFF, g, S, E);
    } SEAM(8);
    if (IN(9)) {
        pg8::Gemm g{WSP(pg8::bf16_t, WS_HID), WSP(pg8::bf16_t, WS_WD), DEXP / 2}; epi::MoeSched<false> S{tbp, cnp, WSP(int, WS_LTOK), 32, 64, F.G, F.vcu};
        epi::EpiDown<1> E{cnp, WSP(int, WS_LTOK), WSP(float, WS_LW), F.out, WSP(unsigned char, WS_R1), WSP(float, WS_TRASH), WSP(bf16, WS_H2U), F.inp(I_GFFN)};
        pg8::gemm_phase<epi::EpiDown<1>, epi::MoeSched<false>, true>(F.lds + RING_OFF, g, S, E);
    }
#ifdef PROBE_K
    PROBE_AT(9);
    if (blockIdx.x == 0 && F.tid == 0) { const unsigned long long t1 = __builtin_amdgcn_s_memrealtime(), tgt = t1 + (unsigned long long)PROBE_MULT * (prb[1] - prb[0]);
        for (unsigned sp = 0; sp < 4000000u && __builtin_amdgcn_s_memrealtime() < tgt; ++sp) __builtin_amdgcn_s_sleep(16); }
#endif
#undef IN
#undef SEAM
}

extern "C" void kernel_launch(void* const* d_in, const int* in_sizes, int n_in, void* d_out, int out_size, void* d_ws, size_t ws_size, hipStream_t stream) {
    static int grid = 0;
    if (grid == 0) {
        if (n_in != 25 || in_sizes[0] != MROWS * DM || out_size != MROWS * DM || ws_size < WS_END) { fprintf(stderr, "kernel_launch: unexpected shapes (n_in %d, in0 %d, out %d, ws %zu)\n", n_in, n_in > 0 ? in_sizes[0] : -1, out_size, ws_size); grid = -1; return; }
        int dev = 0, cus = 0, per_cu = 0;
        if (hipGetDevice(&dev) != hipSuccess || hipDeviceGetAttribute(&cus, hipDeviceAttributeMultiprocessorCount, dev) != hipSuccess) { grid = -1; return; }
        if (hipFuncSetAttribute((const void*)fwd_kernel, hipFuncAttributeMaxDynamicSharedMemorySize, LDS_BYTES) != hipSuccess) { fprintf(stderr, "kernel_launch: hipFuncSetAttribute failed\n"); grid = -1; return; }
        if (hipOccupancyMaxActiveBlocksPerMultiprocessor(&per_cu, (const void*)fwd_kernel, NWAVES * 64, LDS_BYTES) != hipSuccess || per_cu < 1) { fprintf(stderr, "kernel_launch: occupancy query says %d\n", per_cu); }
        (void)hipGetLastError();
        grid = cus;
    }
    if (grid < 0) return;
    if (hipMemsetAsync((char*)d_ws + WS_CTL, 0, CTL_ZERO_BYTES, stream) != hipSuccess) return;
    Args a{};
    for (int i = 0; i < 25; ++i) a.in[i] = (const float*)d_in[i];
    a.out = (float*)d_out; a.ws = (unsigned char*)d_ws;
    if (MK_N_LAUNCHES == 1) { a.ph_lo = 0; a.ph_hi = N_PHASES; hipLaunchKernelGGL(fwd_kernel, dim3(grid), dim3(NWAVES * 64), LDS_BYTES, stream, a); }
    else for (int p = 0; p < N_PHASES; ++p) { a.ph_lo = p; a.ph_hi = p + 1; hipLaunchKernelGGL(fwd_kernel, dim3(grid), dim3(NWAVES * 64), LDS_BYTES, stream, a); }
}
```

```cpp
#include <hip/hip_runtime.h>
#include <hip/hip_bf16.h>
#include <cstdio>
#include <cstdint>
#include <cmath>

namespace pg8 {
#define PG8_LAS __attribute__((address_space(3)))
typedef unsigned short bf16_t;
typedef short bf16x8 __attribute__((ext_vector_type(8)));
typedef float f32x4 __attribute__((ext_vector_type(4)));
typedef float f32x2 __attribute__((ext_vector_type(2)));
typedef unsigned u32x4 __attribute__((ext_vector_type(4)));
typedef unsigned u32x2 __attribute__((ext_vector_type(2)));
typedef int v8i __attribute__((ext_vector_type(8)));
constexpr int BM = 256, BK = 64, HALF = 128, HTB = HALF * BK * 2, STAGE_BYTES = 8 * HTB, NXCD = 8, WGM = 8;

__host__ __device__ __forceinline__ int lds_byte(int r, int c) { const int st = (r >> 4) * 2 + (c >> 5), rr = r & 15, cc = c & 31, ob = rr * 64 + cc * 2; return st * 1024 + (ob ^ (((ob >> 9) & 1) << 5)); }
__host__ __device__ __forceinline__ void stage_rc(int b, int& R, int& C) { const int st = b / 1024, sb = b % 1024, swz = sb ^ (((sb >> 9) & 1) << 5); R = (st >> 1) * 16 + swz / 64; C = (st & 1) * 32 + (swz % 64) / 2; }
__host__ __device__ __forceinline__ int perm32(int rho) { const int n = rho >> 4, i = rho & 15; return 8 * (i >> 2) + 4 * n + (i & 3); }

struct Unit { int pm, pn, aux, half; };
struct Gemm { const bf16_t* A; const bf16_t* Bt; int K; };

__device__ __forceinline__ void tile_of(int L, int nM, int nN, int& pm, int& pn) {
    const int nwg = nM * nN; int wgid = L;
    { const int q = nwg / NXCD, r = nwg % NXCD, xcd = wgid % NXCD, off = wgid / NXCD; wgid = (xcd < r ? xcd * (q + 1) : r * (q + 1) + (xcd - r) * q) + off; }
    const int nig = WGM * nN, gid = wgid / nig, fm = gid * WGM, gsz = (nM - fm) < WGM ? (nM - fm) : WGM;
    pm = fm + ((wgid % nig) % gsz); pn = (wgid % nig) / gsz;
}
struct StaticOrder {
    static constexpr bool GATHER = false;
    int nM, nN, G, c;
    __device__ __forceinline__ bool next(int i, Unit& u) const { const long L = (long)i * G + c; if (L >= (long)nM * nN) return false; tile_of((int)L, nM, nN, u.pm, u.pn); u.aux = 0; u.half = 0; return true; }
    __device__ __forceinline__ int grow(const Unit&, int) const { return 0; }
};
struct PairOrder {
    static constexpr bool GATHER = false;
    int nM, nN, G, c;
    __device__ __forceinline__ bool next(int i, Unit& u) const { const long L = (long)(i >> 1) * G + c; if (L >= (long)nM * nN) return false; tile_of((int)L, nM, nN, u.pm, u.pn); const int br = i & 1; u.pm += nM * br; u.pn += nN * br; u.aux = br; u.half = 0; return true; }
    __device__ __forceinline__ int grow(const Unit&, int) const { return 0; }
};

__device__ __forceinline__ unsigned cvt_pk_bf16(float lo, float hi) { unsigned r; asm volatile("v_cvt_pk_bf16_f32 %0, %1, %2" : "=v"(r) : "v"(lo), "v"(hi)); return r; }
__device__ __forceinline__ u32x4 pack8(const f32x4 a, const f32x4 b) { u32x4 w; w.x = cvt_pk_bf16(a[0], a[1]); w.y = cvt_pk_bf16(a[2], a[3]); w.z = cvt_pk_bf16(b[0], b[1]); w.w = cvt_pk_bf16(b[2], b[3]); return w; }
__device__ __forceinline__ float bf_lo(unsigned w) { return __uint_as_float(w << 16); }
__device__ __forceinline__ float bf_hi(unsigned w) { return __uint_as_float(w & 0xffff0000u); }

template <class Epi, class Sched, bool F8 = false, bool OPQ = false>
__device__ __forceinline__ void gemm_phase(PG8_LAS unsigned char* lds, const Gemm g, const Sched& S, const Epi& E) {
    constexpr bool GA = Sched::GATHER;
    const int tid = threadIdx.x, wid = __builtin_amdgcn_readfirstlane(tid >> 6), lane = tid & 63, wr = wid >> 2, wc = wid & 3, fr = lane & 15, fq = lane >> 4;
    const int K = g.K; int nt = K / BK; if constexpr (OPQ) asm volatile("" : "+s"(nt));
    unsigned voffA[2], voffB[2]; int RA[2], CA[2];
#pragma unroll
    for (int i = 0; i < 2; ++i) { int R, C; stage_rc(tid * 16 + i * 8192, R, C); const int Rb = (R & ~31) + perm32(R & 31);
        voffA[i] = (unsigned)(R * K + C) * 2u; voffB[i] = (unsigned)(Rb * K + C) * 2u; RA[i] = R; CA[i] = C; }
    const size_t kstep = (size_t)(BK * 2);
    const size_t hstep = (size_t)HALF * K * 2;
    const size_t tstep = 2 * hstep;
    const unsigned ldsw = (unsigned)wid * 1024u;
    const int aoff = lds_byte(wr * 64 + fr, F8 ? fq * 16 : fq * 8), boff = lds_byte(wc * 32 + fr, F8 ? fq * 16 : fq * 8);
    unsigned gc[2][2], gn[2][2];
#define PG8_SA(b, h) (((b) * 2 + (h)) * HTB)
#define PG8_SB(b, h) ((4 + (b) * 2 + (h)) * HTB)
#define PG8_GL(src, dstoff) __builtin_amdgcn_global_load_lds((const unsigned*)(src), (PG8_LAS unsigned*)(lds + (dstoff)), 16, 0, 0)
#define PG8_STAGE(bufoff, gbase, voff) do { _Pragma("unroll") for (int _i = 0; _i < 2; ++_i) PG8_GL((const char*)(gbase) + (voff)[_i], (bufoff) + ldsw + _i * 8192); } while (0)
#define PG8_STA(bufoff, kptr, h, NX) do { if constexpr (GA) { _Pragma("unroll") for (int _i = 0; _i < 2; ++_i) { const unsigned _o = (NX) ? gn[h][_i] : gc[h][_i]; PG8_GL((const char*)(kptr) + _o, (bufoff) + ldsw + _i * 8192); } } \
        else { PG8_STAGE(bufoff, (const char*)(kptr) + (h) * hstep, voffA); } } while (0)
#define PG8_GOFF(dst, un) do { _Pragma("unroll") for (int _h = 0; _h < 2; ++_h) _Pragma("unroll") for (int _i = 0; _i < 2; ++_i) dst[_h][_i] = ((unsigned)S.grow(un, _h * HALF + RA[_i]) * (unsigned)K + (unsigned)CA[_i]) * 2u; } while (0)
#define PG8_LDA(dst, b, h) do { _Pragma("unroll") for (int m = 0; m < 4; ++m) _Pragma("unroll") for (int k = 0; k < 2; ++k) dst[m][k] = *(const PG8_LAS bf16x8*)(lds + PG8_SA(b, h) + aoff + m * 2048 + (F8 ? k * 16 : k * 1024)); } while (0)
#define PG8_LDB(dst, b, h) do { _Pragma("unroll") for (int n = 0; n < 2; ++n) _Pragma("unroll") for (int k = 0; k < 2; ++k) dst[n][k] = *(const PG8_LAS bf16x8*)(lds + PG8_SB(b, h) + boff + n * 2048 + (F8 ? k * 16 : k * 1024)); } while (0)
#define PG8_F8V(X) __builtin_shufflevector(__builtin_bit_cast(u32x4, X[0]), __builtin_bit_cast(u32x4, X[1]), 0, 1, 2, 3, 4, 5, 6, 7)
#define PG8_MMA(ai, bj, At, Bt) do { __builtin_amdgcn_s_setprio(1); \
        if constexpr (F8) { _Pragma("unroll") for (int m = 0; m < 4; ++m) _Pragma("unroll") for (int n = 0; n < 2; ++n) \
            acc[ai][bj][m][n] = __builtin_amdgcn_mfma_scale_f32_16x16x128_f8f6f4(__builtin_bit_cast(v8i, PG8_F8V(Bt[n])), __builtin_bit_cast(v8i, PG8_F8V(At[m])), acc[ai][bj][m][n], 0, 0, 0, 0x7f7f7f7f, 0, 0x7f7f7f7f); } \
        else { _Pragma("unroll") for (int m = 0; m < 4; ++m) _Pragma("unroll") for (int n = 0; n < 2; ++n) _Pragma("unroll") for (int k = 0; k < 2; ++k) \
            acc[ai][bj][m][n] = __builtin_amdgcn_mfma_f32_16x16x32_bf16(Bt[n][k], At[m][k], acc[ai][bj][m][n], 0, 0, 0); } __builtin_amdgcn_s_setprio(0); } while (0)
#define PG8_WAIT_V(n) asm volatile("s_waitcnt vmcnt(" #n ")" ::: "memory")
#define PG8_WAIT_L(n) asm volatile("s_waitcnt lgkmcnt(" #n ")" ::: "memory")
#define PG8_BAR __builtin_amdgcn_s_barrier()
#define PG8_SCHED __builtin_amdgcn_sched_barrier(0)
#define PG8_ZERO() do { _Pragma("unroll") for (int a = 0; a < 2; ++a) _Pragma("unroll") for (int b = 0; b < 2; ++b) _Pragma("unroll") for (int m = 0; m < 4; ++m) _Pragma("unroll") for (int n = 0; n < 2; ++n) acc[a][b][m][n] = (f32x4){0.f, 0.f, 0.f, 0.f}; } while (0)
    Unit cur, nxt; int ui = 0;
    if (!S.next(0, cur)) return;
    f32x4 acc[2][2][4][2];
    PG8_ZERO();
    bf16x8 At[4][2], B0[2][2], B1[2][2];
    const char* cA = GA ? (const char*)g.A : (const char*)g.A + (size_t)cur.pm * tstep; const char* cB = (const char*)g.Bt + (size_t)cur.pn * tstep;
    if constexpr (GA) { PG8_GOFF(gc, cur); }
    PG8_STAGE(PG8_SB(0, 0), cB, voffB); PG8_STAGE(PG8_SB(0, 1), cB + hstep, voffB); PG8_STA(PG8_SA(0, 0), cA, 0, false); PG8_STA(PG8_SA(0, 1), cA, 1, false);
    if (wr == 1) PG8_BAR;
    PG8_WAIT_V(2); PG8_BAR;
    PG8_STAGE(PG8_SB(1, 0), cB + kstep, voffB); PG8_STA(PG8_SA(1, 0), cA + kstep, 0, false); PG8_STAGE(PG8_SB(1, 1), cB + hstep + kstep, voffB);
    PG8_WAIT_V(6); PG8_BAR;
    for (;;) {
        const bool has_next = S.next(ui + 1, nxt);
        const char* nA = GA ? (const char*)g.A : (has_next ? (const char*)g.A + (size_t)nxt.pm * tstep : cA); const char* nB = has_next ? (const char*)g.Bt + (size_t)nxt.pn * tstep : cB;
        if constexpr (GA) { if (has_next) { PG8_GOFF(gn, nxt); } else { _Pragma("unroll") for (int _h = 0; _h < 2; ++_h) _Pragma("unroll") for (int _i = 0; _i < 2; ++_i) gn[_h][_i] = gc[_h][_i]; } }
        int hf_ = cur.half; if constexpr (OPQ) asm volatile("" : "+s"(hf_));
        const bool do0 = hf_ != 2, do1 = hf_ != 1;
        for (int t = 0; t < nt; t += 2) {
            const bool last = (t == nt - 2);
            const char* a1 = cA + (size_t)(t + 1) * kstep;
            const char* a2 = last ? nA : cA + (size_t)(t + 2) * kstep; const char* b2 = last ? nB : cB + (size_t)(t + 2) * kstep;
            const char* a3 = a2 + kstep; const char* b3 = b2 + kstep;
            PG8_LDB(B0, 0, 0); PG8_LDB(B1, 0, 1); PG8_SCHED; PG8_LDA(At, 0, 0); PG8_STA(PG8_SA(1, 1), a1, 1, false);
            PG8_WAIT_V(8); PG8_WAIT_L(0); PG8_BAR; if (do0) { PG8_MMA(0, 0, At, B0); PG8_MMA(0, 1, At, B1); } PG8_BAR; PG8_SCHED;
            PG8_LDA(At, 0, 1); PG8_STAGE(PG8_SB(0, 0), b2, voffB); PG8_STAGE(PG8_SB(0, 1), b2 + hstep, voffB); PG8_STA(PG8_SA(0, 0), a2, 0, last);
            PG8_WAIT_V(8); PG8_WAIT_L(0); PG8_BAR; if (do1) { PG8_MMA(1, 0, At, B0); PG8_MMA(1, 1, At, B1); } PG8_BAR; PG8_SCHED;
            PG8_LDB(B0, 1, 0); PG8_LDB(B1, 1, 1); PG8_SCHED; PG8_LDA(At, 1, 0); PG8_STA(PG8_SA(0, 1), a2, 1, last);
            PG8_WAIT_V(8); PG8_WAIT_L(0); PG8_BAR; if (do0) { PG8_MMA(0, 0, At, B0); PG8_MMA(0, 1, At, B1); } PG8_BAR; PG8_SCHED;
            PG8_LDA(At, 1, 1); PG8_STAGE(PG8_SB(1, 0), b3, voffB); PG8_STAGE(PG8_SB(1, 1), b3 + hstep, voffB); PG8_STA(PG8_SA(1, 0), a3, 0, last);
            PG8_WAIT_V(8); PG8_WAIT_L(0); PG8_BAR; if (do1) { PG8_MMA(1, 0, At, B0); PG8_MMA(1, 1, At, B1); } PG8_BAR; PG8_SCHED;
        }
        if (wr == 0) PG8_BAR;
        const bool keep = E(acc, cur, wr, wc, fr, fq);
        if (!has_next) break;
        if (!keep) { PG8_ZERO(); }
        cur = nxt; cA = nA; cB = nB; ++ui;
        if constexpr (GA) { _Pragma("unroll") for (int _h = 0; _h < 2; ++_h) _Pragma("unroll") for (int _i = 0; _i < 2; ++_i) gc[_h][_i] = gn[_h][_i]; }
        if (wr == 1) PG8_BAR;
    }
    PG8_WAIT_V(0);
    PG8_BAR;
#undef PG8_SA
#undef PG8_SB
#undef PG8_GL
#undef PG8_STAGE
#undef PG8_STA
#undef PG8_GOFF
#undef PG8_LDA
#undef PG8_LDB
#undef PG8_MMA
#undef PG8_F8V
#undef PG8_WAIT_V
#undef PG8_WAIT_L
#undef PG8_BAR
#undef PG8_SCHED
#undef PG8_ZERO
}
}
#include <hip/hip_bf16.h>
#include <cmath>
namespace attn_body {
using bf16=__hip_bfloat16;
using bf16x8=__attribute__((ext_vector_type(8)))short;
using s16x4=__attribute__((ext_vector_type(4)))short;
using f32x16=__attribute__((ext_vector_type(16)))float;
using u32x4=__attribute__((ext_vector_type(4)))unsigned;
constexpr int D=64,QP=512,KP=512,VP=512,OP=1024,QSEQ=4096,KSEQ=4160;
constexpr int NW=8,QBLK=32,QB=QBLK*NW,KVBLK=64,NQB=QSEQ/QB;
constexpr int ATTN_UNIT_ROWS=QB;
__device__ __forceinline__ int crow(int r,int hi){return (r&3)+8*(r>>2)+4*hi;}
#define SBAR() __builtin_amdgcn_sched_barrier(0)
__device__ __forceinline__ void cmask(f32x16&p0,f32x16&p1,int jb,int qrel,int hi){
  const float NEG=-INFINITY; int kb=64*jb+4*hi;
  #pragma unroll
  for(int r=0;r<16;++r){int kv=kb+(r&3)+8*(r>>2); if(kv>qrel)p0[r]=NEG; if(kv+32>qrel)p1[r]=NEG;}
}

constexpr int NSLOT=3, SLOTB=8192;
constexpr int QSTG=4608;
constexpr int LDS_K=0, LDS_V=NSLOT*SLOTB, LDS_WS=LDS_V+NSLOT*2*SLOTB, LDS_OST=LDS_WS+NW*64*4, LDS_BYTES=LDS_OST+NW*QSTG;
constexpr float C2=0.125f*1.4426950408889634f;
__device__ __forceinline__ void glds16(const void*gsrc,unsigned lds_dst){unsigned keep;
  asm volatile("s_mov_b32 %0, m0\n\ts_mov_b32 m0, %2\n\ts_nop 0\n\tglobal_load_lds_dwordx4 %1, off\n\ts_mov_b32 m0, %0":"=&s"(keep):"v"(gsrc),"s"(lds_dst):"memory");}
__device__ __forceinline__ float max3f(float a,float b,float c){float r;asm("v_max3_f32 %0, %1, %2, %3":"=v"(r):"v"(a),"v"(b),"v"(c));return r;}
__device__ __forceinline__ float max2f(float a,float b){float r;asm("v_max_f32_e32 %0, %1, %2":"=v"(r):"v"(a),"v"(b));return r;}
__device__ __forceinline__ float fadd_s(float a,float b){float r;asm("v_add_f32_e32 %0, %1, %2":"=v"(r):"v"(a),"v"(b));return r;}
__device__ __forceinline__ float fsub_s(float a,float b){float r;asm("v_sub_f32_e32 %0, %1, %2":"=v"(r):"v"(a),"v"(b));return r;}
typedef float f32x2_t __attribute__((ext_vector_type(2))); typedef __bf16 bf16x2_t __attribute__((ext_vector_type(2)));
__device__ __forceinline__ unsigned cvtpk_s(float lo,float hi){f32x2_t v={lo,hi};bf16x2_t b=__builtin_convertvector(v,bf16x2_t);return __builtin_bit_cast(unsigned,b);}
#define WAIT_BAR(N) asm volatile("s_waitcnt vmcnt(" #N ") lgkmcnt(0)\n\ts_barrier":::"memory")

__device__ __forceinline__ void qkt(f32x16&p0,f32x16&p1,const char*Kslot,const bf16x8*qr,int r32,int hi){ const f32x16 negm=f32x16{};
  const char*kb=Kslot+hi*1024+r32*16;
  #pragma unroll
  for(int d0=0;d0<4;++d0){
    const bf16x8 b0=*reinterpret_cast<const bf16x8*>(kb+d0*2048);
    const bf16x8 b1=*reinterpret_cast<const bf16x8*>(kb+d0*2048+512);
    if(d0==0){p0=__builtin_amdgcn_mfma_f32_32x32x16_bf16(b0,qr[0],negm,0,0,0);p1=__builtin_amdgcn_mfma_f32_32x32x16_bf16(b1,qr[0],negm,0,0,0);}
    else{p0=__builtin_amdgcn_mfma_f32_32x32x16_bf16(b0,qr[d0],p0,0,0,0);p1=__builtin_amdgcn_mfma_f32_32x32x16_bf16(b1,qr[d0],p1,0,0,0);}}
}
typedef __attribute__((address_space(3))) const char* lds_cptr;
typedef short v4i16_t __attribute__((ext_vector_type(4)));
__device__ __forceinline__ void kload8(bf16x8*kf,lds_cptr kp){
  kf[0]=*(const __attribute__((address_space(3))) bf16x8*)(kp);      kf[1]=*(const __attribute__((address_space(3))) bf16x8*)(kp+512);
  kf[2]=*(const __attribute__((address_space(3))) bf16x8*)(kp+2048); kf[3]=*(const __attribute__((address_space(3))) bf16x8*)(kp+2560);
  kf[4]=*(const __attribute__((address_space(3))) bf16x8*)(kp+4096); kf[5]=*(const __attribute__((address_space(3))) bf16x8*)(kp+4608);
  kf[6]=*(const __attribute__((address_space(3))) bf16x8*)(kp+6144); kf[7]=*(const __attribute__((address_space(3))) bf16x8*)(kp+6656);
}
__device__ __forceinline__ void kload2(bf16x8*kf,lds_cptr kp,int j){ kf[2*j]=*(const __attribute__((address_space(3))) bf16x8*)(kp+j*2048); kf[2*j+1]=*(const __attribute__((address_space(3))) bf16x8*)(kp+j*2048+512); }
__device__ __forceinline__ s16x4 vtr(lds_cptr p){ return __builtin_bit_cast(s16x4,__builtin_amdgcn_ds_read_tr16_b64_v4i16((__attribute__((address_space(3))) v4i16_t*)p)); }
__device__ __forceinline__ float rowmax(const f32x16&p0,const f32x16&p1){
  float a=max3f(p0[0],p0[1],p1[0]),b=max3f(p0[2],p0[3],p1[1]);a=max3f(a,p1[2],p1[3]);
  #pragma unroll
  for(int r=4;r<16;r+=4){a=max3f(a,p0[r],p0[r+1]);b=max3f(b,p0[r+2],p0[r+3]);a=max3f(a,p1[r],p1[r+1]);b=max3f(b,p1[r+2],p1[r+3]);}
  const float m=max2f(a,b);
  auto rr=__builtin_amdgcn_permlane32_swap(__float_as_uint(m),__float_as_uint(m),false,false);
  return max2f(__uint_as_float(rr[0]),__uint_as_float(rr[1]));
}
__device__ __forceinline__ void pv(f32x16*o,int vb,bf16x8 pa0,bf16x8 pa1,bf16x8 pa2,bf16x8 pa3){
  #pragma unroll
  for(int d0=0;d0<4;++d0){s16x4 lo[4],hi[4];
    #pragma unroll
    for(int ks=0;ks<4;++ks){
      asm volatile("ds_read_b64_tr_b16 %0,%1 offset:%c2":"=&v"(lo[ks]):"v"(vb),"i"(d0*4096+ks*1024):"memory");
      asm volatile("ds_read_b64_tr_b16 %0,%1 offset:%c2":"=&v"(hi[ks]):"v"(vb),"i"(d0*4096+ks*1024+512):"memory");}
    asm volatile("s_waitcnt lgkmcnt(0)":::"memory");SBAR();
    #define PK(k) (bf16x8){lo[k][0],lo[k][1],lo[k][2],lo[k][3],hi[k][0],hi[k][1],hi[k][2],hi[k][3]}
    o[d0]=__builtin_amdgcn_mfma_f32_32x32x16_bf16(pa0,PK(0),o[d0],0,0,0);
    o[d0]=__builtin_amdgcn_mfma_f32_32x32x16_bf16(pa1,PK(1),o[d0],0,0,0);
    o[d0]=__builtin_amdgcn_mfma_f32_32x32x16_bf16(pa2,PK(2),o[d0],0,0,0);
    o[d0]=__builtin_amdgcn_mfma_f32_32x32x16_bf16(pa3,PK(3),o[d0],0,0,0);
    #undef PK
  }
}

#ifndef ATTN_STORE16
#define ATTN_STORE16(p,v) (*(u32x4*)(p)=(v))
#endif
template<int THRL,bool FAST> __device__ __forceinline__ void attn_unit(int b,int qcol,int kcol,int vcol,int ocol,int qb,const bf16*Q,const bf16*__restrict__ K,const bf16*__restrict__ V,bf16*O,char*shm,int comb,int o0col,float lam,const float*gsub,bf16*OA,int oacol){
  const int tid=threadIdx.x,lane=tid&63,r32=lane&31,hi=lane>>5; const int wid=__builtin_amdgcn_readfirstlane(tid>>6);
  const long qrow0=(long)b*QSEQ, krow0=(long)b*KSEQ; const int q0=qb*QB;
  const bf16*Qw=Q+(qrow0+q0+wid*QBLK)*QP+qcol;
  const bf16*Kh=K+krow0*KP+kcol,*Vh=V+krow0*VP+vcol;
  const unsigned lds0=(unsigned)(uintptr_t)shm;
  float*wsf=(float*)(shm+LDS_WS)+wid*64;
  const bf16*ksrc=Kh+(long)lane*KP+wid*8;
  const bf16*vsrc=Vh+(long)(16*(wid&3)+(lane>>2))*VP+(wid>>2)*32+(lane&3)*8;
  const unsigned kdst=lds0+LDS_K+wid*1024, vdst=lds0+LDS_V+wid*1024;
  #define DMA_K(t,slot) glds16(ksrc+(long)(t)*KVBLK*KP,(unsigned)__builtin_amdgcn_readfirstlane(kdst+(slot)))
  #define DMA_V(t,slot) do{ glds16(vsrc+(long)(t)*KVBLK*VP,(unsigned)__builtin_amdgcn_readfirstlane(vdst+2*(slot))); glds16(vsrc+64+(long)(t)*KVBLK*VP,(unsigned)__builtin_amdgcn_readfirstlane(vdst+2*(slot)+8192)); }while(0)
  const int vb0=(int)(lds0+LDS_V)+((lane>>4)&1)*32+(lane&3)*8+(4*hi+((lane&15)>>2))*64;
  const char*Kbase=shm+LDS_K; bf16x8 kf[8];
  const lds_cptr shm3=(lds_cptr)shm; const lds_cptr kp0=shm3+LDS_K+hi*1024+r32*16; const lds_cptr vp0=shm3+LDS_V+((lane>>4)&1)*32+(lane&3)*8+(4*hi+((lane&15)>>2))*64;
  const int NT=(q0+QB)/KVBLK+1;
  DMA_K(0,0);DMA_V(0,0);DMA_K(1,SLOTB);
  bf16x8 qr[4];
  #pragma unroll
  for(int d0=0;d0<4;++d0)qr[d0]=*reinterpret_cast<const bf16x8*>(&Qw[(long)r32*QP+d0*16+hi*8]);
  const __attribute__((address_space(3))) char* qsp=(const __attribute__((address_space(3))) char*)shm3+LDS_OST+wid*QSTG+r32*144+hi*16;
  #pragma unroll
  for(int d0=0;d0<4;++d0)*(__attribute__((address_space(3))) bf16x8*)(qsp+d0*32)=qr[d0];
  #define QV(d0) (*(const __attribute__((address_space(3))) bf16x8*)(qsp+(d0)*32))
  float mhat=0.f,l_reg=0.f;f32x16 o[4];o[0]=f32x16{};o[1]=f32x16{};o[2]=f32x16{};o[3]=f32x16{};const f32x16 zero16=f32x16{};
  const int qrel=wid*QBLK+r32;
  #define CMASK(P0,P1,t) do{int jb_=(t)-(NT-4); if(jb_>=0)cmask(P0,P1,jb_,qrel,hi);}while(0)
  bool resc=false;
  #define START(P0,P1) do{ resc=false; if constexpr(FAST){ mhat=0.f; _Pragma("unroll") for(int r=0;r<16;++r)P0[r]=__builtin_amdgcn_exp2f(P0[r]); } \
    else { const float rm=rowmax(P0,P1); mhat=rm; _Pragma("unroll") for(int r=0;r<16;++r)P0[r]=__builtin_amdgcn_exp2f(fsub_s(P0[r],mhat)); } }while(0)
  #define RESC() do{ if(resc){ asm volatile("s_waitcnt lgkmcnt(0)":::"memory"); \
      _Pragma("unroll") for(int d_=0;d_<4;++d_) _Pragma("unroll") for(int r=0;r<16;++r)o[d_][r]*=wsf[crow(r,hi)]; } }while(0)
  f32x16 pA0,pA1,pB0,pB1;
  int sl_prev=0,sl_cur=0,sl_next=SLOTB;
  #define ROT() do{sl_prev=sl_cur;sl_cur=sl_next;sl_next=(sl_next==(NSLOT-1)*SLOTB)?0:sl_next+SLOTB;}while(0)
  DMA_K(2,2*SLOTB);
  WAIT_BAR(3);
  qkt(pA0,pA1,Kbase,qr,r32,hi);asm volatile("s_nop 15\n\ts_nop 7":"+v"(pA0),"+v"(pA1));
  { _Pragma("unroll") for(int r=8;r<16;++r)pA0[r]=-INFINITY; _Pragma("unroll") for(int r=0;r<16;++r)pA1[r]=-INFINITY; }
  START(pA0,pA1);
  if constexpr(FAST){ _Pragma("unroll") for(int r=0;r<16;++r)pA1[r]=__builtin_amdgcn_exp2f(pA1[r]); } else { _Pragma("unroll") for(int r=0;r<16;++r)pA1[r]=__builtin_amdgcn_exp2f(fsub_s(pA1[r],mhat)); }
  WAIT_BAR(0);
  DMA_K(3,0);DMA_V(1,SLOTB);
  ROT();
  kload8(kf,kp0+sl_cur);
  WAIT_BAR(3);
  s16x4 vlo[8],vhi[8]; u32x4 pw0,pw1,pw2,pw3;
  #define PKW(P,B) cvtpk_s(P[B],P[B+1])
  #define PAF(k) __builtin_bit_cast(bf16x8,pw##k)
  #define VFR(i) (bf16x8){vlo[i][0],vlo[i][1],vlo[i][2],vlo[i][3],vhi[i][0],vhi[i][1],vhi[i][2],vhi[i][3]}
  #define PIN(x) asm volatile("":"+v"(x))
  #define MX3(a,b,c) __builtin_fmaxf(__builtin_fmaxf((a),(b)),(c))
  #define GAPA(MF,A0,A1,A2,A3,W0,W1,PW) do{ MF; sacc+=A0; sacc+=A1; sacc+=A2; sacc+=A3; PIN(sacc); W0; W1; PIN(PW); SBAR(); }while(0)
  #define EX(v) __builtin_amdgcn_exp2f(v)
  #define GAPB(MF,X,B) do{ MF; if constexpr(FAST){ X[B]=EX(X[B]); X[B+1]=EX(X[B+1]); } else { X[B]=EX(X[B]-mhat); X[B+1]=EX(X[B+1]-mhat); } PIN(X); SBAR(); }while(0)
  #define VOF(j) ((((j)&3)*4096)+(((j)>>2)*1024))
  #define VRD(sl,j) do{ vlo[sl]=vtr(vp_+VOF(j)); vhi[sl]=vtr(vp_+VOF(j)+512); }while(0)
  #define KRD(G,j) do{ if(G){ kload2(kf,kp0+sl_next,j); SBAR(); } }while(0)
  #define PVM(j) o[(j)&3]=__builtin_amdgcn_mfma_f32_32x32x16_bf16(PAFJ(j),VFR((j)&7),o[(j)&3],0,0,0)
  #define PAFJ(j) (((j)>>2)==0?PAF(0):((j)>>2)==1?PAF(1):((j)>>2)==2?PAF(2):PAF(3))
  #define STEP(C0,C1,P0,P1,t,GK,GV,GL) do{ SBAR(); \
    const lds_cptr vp_=vp0+2*sl_prev; \
    VRD(0,0); SBAR(); float sacc=(P0[0]+P0[1]); \
    GAPA(C0=__builtin_amdgcn_mfma_f32_32x32x16_bf16(kf[0],QV(0),zero16,0,0,0), P0[2],P0[3],P0[4],P0[5],     pw0[0]=PKW(P0,0), pw0[1]=PKW(P0,2), pw0); \
    VRD(1,1); SBAR(); GAPA(C1=__builtin_amdgcn_mfma_f32_32x32x16_bf16(kf[1],QV(0),zero16,0,0,0), P0[6],P0[7],P0[8],P0[9],     pw0[2]=PKW(P0,4), pw0[3]=PKW(P0,6), pw0); \
    VRD(2,2); SBAR(); GAPA(C0=__builtin_amdgcn_mfma_f32_32x32x16_bf16(kf[2],QV(1),C0,0,0,0),   P0[10],P0[11],P0[12],P0[13], pw1[0]=PKW(P0,8), pw1[1]=PKW(P0,10), pw1); \
    VRD(3,3); SBAR(); GAPA(C1=__builtin_amdgcn_mfma_f32_32x32x16_bf16(kf[3],QV(1),C1,0,0,0),   P0[14],P0[15],P1[0],P1[1],   pw1[2]=PKW(P0,12),pw1[3]=PKW(P0,14), pw1); \
    VRD(4,4); SBAR(); GAPA(C0=__builtin_amdgcn_mfma_f32_32x32x16_bf16(kf[4],QV(2),C0,0,0,0),   P1[2],P1[3],P1[4],P1[5],     pw2[0]=PKW(P1,0), pw2[1]=PKW(P1,2), pw2); \
    VRD(5,5); SBAR(); GAPA(C1=__builtin_amdgcn_mfma_f32_32x32x16_bf16(kf[5],QV(2),C1,0,0,0),   P1[6],P1[7],P1[8],P1[9],     pw2[2]=PKW(P1,4), pw2[3]=PKW(P1,6), pw2); \
    VRD(6,6); SBAR(); GAPA(C0=__builtin_amdgcn_mfma_f32_32x32x16_bf16(kf[6],QV(3),C0,0,0,0),   P1[10],P1[11],P1[12],P1[13], pw3[0]=PKW(P1,8), pw3[1]=PKW(P1,10), pw3); \
    VRD(7,7); SBAR(); GAPA(C1=__builtin_amdgcn_mfma_f32_32x32x16_bf16(kf[7],QV(3),C1,0,0,0),   P1[14],P1[15],0.f,0.f,       pw3[2]=PKW(P1,12),pw3[3]=PKW(P1,14), pw3); \
    l_reg+=sacc; \
    if(GK){DMA_K((t)+3,sl_cur);} if(GV){DMA_V((t)+1,sl_next);} \
    CMASK(C0,C1,t); \
    if constexpr(!FAST){ float a=MX3(C0[0],C0[1],C1[0]),b=MX3(C0[2],C0[3],C1[1]); a=MX3(a,C1[2],C1[3]); \
      _Pragma("unroll") for(int r=4;r<16;r+=4){a=MX3(a,C0[r],C0[r+1]);b=MX3(b,C0[r+2],C0[r+3]);a=MX3(a,C1[r],C1[r+1]);b=MX3(b,C1[r+2],C1[r+3]);} \
      float rm=__builtin_fmaxf(a,b); { auto rr=__builtin_amdgcn_permlane32_swap(__float_as_uint(rm),__float_as_uint(rm),false,false); rm=__builtin_fmaxf(__uint_as_float(rr[0]),__uint_as_float(rr[1])); } \
      rm-=mhat; resc=false; \
      if(__builtin_expect(__any(rm>(float)THRL),0)){ const float dl=__builtin_fmaxf(rm,0.f); mhat+=dl; \
        const float f=__builtin_amdgcn_exp2f(-dl); l_reg*=f; if(hi==0)wsf[r32]=f; resc=true; } } \
    SBAR(); \
    GAPB(PVM(0), C0,0); \
    GAPB(PVM(1), C0,2);  VRD(0,8);  SBAR(); \
    GAPB(PVM(2), C0,4);  VRD(1,9);  SBAR(); \
    GAPB(PVM(3), C0,6);  VRD(2,10); SBAR(); \
    GAPB(PVM(4), C0,8);  VRD(3,11); SBAR(); \
    GAPB(PVM(5), C0,10); VRD(4,12); SBAR(); \
    GAPB(PVM(6), C0,12); VRD(5,13); SBAR(); \
    GAPB(PVM(7), C0,14); VRD(6,14); SBAR(); \
    GAPB(PVM(8), C1,0);  VRD(7,15); SBAR(); \
    KRD(GL,0); GAPB(PVM(9),  C1,2); \
    KRD(GL,1); GAPB(PVM(10), C1,4); \
    KRD(GL,2); GAPB(PVM(11), C1,6); \
    KRD(GL,3); GAPB(PVM(12), C1,8); \
    GAPB(PVM(13), C1,10); \
    GAPB(PVM(14), C1,12); \
    GAPB(PVM(15), C1,14); \
    }while(0)
  int t=1;
  #undef CMASK
  #define CMASK(P0,P1,t) do{}while(0)
  for(;t+5<NT;t+=2){
    STEP(pB0,pB1,pA0,pA1,t,true,true,true);     WAIT_BAR(3); RESC(); ROT();
    STEP(pA0,pA1,pB0,pB1,t+1,true,true,true);   WAIT_BAR(3); RESC(); ROT();
  }
  #undef CMASK
  #define CMASK(P0,P1,t) do{int jb_=(t)-(NT-4); if(jb_>=0)cmask(P0,P1,jb_,qrel,hi);}while(0)
  #define ENDW(tt) do{ if((tt)+3<NT){WAIT_BAR(3);} else if((tt)+2<NT){WAIT_BAR(2);} else {WAIT_BAR(0);} }while(0)
  for(;t+1<NT;t+=2){
    STEP(pB0,pB1,pA0,pA1,t,(t+3<NT),(t+1<NT),(t+1<NT));       ENDW(t);   RESC(); ROT();
    STEP(pA0,pA1,pB0,pB1,t+1,(t+4<NT),(t+2<NT),(t+2<NT));     ENDW(t+1); RESC(); ROT();
  }
  { float sacc=pA0[0]+pA0[1]; _Pragma("unroll") for(int r=2;r<16;++r)sacc+=pA0[r]; _Pragma("unroll") for(int r=0;r<16;++r)sacc+=pA1[r]; l_reg+=sacc;
    pw0=(u32x4){PKW(pA0,0),PKW(pA0,2),PKW(pA0,4),PKW(pA0,6)};pw1=(u32x4){PKW(pA0,8),PKW(pA0,10),PKW(pA0,12),PKW(pA0,14)};pw2=(u32x4){PKW(pA1,0),PKW(pA1,2),PKW(pA1,4),PKW(pA1,6)};pw3=(u32x4){PKW(pA1,8),PKW(pA1,10),PKW(pA1,12),PKW(pA1,14)};
    SBAR(); pv(o,vb0+2*sl_prev,PAF(0),PAF(1),PAF(2),PAF(3)); }
  #undef PKW
  #undef PAF
  #undef VFR
  #undef PIN
  #undef MX3
  #undef GAPA
  #undef GAPB
  #undef EX
  #undef VRD
  #undef KRD
  #undef STEP
  #undef VOF
  #undef PVM
  #undef PAFJ
  #undef QV
  #undef ENDW
  {auto rr=__builtin_amdgcn_permlane32_swap(__float_as_uint(l_reg),__float_as_uint(l_reg),false,false);l_reg=__uint_as_float(rr[0])+__uint_as_float(rr[1]);}
  if(hi==0)wsf[32+r32]=l_reg;asm volatile("s_waitcnt lgkmcnt(0)":::"memory");
  float rli[16];
  #pragma unroll
  for(int r=0;r<16;++r)rli[r]=__builtin_amdgcn_rcpf(wsf[32+crow(r,hi)]);
  bf16*Ow=O+(qrow0+q0+wid*QBLK)*OP+ocol;
  { int oz_; asm volatile("v_mov_b32 %0, 0":"=v"(oz_)); const int ln=lane+oz_;
    bf16*stg=(bf16*)(shm+LDS_OST+wid*QSTG);
    if(!comb){
      #pragma unroll
      for(int hh=0;hh<2;++hh){
        #pragma unroll
        for(int r=0;r<16;++r){const int orow=crow(r,hi);
          #pragma unroll
          for(int d0=0;d0<2;++d0)stg[orow*64+d0*32+r32]=__float2bfloat16(o[2*hh+d0][r]*rli[r]);}
        asm volatile("s_waitcnt lgkmcnt(0)":::"memory");
        #pragma unroll
        for(int i=0;i<4;++i){const int row=i*8+(ln>>3),ch=ln&7; const u32x4 v=*(const u32x4*)(stg+row*64+ch*8); ATTN_STORE16(Ow+(long)row*OP+hh*64+ch*8,v);}
        asm volatile("s_waitcnt lgkmcnt(0)":::"memory"); }
    } else {
      const bf16*O0w=O+(qrow0+q0+wid*QBLK)*OP+o0col; bf16*OAw=OA+(qrow0+q0+wid*QBLK)*512+oacol;
      float ssr[4]={0.f,0.f,0.f,0.f};
      #pragma unroll
      for(int pass=0;pass<2;++pass){
        if(pass==1){
          #pragma unroll
          for(int i=0;i<4;++i){ float ss=ssr[i]; ss+=__shfl_xor(ss,1); ss+=__shfl_xor(ss,2); ss+=__shfl_xor(ss,4); ssr[i]=0.8f/sqrtf(ss*(1.0f/128.0f)+1e-6f); } }
        #pragma unroll
        for(int hh=0;hh<2;++hh){
          u32x4 v0[4];
          #pragma unroll
          for(int i=0;i<4;++i){const int row=i*8+(ln>>3),ch=ln&7; v0[i]=*(const u32x4*)(O0w+(long)row*OP+hh*64+ch*8);}
          #pragma unroll
          for(int r=0;r<16;++r){const int orow=crow(r,hi);
            #pragma unroll
            for(int d0=0;d0<2;++d0)stg[orow*64+d0*32+r32]=__float2bfloat16(o[2*hh+d0][r]*rli[r]);}
          asm volatile("s_waitcnt lgkmcnt(0)":::"memory");
          const int ch=ln&7; const float4 g0=*(const float4*)(gsub+hh*64+ch*8), g1=*(const float4*)(gsub+hh*64+ch*8+4); const float gg[8]={g0.x,g0.y,g0.z,g0.w,g1.x,g1.y,g1.z,g1.w};
          #pragma unroll
          for(int i=0;i<4;++i){const int row=i*8+(ln>>3); const u32x4 v1=*(const u32x4*)(stg+row*64+ch*8); const u32x4 a=v0[i];
            const unsigned aw[4]={a.x,a.y,a.z,a.w},bw[4]={v1.x,v1.y,v1.z,v1.w}; float dd[8];
            #pragma unroll
            for(int j=0;j<4;++j){ dd[2*j]=__uint_as_float(aw[j]<<16)-lam*__uint_as_float(bw[j]<<16); dd[2*j+1]=__uint_as_float(aw[j]&0xffff0000u)-lam*__uint_as_float(bw[j]&0xffff0000u); }
            if(pass==0){
              #pragma unroll
              for(int j=0;j<8;++j)ssr[i]+=dd[j]*dd[j]; }
            else { const float rn=ssr[i]; u32x4 w;
              w.x=cvtpk_s(dd[0]*rn*gg[0],dd[1]*rn*gg[1]); w.y=cvtpk_s(dd[2]*rn*gg[2],dd[3]*rn*gg[3]); w.z=cvtpk_s(dd[4]*rn*gg[4],dd[5]*rn*gg[5]); w.w=cvtpk_s(dd[6]*rn*gg[6],dd[7]*rn*gg[7]);
              *(u32x4*)(OAw+(long)row*512+hh*64+ch*8)=w; } }
          asm volatile("s_waitcnt lgkmcnt(0)":::"memory"); } }
    } }
  asm volatile("s_waitcnt lgkmcnt(0)\n\ts_barrier":::"memory");
  #undef DMA_K
  #undef DMA_V
  #undef CMASK
  #undef START
  #undef RESC
  #undef ROT
}
constexpr int ATTN_LDS_BYTES=LDS_BYTES;
struct AttnTensors { const bf16* Q; const bf16* K; const bf16* V; bf16* O; };
#undef SBAR
#undef WAIT_BAR
}
#define GAS __attribute__((address_space(1)))
#define LAS __attribute__((address_space(3)))
typedef unsigned short bf16;
typedef unsigned v4u __attribute__((ext_vector_type(4)));
typedef float f32x4 __attribute__((ext_vector_type(4)));
typedef short bf16x8 __attribute__((ext_vector_type(8)));
typedef GAS unsigned gu32;
typedef GAS unsigned long long gu64;
#define RLX_AGENT __ATOMIC_RELAXED, __HIP_MEMORY_SCOPE_AGENT
#define LDS_WAIT() asm volatile("s_waitcnt lgkmcnt(0)" ::: "memory")
#define VM_WAIT() asm volatile("s_waitcnt vmcnt(0)" ::: "memory")
__device__ __forceinline__ unsigned long long rt() { return __builtin_amdgcn_s_memrealtime(); }
__device__ __forceinline__ unsigned f2bf(float f) { unsigned u = __builtin_bit_cast(unsigned, f); return (u + 0x7fffu + ((u >> 16) & 1u)) >> 16; }
__device__ __forceinline__ unsigned pk2(float lo, float hi) { return f2bf(lo) | (f2bf(hi) << 16); }

#define XB_TMO      128
#define XB_XCNT(j)  (256  + 64 * (j))
#define XB_XSUB(j)  (1280 + 64 * (j))
#define XB_XGEN(j)  (2304 + 64 * (j))
#define XB_TOP      3328
#define XB_TOPGEN   3392
#define XCD_BAR_WORDS 3456
#define XB_SPIN_CAP (1u << 18)

__device__ __forceinline__ unsigned xb_ld(unsigned* p)              { return __hip_atomic_load(p, __ATOMIC_RELAXED, __HIP_MEMORY_SCOPE_AGENT); }
__device__ __forceinline__ unsigned xb_add(unsigned* p, unsigned v) { return __hip_atomic_fetch_add(p, v, __ATOMIC_RELAXED, __HIP_MEMORY_SCOPE_AGENT); }
__device__ __forceinline__ unsigned xb_xcc_id() { return (unsigned)__builtin_amdgcn_s_getreg((3 << 11) | 20) & 0xFu; }
#define XB_SPIN(cond, bar) do { unsigned _sp = 0; while (cond) { __builtin_amdgcn_s_sleep(1); \
    if ((++_sp & 255u) == 0u) { if (xb_ld(&(bar)[XB_TMO])) break; if (_sp > XB_SPIN_CAP) { atomicAdd(&(bar)[XB_TMO], 1u); break; } } } } while (0)

struct XcdBarrier {
    unsigned* bar; unsigned x;
    volatile LAS unsigned* st;
};

__device__ __forceinline__ XcdBarrier xcd_barrier_post(unsigned* bar, volatile LAS unsigned* st) {
    XcdBarrier b; b.bar = bar; b.x = xb_xcc_id(); b.st = st;
    if (threadIdx.x == 0) (void)xb_add(&bar[XB_XCNT(b.x)], 1u);
    return b;
}
__device__ __forceinline__ void xcd_barrier_complete(unsigned* bar, unsigned x, unsigned& nloc, unsigned& nx) {
    const unsigned G = gridDim.x * gridDim.y * gridDim.z;
    unsigned sum, cnt, mine, sp = 0u;
    for (;;) {
        sum = 0u; cnt = 0u; mine = 0u;
#pragma unroll
        for (unsigned j = 0; j < 16; ++j) { const unsigned c = xb_ld(&bar[XB_XCNT(j)]); sum += c; cnt += (c > 0u) ? 1u : 0u; mine = (j == x) ? c : mine; }
        if (sum == G) break;
        __builtin_amdgcn_s_sleep(1);
        if ((++sp & 255u) == 0u) { if (xb_ld(&bar[XB_TMO])) break; if (sp > XB_SPIN_CAP) { atomicAdd(&bar[XB_TMO], 1u); break; } }
    }
    nloc = mine > 0u ? mine : 1u; nx = cnt > 0u ? cnt : 1u;
}

__device__ __forceinline__ void xcd_barrier(const XcdBarrier& b) {
    asm volatile("s_waitcnt vmcnt(0)" ::: "memory");
    __syncthreads();
    if (threadIdx.x == 0) {
        unsigned* bar = b.bar;
        __builtin_amdgcn_s_waitcnt(0);
        unsigned nloc = b.st[0], nx = b.st[1];
        if (nloc == 0u) { xcd_barrier_complete(bar, b.x, nloc, nx); b.st[0] = nloc; b.st[1] = nx; }
        const unsigned old = xb_add(&bar[XB_XSUB(b.x)], 1u);
        const unsigned gen = old / nloc;
        if (old + 1u == (gen + 1u) * nloc) {
            __builtin_amdgcn_fence(__ATOMIC_RELEASE, "agent");
            asm volatile("s_waitcnt vmcnt(0)" ::: "memory");
            const unsigned og = xb_add(&bar[XB_TOP], 1u);
            const unsigned tg = og / nx;
            if (og + 1u == (tg + 1u) * nx) xb_add(&bar[XB_TOPGEN], 1u);
            else XB_SPIN(xb_ld(&bar[XB_TOPGEN]) == tg, bar);
            __builtin_amdgcn_fence(__ATOMIC_ACQUIRE, "agent");
            xb_add(&bar[XB_XGEN(b.x)], 1u);
            asm volatile("s_waitcnt vmcnt(0)" ::: "memory");
        } else {
            XB_SPIN(xb_ld(&bar[XB_XGEN(b.x)]) == gen, bar);
            __builtin_amdgcn_fence(__ATOMIC_ACQUIRE, "agent");
            asm volatile("s_waitcnt vmcnt(0)" ::: "memory");
        }
    }
    __syncthreads();
}
constexpr int NWAVES = 8;
constexpr int DM = 1024, NBATCH = 8, SEQ = 4096, NMETA = 16;
constexpr int MROWS = NBATCH * SEQ;
constexpr int LPB = SEQ + 64;
constexpr int PROWS = NBATCH * LPB + 64;
constexpr int MZ = MROWS + 256;
constexpr int NZ = 5376, DIN = 5136;
constexpr int C_DAQ = 0, C_DAK = 512, C_DAV = 1024, C_GQ = 1536, C_GK = 1792, C_GV = 2048, C_GR = 2560, C_GG = 3072, C_GL = 3088;
constexpr float EPS = 1e-6f;
constexpr int NEXP = 32, DEXP = 512, LCAP = 32768;
constexpr int NPOS = SEQ + NMETA;

constexpr size_t MiB = 1u << 20;
constexpr size_t WS_CTL = 0, CTL_ZERO_BYTES = 1 * MiB, WS_TRASH = 768 * 1024;
constexpr size_t WS_ROPE = 1 * MiB;
constexpr size_t WS_WRH = 3 * MiB, WS_WRL = 3 * MiB + 128 * 1024;
constexpr size_t WS_IG2 = 3 * MiB + 512 * 1024;
constexpr size_t WS_LTOK = 4 * MiB, WS_LRS = 12 * MiB, WS_LW = 20 * MiB;
constexpr size_t WS_WIN = 28 * MiB, WS_WBR = 39 * MiB, WS_WOUT = 41 * MiB, WS_WGU = 43 * MiB, WS_WD = 107 * MiB;
constexpr size_t WS_R1 = 139 * MiB;
constexpr size_t WS_Q = 204 * MiB, WS_K = 236 * MiB, WS_V = 269 * MiB;
constexpr size_t WS_OA = 204 * MiB, WS_H2U = 204 * MiB;
constexpr size_t WS_GQ = 302 * MiB, WS_GK = 319 * MiB, WS_GV = 336 * MiB, WS_GR = 369 * MiB, WS_LOGA = 402 * MiB;
constexpr size_t WS_HID = 302 * MiB;
constexpr size_t WS_H2U8 = 269 * MiB;
constexpr float W8SCALE = 32.0f, H8SCALE = 4.0f;
constexpr size_t WS_DS = 435 * MiB, WS_END = 500 * MiB;
constexpr size_t WS_XN8 = WS_DS, WS_WIN8 = WS_WIN + 7 * MiB;
constexpr float X8SCALE = 8.0f;
static_assert((size_t)13 * 256 * DM * 2 <= 7 * MiB && WS_WIN8 + (size_t)2048 * DM <= WS_WBR && WS_XN8 + (size_t)MROWS * DM <= WS_END, "ws map 4");
static_assert(WS_R1 + (size_t)MZ * DM * 2 <= WS_Q && WS_K + (size_t)PROWS * 512 * 2 <= WS_V && WS_V + (size_t)PROWS * 512 * 2 <= WS_GQ, "ws map 1");
static_assert(WS_GQ + (size_t)PROWS * 256 * 2 <= WS_GK && WS_GK + (size_t)PROWS * 256 * 2 <= WS_GV && WS_GV + (size_t)PROWS * 512 * 2 <= WS_GR && WS_GR + (size_t)PROWS * 512 * 2 <= WS_LOGA && WS_LOGA + (size_t)PROWS * 256 * 4 <= WS_DS, "ws map 2");
static_assert(WS_HID + (size_t)81920 * 512 * 2 <= WS_DS && WS_DS + (size_t)32 * 64 * 8192 * 4 <= WS_END && WS_WIN + (size_t)NZ * DM * 2 <= WS_WBR && WS_WD + (size_t)32 * 1024 * 512 * 2 <= WS_R1, "ws map 3");
constexpr int CW_TMO = 0, CW_BAR = 4096, CW_CNT = 16384;

constexpr int RING_OFF = 0, RING_BYTES = 131072;
constexpr int LDSCTL_OFF = RING_BYTES, MISC_OFF = LDSCTL_OFF + 320, TB_OFF = LDSCTL_OFF + 1024, CN_OFF = LDSCTL_OFF + 1536;
constexpr int INTAB_OFF = LDSCTL_OFF + 3072;
constexpr int BML_OFF = LDSCTL_OFF + 4096;
constexpr int LDS_BYTES = 147456;
struct Frame {
    LAS unsigned char* lds;
    volatile LAS unsigned* MISC;
    gu32* ctl;
    int tid, lane, wave, vcu, G;
    float* out; unsigned char* ws;
    __device__ __forceinline__ const float* inp(int i) const { const unsigned long long v = ((const LAS unsigned long long*)(lds + INTAB_OFF))[i];
        return (const float*)(((unsigned long long)(unsigned)__builtin_amdgcn_readfirstlane((int)(v >> 32)) << 32) | (unsigned)__builtin_amdgcn_readfirstlane((int)v)); }
};
enum { I_X = 0, I_META, I_GMIX, I_WIN, I_GQN, I_GKN, I_LQ1, I_LK1, I_LQ2, I_LK2, I_GSUB, I_WGUP, I_BGATE, I_GGLA, I_WBR, I_BMERGE, I_WOUT, I_GFFN, I_WRG, I_BRG, I_WRE, I_BRE, I_WEG, I_WEU, I_WED };
#define WSP(T, off) ((T*)(F.ws + (off)))

__device__ __forceinline__ float wave_sum(float v) {
#pragma unroll
    for (int o = 1; o < 64; o <<= 1) v += __shfl_xor(v, o);
    return v;
}
__device__ __forceinline__ float bf2f(bf16 v) { return __uint_as_float((unsigned)v << 16); }
__device__ __forceinline__ float sigmoidf_(float x) { return 1.0f / (1.0f + __expf(-x)); }
__device__ __forceinline__ float clamp8(float x) { return fminf(fmaxf(x, -448.0f), 448.0f); }
__device__ __forceinline__ unsigned pk4_fp8(float a, float b, float c, float d) { unsigned w = 0; w = __builtin_amdgcn_cvt_pk_fp8_f32(clamp8(a), clamp8(b), w, false); w = __builtin_amdgcn_cvt_pk_fp8_f32(clamp8(c), clamp8(d), w, true); return w; }

__device__ __forceinline__ void transpose_tile(const float* src, int Ns, unsigned char* dstb, unsigned pitch, bool f8, LAS float* scr, int lane) {
    float tv[32];
#pragma unroll
    for (int i = 0; i < 32; ++i) tv[i] = src[(unsigned)((2 * i + (lane >> 5)) * Ns + (lane & 31))];
#pragma unroll
    for (int i = 0; i < 32; ++i) scr[(2 * i + (lane >> 5)) * 33 + (lane & 31)] = tv[i];
    LDS_WAIT(); asm volatile("" ::: "memory");
    const int c = lane & 7;
#pragma unroll
    for (int j = 0; j < 4; ++j) { const int n = (lane >> 3) + 8 * j; const LAS float* s = scr + (8 * c) * 33 + n;
        if (f8) { const unsigned lo = pk4_fp8(s[0 * 33] * W8SCALE, s[1 * 33] * W8SCALE, s[2 * 33] * W8SCALE, s[3 * 33] * W8SCALE), hi = pk4_fp8(s[4 * 33] * W8SCALE, s[5 * 33] * W8SCALE, s[6 * 33] * W8SCALE, s[7 * 33] * W8SCALE);
            *(GAS unsigned long long*)(dstb + (unsigned)n * pitch + 8 * c) = (unsigned long long)lo | ((unsigned long long)hi << 32); }
        else { v4u o; o.x = pk2(s[0 * 33], s[1 * 33]); o.y = pk2(s[2 * 33], s[3 * 33]); o.z = pk2(s[4 * 33], s[5 * 33]); o.w = pk2(s[6 * 33], s[7 * 33]);
            *(GAS v4u*)(dstb + (unsigned)n * pitch + 16 * c) = o; } }
    LDS_WAIT(); asm volatile("" ::: "memory");
}
__device__ __forceinline__ void product_tile(const float* win, const float* wgu, int k0, int n0, bf16* dst, LAS float* scr, int lane) {
    float wg[16];
#pragma unroll
    for (int r = 0; r < 16; ++r) wg[r] = wgu[r * 256 + n0 + (lane & 31)];
    LAS float* gb = scr + 64 * 33;
#pragma unroll
    for (int j = 0; j < 4; ++j) { const int idx = lane + 64 * j, kk = idx >> 2, q = idx & 3; *(LAS f32x4*)(gb + kk * 16 + 4 * q) = *(const GAS f32x4*)(win + (size_t)(k0 + kk) * DIN + C_GG + 4 * q); }
    LDS_WAIT(); asm volatile("" ::: "memory");
#pragma unroll 4
    for (int i = 0; i < 32; ++i) { const int kk = 2 * i + (lane >> 5); const LAS f32x4* g4 = (const LAS f32x4*)(gb + kk * 16); float s = 0.f;
#pragma unroll
        for (int q = 0; q < 4; ++q) { const f32x4 g = g4[q]; s += g.x * wg[4 * q] + g.y * wg[4 * q + 1] + g.z * wg[4 * q + 2] + g.w * wg[4 * q + 3]; }
        scr[kk * 33 + (lane & 31)] = s; }
    LDS_WAIT(); asm volatile("" ::: "memory");
    const int c = lane & 7;
#pragma unroll
    for (int j = 0; j < 4; ++j) { const int n = (lane >> 3) + 8 * j; const LAS float* s = scr + (8 * c) * 33 + n;
        v4u o; o.x = pk2(s[0 * 33], s[1 * 33]); o.y = pk2(s[2 * 33], s[3 * 33]); o.z = pk2(s[4 * 33], s[5 * 33]); o.w = pk2(s[6 * 33], s[7 * 33]);
        *(GAS v4u*)(dst + (size_t)n * DM + 8 * c) = o; }
    LDS_WAIT(); asm volatile("" ::: "memory");
}
__device__ __forceinline__ int win_src_col(int T, int p0) {
    if (T < 4) { const int bj = p0 >> 7, wc = (p0 >> 5) & 3; return (T < 2 ? C_DAQ + 256 * T : C_DAK + 256 * (T - 2)) + 64 * wc + 32 * bj; }
    if (T < 6) return C_DAV + 256 * (T - 4) + p0;
    if (T == 6) return C_GQ + p0;
    if (T == 7) return C_GK + p0;
    if (T < 10) return C_GV + 256 * (T - 8) + p0;
    if (T < 12) return C_GR + 256 * (T - 10) + p0;
    const int t = T - 13; return p0 < 128 ? C_GL + 128 * t + p0 : C_GL + 1024 + 128 * t + (p0 - 128);
}
template <int NR, bool F8C> __device__ __forceinline__ void rms_rows_to_bf16(Frame& F, const float* const (&xrow)[NR], const float* gain, bf16* const (&orow)[NR]) {
    const GAS f32x4* gr = (const GAS f32x4*)gain + F.lane;
    f32x4 v[NR][4];
#pragma unroll
    for (int r = 0; r < NR; ++r) { const GAS f32x4* xr = (const GAS f32x4*)xrow[r] + F.lane;
#pragma unroll
        for (int j = 0; j < 4; ++j) v[r][j] = xr[64 * j]; }
#pragma unroll
    for (int r = 0; r < NR; ++r) { float s = 0.f;
#pragma unroll
        for (int j = 0; j < 4; ++j) s += (v[r][j].x * v[r][j].x + v[r][j].y * v[r][j].y) + (v[r][j].z * v[r][j].z + v[r][j].w * v[r][j].w);
        const float rstd = 1.f / sqrtf(wave_sum(s) * (1.f / DM) + EPS);
        GAS unsigned long long* o8 = (GAS unsigned long long*)orow[r] + F.lane;
        GAS unsigned* o4 = (GAS unsigned*)(F.ws + WS_XN8 + (size_t)(((const unsigned char*)orow[r] - (F.ws + WS_R1)) >> 1)) + F.lane;
#pragma unroll
        for (int j = 0; j < 4; ++j) { const f32x4 g = gr[64 * j]; const float y0 = v[r][j].x * rstd * g.x, y1 = v[r][j].y * rstd * g.y, y2 = v[r][j].z * rstd * g.z, y3 = v[r][j].w * rstd * g.w;
            o8[64 * j] = (unsigned long long)pk2(y0, y1) | ((unsigned long long)pk2(y2, y3) << 32);
            if (F8C) o4[64 * j] = pk4_fp8(y0 * X8SCALE, y1 * X8SCALE, y2 * X8SCALE, y3 * X8SCALE); } }
}
constexpr int N_EXPERT_ITEMS = NEXP * 256 + NEXP * 128;
__device__ __forceinline__ void expert_conv_desc(Frame& F, int it, const float*& src, unsigned char*& dst, unsigned& Ns, unsigned& Kd) {
    if (it < NEXP * 256) { const int e = it >> 8, q = it & 255, kb = q >> 4, nbp = q & 15, P0 = nbp * 64, pn = P0 >> 8, p = P0 & 255;
        src = (p < 128 ? F.inp(I_WEG) : F.inp(I_WEU)) + (size_t)e * 1024 * 512 + (size_t)(kb * 64) * 512 + 128 * pn + (p & 127); Ns = 512;
        dst = WSP(unsigned char, WS_WGU) + (size_t)(e * 1024 + P0) * 1024 + kb * 64; Kd = 1024; }
    else { const int r = it - NEXP * 256, e = r >> 7, q = r & 127, kb = q >> 4, nb = q & 15;
        src = F.inp(I_WED) + (size_t)e * 512 * 1024 + (size_t)(kb * 64) * 1024 + nb * 64; Ns = 1024; dst = WSP(unsigned char, WS_WD) + (size_t)(e * 1024 + nb * 64) * 512 + kb * 64; Kd = 512; }
}
__device__ __forceinline__ void expert_conv_store(unsigned char* dst, unsigned Kd, const float (&v)[64], int lane, LAS unsigned char* stg) {
#pragma unroll
    for (int kg = 0; kg < 4; ++kg) { v4u o;
        o.x = pk4_fp8(v[16 * kg] * W8SCALE, v[16 * kg + 1] * W8SCALE, v[16 * kg + 2] * W8SCALE, v[16 * kg + 3] * W8SCALE); o.y = pk4_fp8(v[16 * kg + 4] * W8SCALE, v[16 * kg + 5] * W8SCALE, v[16 * kg + 6] * W8SCALE, v[16 * kg + 7] * W8SCALE);
        o.z = pk4_fp8(v[16 * kg + 8] * W8SCALE, v[16 * kg + 9] * W8SCALE, v[16 * kg + 10] * W8SCALE, v[16 * kg + 11] * W8SCALE); o.w = pk4_fp8(v[16 * kg + 12] * W8SCALE, v[16 * kg + 13] * W8SCALE, v[16 * kg + 14] * W8SCALE, v[16 * kg + 15] * W8SCALE);
        *(LAS v4u*)(stg + lane * 80 + kg * 16) = o; }
    LDS_WAIT(); asm volatile("" ::: "memory");
#pragma unroll
    for (int i = 0; i < 4; ++i) { const int r = (lane >> 2) + 16 * i, c = lane & 3; const v4u o = *(const LAS v4u*)(stg + r * 80 + c * 16); *(GAS v4u*)(dst + (size_t)r * Kd + 16 * c) = o; }
    LDS_WAIT(); asm volatile("" ::: "memory");
}
__device__ __forceinline__ void expert_conv_range(Frame& F, int first, int me, int nw) {
    const int stride = nw; LAS unsigned char* stg = F.lds + RING_OFF + F.wave * 9216;
    for (int it = first + me; it < N_EXPERT_ITEMS; it += 2 * stride) {
        const float *s0, *s1; unsigned char *d0, *d1; unsigned n0, k0, n1, k1; const bool two = it + stride < N_EXPERT_ITEMS;
        expert_conv_desc(F, it, s0, d0, n0, k0); expert_conv_desc(F, two ? it + stride : it, s1, d1, n1, k1);
        float va[64], vb[64];
#pragma unroll
        for (int k = 0; k < 64; ++k) va[k] = s0[(unsigned)k * n0 + (unsigned)F.lane];
        if (two) {
#pragma unroll
            for (int k = 0; k < 64; ++k) vb[k] = s1[(unsigned)k * n1 + (unsigned)F.lane]; }
        expert_conv_store(d0, k0, va, F.lane, stg);
        if (two) expert_conv_store(d1, k1, vb, F.lane, stg);
    }
    asm volatile("s_waitcnt lgkmcnt(0)" ::: "memory"); __syncthreads();
}
__device__ __forceinline__ void expert_conv_slot(Frame& F, int slot, int nslot, int first) { expert_conv_range(F, first, (slot * F.G + F.vcu) * NWAVES + F.wave, nslot * F.G * NWAVES); }
__device__ __forceinline__ void late_tables(Frame& F, int gt, int NGT) {
    { bf16* wh = WSP(bf16, WS_WRH); bf16* wl = WSP(bf16, WS_WRL);
      for (int i = gt; i < 48 * 1024; i += NGT) { const int n = i >> 10, k = i & 1023; const float v = n < 4 ? F.inp(I_WRG)[k * 4 + n] : (n < 36 ? F.inp(I_WRE)[k * 32 + (n - 4)] : 0.f);
          const unsigned h = f2bf(v); const float hf = __uint_as_float(h << 16); wh[i] = (bf16)h; wl[i] = (bf16)f2bf(v - hf); } }
    { float* ig = WSP(float, WS_IG2); for (int i = gt; i < DM; i += NGT) { const float g = F.inp(I_GFFN)[i]; ig[i] = 1.0f / (g * g); } }
    { unsigned* kz = (unsigned*)(WSP(bf16, WS_K) + (size_t)NBATCH * LPB * 512); unsigned* vz = (unsigned*)(WSP(bf16, WS_V) + (size_t)NBATCH * LPB * 512);
      for (int i = gt; i < 64 * 512 / 2; i += NGT) { kz[i] = 0u; vz[i] = 0u; } }
}
#define P1_EXTRA(G) (((MZ / 256) * 13) % (G))
constexpr int P1_TILES_PER_WAVE = 6;
__device__ __forceinline__ int p1_conv_items(int G) { const int ex = P1_EXTRA(G), n = ex ? (G - ex) * NWAVES * P1_TILES_PER_WAVE : 0; return n < N_EXPERT_ITEMS ? n : N_EXPERT_ITEMS; }
__device__ __forceinline__ void expert_conv_first(Frame& F, int me, int nw, int cnt) {
    LAS unsigned char* stg = F.lds + RING_OFF + F.wave * 9216;
    for (int it = me; it < cnt; it += 2 * nw) {
        const float *s0, *s1; unsigned char *d0, *d1; unsigned n0, k0, n1, k1; const bool two = it + nw < cnt;
        expert_conv_desc(F, it, s0, d0, n0, k0); expert_conv_desc(F, two ? it + nw : it, s1, d1, n1, k1);
        float va[64], vb[64];
#pragma unroll
        for (int k = 0; k < 64; ++k) va[k] = s0[(unsigned)k * n0 + (unsigned)F.lane];
        if (two) {
#pragma unroll
            for (int k = 0; k < 64; ++k) vb[k] = s1[(unsigned)k * n1 + (unsigned)F.lane]; }
        expert_conv_store(d0, k0, va, F.lane, stg);
        if (two) expert_conv_store(d1, k1, vb, F.lane, stg);
    }
}
__device__ __forceinline__ void p0_prologue(Frame& F) {
    LAS float* scr = (LAS float*)(F.lds + RING_OFF + F.wave * 16384);
    const int gw = F.vcu * NWAVES + F.wave, NGW = F.G * NWAVES;
    constexpr int I_A = (NZ / 32) * 16, I_B = 2 * 32 * 8, I_C = 32 * 16, NITEMS = I_A + I_B + I_C;
    bf16* WIN = WSP(bf16, WS_WIN);
    for (int it = gw; it < NITEMS; it += NGW) {
        int r = it; const float* src; bf16* dst; int Ns, Kd; bool f8 = false;
        if (r < I_A) { const int kb = r / (NZ / 32), nb = r % (NZ / 32), T = nb >> 3, p0 = (nb & 7) * 32; dst = WIN + (size_t)(nb * 32) * DM + kb * 64;
            if (T == 12) { product_tile(F.inp(I_WIN), F.inp(I_WGUP), kb * 64, p0, dst, scr, F.lane); continue; }
            src = F.inp(I_WIN) + (size_t)(kb * 64) * DIN + win_src_col(T, p0); Ns = DIN; Kd = DM;
            if (T > 12) { f8 = true; dst = (bf16*)(WSP(unsigned char, WS_WIN8) + (size_t)((nb - 104) * 32) * DM + kb * 64); Kd = DM / 2; } }
        else if ((r -= I_A) < I_B) { const int br = r >> 8, q = r & 255, kb = q >> 5, nb = q & 31;
            src = F.inp(I_WBR) + (size_t)br * 512 * 1024 + (size_t)(kb * 64) * 1024 + nb * 32; Ns = 1024; dst = WSP(bf16, WS_WBR) + (size_t)(br * 1024 + nb * 32) * 512 + kb * 64; Kd = 512; }
        else { r -= I_B; const int kb = r >> 5, nb = r & 31;
            src = F.inp(I_WOUT) + (size_t)(kb * 64) * 1024 + nb * 32; Ns = 1024; dst = WSP(bf16, WS_WOUT) + (size_t)(nb * 32) * 1024 + kb * 64; Kd = 1024; }
        transpose_tile(src, Ns, (unsigned char*)dst, (unsigned)Kd * 2u, f8, scr, F.lane);
    }
#ifdef PROBE_K
    if (PROBE_K == 100 && blockIdx.x == 0 && F.tid == 0) ((volatile LAS unsigned long long*)(F.lds + LDSCTL_OFF + 2048))[1] = __builtin_amdgcn_s_memrealtime();
#endif
    bf16* XN = WSP(bf16, WS_R1);
    for (int m = gw; m < MROWS; m += 4 * NGW) {
        if (m + 3 * NGW < MROWS) { const float* const xr[4] = {F.inp(I_X) + (size_t)m * DM, F.inp(I_X) + (size_t)(m + NGW) * DM, F.inp(I_X) + (size_t)(m + 2 * NGW) * DM, F.inp(I_X) + (size_t)(m + 3 * NGW) * DM};
            bf16* const orr[4] = {XN + (size_t)m * DM, XN + (size_t)(m + NGW) * DM, XN + (size_t)(m + 2 * NGW) * DM, XN + (size_t)(m + 3 * NGW) * DM}; rms_rows_to_bf16<4, true>(F, xr, F.inp(I_GMIX), orr); }
        else for (int k = 0; k < 4; ++k) { const int mm = m + k * NGW; if (mm < MROWS) { const float* const xr[1] = {F.inp(I_X) + (size_t)mm * DM}; bf16* const orr[1] = {XN + (size_t)mm * DM}; rms_rows_to_bf16<1, true>(F, xr, F.inp(I_GMIX), orr); } }
    }
    for (int m = MROWS + gw; m < MZ; m += NGW) {
        if (m < MROWS + NMETA) { const float* const xr[1] = {F.inp(I_META) + (size_t)(m - MROWS) * DM}; bf16* const orr[1] = {XN + (size_t)m * DM}; rms_rows_to_bf16<1, false>(F, xr, F.inp(I_GMIX), orr); }
        else { GAS v4u* o = (GAS v4u*)(XN + (size_t)m * DM) + F.lane; o[0] = (v4u){0u, 0u, 0u, 0u}; o[64] = (v4u){0u, 0u, 0u, 0u}; }
    }
#ifdef PROBE_K
    if (PROBE_K == 101 && blockIdx.x == 0 && F.tid == 0) ((volatile LAS unsigned long long*)(F.lds + LDSCTL_OFF + 2048))[1] = __builtin_amdgcn_s_memrealtime();
#endif
    const int gt = gw * 64 + F.lane, NGT = NGW * 64;
    { float* rc = WSP(float, WS_ROPE); float* rs = rc + NPOS * 32;
      for (int i = gt; i < NPOS * 32; i += NGT) { const int pos = i >> 5, j = i & 31; const float inv = exp2f(-(float)j * 0.41524101186092029f); const float ang = (float)pos * inv;
          const double rev = (double)ang * 0.15915494309189535; const float x = (float)(rev - rint(rev));
          rc[i] = __builtin_amdgcn_cosf(x); rs[i] = __builtin_amdgcn_sinf(x); } }
}
namespace epi {
using pg8::f32x4; using pg8::u32x4; using pg8::Unit; using pg8::pack8; using pg8::HALF;
__device__ __forceinline__ unsigned pk4_fp8(float a, float b, float c, float d) { unsigned w = 0; w = __builtin_amdgcn_cvt_pk_fp8_f32(clamp8(a), clamp8(b), w, false); w = __builtin_amdgcn_cvt_pk_fp8_f32(clamp8(c), clamp8(d), w, true); return w; }
constexpr float Y8SCALE = 64.0f;
__device__ __forceinline__ float cy8(float y) { return y * Y8SCALE; }
__device__ __forceinline__ f32x4 un4_fp8(unsigned w) { typedef float f2_ __attribute__((ext_vector_type(2))); const f2_ a = __builtin_amdgcn_cvt_pk_f32_fp8(w, false), b = __builtin_amdgcn_cvt_pk_f32_fp8(w, true); return (f32x4){a[0], a[1], b[0], b[1]}; }
__device__ __forceinline__ float c8(float h) { return h * H8SCALE; }
__device__ __forceinline__ float log_sigmoid(float x) { return fminf(x, 0.f) - __logf(1.0f + __expf(-fabsf(x))); }

struct EpiZ {
    bf16 *Q, *K, *V, *GQ, *GK, *GV, *GR; float* LOGA;
    const float *gq, *gk, *bgate, *ropec, *ropes;
    __device__ __forceinline__ bool operator()(f32x4 (&acc)[2][2][4][2], const Unit& u, int wr, int wc, int fr, int fq) const {
        const int pn = u.pn, pm = u.pm; const bool meta = (pm == MROWS / 256);
        int oz; asm volatile("v_mov_b32 %0, 0" : "=v"(oz));
        const int r0 = wr * 64 + fr + oz, cl = wc * 32 + 8 * fq;
        const int bsh = 64 * ((pm >> 4) + 1);
        if (pn < 4) {
            const bool isq = pn < 2; if (isq && meta) return false;
            const float* gn = isq ? gq : gk;
            const f32x4 ga0 = *(const f32x4*)(gn + 8 * fq), ga1 = *(const f32x4*)(gn + 8 * fq + 4), gb0 = *(const f32x4*)(gn + 32 + 8 * fq), gb1 = *(const f32x4*)(gn + 36 + 8 * fq);
            const int hcol = ((pn & 1) * 4 + wc) * 64 + 8 * fq;
            const float osc = isq ? 0.125f * 1.4426950408889634f : 1.0f;
#pragma unroll
            for (int ai = 0; ai < 2; ++ai)
#pragma unroll
                for (int m = 0; m < 4; ++m) {
                    if (meta && (ai != 0 || wr != 0)) continue;
                    const int r = r0 + ai * HALF + m * 16;
                    const f32x4 x1a = acc[ai][0][m][0], x1b = acc[ai][0][m][1], x2a = acc[ai][1][m][0], x2b = acc[ai][1][m][1];
                    float ss = (x1a[0] * x1a[0] + x1a[1] * x1a[1]) + (x1a[2] * x1a[2] + x1a[3] * x1a[3]) + (x1b[0] * x1b[0] + x1b[1] * x1b[1]) + (x1b[2] * x1b[2] + x1b[3] * x1b[3])
                             + (x2a[0] * x2a[0] + x2a[1] * x2a[1]) + (x2a[2] * x2a[2] + x2a[3] * x2a[3]) + (x2b[0] * x2b[0] + x2b[1] * x2b[1]) + (x2b[2] * x2b[2] + x2b[3] * x2b[3]);
                    ss += __shfl_xor(ss, 16); ss += __shfl_xor(ss, 32);
                    const float rn = 1.0f / sqrtf(ss * (1.0f / 64.0f) + EPS);
                    const int pos = meta ? r : NMETA + ((pm * 256 + r) & (SEQ - 1));
                    const f32x4 c0 = *(const f32x4*)(ropec + pos * 32 + 8 * fq), c1 = *(const f32x4*)(ropec + pos * 32 + 8 * fq + 4), s0 = *(const f32x4*)(ropes + pos * 32 + 8 * fq), s1 = *(const f32x4*)(ropes + pos * 32 + 8 * fq + 4);
                    const f32x4 y1a = x1a * rn * ga0, y1b = x1b * rn * ga1, y2a = x2a * rn * gb0, y2b = x2b * rn * gb1;
                    const f32x4 o1a = (y1a * c0 - y2a * s0) * osc, o1b = (y1b * c1 - y2b * s1) * osc, o2a = (y2a * c0 + y1a * s0) * osc, o2b = (y2b * c1 + y1b * s1) * osc;
                    const u32x4 w1 = pack8(o1a, o1b), w2 = pack8(o2a, o2b);
                    if (isq) { bf16* p = Q + (size_t)(pm * 256 + r) * 512 + hcol; *(u32x4*)p = w1; *(u32x4*)(p + 32) = w2; }
                    else if (!meta) { bf16* p = K + (size_t)(pm * 256 + r + bsh) * 512 + hcol; *(u32x4*)p = w1; *(u32x4*)(p + 32) = w2; }
                    else { for (int b = 0; b < NBATCH; ++b) { bf16* p = K + (size_t)(b * LPB + r) * 512 + hcol; *(u32x4*)p = w1; *(u32x4*)(p + 32) = w2; } }
                    asm volatile("" ::: "memory");
                }
            return false;
        }
        if (pn < 12) {
            bf16* T; int pitch, cb; float sc = 1.0f; bool wmeta = true;
            if (pn < 6) { T = V; pitch = 512; cb = (pn - 4) * 256; }
            else if (pn == 6) { T = GQ; pitch = 256; cb = 0; sc = 0.125f; wmeta = false; }
            else if (pn == 7) { T = GK; pitch = 256; cb = 0; }
            else if (pn < 10) { T = GV; pitch = 512; cb = (pn - 8) * 256; }
            else { T = GR; pitch = 512; cb = (pn - 10) * 256; wmeta = false; }
            if (meta && !wmeta) return false;
#pragma unroll
            for (int ai = 0; ai < 2; ++ai)
#pragma unroll
                for (int m = 0; m < 4; ++m) {
                    if (meta && (ai != 0 || wr != 0)) continue;
                    const int r = r0 + ai * HALF + m * 16;
#pragma unroll
                    for (int bj = 0; bj < 2; ++bj) { const u32x4 w = pack8(acc[ai][bj][m][0] * sc, acc[ai][bj][m][1] * sc); const int col = cb + bj * HALF + cl;
                        if (!meta) *(u32x4*)(T + (size_t)(pm * 256 + r + bsh) * pitch + col) = w;
                        else for (int b = 0; b < NBATCH; ++b) *(u32x4*)(T + (size_t)(b * LPB + r) * pitch + col) = w; }
                    asm volatile("" ::: "memory");
                }
            return false;
        }
        if (pn == 12) {
#pragma unroll
            for (int bj = 0; bj < 2; ++bj) { const int col = bj * HALF + cl; const f32x4 b0 = *(const f32x4*)(bgate + col), b1 = *(const f32x4*)(bgate + col + 4);
#pragma unroll
                for (int ai = 0; ai < 2; ++ai)
#pragma unroll
                    for (int m = 0; m < 4; ++m) {
                        if (meta && (ai != 0 || wr != 0)) continue;
                        const int r = r0 + ai * HALF + m * 16; const f32x4 a0 = acc[ai][bj][m][0] + b0, a1 = acc[ai][bj][m][1] + b1; f32x4 v0, v1;
#pragma unroll
                        for (int i = 0; i < 4; ++i) { v0[i] = log_sigmoid(a0[i]) * (1.0f / 16.0f); v1[i] = log_sigmoid(a1[i]) * (1.0f / 16.0f); }
                        if (!meta) { float* p = LOGA + (size_t)(pm * 256 + r + bsh) * 256 + col; *(f32x4*)p = v0; *(f32x4*)(p + 4) = v1; }
                        else { if (r >= NMETA) { v0 = (f32x4){0.f, 0.f, 0.f, 0.f}; v1 = v0; }
                               for (int b = 0; b < NBATCH; ++b) { float* p = LOGA + (size_t)(b * LPB + r) * 256 + col; *(f32x4*)p = v0; *(f32x4*)(p + 4) = v1; } }
                        asm volatile("" ::: "memory");
                    } }
            return false;
        }
        return false;
    }
};
struct EpiGates {
    bf16 *RATIO, *G1; const LAS float* bml; float zs;
    __device__ __forceinline__ bool operator()(f32x4 (&acc)[2][2][4][2], const Unit& u, int wr, int wc, int fr, int fq) const {
        int oz; asm volatile("v_mov_b32 %0, 0" : "=v"(oz));
        const int r0 = u.pm * 256 + wr * 64 + fr + oz, d = 128 * u.pn + wc * 32 + 8 * fq;
#pragma unroll
        for (int bj = 0; bj < 2; ++bj) { const f32x4 b0 = *(const LAS f32x4*)(bml + bj * DM + d), b1 = *(const LAS f32x4*)(bml + bj * DM + d + 4);
#pragma unroll
            for (int ai = 0; ai < 2; ++ai)
#pragma unroll
                for (int m = 0; m < 4; ++m) { const f32x4 x0 = acc[ai][bj][m][0] * zs + b0, x1 = acc[ai][bj][m][1] * zs + b1;
#pragma unroll
                    for (int i = 0; i < 4; ++i) { acc[ai][bj][m][0][i] = 1.0f + __expf(-x0[i]); acc[ai][bj][m][1][i] = 1.0f + __expf(-x1[i]); } }
            asm volatile("" ::: "memory"); }
#pragma unroll
        for (int ai = 0; ai < 2; ++ai)
#pragma unroll
            for (int m = 0; m < 4; ++m) { const int r = r0 + ai * HALF + m * 16; f32x4 ra, rb, ga, gb;
#pragma unroll
                for (int i = 0; i < 4; ++i) { ra[i] = acc[ai][1][m][0][i] * __builtin_amdgcn_rcpf(acc[ai][0][m][0][i]); ga[i] = __builtin_amdgcn_rcpf(acc[ai][1][m][0][i]);
                                              rb[i] = acc[ai][1][m][1][i] * __builtin_amdgcn_rcpf(acc[ai][0][m][1][i]); gb[i] = __builtin_amdgcn_rcpf(acc[ai][1][m][1][i]); }
                const size_t o = (size_t)r * DM + d; *(u32x4*)(RATIO + o) = pack8(ra, rb); *(u32x4*)(G1 + o) = pack8(ga, gb); asm volatile("" ::: "memory"); }
        return false;
    }
};
struct EpiMerge {
    const bf16 *RATIO, *G1; bf16* MERGED;
    __device__ __forceinline__ bool operator()(f32x4 (&acc)[2][2][4][2], const Unit& u, int wr, int wc, int fr, int fq) const {
        const int br = u.aux, pm = u.pm - (MROWS / 256) * br, pn = u.pn - 4 * br;
        const int r0 = pm * 256 + wr * 64 + fr, c0 = pn * 256 + wc * 32 + 8 * fq;
        const bf16* src = br ? G1 : RATIO;
#pragma unroll
        for (int ai = 0; ai < 2; ++ai) { u32x4 g[4][2];
#pragma unroll
            for (int m = 0; m < 4; ++m)
#pragma unroll
                for (int bj = 0; bj < 2; ++bj) g[m][bj] = *(const u32x4*)(src + (size_t)(r0 + ai * HALF + m * 16) * DM + c0 + bj * HALF);
#pragma unroll
            for (int m = 0; m < 4; ++m)
#pragma unroll
                for (int bj = 0; bj < 2; ++bj) { const size_t o = (size_t)(r0 + ai * HALF + m * 16) * DM + c0 + bj * HALF; const u32x4 gg = g[m][bj];
                    const f32x4 g0 = {pg8::bf_lo(gg.x), pg8::bf_hi(gg.x), pg8::bf_lo(gg.y), pg8::bf_hi(gg.y)}, g1 = {pg8::bf_lo(gg.z), pg8::bf_hi(gg.z), pg8::bf_lo(gg.w), pg8::bf_hi(gg.w)};
                    const f32x4 v0 = acc[ai][bj][m][0] * g0, v1 = acc[ai][bj][m][1] * g1;
                    if (br) *(u32x4*)(MERGED + o) = pack8(v0, v1); else { acc[ai][bj][m][0] = v0; acc[ai][bj][m][1] = v1; } }
            asm volatile("" ::: "memory"); }
        return br == 0;
    }
};
struct EpiOut {
    const float* x; bf16* H2U; const float* gffn; unsigned char* H2U8;
    __device__ __forceinline__ bool operator()(f32x4 (&acc)[2][2][4][2], const Unit& u, int wr, int wc, int fr, int fq) const {
        const int r0 = u.pm * 256 + wr * 64 + fr, c0 = u.pn * 256 + wc * 32 + 8 * fq;
#pragma unroll
        for (int bj = 0; bj < 2; ++bj) { const f32x4 ga = *(const f32x4*)(gffn + c0 + bj * HALF), gb = *(const f32x4*)(gffn + c0 + bj * HALF + 4);
#pragma unroll
            for (int ai = 0; ai < 2; ++ai) { f32x4 xa[4], xb[4];
#pragma unroll
                for (int m = 0; m < 4; ++m) { const size_t o = (size_t)(r0 + ai * HALF + m * 16) * DM + c0 + bj * HALF; xa[m] = *(const f32x4*)(x + o); xb[m] = *(const f32x4*)(x + o + 4); }
#pragma unroll
                for (int m = 0; m < 4; ++m) { const size_t o = (size_t)(r0 + ai * HALF + m * 16) * DM + c0 + bj * HALF;
                    const f32x4 u0 = xa[m] + acc[ai][bj][m][0], u1 = xb[m] + acc[ai][bj][m][1];
                    const f32x4 h0 = u0 * ga, h1 = u1 * gb; *(u32x4*)(H2U + o) = pack8(h0, h1); *(pg8::u32x2*)(H2U8 + o) = (pg8::u32x2){pk4_fp8(h0[0], h0[1], h0[2], h0[3]), pk4_fp8(h1[0], h1[1], h1[2], h1[3])}; }
                asm volatile("" ::: "memory"); } }
        return false;
    }
};
template <bool GATHER_> struct MoeSched {
    static constexpr bool GATHER = GATHER_;
    const LAS int* tb; const LAS int* cn; const int* ltok; int seg_lo, seg_hi, G, c;
    __device__ __forceinline__ bool next(int i, Unit& u) const {
        const int t0 = __builtin_amdgcn_readfirstlane(tb[seg_lo]), t1 = __builtin_amdgcn_readfirstlane(tb[seg_hi]);
        const int U = (t1 - t0) * 4, R = U / G, r = U - R * G; int L, hf = 0;
        if (i < R) L = i * G + c;
        else if (i > R) return false;
        else if (2 * r <= G) { if (c >= 2 * r) return false; L = R * G + (c >> 1); hf = 1 + (c & 1); }
        else { if (c >= r) return false; L = R * G + c; }
        const int rt = t0 + (L >> 2), pnl = L & 3; int s = seg_lo, hi_ = seg_hi;
        while (hi_ - s > 1) { const int mid = (s + hi_) >> 1; if (__builtin_amdgcn_readfirstlane(tb[mid]) <= rt) s = mid; else hi_ = mid; }
        u.pm = rt; u.pn = (s & 31) * 4 + pnl; u.aux = s | ((rt - __builtin_amdgcn_readfirstlane(tb[s])) << 8); u.half = hf; return true;
    }
    __device__ __forceinline__ int grow(const Unit& u, int r) const { const int s = u.aux & 255, si = (u.aux >> 8) * 256 + r, last = cn[s] - 1; return ltok[(size_t)s * LCAP + (si < last ? si : last)]; }
};
struct EpiUp {
    const LAS int* cn; const float* lrs; unsigned char* HID;
    __device__ __forceinline__ bool operator()(f32x4 (&acc)[2][2][4][2], const Unit& u, int wr, int wc, int fr, int fq) const {
        const int s = u.aux & 255, rtl = u.aux >> 8, last = cn[s] - 1, pnl = u.pn & 3; float rsv[2][4];
#pragma unroll
        for (int ai = 0; ai < 2; ++ai)
#pragma unroll
            for (int m = 0; m < 4; ++m) { if (u.half == 2 - ai) { rsv[ai][m] = 0.f; continue; } const int si = rtl * 256 + wr * 64 + fr + ai * HALF + m * 16; rsv[ai][m] = lrs[(size_t)s * LCAP + (si < last ? si : last)] * (1.0f / W8SCALE); }
#pragma unroll
        for (int ai = 0; ai < 2; ++ai)
#pragma unroll
            for (int m = 0; m < 4; ++m) { if (u.half == 2 - ai) continue; const int r = wr * 64 + fr + ai * HALF + m * 16; const float rs = rsv[ai][m];
                f32x4 h0, h1;
#pragma unroll
                for (int i = 0; i < 4; ++i) { const float g0 = acc[ai][0][m][0][i] * rs, g1 = acc[ai][0][m][1][i] * rs;
                    h0[i] = g0 * __builtin_amdgcn_rcpf(1.0f + __expf(-g0)) * (acc[ai][1][m][0][i] * rs); h1[i] = g1 * __builtin_amdgcn_rcpf(1.0f + __expf(-g1)) * (acc[ai][1][m][1][i] * rs); }
                *(pg8::u32x2*)(HID + (size_t)(u.pm * 256 + r) * DEXP + pnl * 128 + wc * 32 + 8 * fq) = (pg8::u32x2){pk4_fp8(c8(h0[0]), c8(h0[1]), c8(h0[2]), c8(h0[3])), pk4_fp8(c8(h1[0]), c8(h1[1]), c8(h1[2]), c8(h1[3]))}; }
        return false;
    }
};
template <int MODE> struct EpiDown {
    const LAS int* cn; const int* ltok; const float* lw; float* out; unsigned char* Y0; float* trash; const bf16* H2U; const float* gffn;
    __device__ __forceinline__ bool operator()(f32x4 (&acc)[2][2][4][2], const Unit& u, int wr, int wc, int fr, int fq) const {
        const int s = u.aux & 255, rtl = u.aux >> 8, cnt = cn[s], pnl = u.pn & 3; int tok[2][4]; float wv[2][4];
#pragma unroll
        for (int ai = 0; ai < 2; ++ai)
#pragma unroll
            for (int m = 0; m < 4; ++m) { const int si = rtl * 256 + wr * 64 + fr + ai * HALF + m * 16, sc = si < cnt ? si : cnt - 1; tok[ai][m] = ltok[(size_t)s * LCAP + sc]; wv[ai][m] = lw[(size_t)s * LCAP + sc] * (1.0f / (W8SCALE * H8SCALE)); }
        const int cofs = pnl * 256 + wc * 32 + 8 * fq;
        f32x4 ig[2][2];
        if (MODE == 1) {
#pragma unroll
            for (int bj = 0; bj < 2; ++bj)
#pragma unroll
                for (int n = 0; n < 2; ++n) { const f32x4 g = *(const f32x4*)(gffn + cofs + bj * HALF + 4 * n); ig[bj][n] = (f32x4){__builtin_amdgcn_rcpf(g[0]), __builtin_amdgcn_rcpf(g[1]), __builtin_amdgcn_rcpf(g[2]), __builtin_amdgcn_rcpf(g[3])}; } }
#pragma unroll
        for (int ai = 0; ai < 2; ++ai)
#pragma unroll
            for (int mp = 0; mp < 4; mp += 2) { if (u.half == 2 - ai) continue; float* po[2]; unsigned char* py[2]; const bf16* ph[2]; pg8::u32x2 yv[2][2]; u32x4 hv[2][2];
#pragma unroll
                for (int k = 0; k < 2; ++k) { const int m = mp + k, si = rtl * 256 + wr * 64 + fr + ai * HALF + m * 16; const bool ok = si < cnt;
                    po[k] = ok ? out + (size_t)tok[ai][m] * DM + cofs : trash + cofs; py[k] = ok ? Y0 + (size_t)tok[ai][m] * DM + cofs : (unsigned char*)(trash + DM) + cofs; ph[k] = H2U + (size_t)tok[ai][m] * DM + cofs; }
                if (MODE == 1) {
#pragma unroll
                    for (int k = 0; k < 2; ++k)
#pragma unroll
                        for (int bj = 0; bj < 2; ++bj) { yv[k][bj] = *(const pg8::u32x2*)(py[k] + bj * HALF); hv[k][bj] = *(const u32x4*)(ph[k] + bj * HALF); } }
#pragma unroll
                for (int k = 0; k < 2; ++k) { const int m = mp + k; const float w = wv[ai][m];
#pragma unroll
                    for (int bj = 0; bj < 2; ++bj) {
                        if (MODE == 0) { const f32x4 a0 = acc[ai][bj][m][0] * w, a1 = acc[ai][bj][m][1] * w; *(pg8::u32x2*)(py[k] + bj * HALF) = (pg8::u32x2){pk4_fp8(cy8(a0[0]), cy8(a0[1]), cy8(a0[2]), cy8(a0[3])), pk4_fp8(cy8(a1[0]), cy8(a1[1]), cy8(a1[2]), cy8(a1[3]))}; }
                        else { const pg8::u32x2 y = yv[k][bj]; const u32x4 h = hv[k][bj]; float* p = po[k] + bj * HALF;
                            const f32x4 ya = un4_fp8(y.x) * (1.0f / Y8SCALE), yb = un4_fp8(y.y) * (1.0f / Y8SCALE);
                            const f32x4 ha = {pg8::bf_lo(h.x), pg8::bf_hi(h.x), pg8::bf_lo(h.y), pg8::bf_hi(h.y)}, hb = {pg8::bf_lo(h.z), pg8::bf_hi(h.z), pg8::bf_lo(h.w), pg8::bf_hi(h.w)};
                            *(f32x4*)p = (ha * ig[bj][0] + ya) + acc[ai][bj][m][0] * w; *(f32x4*)(p + 4) = (hb * ig[bj][1] + yb) + acc[ai][bj][m][1] * w; } } }
                asm volatile("" ::: "memory"); }
        return false;
    }
};
}
constexpr int GP = 144;
typedef LAS unsigned char* ldsp;
__device__ __forceinline__ pg8::bf16x8 ldfrag(ldsp base, int row, int ks, int fq) { return *(const LAS pg8::bf16x8*)(base + row * GP + ks * 64 + fq * 16); }
#define MFMA16(a, b, c) __builtin_amdgcn_mfma_f32_16x16x32_bf16((a), (b), (c), 0, 0, 0)
constexpr size_t WS_O0 = WS_DS, WS_QD = WS_DS + 32 * MiB, WS_GG = WS_DS + 48 * MiB, WS_GD = WS_DS + 56 * MiB;
__device__ __forceinline__ void gla_x(Frame& F, int unit) {
    const int bh = unit >> 3, g = unit & 7, b = bh >> 2, h = bh & 3, d = F.tid & 63, tq = F.wave, fr = F.lane & 15, fq = F.lane >> 4;
    LAS float* part = (LAS float*)(F.lds + 0); LAS float* TOT = (LAS float*)(F.lds + 2048);
    const ldsp QT = F.lds + 4096, KT = F.lds + 13312, AH = F.lds + 22528, VT = F.lds + 31744, SB = F.lds + 50176, PP = F.lds + 68608;
    for (int i = F.tid; i < 128 * GP / 4; i += NWAVES * 64) ((LAS unsigned*)SB)[i] = 0u;
    pg8::f32x4 accS[4];
#pragma unroll
    for (int db = 0; db < 4; ++db) accS[db] = (pg8::f32x4){0.f, 0.f, 0.f, 0.f};
    float cd = 1.0f;
    const int c_first = g ? 8 * g + 1 : 0, c_last = 8 * g + 8;
    bf16* QD = WSP(bf16, WS_QD); bf16* O0 = WSP(bf16, WS_O0);
    const float* LOGA = WSP(float, WS_LOGA); const bf16* GQ = WSP(bf16, WS_GQ); const bf16* GK = WSP(bf16, WS_GK); const bf16* GV = WSP(bf16, WS_GV);
    float an[8]; bf16 qn[8], kn[8]; v4u vn[2];
#define GX_LOAD(cc) do { const size_t ro_ = (size_t)(b * LPB + 64 * (cc) + 8 * tq) * 256 + h * 64 + d; \
        _Pragma("unroll") for (int i_ = 0; i_ < 8; ++i_) { an[i_] = LOGA[ro_ + i_ * 256]; qn[i_] = GQ[ro_ + i_ * 256]; kn[i_] = GK[ro_ + i_ * 256]; } \
        _Pragma("unroll") for (int j_ = 0; j_ < 2; ++j_) { const int p_ = F.tid + 512 * j_; vn[j_] = *(const GAS v4u*)(GV + (size_t)(b * LPB + 64 * (cc) + (p_ >> 4)) * 512 + h * 128 + (p_ & 15) * 8); } } while (0)
    GX_LOAD(c_first);
    for (int c = c_first; c <= c_last; ++c) {
        const int mrow0 = b * SEQ + 64 * (c - 1);
        float bt[8]; bt[0] = an[0];
#pragma unroll
        for (int i = 1; i < 8; ++i) bt[i] = bt[i - 1] + an[i];
        part[tq * 64 + d] = bt[7];
        __syncthreads();
        float off = 0.f, tot = 0.f;
#pragma unroll
        for (int j = 0; j < 8; ++j) { const float p = part[j * 64 + d]; tot += p; if (j < tq) off += p; }
        if (tq == 0) TOT[d] = tot;
        float kh[8];
#pragma unroll
        for (int i = 0; i < 8; ++i) { const float bti = bt[i] + off; const float kk = bf2f(kn[i]); const float qv = bf2f(qn[i]) * __expf(bti), kv = kk * __expf(fminf(-bti, 80.f)); kh[i] = kk * __expf(tot - bti);
            *(LAS bf16*)(QT + (8 * tq + i) * GP + d * 2) = (bf16)f2bf(qv); *(LAS bf16*)(KT + (8 * tq + i) * GP + d * 2) = (bf16)f2bf(kv);
            if (c >= 1) QD[(size_t)(mrow0 + 8 * tq + i) * 256 + h * 64 + d] = (bf16)f2bf(qv * cd); }
        { v4u w; w.x = pk2(kh[0], kh[1]); w.y = pk2(kh[2], kh[3]); w.z = pk2(kh[4], kh[5]); w.w = pk2(kh[6], kh[7]); *(LAS v4u*)(AH + d * GP + tq * 16) = w; }
        cd *= __expf(tot);
#pragma unroll
        for (int j = 0; j < 2; ++j) { const int p = F.tid + 512 * j, sv = p >> 4, ec = p & 15; const unsigned ww[4] = {vn[j].x, vn[j].y, vn[j].z, vn[j].w};
#pragma unroll
            for (int i = 0; i < 4; ++i) { *(LAS bf16*)(VT + (8 * ec + 2 * i) * GP + sv * 2) = (bf16)(ww[i] & 0xffffu); *(LAS bf16*)(VT + (8 * ec + 2 * i + 1) * GP + sv * 2) = (bf16)(ww[i] >> 16); } }
        if (c < c_last) GX_LOAD(c + 1);
        __syncthreads();
        const int tb = tq >> 1, t0 = 16 * tb, t = t0 + fr;
#pragma unroll
        for (int sbi = 0; sbi < 2; ++sbi) { const int s0 = 16 * (2 * (tq & 1) + sbi); pg8::f32x4 a = {0.f, 0.f, 0.f, 0.f};
#pragma unroll
            for (int ks = 0; ks < 2; ++ks) a = MFMA16(ldfrag(KT, s0 + fr, ks, fq), ldfrag(QT, t0 + fr, ks, fq), a);
            const int s = s0 + 4 * fq;
            const float p0 = (s + 0 <= t) ? a[0] : 0.f, p1 = (s + 1 <= t) ? a[1] : 0.f, p2 = (s + 2 <= t) ? a[2] : 0.f, p3 = (s + 3 <= t) ? a[3] : 0.f;
            *(LAS unsigned*)(PP + t * GP + s * 2) = pk2(p0, p1); *(LAS unsigned*)(PP + t * GP + s * 2 + 4) = pk2(p2, p3); }
#pragma unroll
        for (int db = 0; db < 4; ++db) { const pg8::f32x4 tv = *(const LAS pg8::f32x4*)(TOT + 16 * db + 4 * fq);
            accS[db][0] *= __expf(tv[0]); accS[db][1] *= __expf(tv[1]); accS[db][2] *= __expf(tv[2]); accS[db][3] *= __expf(tv[3]); }
#pragma unroll
        for (int ks = 0; ks < 2; ++ks) { const pg8::bf16x8 bfr = ldfrag(VT, 16 * tq + fr, ks, fq);
#pragma unroll
            for (int db = 0; db < 4; ++db) accS[db] = MFMA16(ldfrag(AH, 16 * db + fr, ks, fq), bfr, accS[db]); }
        __syncthreads();
        if (c >= 1) {
            const int eh = tq & 1; pg8::f32x4 o[4];
#pragma unroll
            for (int eb = 0; eb < 4; ++eb) o[eb] = (pg8::f32x4){0.f, 0.f, 0.f, 0.f};
#pragma unroll
            for (int ks = 0; ks < 4; ++ks) { const pg8::bf16x8 bfr = ks < 2 ? ldfrag(PP, t0 + fr, ks, fq) : ldfrag(QT, t0 + fr, ks - 2, fq);
#pragma unroll
                for (int eb = 0; eb < 4; ++eb) { const int e0 = 64 * eh + 16 * eb; o[eb] = MFMA16(ks < 2 ? ldfrag(VT, e0 + fr, ks, fq) : ldfrag(SB, e0 + fr, ks - 2, fq), bfr, o[eb]); } }
            bf16* op = O0 + (size_t)(mrow0 + t) * 512 + h * 128 + 64 * eh + 4 * fq;
#pragma unroll
            for (int eb = 0; eb < 4; ++eb) *(GAS unsigned long long*)(op + 16 * eb) = (unsigned long long)pk2(o[eb][0], o[eb][1]) | ((unsigned long long)pk2(o[eb][2], o[eb][3]) << 32);
        }
        __syncthreads();
#pragma unroll
        for (int db = 0; db < 4; ++db) { LAS unsigned* sp = (LAS unsigned*)(SB + (16 * tq + fr) * GP + (16 * db + 4 * fq) * 2); sp[0] = pk2(accS[db][0], accS[db][1]); sp[1] = pk2(accS[db][2], accS[db][3]); }
    }
#undef GX_LOAD
    float* gg = WSP(float, WS_GG) + ((size_t)(bh * 8 + g) * 128 + 16 * tq + fr) * 64;
#pragma unroll
    for (int db = 0; db < 4; ++db) *(pg8::f32x4*)(gg + 16 * db + 4 * fq) = accS[db];
    if (tq == 0) WSP(float, WS_GD)[(bh * 8 + g) * 64 + d] = cd;
    __syncthreads();
}
__device__ __forceinline__ void gla_z(Frame& F, int unit) {
    const int bh = unit >> 3, g = unit & 7, b = bh >> 2, h = bh & 3, fr = F.lane & 15, fq = F.lane >> 4;
    const ldsp SB = F.lds + 0;
    { const pg8::f32x4* G4 = WSP(pg8::f32x4, WS_GG); const float* GD = WSP(float, WS_GD);
#pragma unroll
      for (int j = 0; j < 4; ++j) { const int q = F.tid + 512 * j, e = q >> 4, d4 = (q & 15) * 4; pg8::f32x4 S = {0.f, 0.f, 0.f, 0.f}, Gv[7], Dv[7];
#pragma unroll
          for (int gp = 0; gp < 7; ++gp) if (gp < g) { Dv[gp] = *(const pg8::f32x4*)(GD + (bh * 8 + gp) * 64 + d4); Gv[gp] = G4[(size_t)(bh * 8 + gp) * 2048 + q]; }
#pragma unroll
          for (int gp = 0; gp < 7; ++gp) if (gp < g) S = Dv[gp] * S + Gv[gp];
          *(LAS unsigned*)(SB + e * GP + d4 * 2) = pk2(S.x, S.y); *(LAS unsigned*)(SB + e * GP + d4 * 2 + 4) = pk2(S.z, S.w); } }
    __syncthreads();
    const bf16* QD = WSP(bf16, WS_QD); const bf16* O0 = WSP(bf16, WS_O0); const float* gg = F.inp(I_GGLA);
    pg8::bf16x8 qf[2]; unsigned long long ow[8], rw[8];
#define GZ_LOAD(itn) do { const int tl_ = 512 * g + 128 * (itn) + 16 * F.wave + fr; const size_t mr_ = (size_t)(b * SEQ + tl_), pr_ = (size_t)(b * LPB + 64 + tl_); \
        _Pragma("unroll") for (int ks_ = 0; ks_ < 2; ++ks_) qf[ks_] = *(const pg8::bf16x8*)(QD + mr_ * 256 + h * 64 + 32 * ks_ + 8 * fq); \
        _Pragma("unroll") for (int eb_ = 0; eb_ < 8; ++eb_) { ow[eb_] = *(const GAS unsigned long long*)(O0 + mr_ * 512 + h * 128 + 16 * eb_ + 4 * fq); rw[eb_] = *(const GAS unsigned long long*)(WSP(bf16, WS_GR) + pr_ * 512 + h * 128 + 16 * eb_ + 4 * fq); } } while (0)
    GZ_LOAD(0);
    for (int it = 0; it < 4; ++it) {
        const int tl = 512 * g + 128 * it + 16 * F.wave + fr, mrow = b * SEQ + tl;
        pg8::f32x4 o[8];
#pragma unroll
        for (int eb = 0; eb < 8; ++eb) o[eb] = (pg8::f32x4){0.f, 0.f, 0.f, 0.f};
#pragma unroll
        for (int ks = 0; ks < 2; ++ks)
#pragma unroll
            for (int eb = 0; eb < 8; ++eb) o[eb] = MFMA16(ldfrag(SB, 16 * eb + fr, ks, fq), qf[ks], o[eb]);
        float ss = 0.f; float sr[8][4];
#pragma unroll
        for (int eb = 0; eb < 8; ++eb) { const unsigned long long w = ow[eb], r = rw[eb];
            o[eb][0] += __uint_as_float((unsigned)w << 16); o[eb][1] += __uint_as_float((unsigned)w & 0xffff0000u); o[eb][2] += __uint_as_float((unsigned)(w >> 32) << 16); o[eb][3] += __uint_as_float((unsigned)(w >> 32) & 0xffff0000u);
            ss += (o[eb][0] * o[eb][0] + o[eb][1] * o[eb][1]) + (o[eb][2] * o[eb][2] + o[eb][3] * o[eb][3]);
            sr[eb][0] = __uint_as_float((unsigned)r << 16); sr[eb][1] = __uint_as_float((unsigned)r & 0xffff0000u); sr[eb][2] = __uint_as_float((unsigned)(r >> 32) << 16); sr[eb][3] = __uint_as_float((unsigned)(r >> 32) & 0xffff0000u); }
        if (it < 3) GZ_LOAD(it + 1);
        ss += __shfl_xor(ss, 16); ss += __shfl_xor(ss, 32);
        const float rn = 1.0f / sqrtf(ss * (1.0f / 128.0f) + EPS);
        bf16* op = WSP(bf16, WS_OA) + (size_t)MROWS * 512 + (size_t)mrow * 512 + h * 128;
#pragma unroll
        for (int eb = 0; eb < 8; ++eb) { const int e = 16 * eb + 4 * fq; const pg8::f32x4 gv = *(const pg8::f32x4*)(gg + e);
            const float v0 = o[eb][0] * rn * gv.x * (sr[eb][0] * sigmoidf_(sr[eb][0])), v1 = o[eb][1] * rn * gv.y * (sr[eb][1] * sigmoidf_(sr[eb][1])), v2 = o[eb][2] * rn * gv.z * (sr[eb][2] * sigmoidf_(sr[eb][2])), v3 = o[eb][3] * rn * gv.w * (sr[eb][3] * sigmoidf_(sr[eb][3]));
            *(GAS unsigned long long*)(op + e) = (unsigned long long)pk2(v0, v1) | ((unsigned long long)pk2(v2, v3) << 32); }
    }
#undef GZ_LOAD
    __syncthreads();
}
__device__ __forceinline__ void router_phase(Frame& F) {
    LAS float* lgp = (LAS float*)(F.lds + 0);
    LAS float* ssp = (LAS float*)(F.lds + 49152);
    LAS int* lcnt = (LAS int*)(F.lds + 51200); LAS int* lbase = lcnt + 64;
    const bf16* H = WSP(bf16, WS_H2U); const bf16* wh = WSP(bf16, WS_WRH); const bf16* wl = WSP(bf16, WS_WRL);
    int* ltok = WSP(int, WS_LTOK); float* lrs = WSP(float, WS_LRS); float* lw = WSP(float, WS_LW);
    const int fr = F.lane & 15, kg = F.lane >> 4, rbk = F.wave & 3, kh = F.wave >> 2;
    for (int rb = F.vcu; rb < MROWS / 128; rb += F.G) {
        if (F.tid < 64) lcnt[F.tid] = 0;
        const bf16* h0 = H + (size_t)(rb * 128 + rbk * 32 + fr) * DM + kh * 512 + 8 * kg; const bf16* h1 = h0 + 16 * DM;
        const bf16* whp = wh + (size_t)fr * DM + kh * 512 + 8 * kg; const bf16* wlp = wl + (size_t)fr * DM + kh * 512 + 8 * kg;
        pg8::f32x4 acc[2][3];
#pragma unroll
        for (int a = 0; a < 2; ++a)
#pragma unroll
            for (int cb = 0; cb < 3; ++cb) acc[a][cb] = (pg8::f32x4){0.f, 0.f, 0.f, 0.f};
        float ss0 = 0.f, ss1 = 0.f; const float* ig2 = WSP(float, WS_IG2) + kh * 512 + 8 * kg;
#pragma unroll 4
        for (int s = 0; s < 16; ++s) {
            const pg8::bf16x8 a0 = *(const pg8::bf16x8*)(h0 + 32 * s), a1 = *(const pg8::bf16x8*)(h1 + 32 * s);
            { const pg8::f32x4 ia = *(const pg8::f32x4*)(ig2 + 32 * s), ib = *(const pg8::f32x4*)(ig2 + 32 * s + 4); const float iv[8] = {ia[0], ia[1], ia[2], ia[3], ib[0], ib[1], ib[2], ib[3]};
#pragma unroll
              for (int j = 0; j < 8; ++j) { const float x0 = __uint_as_float((unsigned)(unsigned short)a0[j] << 16), x1 = __uint_as_float((unsigned)(unsigned short)a1[j] << 16); ss0 += x0 * x0 * iv[j]; ss1 += x1 * x1 * iv[j]; } }
#pragma unroll
            for (int cb = 0; cb < 3; ++cb) { const pg8::bf16x8 bh = *(const pg8::bf16x8*)(whp + (size_t)(16 * cb) * DM + 32 * s), bl = *(const pg8::bf16x8*)(wlp + (size_t)(16 * cb) * DM + 32 * s);
                acc[0][cb] = MFMA16(a0, bh, acc[0][cb]); acc[0][cb] = MFMA16(a0, bl, acc[0][cb]); acc[1][cb] = MFMA16(a1, bh, acc[1][cb]); acc[1][cb] = MFMA16(a1, bl, acc[1][cb]); }
        }
#pragma unroll
        for (int a = 0; a < 2; ++a)
#pragma unroll
            for (int cb = 0; cb < 3; ++cb)
#pragma unroll
                for (int i = 0; i < 4; ++i) lgp[(kh * 128 + rbk * 32 + a * 16 + 4 * kg + i) * 48 + 16 * cb + fr] = acc[a][cb][i];
        ss0 += __shfl_xor(ss0, 16); ss0 += __shfl_xor(ss0, 32); ss1 += __shfl_xor(ss1, 16); ss1 += __shfl_xor(ss1, 32);
        if (kg == 0) { ssp[kh * 128 + rbk * 32 + fr] = ss0; ssp[kh * 128 + rbk * 32 + 16 + fr] = ss1; }
        __syncthreads();
        int seg0 = 0, seg1 = 0, rk0 = 0, rk1 = 0; float w0 = 0.f, w1 = 0.f, rs = 0.f;
        if (F.tid < 128) {
            const LAS float* L0 = lgp + F.tid * 48; const LAS float* L1 = L0 + 128 * 48; rs = 1.0f / sqrtf((ssp[F.tid] + ssp[128 + F.tid]) * (1.0f / DM) + EPS);
            float gl[4];
#pragma unroll
            for (int j = 0; j < 4; ++j) gl[j] = (L0[j] + L1[j]) * rs + F.inp(I_BRG)[j];
            int gi = 0; float gm = gl[0];
#pragma unroll
            for (int j = 1; j < 4; ++j) if (gl[j] > gm) { gm = gl[j]; gi = j; }
            float gs = 0.f;
#pragma unroll
            for (int j = 0; j < 4; ++j) gs += expf(gl[j] - gm);
            const float gw_ = 1.0f / gs;
            float v1 = -INFINITY, v2 = -INFINITY; int i1 = 0, i2 = 0;
            for (int j = 0; j < 8; ++j) { const float v = (L0[4 + gi * 8 + j] + L1[4 + gi * 8 + j]) * rs + F.inp(I_BRE)[gi * 8 + j];
                if (v > v1) { v2 = v1; i2 = i1; v1 = v; i1 = j; } else if (v > v2) { v2 = v; i2 = j; } }
            const float e1 = 1.0f / (1.0f + expf(v2 - v1));
            w0 = gw_ * e1; w1 = gw_ * (1.0f - e1); seg0 = gi * 8 + i1; seg1 = 32 + gi * 8 + i2;
            rk0 = atomicAdd((int*)(lcnt + seg0), 1); rk1 = atomicAdd((int*)(lcnt + seg1), 1);
        }
        __syncthreads();
        if (F.tid < 64) { const int n = lcnt[F.tid]; lbase[F.tid] = n ? (int)__hip_atomic_fetch_add((unsigned*)(F.ctl + CW_CNT + F.tid), (unsigned)n, RLX_AGENT) : 0; }
        __syncthreads();
        if (F.tid < 128) { const int tok = rb * 128 + F.tid; const size_t p0 = (size_t)seg0 * LCAP + lbase[seg0] + rk0, p1 = (size_t)seg1 * LCAP + lbase[seg1] + rk1;
            ltok[p0] = tok; lrs[p0] = rs; lw[p0] = w0; ltok[p1] = tok; lrs[p1] = rs; lw[p1] = w1; }
        __syncthreads();
    }
}
#ifndef MK_N_LAUNCHES
#define MK_N_LAUNCHES 1
#endif
constexpr int N_PHASES = 10;
struct Args { const float* in[25]; float* out; unsigned char* ws; int ph_lo, ph_hi; };
__global__ void __launch_bounds__(NWAVES * 64, 2) fwd_kernel(Args args) {
    extern __shared__ __attribute__((aligned(16))) unsigned char lds[];
    Frame F;
    F.lds = (LAS unsigned char*)lds;
    F.MISC = (volatile LAS unsigned*)(F.lds + MISC_OFF);
    F.tid = threadIdx.x; F.lane = F.tid & 63; F.wave = __builtin_amdgcn_readfirstlane(F.tid >> 6);
    F.G = gridDim.x; { const int bx = blockIdx.x; F.vcu = (F.G % 8 == 0) ? (bx % 8) * (F.G / 8) + bx / 8 : bx; }
    F.ws = args.ws; F.out = args.out; F.ctl = (gu32*)(args.ws + WS_CTL);
    for (int u = F.tid; u < (LDS_BYTES - LDSCTL_OFF) / 4; u += NWAVES * 64) ((LAS unsigned*)(F.lds + LDSCTL_OFF))[u] = 0u;
    __syncthreads();
    if (F.tid < 25) ((LAS unsigned long long*)(F.lds + INTAB_OFF))[F.tid] = (unsigned long long)args.in[F.tid];
    __syncthreads();
    XcdBarrier bar; bar.bar = (unsigned*)(F.ctl + CW_BAR); bar.x = 0; bar.st = nullptr;
    if (MK_N_LAUNCHES == 1) bar = xcd_barrier_post((unsigned*)(F.ctl + CW_BAR), F.MISC + 8);
    const int lo = args.ph_lo, hi = args.ph_hi;
#ifdef PROBE_K
    volatile LAS unsigned long long* prb = (volatile LAS unsigned long long*)(F.lds + LDSCTL_OFF + 2048); if (blockIdx.x == 0 && F.tid == 0) prb[0] = __builtin_amdgcn_s_memrealtime();
#define PROBE_AT(k) do { if ((k) == PROBE_K && blockIdx.x == 0 && F.tid == 0) prb[1] = __builtin_amdgcn_s_memrealtime(); } while (0)
#else
#define PROBE_AT(k) do {} while (0)
#endif
#ifndef PH_MASK
#define PH_MASK 0x3ff
#endif
#define IN(k) (((PH_MASK >> (k)) & 1) && lo <= (k) && (k) < hi)
#define SEAM(k) do { if (IN(k) && IN((k) + 1)) xcd_barrier(bar); PROBE_AT(k); } while (0)
    const LAS int* tbp = (const LAS int*)(F.lds + TB_OFF); const LAS int* cnp = (const LAS int*)(F.lds + CN_OFF);

    if (IN(0)) { p0_prologue(F); } SEAM(0);
    if (IN(1)) {
#ifdef SKEW_US
        { const unsigned long long t0_ = __builtin_amdgcn_s_memrealtime(), dl_ = (unsigned long long)(F.vcu & 7) * (SKEW_US * 100 / 8); while (__builtin_amdgcn_s_memrealtime() - t0_ < dl_) __builtin_amdgcn_s_sleep(8); }
#endif
        for (int u = F.tid; u < 2 * DM; u += NWAVES * 64) ((LAS float*)(F.lds + BML_OFF))[u] = F.inp(I_BMERGE)[u];
        __syncthreads();
        { pg8::Gemm g{WSP(pg8::bf16_t, WS_XN8), WSP(pg8::bf16_t, WS_WIN8), DM / 2}; pg8::StaticOrder S{MROWS / 256, 8, F.G, (int)blockIdx.x};
          epi::EpiGates E{(bf16*)F.out, (bf16*)F.out + (size_t)MROWS * DM, (const LAS float*)(F.lds + BML_OFF), 1.0f / (X8SCALE * W8SCALE)};
          pg8::gemm_phase<epi::EpiGates, pg8::StaticOrder, true, true>(F.lds + RING_OFF, g, S, E); }
        asm volatile("s_waitcnt vmcnt(0) lgkmcnt(0)" ::: "memory"); __syncthreads();
        pg8::Gemm g{WSP(pg8::bf16_t, WS_R1), WSP(pg8::bf16_t, WS_WIN), DM}; pg8::StaticOrder S{MZ / 256, 13, F.G, (int)blockIdx.x};
        epi::EpiZ E{WSP(bf16, WS_Q), WSP(bf16, WS_K), WSP(bf16, WS_V), WSP(bf16, WS_GQ), WSP(bf16, WS_GK), WSP(bf16, WS_GV), WSP(bf16, WS_GR), WSP(float, WS_LOGA),
                    F.inp(I_GQN), F.inp(I_GKN), F.inp(I_BGATE), WSP(float, WS_ROPE), WSP(float, WS_ROPE) + NPOS * 32};
        pg8::gemm_phase(F.lds + RING_OFF, g, S, E);
        if ((int)blockIdx.x >= P1_EXTRA(F.G)) { const int nidle = F.G - P1_EXTRA(F.G), j = (int)blockIdx.x - P1_EXTRA(F.G), nw = nidle * NWAVES, me = j * NWAVES + F.wave, cnt = p1_conv_items(F.G);
            late_tables(F, me * 64 + F.lane, nw * 64); expert_conv_first(F, me, nw, cnt); }
    } SEAM(1);
    if (IN(2)) {
        const attn_body::AttnTensors AT{(const attn_body::bf16*)WSP(bf16, WS_Q), (const attn_body::bf16*)WSP(bf16, WS_K), (const attn_body::bf16*)WSP(bf16, WS_V), (attn_body::bf16*)WSP(bf16, WS_R1)};
        { const float lam = expf(wave_sum(F.inp(I_LQ1)[F.lane] * F.inp(I_LK1)[F.lane])) - expf(wave_sum(F.inp(I_LQ2)[F.lane] * F.inp(I_LK2)[F.lane])) + 0.2f;
          float gqm = fabsf(F.inp(I_GQN)[F.lane]), gkm = fabsf(F.inp(I_GKN)[F.lane]);
#pragma unroll
          for (int o_ = 1; o_ < 64; o_ <<= 1) { gqm = fmaxf(gqm, __shfl_xor(gqm, o_)); gkm = fmaxf(gkm, __shfl_xor(gkm, o_)); }
          const bool fastsm = __builtin_amdgcn_readfirstlane((0.125f * 1.4426950408889634f * 64.0f) * gqm * gkm < 48.0f ? 1 : 0) != 0;
          const int nslot = 2 * ((256 + F.G - 1) / F.G);
          int i = 0;
#define ATTN_LOOP(FASTSM) for (;; ++i) { const int p = (i >> 2) * F.G + F.vcu; if (p >= 256) break; \
              if ((i & 3) == 1 || (i & 3) == 3) expert_conv_slot(F, (i >> 2) * 2 + ((i & 3) >> 1), nslot, p1_conv_items(F.G)); \
              const int bh = p >> 3, s = p & 7, b = bh >> 2, h = bh & 3, mp = i & 1, qb = (i & 2) ? 15 - s : s, hm = 2 * h + mp; \
              attn_body::attn_unit<8, FASTSM>(b, hm * 64, hm * 64, h * 128, hm * 128, qb, AT.Q, AT.K, AT.V, AT.O, (char*)lds + RING_OFF, mp, 2 * h * 128, lam, F.inp(I_GSUB), (attn_body::bf16*)WSP(bf16, WS_OA), h * 128); }
          if (fastsm) { ATTN_LOOP(true) } else { ATTN_LOOP(false) }
#undef ATTN_LOOP
          for (int sl = (i >> 2) * 2 + (((i & 3) + 1) >> 1 > 2 ? 2 : ((i & 3) + 1) >> 1); sl < nslot; ++sl) expert_conv_slot(F, sl, nslot, p1_conv_items(F.G)); }
        asm volatile("s_waitcnt vmcnt(0) lgkmcnt(0)" ::: "memory"); __syncthreads();
        for (int un = F.vcu; un < 32 * 8; un += F.G) gla_x(F, un);
    } SEAM(2);
    if (IN(3)) { for (int un = F.vcu; un < 32 * 8; un += F.G) gla_z(F, un); } SEAM(3);
    if (IN(4)) {
        pg8::Gemm g{WSP(pg8::bf16_t, WS_OA), WSP(pg8::bf16_t, WS_WBR), 512}; pg8::PairOrder S{MROWS / 256, DM / 256, F.G, (int)blockIdx.x};
        epi::EpiMerge E{(const bf16*)F.out, (const bf16*)F.out + (size_t)MROWS * DM, WSP(bf16, WS_R1)};
        pg8::gemm_phase(F.lds + RING_OFF, g, S, E);
    } SEAM(4);
    if (IN(5)) {
        pg8::Gemm g{WSP(pg8::bf16_t, WS_R1), WSP(pg8::bf16_t, WS_WOUT), DM}; pg8::StaticOrder S{MROWS / 256, DM / 256, F.G, (int)blockIdx.x};
        epi::EpiOut E{F.inp(I_X), WSP(bf16, WS_H2U), F.inp(I_GFFN), WSP(unsigned char, WS_H2U8)};
        pg8::gemm_phase(F.lds + RING_OFF, g, S, E);
    } SEAM(5);
    if (IN(6)) { router_phase(F); } SEAM(6);
    if ((PH_MASK >> 7) && hi > 7) {
        LAS int* tb = (LAS int*)(F.lds + TB_OFF); LAS int* cn = (LAS int*)(F.lds + CN_OFF);
        if (F.tid < 64) { const int c = (int)__hip_atomic_load(F.ctl + CW_CNT + F.tid, RLX_AGENT); cn[F.tid] = c;
            const int t = (c + 255) >> 8; int incl = t;
#pragma unroll
            for (int o = 1; o < 64; o <<= 1) { const int v = __shfl_up(incl, o); if (F.lane >= o) incl += v; }
            tb[F.tid] = incl - t; if (F.tid == 63) tb[64] = incl; }
        __syncthreads();
    }
    if (IN(7)) {
        pg8::Gemm g{WSP(pg8::bf16_t, WS_H2U8), WSP(pg8::bf16_t, WS_WGU), DM / 2}; epi::MoeSched<true> S{tbp, cnp, WSP(int, WS_LTOK), 0, 64, F.G, F.vcu};
        epi::EpiUp E{cnp, WSP(float, WS_LRS), WSP(unsigned char, WS_HID)};
        pg8::gemm_phase<epi::EpiUp, epi::MoeSched<true>, true>(F.lds + RING_OFF, g, S, E);
    } SEAM(7);
    if (IN(8)) {
        pg8::Gemm g{WSP(pg8::bf16_t, WS_HID), WSP(pg8::bf16_t, WS_WD), DEXP / 2}; epi::MoeSched<false> S{tbp, cnp, WSP(int, WS_LTOK), 0, 32, F.G, F.vcu};
        epi::EpiDown<0> E{cnp, WSP(int, WS_LTOK), WSP(float, WS_LW), F.out, WSP(unsigned char, WS_R1), WSP(float, WS_TRASH), WSP(bf16, WS_H2U), F.inp(I_GFFN)};
        pg8::gemm_phase<epi::EpiDown<0>, epi::MoeSched<false>, true>(F.lds + RING_OFF, g, S, E);
    } SEAM(8);
    if (IN(9)) {
        pg8::Gemm g{WSP(pg8::bf16_t, WS_HID), WSP(pg8::bf16_t, WS_WD), DEXP / 2}; epi::MoeSched<false> S{tbp, cnp, WSP(int, WS_LTOK), 32, 64, F.G, F.vcu};
        epi::EpiDown<1> E{cnp, WSP(int, WS_LTOK), WSP(float, WS_LW), F.out, WSP(unsigned char, WS_R1), WSP(float, WS_TRASH), WSP(bf16, WS_H2U), F.inp(I_GFFN)};
        pg8::gemm_phase<epi::EpiDown<1>, epi::MoeSched<false>, true>(F.lds + RING_OFF, g, S, E);
    }
#ifdef PROBE_K
    PROBE_AT(9);
    if (blockIdx.x == 0 && F.tid == 0) { const unsigned long long t1 = __builtin_amdgcn_s_memrealtime(), tgt = t1 + (unsigned long long)PROBE_MULT * (prb[1] - prb[0]);
        for (unsigned sp = 0; sp < 4000000u && __builtin_amdgcn_s_memrealtime() < tgt; ++sp) __builtin_amdgcn_s_sleep(16); }
#endif
#undef IN
#undef SEAM
}

extern "C" void kernel_launch(void* const* d_in, const int* in_sizes, int n_in, void* d_out, int out_size, void* d_ws, size_t ws_size, hipStream_t stream) {
    static int grid = 0;
    if (grid == 0) {
        if (n_in != 25 || in_sizes[0] != MROWS * DM || out_size != MROWS * DM || ws_size < WS_END) { fprintf(stderr, "kernel_launch: unexpected shapes (n_in %d, in0 %d, out %d, ws %zu)\n", n_in, n_in > 0 ? in_sizes[0] : -1, out_size, ws_size); grid = -1; return; }
        int dev = 0, cus = 0, per_cu = 0;
        if (hipGetDevice(&dev) != hipSuccess || hipDeviceGetAttribute(&cus, hipDeviceAttributeMultiprocessorCount, dev) != hipSuccess) { grid = -1; return; }
        if (hipFuncSetAttribute((const void*)fwd_kernel, hipFuncAttributeMaxDynamicSharedMemorySize, LDS_BYTES) != hipSuccess) { fprintf(stderr, "kernel_launch: hipFuncSetAttribute failed\n"); grid = -1; return; }
        if (hipOccupancyMaxActiveBlocksPerMultiprocessor(&per_cu, (const void*)fwd_kernel, NWAVES * 64, LDS_BYTES) != hipSuccess || per_cu < 1) { fprintf(stderr, "kernel_launch: occupancy query says %d\n", per_cu); }
        (void)hipGetLastError();
        grid = cus;
    }
    if (grid < 0) return;
    if (hipMemsetAsync((char*)d_ws + WS_CTL, 0, CTL_ZERO_BYTES, stream) != hipSuccess) return;
    Args a{};
    for (int i = 0; i < 25; ++i) a.in[i] = (const float*)d_in[i];
    a.out = (float*)d_out; a.ws = (unsigned char*)d_ws;
    if (MK_N_LAUNCHES == 1) { a.ph_lo = 0; a.ph_hi = N_PHASES; hipLaunchKernelGGL(fwd_kernel, dim3(grid), dim3(NWAVES * 64), LDS_BYTES, stream, a); }
    else for (int p = 0; p < N_PHASES; ++p) { a.ph_lo = p; a.ph_hi = p + 1; hipLaunchKernelGGL(fwd_kernel, dim3(grid), dim3(NWAVES * 64), LDS_BYTES, stream, a); }
}
```

```cpp
#include <hip/hip_runtime.h>
#include <hip/hip_bf16.h>
#include <cstdio>
#include <cstdint>
#include <cmath>

namespace pg8 {
#define PG8_LAS __attribute__((address_space(3)))
typedef unsigned short bf16_t;
typedef short bf16x8 __attribute__((ext_vector_type(8)));
typedef float f32x4 __attribute__((ext_vector_type(4)));
typedef float f32x2 __attribute__((ext_vector_type(2)));
typedef unsigned u32x4 __attribute__((ext_vector_type(4)));
typedef unsigned u32x2 __attribute__((ext_vector_type(2)));
typedef int v8i __attribute__((ext_vector_type(8)));
constexpr int BM = 256, BK = 64, HALF = 128, HTB = HALF * BK * 2, STAGE_BYTES = 8 * HTB, NXCD = 8, WGM = 8;

__host__ __device__ __forceinline__ int lds_byte(int r, int c) { const int st = (r >> 4) * 2 + (c >> 5), rr = r & 15, cc = c & 31, ob = rr * 64 + cc * 2; return st * 1024 + (ob ^ (((ob >> 9) & 1) << 5)); }
__host__ __device__ __forceinline__ void stage_rc(int b, int& R, int& C) { const int st = b / 1024, sb = b % 1024, swz = sb ^ (((sb >> 9) & 1) << 5); R = (st >> 1) * 16 + swz / 64; C = (st & 1) * 32 + (swz % 64) / 2; }
__host__ __device__ __forceinline__ int perm32(int rho) { const int n = rho >> 4, i = rho & 15; return 8 * (i >> 2) + 4 * n + (i & 3); }

struct Unit { int pm, pn, aux, half; };
struct Gemm { const bf16_t* A; const bf16_t* Bt; int K; };

__device__ __forceinline__ void tile_of(int L, int nM, int nN, int& pm, int& pn) {
    const int nwg = nM * nN; int wgid = L;
    { const int q = nwg / NXCD, r = nwg % NXCD, xcd = wgid % NXCD, off = wgid / NXCD; wgid = (xcd < r ? xcd * (q + 1) : r * (q + 1) + (xcd - r) * q) + off; }
    const int nig = WGM * nN, gid = wgid / nig, fm = gid * WGM, gsz = (nM - fm) < WGM ? (nM - fm) : WGM;
    pm = fm + ((wgid % nig) % gsz); pn = (wgid % nig) / gsz;
}
struct StaticOrder {
    static constexpr bool GATHER = false;
    int nM, nN, G, c;
    __device__ __forceinline__ bool next(int i, Unit& u) const { const long L = (long)i * G + c; if (L >= (long)nM * nN) return false; tile_of((int)L, nM, nN, u.pm, u.pn); u.aux = 0; u.half = 0; return true; }
    __device__ __forceinline__ int grow(const Unit&, int) const { return 0; }
};
struct PairOrder {
    static constexpr bool GATHER = false;
    int nM, nN, G, c;
    __device__ __forceinline__ bool next(int i, Unit& u) const { const long L = (long)(i >> 1) * G + c; if (L >= (long)nM * nN) return false; tile_of((int)L, nM, nN, u.pm, u.pn); const int br = i & 1; u.pm += nM * br; u.pn += nN * br; u.aux = br; u.half = 0; return true; }
    __device__ __forceinline__ int grow(const Unit&, int) const { return 0; }
};

__device__ __forceinline__ unsigned cvt_pk_bf16(float lo, float hi) { unsigned r; asm volatile("v_cvt_pk_bf16_f32 %0, %1, %2" : "=v"(r) : "v"(lo), "v"(hi)); return r; }
__device__ __forceinline__ u32x4 pack8(const f32x4 a, const f32x4 b) { u32x4 w; w.x = cvt_pk_bf16(a[0], a[1]); w.y = cvt_pk_bf16(a[2], a[3]); w.z = cvt_pk_bf16(b[0], b[1]); w.w = cvt_pk_bf16(b[2], b[3]); return w; }
__device__ __forceinline__ float bf_lo(unsigned w) { return __uint_as_float(w << 16); }
__device__ __forceinline__ float bf_hi(unsigned w) { return __uint_as_float(w & 0xffff0000u); }

template <class Epi, class Sched, bool F8 = false, bool OPQ = false>
__device__ __forceinline__ void gemm_phase(PG8_LAS unsigned char* lds, const Gemm g, const Sched& S, const Epi& E) {
    constexpr bool GA = Sched::GATHER;
    const int tid = threadIdx.x, wid = __builtin_amdgcn_readfirstlane(tid >> 6), lane = tid & 63, wr = wid >> 2, wc = wid & 3, fr = lane & 15, fq = lane >> 4;
    const int K = g.K; int nt = K / BK; if constexpr (OPQ) asm volatile("" : "+s"(nt));
    unsigned voffA[2], voffB[2]; int RA[2], CA[2];
#pragma unroll
    for (int i = 0; i < 2; ++i) { int R, C; stage_rc(tid * 16 + i * 8192, R, C); const int Rb = (R & ~31) + perm32(R & 31);
        voffA[i] = (unsigned)(R * K + C) * 2u; voffB[i] = (unsigned)(Rb * K + C) * 2u; RA[i] = R; CA[i] = C; }
    const size_t kstep = (size_t)(BK * 2);
    const size_t hstep = (size_t)HALF * K * 2;
    const size_t tstep = 2 * hstep;
    const unsigned ldsw = (unsigned)wid * 1024u;
    const int aoff = lds_byte(wr * 64 + fr, F8 ? fq * 16 : fq * 8), boff = lds_byte(wc * 32 + fr, F8 ? fq * 16 : fq * 8);
    unsigned gc[2][2], gn[2][2];
#define PG8_SA(b, h) (((b) * 2 + (h)) * HTB)
#define PG8_SB(b, h) ((4 + (b) * 2 + (h)) * HTB)
#define PG8_GL(src, dstoff) __builtin_amdgcn_global_load_lds((const unsigned*)(src), (PG8_LAS unsigned*)(lds + (dstoff)), 16, 0, 0)
#define PG8_STAGE(bufoff, gbase, voff) do { _Pragma("unroll") for (int _i = 0; _i < 2; ++_i) PG8_GL((const char*)(gbase) + (voff)[_i], (bufoff) + ldsw + _i * 8192); } while (0)
#define PG8_STA(bufoff, kptr, h, NX) do { if constexpr (GA) { _Pragma("unroll") for (int _i = 0; _i < 2; ++_i) { const unsigned _o = (NX) ? gn[h][_i] : gc[h][_i]; PG8_GL((const char*)(kptr) + _o, (bufoff) + ldsw + _i * 8192); } } \
        else { PG8_STAGE(bufoff, (const char*)(kptr) + (h) * hstep, voffA); } } while (0)
#define PG8_GOFF(dst, un) do { _Pragma("unroll") for (int _h = 0; _h < 2; ++_h) _Pragma("unroll") for (int _i = 0; _i < 2; ++_i) dst[_h][_i] = ((unsigned)S.grow(un, _h * HALF + RA[_i]) * (unsigned)K + (unsigned)CA[_i]) * 2u; } while (0)
#define PG8_LDA(dst, b, h) do { _Pragma("unroll") for (int m = 0; m < 4; ++m) _Pragma("unroll") for (int k = 0; k < 2; ++k) dst[m][k] = *(const PG8_LAS bf16x8*)(lds + PG8_SA(b, h) + aoff + m * 2048 + (F8 ? k * 16 : k * 1024)); } while (0)
#define PG8_LDB(dst, b, h) do { _Pragma("unroll") for (int n = 0; n < 2; ++n) _Pragma("unroll") for (int k = 0; k < 2; ++k) dst[n][k] = *(const PG8_LAS bf16x8*)(lds + PG8_SB(b, h) + boff + n * 2048 + (F8 ? k * 16 : k * 1024)); } while (0)
#define PG8_F8V(X) __builtin_shufflevector(__builtin_bit_cast(u32x4, X[0]), __builtin_bit_cast(u32x4, X[1]), 0, 1, 2, 3, 4, 5, 6, 7)
#define PG8_MMA(ai, bj, At, Bt) do { __builtin_amdgcn_s_setprio(1); \
        if constexpr (F8) { _Pragma("unroll") for (int m = 0; m < 4; ++m) _Pragma("unroll") for (int n = 0; n < 2; ++n) \
            acc[ai][bj][m][n] = __builtin_amdgcn_mfma_scale_f32_16x16x128_f8f6f4(__builtin_bit_cast(v8i, PG8_F8V(Bt[n])), __builtin_bit_cast(v8i, PG8_F8V(At[m])), acc[ai][bj][m][n], 0, 0, 0, 0x7f7f7f7f, 0, 0x7f7f7f7f); } \
        else { _Pragma("unroll") for (int m = 0; m < 4; ++m) _Pragma("unroll") for (int n = 0; n < 2; ++n) _Pragma("unroll") for (int k = 0; k < 2; ++k) \
            acc[ai][bj][m][n] = __builtin_amdgcn_mfma_f32_16x16x32_bf16(Bt[n][k], At[m][k], acc[ai][bj][m][n], 0, 0, 0); } __builtin_amdgcn_s_setprio(0); } while (0)
#define PG8_WAIT_V(n) asm volatile("s_waitcnt vmcnt(" #n ")" ::: "memory")
#define PG8_WAIT_L(n) asm volatile("s_waitcnt lgkmcnt(" #n ")" ::: "memory")
#define PG8_BAR __builtin_amdgcn_s_barrier()
#define PG8_SCHED __builtin_amdgcn_sched_barrier(0)
#define PG8_ZERO() do { _Pragma("unroll") for (int a = 0; a < 2; ++a) _Pragma("unroll") for (int b = 0; b < 2; ++b) _Pragma("unroll") for (int m = 0; m < 4; ++m) _Pragma("unroll") for (int n = 0; n < 2; ++n) acc[a][b][m][n] = (f32x4){0.f, 0.f, 0.f, 0.f}; } while (0)
    Unit cur, nxt; int ui = 0;
    if (!S.next(0, cur)) return;
    f32x4 acc[2][2][4][2];
    PG8_ZERO();
    bf16x8 At[4][2], B0[2][2], B1[2][2];
    const char* cA = GA ? (const char*)g.A : (const char*)g.A + (size_t)cur.pm * tstep; const char* cB = (const char*)g.Bt + (size_t)cur.pn * tstep;
    if constexpr (GA) { PG8_GOFF(gc, cur); }
    PG8_STAGE(PG8_SB(0, 0), cB, voffB); PG8_STAGE(PG8_SB(0, 1), cB + hstep, voffB); PG8_STA(PG8_SA(0, 0), cA, 0, false); PG8_STA(PG8_SA(0, 1), cA, 1, false);
    if (wr == 1) PG8_BAR;
    PG8_WAIT_V(2); PG8_BAR;
    PG8_STAGE(PG8_SB(1, 0), cB + kstep, voffB); PG8_STA(PG8_SA(1, 0), cA + kstep, 0, false); PG8_STAGE(PG8_SB(1, 1), cB + hstep + kstep, voffB);
    PG8_WAIT_V(6); PG8_BAR;
    for (;;) {
        const bool has_next = S.next(ui + 1, nxt);
        const char* nA = GA ? (const char*)g.A : (has_next ? (const char*)g.A + (size_t)nxt.pm * tstep : cA); const char* nB = has_next ? (const char*)g.Bt + (size_t)nxt.pn * tstep : cB;
        if constexpr (GA) { if (has_next) { PG8_GOFF(gn, nxt); } else { _Pragma("unroll") for (int _h = 0; _h < 2; ++_h) _Pragma("unroll") for (int _i = 0; _i < 2; ++_i) gn[_h][_i] = gc[_h][_i]; } }
        int hf_ = cur.half; if constexpr (OPQ) asm volatile("" : "+s"(hf_));
        const bool do0 = hf_ != 2, do1 = hf_ != 1;
        for (int t = 0; t < nt; t += 2) {
            const bool last = (t == nt - 2);
            const char* a1 = cA + (size_t)(t + 1) * kstep;
            const char* a2 = last ? nA : cA + (size_t)(t + 2) * kstep; const char* b2 = last ? nB : cB + (size_t)(t + 2) * kstep;
            const char* a3 = a2 + kstep; const char* b3 = b2 + kstep;
            PG8_LDB(B0, 0, 0); PG8_LDB(B1, 0, 1); PG8_SCHED; PG8_LDA(At, 0, 0); PG8_STA(PG8_SA(1, 1), a1, 1, false);
            PG8_WAIT_V(8); PG8_WAIT_L(0); PG8_BAR; if (do0) { PG8_MMA(0, 0, At, B0); PG8_MMA(0, 1, At, B1); } PG8_BAR; PG8_SCHED;
            PG8_LDA(At, 0, 1); PG8_STAGE(PG8_SB(0, 0), b2, voffB); PG8_STAGE(PG8_SB(0, 1), b2 + hstep, voffB); PG8_STA(PG8_SA(0, 0), a2, 0, last);
            PG8_WAIT_V(8); PG8_WAIT_L(0); PG8_BAR; if (do1) { PG8_MMA(1, 0, At, B0); PG8_MMA(1, 1, At, B1); } PG8_BAR; PG8_SCHED;
            PG8_LDB(B0, 1, 0); PG8_LDB(B1, 1, 1); PG8_SCHED; PG8_LDA(At, 1, 0); PG8_STA(PG8_SA(0, 1), a2, 1, last);
            PG8_WAIT_V(8); PG8_WAIT_L(0); PG8_BAR; if (do0) { PG8_MMA(0, 0, At, B0); PG8_MMA(0, 1, At, B1); } PG8_BAR; PG8_SCHED;
            PG8_LDA(At, 1, 1); PG8_STAGE(PG8_SB(1, 0), b3, voffB); PG8_STAGE(PG8_SB(1, 1), b3 + hstep, voffB); PG8_STA(PG8_SA(1, 0), a3, 0, last);
            PG8_WAIT_V(8); PG8_WAIT_L(0); PG8_BAR; if (do1) { PG8_MMA(1, 0, At, B0); PG8_MMA(1, 1, At, B1); } PG8_BAR; PG8_SCHED;
        }
        if (wr == 0) PG8_BAR;
        const bool keep = E(acc, cur, wr, wc, fr, fq);
        if (!has_next) break;
        if (!keep) { PG8_ZERO(); }
        cur = nxt; cA = nA; cB = nB; ++ui;
        if constexpr (GA) { _Pragma("unroll") for (int _h = 0; _h < 2; ++_h) _Pragma("unroll") for (int _i = 0; _i < 2; ++_i) gc[_h][_i] = gn[_h][_i]; }
        if (wr == 1) PG8_BAR;
    }
    PG8_WAIT_V(0);
    PG8_BAR;
#undef PG8_SA
#undef PG8_SB
#undef PG8_GL
#undef PG8_STAGE
#undef PG8_STA
#undef PG8_GOFF
#undef PG8_LDA
#undef PG8_LDB
#undef PG8_MMA
#undef PG8_F8V
#undef PG8_WAIT_V
#undef PG8_WAIT_L
#undef PG8_BAR
#undef PG8_SCHED
#undef PG8_ZERO
}
}
#include <hip/hip_bf16.h>
#include <cmath>
namespace attn_body {
using bf16=__hip_bfloat16;
using bf16x8=__attribute__((ext_vector_type(8)))short;
using s16x4=__attribute__((ext_vector_type(4)))short;
using f32x16=__attribute__((ext_vector_type(16)))float;
using u32x4=__attribute__((ext_vector_type(4)))unsigned;
constexpr int D=64,QP=512,KP=512,VP=512,OP=1024,QSEQ=4096,KSEQ=4160;
constexpr int NW=8,QBLK=32,QB=QBLK*NW,KVBLK=64,NQB=QSEQ/QB;
constexpr int ATTN_UNIT_ROWS=QB;
__device__ __forceinline__ int crow(int r,int hi){return (r&3)+8*(r>>2)+4*hi;}
#define SBAR() __builtin_amdgcn_sched_barrier(0)
__device__ __forceinline__ void cmask(f32x16&p0,f32x16&p1,int jb,int qrel,int hi){
  const float NEG=-INFINITY; int kb=64*jb+4*hi;
  #pragma unroll
  for(int r=0;r<16;++r){int kv=kb+(r&3)+8*(r>>2); if(kv>qrel)p0[r]=NEG; if(kv+32>qrel)p1[r]=NEG;}
}

constexpr int NSLOT=3, SLOTB=8192;
constexpr int QSTG=4608;
constexpr int LDS_K=0, LDS_V=NSLOT*SLOTB, LDS_WS=LDS_V+NSLOT*2*SLOTB, LDS_OST=LDS_WS+NW*64*4, LDS_BYTES=LDS_OST+NW*QSTG;
constexpr float C2=0.125f*1.4426950408889634f;
__device__ __forceinline__ void glds16(const void*gsrc,unsigned lds_dst){unsigned keep;
  asm volatile("s_mov_b32 %0, m0\n\ts_mov_b32 m0, %2\n\ts_nop 0\n\tglobal_load_lds_dwordx4 %1, off\n\ts_mov_b32 m0, %0":"=&s"(keep):"v"(gsrc),"s"(lds_dst):"memory");}
__device__ __forceinline__ float max3f(float a,float b,float c){float r;asm("v_max3_f32 %0, %1, %2, %3":"=v"(r):"v"(a),"v"(b),"v"(c));return r;}
__device__ __forceinline__ float max2f(float a,float b){float r;asm("v_max_f32_e32 %0, %1, %2":"=v"(r):"v"(a),"v"(b));return r;}
__device__ __forceinline__ float fadd_s(float a,float b){float r;asm("v_add_f32_e32 %0, %1, %2":"=v"(r):"v"(a),"v"(b));return r;}
__device__ __forceinline__ float fsub_s(float a,float b){float r;asm("v_sub_f32_e32 %0, %1, %2":"=v"(r):"v"(a),"v"(b));return r;}
typedef float f32x2_t __attribute__((ext_vector_type(2))); typedef __bf16 bf16x2_t __attribute__((ext_vector_type(2)));
__device__ __forceinline__ unsigned cvtpk_s(float lo,float hi){f32x2_t v={lo,hi};bf16x2_t b=__builtin_convertvector(v,bf16x2_t);return __builtin_bit_cast(unsigned,b);}
#define WAIT_BAR(N) asm volatile("s_waitcnt vmcnt(" #N ") lgkmcnt(0)\n\ts_barrier":::"memory")

__device__ __forceinline__ void qkt(f32x16&p0,f32x16&p1,const char*Kslot,const bf16x8*qr,int r32,int hi){ const f32x16 negm=f32x16{};
  const char*kb=Kslot+hi*1024+r32*16;
  #pragma unroll
  for(int d0=0;d0<4;++d0){
    const bf16x8 b0=*reinterpret_cast<const bf16x8*>(kb+d0*2048);
    const bf16x8 b1=*reinterpret_cast<const bf16x8*>(kb+d0*2048+512);
    if(d0==0){p0=__builtin_amdgcn_mfma_f32_32x32x16_bf16(b0,qr[0],negm,0,0,0);p1=__builtin_amdgcn_mfma_f32_32x32x16_bf16(b1,qr[0],negm,0,0,0);}
    else{p0=__builtin_amdgcn_mfma_f32_32x32x16_bf16(b0,qr[d0],p0,0,0,0);p1=__builtin_amdgcn_mfma_f32_32x32x16_bf16(b1,qr[d0],p1,0,0,0);}}
}
typedef __attribute__((address_space(3))) const char* lds_cptr;
typedef short v4i16_t __attribute__((ext_vector_type(4)));
__device__ __forceinline__ void kload8(bf16x8*kf,lds_cptr kp){
  kf[0]=*(const __attribute__((address_space(3))) bf16x8*)(kp);      kf[1]=*(const __attribute__((address_space(3))) bf16x8*)(kp+512);
  kf[2]=*(const __attribute__((address_space(3))) bf16x8*)(kp+2048); kf[3]=*(const __attribute__((address_space(3))) bf16x8*)(kp+2560);
  kf[4]=*(const __attribute__((address_space(3))) bf16x8*)(kp+4096); kf[5]=*(const __attribute__((address_space(3))) bf16x8*)(kp+4608);
  kf[6]=*(const __attribute__((address_space(3))) bf16x8*)(kp+6144); kf[7]=*(const __attribute__((address_space(3))) bf16x8*)(kp+6656);
}
__device__ __forceinline__ void kload2(bf16x8*kf,lds_cptr kp,int j){ kf[2*j]=*(const __attribute__((address_space(3))) bf16x8*)(kp+j*2048); kf[2*j+1]=*(const __attribute__((address_space(3))) bf16x8*)(kp+j*2048+512); }
__device__ __forceinline__ s16x4 vtr(lds_cptr p){ return __builtin_bit_cast(s16x4,__builtin_amdgcn_ds_read_tr16_b64_v4i16((__attribute__((address_space(3))) v4i16_t*)p)); }
__device__ __forceinline__ float rowmax(const f32x16&p0,const f32x16&p1){
  float a=max3f(p0[0],p0[1],p1[0]),b=max3f(p0[2],p0[3],p1[1]);a=max3f(a,p1[2],p1[3]);
  #pragma unroll
  for(int r=4;r<16;r+=4){a=max3f(a,p0[r],p0[r+1]);b=max3f(b,p0[r+2],p0[r+3]);a=max3f(a,p1[r],p1[r+1]);b=max3f(b,p1[r+2],p1[r+3]);}
  const float m=max2f(a,b);
  auto rr=__builtin_amdgcn_permlane32_swap(__float_as_uint(m),__float_as_uint(m),false,false);
  return max2f(__uint_as_float(rr[0]),__uint_as_float(rr[1]));
}
__device__ __forceinline__ void pv(f32x16*o,int vb,bf16x8 pa0,bf16x8 pa1,bf16x8 pa2,bf16x8 pa3){
  #pragma unroll
  for(int d0=0;d0<4;++d0){s16x4 lo[4],hi[4];
    #pragma unroll
    for(int ks=0;ks<4;++ks){
      asm volatile("ds_read_b64_tr_b16 %0,%1 offset:%c2":"=&v"(lo[ks]):"v"(vb),"i"(d0*4096+ks*1024):"memory");
      asm volatile("ds_read_b64_tr_b16 %0,%1 offset:%c2":"=&v"(hi[ks]):"v"(vb),"i"(d0*4096+ks*1024+512):"memory");}
    asm volatile("s_waitcnt lgkmcnt(0)":::"memory");SBAR();
    #define PK(k) (bf16x8){lo[k][0],lo[k][1],lo[k][2],lo[k][3],hi[k][0],hi[k][1],hi[k][2],hi[k][3]}
    o[d0]=__builtin_amdgcn_mfma_f32_32x32x16_bf16(pa0,PK(0),o[d0],0,0,0);
    o[d0]=__builtin_amdgcn_mfma_f32_32x32x16_bf16(pa1,PK(1),o[d0],0,0,0);
    o[d0]=__builtin_amdgcn_mfma_f32_32x32x16_bf16(pa2,PK(2),o[d0],0,0,0);
    o[d0]=__builtin_amdgcn_mfma_f32_32x32x16_bf16(pa3,PK(3),o[d0],0,0,0);
    #undef PK
  }
}

#ifndef ATTN_STORE16
#define ATTN_STORE16(p,v) (*(u32x4*)(p)=(v))
#endif
template<int THRL,bool FAST> __device__ __forceinline__ void attn_unit(int b,int qcol,int kcol,int vcol,int ocol,int qb,const bf16*Q,const bf16*__restrict__ K,const bf16*__restrict__ V,bf16*O,char*shm,int comb,int o0col,float lam,const float*gsub,bf16*OA,int oacol){
  const int tid=threadIdx.x,lane=tid&63,r32=lane&31,hi=lane>>5; const int wid=__builtin_amdgcn_readfirstlane(tid>>6);
  const long qrow0=(long)b*QSEQ, krow0=(long)b*KSEQ; const int q0=qb*QB;
  const bf16*Qw=Q+(qrow0+q0+wid*QBLK)*QP+qcol;
  const bf16*Kh=K+krow0*KP+kcol,*Vh=V+krow0*VP+vcol;
  const unsigned lds0=(unsigned)(uintptr_t)shm;
  float*wsf=(float*)(shm+LDS_WS)+wid*64;
  const bf16*ksrc=Kh+(long)lane*KP+wid*8;
  const bf16*vsrc=Vh+(long)(16*(wid&3)+(lane>>2))*VP+(wid>>2)*32+(lane&3)*8;
  const unsigned kdst=lds0+LDS_K+wid*1024, vdst=lds0+LDS_V+wid*1024;
  #define DMA_K(t,slot) glds16(ksrc+(long)(t)*KVBLK*KP,(unsigned)__builtin_amdgcn_readfirstlane(kdst+(slot)))
  #define DMA_V(t,slot) do{ glds16(vsrc+(long)(t)*KVBLK*VP,(unsigned)__builtin_amdgcn_readfirstlane(vdst+2*(slot))); glds16(vsrc+64+(long)(t)*KVBLK*VP,(unsigned)__builtin_amdgcn_readfirstlane(vdst+2*(slot)+8192)); }while(0)
  const int vb0=(int)(lds0+LDS_V)+((lane>>4)&1)*32+(lane&3)*8+(4*hi+((lane&15)>>2))*64;
  const char*Kbase=shm+LDS_K; bf16x8 kf[8];
  const lds_cptr shm3=(lds_cptr)shm; const lds_cptr kp0=shm3+LDS_K+hi*1024+r32*16; const lds_cptr vp0=shm3+LDS_V+((lane>>4)&1)*32+(lane&3)*8+(4*hi+((lane&15)>>2))*64;
  const int NT=(q0+QB)/KVBLK+1;
  DMA_K(0,0);DMA_V(0,0);DMA_K(1,SLOTB);
  bf16x8 qr[4];
  #pragma unroll
  for(int d0=0;d0<4;++d0)qr[d0]=*reinterpret_cast<const bf16x8*>(&Qw[(long)r32*QP+d0*16+hi*8]);
  const __attribute__((address_space(3))) char* qsp=(const __attribute__((address_space(3))) char*)shm3+LDS_OST+wid*QSTG+r32*144+hi*16;
  #pragma unroll
  for(int d0=0;d0<4;++d0)*(__attribute__((address_space(3))) bf16x8*)(qsp+d0*32)=qr[d0];
  #define QV(d0) (*(const __attribute__((address_space(3))) bf16x8*)(qsp+(d0)*32))
  float mhat=0.f,l_reg=0.f;f32x16 o[4];o[0]=f32x16{};o[1]=f32x16{};o[2]=f32x16{};o[3]=f32x16{};const f32x16 zero16=f32x16{};
  const int qrel=wid*QBLK+r32;
  #define CMASK(P0,P1,t) do{int jb_=(t)-(NT-4); if(jb_>=0)cmask(P0,P1,jb_,qrel,hi);}while(0)
  bool resc=false;
  #define START(P0,P1) do{ resc=false; if constexpr(FAST){ mhat=0.f; _Pragma("unroll") for(int r=0;r<16;++r)P0[r]=__builtin_amdgcn_exp2f(P0[r]); } \
    else { const float rm=rowmax(P0,P1); mhat=rm; _Pragma("unroll") for(int r=0;r<16;++r)P0[r]=__builtin_amdgcn_exp2f(fsub_s(P0[r],mhat)); } }while(0)
  #define RESC() do{ if(resc){ asm volatile("s_waitcnt lgkmcnt(0)":::"memory"); \
      _Pragma("unroll") for(int d_=0;d_<4;++d_) _Pragma("unroll") for(int r=0;r<16;++r)o[d_][r]*=wsf[crow(r,hi)]; } }while(0)
  f32x16 pA0,pA1,pB0,pB1;
  int sl_prev=0,sl_cur=0,sl_next=SLOTB;
  #define ROT() do{sl_prev=sl_cur;sl_cur=sl_next;sl_next=(sl_next==(NSLOT-1)*SLOTB)?0:sl_next+SLOTB;}while(0)
  DMA_K(2,2*SLOTB);
  WAIT_BAR(3);
  qkt(pA0,pA1,Kbase,qr,r32,hi);asm volatile("s_nop 15\n\ts_nop 7":"+v"(pA0),"+v"(pA1));
  { _Pragma("unroll") for(int r=8;r<16;++r)pA0[r]=-INFINITY; _Pragma("unroll") for(int r=0;r<16;++r)pA1[r]=-INFINITY; }
  START(pA0,pA1);
  if constexpr(FAST){ _Pragma("unroll") for(int r=0;r<16;++r)pA1[r]=__builtin_amdgcn_exp2f(pA1[r]); } else { _Pragma("unroll") for(int r=0;r<16;++r)pA1[r]=__builtin_amdgcn_exp2f(fsub_s(pA1[r],mhat)); }
  WAIT_BAR(0);
  DMA_K(3,0);DMA_V(1,SLOTB);
  ROT();
  kload8(kf,kp0+sl_cur);
  WAIT_BAR(3);
  s16x4 vlo[8],vhi[8]; u32x4 pw0,pw1,pw2,pw3;
  #define PKW(P,B) cvtpk_s(P[B],P[B+1])
  #define PAF(k) __builtin_bit_cast(bf16x8,pw##k)
  #define VFR(i) (bf16x8){vlo[i][0],vlo[i][1],vlo[i][2],vlo[i][3],vhi[i][0],vhi[i][1],vhi[i][2],vhi[i][3]}
  #define PIN(x) asm volatile("":"+v"(x))
  #define MX3(a,b,c) __builtin_fmaxf(__builtin_fmaxf((a),(b)),(c))
  #define GAPA(MF,A0,A1,A2,A3,W0,W1,PW) do{ MF; sacc+=A0; sacc+=A1; sacc+=A2; sacc+=A3; PIN(sacc); W0; W1; PIN(PW); SBAR(); }while(0)
  #define EX(v) __builtin_amdgcn_exp2f(v)
  #define GAPB(MF,X,B) do{ MF; if constexpr(FAST){ X[B]=EX(X[B]); X[B+1]=EX(X[B+1]); } else { X[B]=EX(X[B]-mhat); X[B+1]=EX(X[B+1]-mhat); } PIN(X); SBAR(); }while(0)
  #define VOF(j) ((((j)&3)*4096)+(((j)>>2)*1024))
  #define VRD(sl,j) do{ vlo[sl]=vtr(vp_+VOF(j)); vhi[sl]=vtr(vp_+VOF(j)+512); }while(0)
  #define KRD(G,j) do{ if(G){ kload2(kf,kp0+sl_next,j); SBAR(); } }while(0)
  #define PVM(j) o[(j)&3]=__builtin_amdgcn_mfma_f32_32x32x16_bf16(PAFJ(j),VFR((j)&7),o[(j)&3],0,0,0)
  #define PAFJ(j) (((j)>>2)==0?PAF(0):((j)>>2)==1?PAF(1):((j)>>2)==2?PAF(2):PAF(3))
  #define STEP(C0,C1,P0,P1,t,GK,GV,GL) do{ SBAR(); \
    const lds_cptr vp_=vp0+2*sl_prev; \
    VRD(0,0); SBAR(); float sacc=(P0[0]+P0[1]); \
    GAPA(C0=__builtin_amdgcn_mfma_f32_32x32x16_bf16(kf[0],QV(0),zero16,0,0,0), P0[2],P0[3],P0[4],P0[5],     pw0[0]=PKW(P0,0), pw0[1]=PKW(P0,2), pw0); \
    VRD(1,1); SBAR(); GAPA(C1=__builtin_amdgcn_mfma_f32_32x32x16_bf16(kf[1],QV(0),zero16,0,0,0), P0[6],P0[7],P0[8],P0[9],     pw0[2]=PKW(P0,4), pw0[3]=PKW(P0,6), pw0); \
    VRD(2,2); SBAR(); GAPA(C0=__builtin_amdgcn_mfma_f32_32x32x16_bf16(kf[2],QV(1),C0,0,0,0),   P0[10],P0[11],P0[12],P0[13], pw1[0]=PKW(P0,8), pw1[1]=PKW(P0,10), pw1); \
    VRD(3,3); SBAR(); GAPA(C1=__builtin_amdgcn_mfma_f32_32x32x16_bf16(kf[3],QV(1),C1,0,0,0),   P0[14],P0[15],P1[0],P1[1],   pw1[2]=PKW(P0,12),pw1[3]=PKW(P0,14), pw1); \
    VRD(4,4); SBAR(); GAPA(C0=__builtin_amdgcn_mfma_f32_32x32x16_bf16(kf[4],QV(2),C0,0,0,0),   P1[2],P1[3],P1[4],P1[5],     pw2[0]=PKW(P1,0), pw2[1]=PKW(P1,2), pw2); \
    VRD(5,5); SBAR(); GAPA(C1=__builtin_amdgcn_mfma_f32_32x32x16_bf16(kf[5],QV(2),C1,0,0,0),   P1[6],P1[7],P1[8],P1[9],     pw2[2]=PKW(P1,4), pw2[3]=PKW(P1,6), pw2); \
    VRD(6,6); SBAR(); GAPA(C0=__builtin_amdgcn_mfma_f32_32x32x16_bf16(kf[6],QV(3),C0,0,0,0),   P1[10],P1[11],P1[12],P1[13], pw3[0]=PKW(P1,8), pw3[1]=PKW(P1,10), pw3); \
    VRD(7,7); SBAR(); GAPA(C1=__builtin_amdgcn_mfma_f32_32x32x16_bf16(kf[7],QV(3),C1,0,0,0),   P1[14],P1[15],0.f,0.f,       pw3[2]=PKW(P1,12),pw3[3]=PKW(P1,14), pw3); \
    l_reg+=sacc; \
    if(GK){DMA_K((t)+3,sl_cur);} if(GV){DMA_V((t)+1,sl_next);} \
    CMASK(C0,C1,t); \
    if constexpr(!FAST){ float a=MX3(C0[0],C0[1],C1[0]),b=MX3(C0[2],C0[3],C1[1]); a=MX3(a,C1[2],C1[3]); \
      _Pragma("unroll") for(int r=4;r<16;r+=4){a=MX3(a,C0[r],C0[r+1]);b=MX3(b,C0[r+2],C0[r+3]);a=MX3(a,C1[r],C1[r+1]);b=MX3(b,C1[r+2],C1[r+3]);} \
      float rm=__builtin_fmaxf(a,b); { auto rr=__builtin_amdgcn_permlane32_swap(__float_as_uint(rm),__float_as_uint(rm),false,false); rm=__builtin_fmaxf(__uint_as_float(rr[0]),__uint_as_float(rr[1])); } \
      rm-=mhat; resc=false; \
      if(__builtin_expect(__any(rm>(float)THRL),0)){ const float dl=__builtin_fmaxf(rm,0.f); mhat+=dl; \
        const float f=__builtin_amdgcn_exp2f(-dl); l_reg*=f; if(hi==0)wsf[r32]=f; resc=true; } } \
    SBAR(); \
    GAPB(PVM(0), C0,0); \
    GAPB(PVM(1), C0,2);  VRD(0,8);  SBAR(); \
    GAPB(PVM(2), C0,4);  VRD(1,9);  SBAR(); \
    GAPB(PVM(3), C0,6);  VRD(2,10); SBAR(); \
    GAPB(PVM(4), C0,8);  VRD(3,11); SBAR(); \
    GAPB(PVM(5), C0,10); VRD(4,12); SBAR(); \
    GAPB(PVM(6), C0,12); VRD(5,13); SBAR(); \
    GAPB(PVM(7), C0,14); VRD(6,14); SBAR(); \
    GAPB(PVM(8), C1,0);  VRD(7,15); SBAR(); \
    KRD(GL,0); GAPB(PVM(9),  C1,2); \
    KRD(GL,1); GAPB(PVM(10), C1,4); \
    KRD(GL,2); GAPB(PVM(11), C1,6); \
    KRD(GL,3); GAPB(PVM(12), C1,8); \
    GAPB(PVM(13), C1,10); \
    GAPB(PVM(14), C1,12); \
    GAPB(PVM(15), C1,14); \
    }while(0)
  int t=1;
  #undef CMASK
  #define CMASK(P0,P1,t) do{}while(0)
  for(;t+5<NT;t+=2){
    STEP(pB0,pB1,pA0,pA1,t,true,true,true);     WAIT_BAR(3); RESC(); ROT();
    STEP(pA0,pA1,pB0,pB1,t+1,true,true,true);   WAIT_BAR(3); RESC(); ROT();
  }
  #undef CMASK
  #define CMASK(P0,P1,t) do{int jb_=(t)-(NT-4); if(jb_>=0)cmask(P0,P1,jb_,qrel,hi);}while(0)
  #define ENDW(tt) do{ if((tt)+3<NT){WAIT_BAR(3);} else if((tt)+2<NT){WAIT_BAR(2);} else {WAIT_BAR(0);} }while(0)
  for(;t+1<NT;t+=2){
    STEP(pB0,pB1,pA0,pA1,t,(t+3<NT),(t+1<NT),(t+1<NT));       ENDW(t);   RESC(); ROT();
    STEP(pA0,pA1,pB0,pB1,t+1,(t+4<NT),(t+2<NT),(t+2<NT));     ENDW(t+1); RESC(); ROT();
  }
  { float sacc=pA0[0]+pA0[1]; _Pragma("unroll") for(int r=2;r<16;++r)sacc+=pA0[r]; _Pragma("unroll") for(int r=0;r<16;++r)sacc+=pA1[r]; l_reg+=sacc;
    pw0=(u32x4){PKW(pA0,0),PKW(pA0,2),PKW(pA0,4),PKW(pA0,6)};pw1=(u32x4){PKW(pA0,8),PKW(pA0,10),PKW(pA0,12),PKW(pA0,14)};pw2=(u32x4){PKW(pA1,0),PKW(pA1,2),PKW(pA1,4),PKW(pA1,6)};pw3=(u32x4){PKW(pA1,8),PKW(pA1,10),PKW(pA1,12),PKW(pA1,14)};
    SBAR(); pv(o,vb0+2*sl_prev,PAF(0),PAF(1),PAF(2),PAF(3)); }
  #undef PKW
  #undef PAF
  #undef VFR
  #undef PIN
  #undef MX3
  #undef GAPA
  #undef GAPB
  #undef EX
  #undef VRD
  #undef KRD
  #undef STEP
  #undef VOF
  #undef PVM
  #undef PAFJ
  #undef QV
  #undef ENDW
  {auto rr=__builtin_amdgcn_permlane32_swap(__float_as_uint(l_reg),__float_as_uint(l_reg),false,false);l_reg=__uint_as_float(rr[0])+__uint_as_float(rr[1]);}
  if(hi==0)wsf[32+r32]=l_reg;asm volatile("s_waitcnt lgkmcnt(0)":::"memory");
  float rli[16];
  #pragma unroll
  for(int r=0;r<16;++r)rli[r]=__builtin_amdgcn_rcpf(wsf[32+crow(r,hi)]);
  bf16*Ow=O+(qrow0+q0+wid*QBLK)*OP+ocol;
  { int oz_; asm volatile("v_mov_b32 %0, 0":"=v"(oz_)); const int ln=lane+oz_;
    bf16*stg=(bf16*)(shm+LDS_OST+wid*QSTG);
    if(!comb){
      #pragma unroll
      for(int hh=0;hh<2;++hh){
        #pragma unroll
        for(int r=0;r<16;++r){const int orow=crow(r,hi);
          #pragma unroll
          for(int d0=0;d0<2;++d0)stg[orow*64+d0*32+r32]=__float2bfloat16(o[2*hh+d0][r]*rli[r]);}
        asm volatile("s_waitcnt lgkmcnt(0)":::"memory");
        #pragma unroll
        for(int i=0;i<4;++i){const int row=i*8+(ln>>3),ch=ln&7; const u32x4 v=*(const u32x4*)(stg+row*64+ch*8); ATTN_STORE16(Ow+(long)row*OP+hh*64+ch*8,v);}
        asm volatile("s_waitcnt lgkmcnt(0)":::"memory"); }
    } else {
      const bf16*O0w=O+(qrow0+q0+wid*QBLK)*OP+o0col; bf16*OAw=OA+(qrow0+q0+wid*QBLK)*512+oacol;
      float ssr[4]={0.f,0.f,0.f,0.f};
      #pragma unroll
      for(int pass=0;pass<2;++pass){
        if(pass==1){
          #pragma unroll
          for(int i=0;i<4;++i){ float ss=ssr[i]; ss+=__shfl_xor(ss,1); ss+=__shfl_xor(ss,2); ss+=__shfl_xor(ss,4); ssr[i]=0.8f/sqrtf(ss*(1.0f/128.0f)+1e-6f); } }
        #pragma unroll
        for(int hh=0;hh<2;++hh){
          u32x4 v0[4];
          #pragma unroll
          for(int i=0;i<4;++i){const int row=i*8+(ln>>3),ch=ln&7; v0[i]=*(const u32x4*)(O0w+(long)row*OP+hh*64+ch*8);}
          #pragma unroll
          for(int r=0;r<16;++r){const int orow=crow(r,hi);
            #pragma unroll
            for(int d0=0;d0<2;++d0)stg[orow*64+d0*32+r32]=__float2bfloat16(o[2*hh+d0][r]*rli[r]);}
          asm volatile("s_waitcnt lgkmcnt(0)":::"memory");
          const int ch=ln&7; const float4 g0=*(const float4*)(gsub+hh*64+ch*8), g1=*(const float4*)(gsub+hh*64+ch*8+4); const float gg[8]={g0.x,g0.y,g0.z,g0.w,g1.x,g1.y,g1.z,g1.w};
          #pragma unroll
          for(int i=0;i<4;++i){const int row=i*8+(ln>>3); const u32x4 v1=*(const u32x4*)(stg+row*64+ch*8); const u32x4 a=v0[i];
            const unsigned aw[4]={a.x,a.y,a.z,a.w},bw[4]={v1.x,v1.y,v1.z,v1.w}; float dd[8];
            #pragma unroll
            for(int j=0;j<4;++j){ dd[2*j]=__uint_as_float(aw[j]<<16)-lam*__uint_as_float(bw[j]<<16); dd[2*j+1]=__uint_as_float(aw[j]&0xffff0000u)-lam*__uint_as_float(bw[j]&0xffff0000u); }
            if(pass==0){
              #pragma unroll
              for(int j=0;j<8;++j)ssr[i]+=dd[j]*dd[j]; }
            else { const float rn=ssr[i]; u32x4 w;
              w.x=cvtpk_s(dd[0]*rn*gg[0],dd[1]*rn*gg[1]); w.y=cvtpk_s(dd[2]*rn*gg[2],dd[3]*rn*gg[3]); w.z=cvtpk_s(dd[4]*rn*gg[4],dd[5]*rn*gg[5]); w.w=cvtpk_s(dd[6]*rn*gg[6],dd[7]*rn*gg[7]);
              *(u32x4*)(OAw+(long)row*512+hh*64+ch*8)=w; } }
          asm volatile("s_waitcnt lgkmcnt(0)":::"memory"); } }
    } }
  asm volatile("s_waitcnt lgkmcnt(0)\n\ts_barrier":::"memory");
  #undef DMA_K
  #undef DMA_V
  #undef CMASK
  #undef START
  #undef RESC
  #undef ROT
}
constexpr int ATTN_LDS_BYTES=LDS_BYTES;
struct AttnTensors { const bf16* Q; const bf16* K; const bf16* V; bf16* O; };
#undef SBAR
#undef WAIT_BAR
}
#define GAS __attribute__((address_space(1)))
#define LAS __attribute__((address_space(3)))
typedef unsigned short bf16;
typedef unsigned v4u __attribute__((ext_vector_type(4)));
typedef float f32x4 __attribute__((ext_vector_type(4)));
typedef short bf16x8 __attribute__((ext_vector_type(8)));
typedef GAS unsigned gu32;
typedef GAS unsigned long long gu64;
#define RLX_AGENT __ATOMIC_RELAXED, __HIP_MEMORY_SCOPE_AGENT
#define LDS_WAIT() asm volatile("s_waitcnt lgkmcnt(0)" ::: "memory")
#define VM_WAIT() asm volatile("s_waitcnt vmcnt(0)" ::: "memory")
__device__ __forceinline__ unsigned long long rt() { return __builtin_amdgcn_s_memrealtime(); }
__device__ __forceinline__ unsigned f2bf(float f) { unsigned u = __builtin_bit_cast(unsigned, f); return (u + 0x7fffu + ((u >> 16) & 1u)) >> 16; }
__device__ __forceinline__ unsigned pk2(float lo, float hi) { return f2bf(lo) | (f2bf(hi) << 16); }

#define XB_TMO      128
#define XB_XCNT(j)  (256  + 64 * (j))
#define XB_XSUB(j)  (1280 + 64 * (j))
#define XB_XGEN(j)  (2304 + 64 * (j))
#define XB_TOP      3328
#define XB_TOPGEN   3392
#define XCD_BAR_WORDS 3456
#define XB_SPIN_CAP (1u << 18)

__device__ __forceinline__ unsigned xb_ld(unsigned* p)              { return __hip_atomic_load(p, __ATOMIC_RELAXED, __HIP_MEMORY_SCOPE_AGENT); }
__device__ __forceinline__ unsigned xb_add(unsigned* p, unsigned v) { return __hip_atomic_fetch_add(p, v, __ATOMIC_RELAXED, __HIP_MEMORY_SCOPE_AGENT); }
__device__ __forceinline__ unsigned xb_xcc_id() { return (unsigned)__builtin_amdgcn_s_getreg((3 << 11) | 20) & 0xFu; }
#define XB_SPIN(cond, bar) do { unsigned _sp = 0; while (cond) { __builtin_amdgcn_s_sleep(1); \
    if ((++_sp & 255u) == 0u) { if (xb_ld(&(bar)[XB_TMO])) break; if (_sp > XB_SPIN_CAP) { atomicAdd(&(bar)[XB_TMO], 1u); break; } } } } while (0)

struct XcdBarrier {
    unsigned* bar; unsigned x;
    volatile LAS unsigned* st;
};

__device__ __forceinline__ XcdBarrier xcd_barrier_post(unsigned* bar, volatile LAS unsigned* st) {
    XcdBarrier b; b.bar = bar; b.x = xb_xcc_id(); b.st = st;
    if (threadIdx.x == 0) (void)xb_add(&bar[XB_XCNT(b.x)], 1u);
    return b;
}
__device__ __forceinline__ void xcd_barrier_complete(unsigned* bar, unsigned x, unsigned& nloc, unsigned& nx) {
    const unsigned G = gridDim.x * gridDim.y * gridDim.z;
    unsigned sum, cnt, mine, sp = 0u;
    for (;;) {
        sum = 0u; cnt = 0u; mine = 0u;
#pragma unroll
        for (unsigned j = 0; j < 16; ++j) { const unsigned c = xb_ld(&bar[XB_XCNT(j)]); sum += c; cnt += (c > 0u) ? 1u : 0u; mine = (j == x) ? c : mine; }
        if (sum == G) break;
        __builtin_amdgcn_s_sleep(1);
        if ((++sp & 255u) == 0u) { if (xb_ld(&bar[XB_TMO])) break; if (sp > XB_SPIN_CAP) { atomicAdd(&bar[XB_TMO], 1u); break; } }
    }
    nloc = mine > 0u ? mine : 1u; nx = cnt > 0u ? cnt : 1u;
}

__device__ __forceinline__ void xcd_barrier(const XcdBarrier& b) {
    asm volatile("s_waitcnt vmcnt(0)" ::: "memory");
    __syncthreads();
    if (threadIdx.x == 0) {
        unsigned* bar = b.bar;
        __builtin_amdgcn_s_waitcnt(0);
        unsigned nloc = b.st[0], nx = b.st[1];
        if (nloc == 0u) { xcd_barrier_complete(bar, b.x, nloc, nx); b.st[0] = nloc; b.st[1] = nx; }
        const unsigned old = xb_add(&bar[XB_XSUB(b.x)], 1u);
        const unsigned gen = old / nloc;
        if (old + 1u == (gen + 1u) * nloc) {
            __builtin_amdgcn_fence(__ATOMIC_RELEASE, "agent");
            asm volatile("s_waitcnt vmcnt(0)" ::: "memory");
            const unsigned og = xb_add(&bar[XB_TOP], 1u);
            const unsigned tg = og / nx;
            if (og + 1u == (tg + 1u) * nx) xb_add(&bar[XB_TOPGEN], 1u);
            else XB_SPIN(xb_ld(&bar[XB_TOPGEN]) == tg, bar);
            __builtin_amdgcn_fence(__ATOMIC_ACQUIRE, "agent");
            xb_add(&bar[XB_XGEN(b.x)], 1u);
            asm volatile("s_waitcnt vmcnt(0)" ::: "memory");
        } else {
            XB_SPIN(xb_ld(&bar[XB_XGEN(b.x)]) == gen, bar);
            __builtin_amdgcn_fence(__ATOMIC_ACQUIRE, "agent");
            asm volatile("s_waitcnt vmcnt(0)" ::: "memory");
        }
    }
    __syncthreads();
}
constexpr int NWAVES = 8;
constexpr int DM = 1024, NBATCH = 8, SEQ = 4096, NMETA = 16;
constexpr int MROWS = NBATCH * SEQ;
constexpr int LPB = SEQ + 64;
constexpr int PROWS = NBATCH * LPB + 64;
constexpr int MZ = MROWS + 256;
constexpr int NZ = 5376, DIN = 5136;
constexpr int C_DAQ = 0, C_DAK = 512, C_DAV = 1024, C_GQ = 1536, C_GK = 1792, C_GV = 2048, C_GR = 2560, C_GG = 3072, C_GL = 3088;
constexpr float EPS = 1e-6f;
constexpr int NEXP = 32, DEXP = 512, LCAP = 32768;
constexpr int NPOS = SEQ + NMETA;

constexpr size_t MiB = 1u << 20;
constexpr size_t WS_CTL = 0, CTL_ZERO_BYTES = 1 * MiB, WS_TRASH = 768 * 1024;
constexpr size_t WS_ROPE = 1 * MiB;
constexpr size_t WS_WRH = 3 * MiB, WS_WRL = 3 * MiB + 128 * 1024;
constexpr size_t WS_IG2 = 3 * MiB + 512 * 1024;
constexpr size_t WS_LTOK = 4 * MiB, WS_LRS = 12 * MiB, WS_LW = 20 * MiB;
constexpr size_t WS_WIN = 28 * MiB, WS_WBR = 39 * MiB, WS_WOUT = 41 * MiB, WS_WGU = 43 * MiB, WS_WD = 107 * MiB;
constexpr size_t WS_R1 = 139 * MiB;
constexpr size_t WS_Q = 204 * MiB, WS_K = 236 * MiB, WS_V = 269 * MiB;
constexpr size_t WS_OA = 204 * MiB, WS_H2U = 204 * MiB;
constexpr size_t WS_GQ = 302 * MiB, WS_GK = 319 * MiB, WS_GV = 336 * MiB, WS_GR = 369 * MiB, WS_LOGA = 402 * MiB;
constexpr size_t WS_HID = 302 * MiB;
constexpr size_t WS_H2U8 = 269 * MiB;
constexpr float W8SCALE = 32.0f, H8SCALE = 4.0f;
constexpr size_t WS_DS = 435 * MiB, WS_END = 500 * MiB;
constexpr size_t WS_XN8 = WS_DS, WS_WIN8 = WS_WIN + 7 * MiB;
constexpr float X8SCALE = 8.0f;
static_assert((size_t)13 * 256 * DM * 2 <= 7 * MiB && WS_WIN8 + (size_t)2048 * DM <= WS_WBR && WS_XN8 + (size_t)MROWS * DM <= WS_END, "ws map 4");
static_assert(WS_R1 + (size_t)MZ * DM * 2 <= WS_Q && WS_K + (size_t)PROWS * 512 * 2 <= WS_V && WS_V + (size_t)PROWS * 512 * 2 <= WS_GQ, "ws map 1");
static_assert(WS_GQ + (size_t)PROWS * 256 * 2 <= WS_GK && WS_GK + (size_t)PROWS * 256 * 2 <= WS_GV && WS_GV + (size_t)PROWS * 512 * 2 <= WS_GR && WS_GR + (size_t)PROWS * 512 * 2 <= WS_LOGA && WS_LOGA + (size_t)PROWS * 256 * 4 <= WS_DS, "ws map 2");
static_assert(WS_HID + (size_t)81920 * 512 * 2 <= WS_DS && WS_DS + (size_t)32 * 64 * 8192 * 4 <= WS_END && WS_WIN + (size_t)NZ * DM * 2 <= WS_WBR && WS_WD + (size_t)32 * 1024 * 512 * 2 <= WS_R1, "ws map 3");
constexpr int CW_TMO = 0, CW_BAR = 4096, CW_CNT = 16384;

constexpr int RING_OFF = 0, RING_BYTES = 131072;
constexpr int LDSCTL_OFF = RING_BYTES, MISC_OFF = LDSCTL_OFF + 320, TB_OFF = LDSCTL_OFF + 1024, CN_OFF = LDSCTL_OFF + 1536;
constexpr int INTAB_OFF = LDSCTL_OFF + 3072;
constexpr int BML_OFF = LDSCTL_OFF + 4096;
constexpr int LDS_BYTES = 147456;
struct Frame {
    LAS unsigned char* lds;
    volatile LAS unsigned* MISC;
    gu32* ctl;
    int tid, lane, wave, vcu, G;
    float* out; unsigned char* ws;
    __device__ __forceinline__ const float* inp(int i) const { const unsigned long long v = ((const LAS unsigned long long*)(lds + INTAB_OFF))[i];
        return (const float*)(((unsigned long long)(unsigned)__builtin_amdgcn_readfirstlane((int)(v >> 32)) << 32) | (unsigned)__builtin_amdgcn_readfirstlane((int)v)); }
};
enum { I_X = 0, I_META, I_GMIX, I_WIN, I_GQN, I_GKN, I_LQ1, I_LK1, I_LQ2, I_LK2, I_GSUB, I_WGUP, I_BGATE, I_GGLA, I_WBR, I_BMERGE, I_WOUT, I_GFFN, I_WRG, I_BRG, I_WRE, I_BRE, I_WEG, I_WEU, I_WED };
#define WSP(T, off) ((T*)(F.ws + (off)))

__device__ __forceinline__ float wave_sum(float v) {
#pragma unroll
    for (int o = 1; o < 64; o <<= 1) v += __shfl_xor(v, o);
    return v;
}
__device__ __forceinline__ float bf2f(bf16 v) { return __uint_as_float((unsigned)v << 16); }
__device__ __forceinline__ float sigmoidf_(float x) { return 1.0f / (1.0f + __expf(-x)); }
__device__ __forceinline__ float clamp8(float x) { return fminf(fmaxf(x, -448.0f), 448.0f); }
__device__ __forceinline__ unsigned pk4_fp8(float a, float b, float c, float d) { unsigned w = 0; w = __builtin_amdgcn_cvt_pk_fp8_f32(clamp8(a), clamp8(b), w, false); w = __builtin_amdgcn_cvt_pk_fp8_f32(clamp8(c), clamp8(d), w, true); return w; }

__device__ __forceinline__ void transpose_tile(const float* src, int Ns, unsigned char* dstb, unsigned pitch, bool f8, LAS float* scr, int lane) {
    float tv[32];
#pragma unroll
    for (int i = 0; i < 32; ++i) tv[i] = src[(unsigned)((2 * i + (lane >> 5)) * Ns + (lane & 31))];
#pragma unroll
    for (int i = 0; i < 32; ++i) scr[(2 * i + (lane >> 5)) * 33 + (lane & 31)] = tv[i];
    LDS_WAIT(); asm volatile("" ::: "memory");
    const int c = lane & 7;
#pragma unroll
    for (int j = 0; j < 4; ++j) { const int n = (lane >> 3) + 8 * j; const LAS float* s = scr + (8 * c) * 33 + n;
        if (f8) { const unsigned lo = pk4_fp8(s[0 * 33] * W8SCALE, s[1 * 33] * W8SCALE, s[2 * 33] * W8SCALE, s[3 * 33] * W8SCALE), hi = pk4_fp8(s[4 * 33] * W8SCALE, s[5 * 33] * W8SCALE, s[6 * 33] * W8SCALE, s[7 * 33] * W8SCALE);
            *(GAS unsigned long long*)(dstb + (unsigned)n * pitch + 8 * c) = (unsigned long long)lo | ((unsigned long long)hi << 32); }
        else { v4u o; o.x = pk2(s[0 * 33], s[1 * 33]); o.y = pk2(s[2 * 33], s[3 * 33]); o.z = pk2(s[4 * 33], s[5 * 33]); o.w = pk2(s[6 * 33], s[7 * 33]);
            *(GAS v4u*)(dstb + (unsigned)n * pitch + 16 * c) = o; } }
    LDS_WAIT(); asm volatile("" ::: "memory");
}
__device__ __forceinline__ void product_tile(const float* win, const float* wgu, int k0, int n0, bf16* dst, LAS float* scr, int lane) {
    float wg[16];
#pragma unroll
    for (int r = 0; r < 16; ++r) wg[r] = wgu[r * 256 + n0 + (lane & 31)];
    LAS float* gb = scr + 64 * 33;
#pragma unroll
    for (int j = 0; j < 4; ++j) { const int idx = lane + 64 * j, kk = idx >> 2, q = idx & 3; *(LAS f32x4*)(gb + kk * 16 + 4 * q) = *(const GAS f32x4*)(win + (size_t)(k0 + kk) * DIN + C_GG + 4 * q); }
    LDS_WAIT(); asm volatile("" ::: "memory");
#pragma unroll 4
    for (int i = 0; i < 32; ++i) { const int kk = 2 * i + (lane >> 5); const LAS f32x4* g4 = (const LAS f32x4*)(gb + kk * 16); float s = 0.f;
#pragma unroll
        for (int q = 0; q < 4; ++q) { const f32x4 g = g4[q]; s += g.x * wg[4 * q] + g.y * wg[4 * q + 1] + g.z * wg[4 * q + 2] + g.w * wg[4 * q + 3]; }
        scr[kk * 33 + (lane & 31)] = s; }
    LDS_WAIT(); asm volatile("" ::: "memory");
    const int c = lane & 7;
#pragma unroll
    for (int j = 0; j < 4; ++j) { const int n = (lane >> 3) + 8 * j; const LAS float* s = scr + (8 * c) * 33 + n;
        v4u o; o.x = pk2(s[0 * 33], s[1 * 33]); o.y = pk2(s[2 * 33], s[3 * 33]); o.z = pk2(s[4 * 33], s[5 * 33]); o.w = pk2(s[6 * 33], s[7 * 33]);
        *(GAS v4u*)(dst + (size_t)n * DM + 8 * c) = o; }
    LDS_WAIT(); asm volatile("" ::: "memory");
}
__device__ __forceinline__ int win_src_col(int T, int p0) {
    if (T < 4) { const int bj = p0 >> 7, wc = (p0 >> 5) & 3; return (T < 2 ? C_DAQ + 256 * T : C_DAK + 256 * (T - 2)) + 64 * wc + 32 * bj; }
    const int pc = 64 * ((p0 >> 5) & 3) + 32 * (p0 >> 7);
    if (T < 6) return C_DAV + 256 * (T - 4) + pc;
    if (T == 6) return C_GQ + pc;
    if (T == 7) return C_GK + pc;
    if (T < 10) return C_GV + 256 * (T - 8) + pc;
    if (T < 12) return C_GR + 256 * (T - 10) + pc;
    const int t = T - 13; return p0 < 128 ? C_GL + 128 * t + p0 : C_GL + 1024 + 128 * t + (p0 - 128);
}
template <int NR, bool F8C> __device__ __forceinline__ void rms_rows_to_bf16(Frame& F, const float* const (&xrow)[NR], const float* gain, bf16* const (&orow)[NR]) {
    const GAS f32x4* gr = (const GAS f32x4*)gain + F.lane;
    f32x4 v[NR][4];
#pragma unroll
    for (int r = 0; r < NR; ++r) { const GAS f32x4* xr = (const GAS f32x4*)xrow[r] + F.lane;
#pragma unroll
        for (int j = 0; j < 4; ++j) v[r][j] = xr[64 * j]; }
#pragma unroll
    for (int r = 0; r < NR; ++r) { float s = 0.f;
#pragma unroll
        for (int j = 0; j < 4; ++j) s += (v[r][j].x * v[r][j].x + v[r][j].y * v[r][j].y) + (v[r][j].z * v[r][j].z + v[r][j].w * v[r][j].w);
        const float rstd = 1.f / sqrtf(wave_sum(s) * (1.f / DM) + EPS);
        GAS unsigned long long* o8 = (GAS unsigned long long*)orow[r] + F.lane;
        GAS unsigned* o4 = (GAS unsigned*)(F.ws + WS_XN8 + (size_t)(((const unsigned char*)orow[r] - (F.ws + WS_R1)) >> 1)) + F.lane;
#pragma unroll
        for (int j = 0; j < 4; ++j) { const f32x4 g = gr[64 * j]; const float y0 = v[r][j].x * rstd * g.x, y1 = v[r][j].y * rstd * g.y, y2 = v[r][j].z * rstd * g.z, y3 = v[r][j].w * rstd * g.w;
            o8[64 * j] = (unsigned long long)pk2(y0, y1) | ((unsigned long long)pk2(y2, y3) << 32);
            if (F8C) o4[64 * j] = pk4_fp8(y0 * X8SCALE, y1 * X8SCALE, y2 * X8SCALE, y3 * X8SCALE); } }
}
constexpr int N_EXPERT_ITEMS = NEXP * 256 + NEXP * 128;
__device__ __forceinline__ void expert_conv_desc(Frame& F, int it, const float*& src, unsigned char*& dst, unsigned& Ns, unsigned& Kd) {
    if (it < NEXP * 256) { const int e = it >> 8, q = it & 255, kb = q >> 4, nbp = q & 15, P0 = nbp * 64, pn = P0 >> 8, p = P0 & 255;
        src = (p < 128 ? F.inp(I_WEG) : F.inp(I_WEU)) + (size_t)e * 1024 * 512 + (size_t)(kb * 64) * 512 + 128 * pn + (p & 127); Ns = 512;
        dst = WSP(unsigned char, WS_WGU) + (size_t)(e * 1024 + P0) * 1024 + kb * 64; Kd = 1024; }
    else { const int r = it - NEXP * 256, e = r >> 7, q = r & 127, kb = q >> 4, nb = q & 15;
        src = F.inp(I_WED) + (size_t)e * 512 * 1024 + (size_t)(kb * 64) * 1024 + nb * 64; Ns = 1024; dst = WSP(unsigned char, WS_WD) + (size_t)(e * 1024 + nb * 64) * 512 + kb * 64; Kd = 512; }
}
__device__ __forceinline__ void expert_conv_store(unsigned char* dst, unsigned Kd, const float (&v)[64], int lane, LAS unsigned char* stg) {
#pragma unroll
    for (int kg = 0; kg < 4; ++kg) { v4u o;
        o.x = pk4_fp8(v[16 * kg] * W8SCALE, v[16 * kg + 1] * W8SCALE, v[16 * kg + 2] * W8SCALE, v[16 * kg + 3] * W8SCALE); o.y = pk4_fp8(v[16 * kg + 4] * W8SCALE, v[16 * kg + 5] * W8SCALE, v[16 * kg + 6] * W8SCALE, v[16 * kg + 7] * W8SCALE);
        o.z = pk4_fp8(v[16 * kg + 8] * W8SCALE, v[16 * kg + 9] * W8SCALE, v[16 * kg + 10] * W8SCALE, v[16 * kg + 11] * W8SCALE); o.w = pk4_fp8(v[16 * kg + 12] * W8SCALE, v[16 * kg + 13] * W8SCALE, v[16 * kg + 14] * W8SCALE, v[16 * kg + 15] * W8SCALE);
        *(LAS v4u*)(stg + lane * 80 + kg * 16) = o; }
    LDS_WAIT(); asm volatile("" ::: "memory");
#pragma unroll
    for (int i = 0; i < 4; ++i) { const int r = (lane >> 2) + 16 * i, c = lane & 3; const v4u o = *(const LAS v4u*)(stg + r * 80 + c * 16); *(GAS v4u*)(dst + (size_t)r * Kd + 16 * c) = o; }
    LDS_WAIT(); asm volatile("" ::: "memory");
}
__device__ __forceinline__ void expert_conv_range(Frame& F, int first, int me, int nw) {
    const int stride = nw; LAS unsigned char* stg = F.lds + RING_OFF + F.wave * 9216;
    for (int it = first + me; it < N_EXPERT_ITEMS; it += 2 * stride) {
        const float *s0, *s1; unsigned char *d0, *d1; unsigned n0, k0, n1, k1; const bool two = it + stride < N_EXPERT_ITEMS;
        expert_conv_desc(F, it, s0, d0, n0, k0); expert_conv_desc(F, two ? it + stride : it, s1, d1, n1, k1);
        float va[64], vb[64];
#pragma unroll
        for (int k = 0; k < 64; ++k) va[k] = s0[(unsigned)k * n0 + (unsigned)F.lane];
        if (two) {
#pragma unroll
            for (int k = 0; k < 64; ++k) vb[k] = s1[(unsigned)k * n1 + (unsigned)F.lane]; }
        expert_conv_store(d0, k0, va, F.lane, stg);
        if (two) expert_conv_store(d1, k1, vb, F.lane, stg);
    }
    asm volatile("s_waitcnt lgkmcnt(0)" ::: "memory"); __syncthreads();
}
__device__ __forceinline__ void expert_conv_slot(Frame& F, int slot, int nslot, int first) { expert_conv_range(F, first, (slot * F.G + F.vcu) * NWAVES + F.wave, nslot * F.G * NWAVES); }
__device__ __forceinline__ void late_tables(Frame& F, int gt, int NGT) {
    { bf16* wh = WSP(bf16, WS_WRH); bf16* wl = WSP(bf16, WS_WRL);
      for (int i = gt; i < 48 * 1024; i += NGT) { const int n = i >> 10, k = i & 1023; const float v = n < 4 ? F.inp(I_WRG)[k * 4 + n] : (n < 36 ? F.inp(I_WRE)[k * 32 + (n - 4)] : 0.f);
          const unsigned h = f2bf(v); const float hf = __uint_as_float(h << 16); wh[i] = (bf16)h; wl[i] = (bf16)f2bf(v - hf); } }
    { float* ig = WSP(float, WS_IG2); for (int i = gt; i < DM; i += NGT) { const float g = F.inp(I_GFFN)[i]; ig[i] = 1.0f / (g * g); } }
    { unsigned* kz = (unsigned*)(WSP(bf16, WS_K) + (size_t)NBATCH * LPB * 512); unsigned* vz = (unsigned*)(WSP(bf16, WS_V) + (size_t)NBATCH * LPB * 512);
      for (int i = gt; i < 64 * 512 / 2; i += NGT) { kz[i] = 0u; vz[i] = 0u; } }
}
#define P1_EXTRA(G) (((MZ / 256) * 13) % (G))
constexpr int P1_TILES_PER_WAVE = 6;
__device__ __forceinline__ int p1_conv_items(int G) { const int ex = P1_EXTRA(G), n = ex ? (G - ex) * NWAVES * P1_TILES_PER_WAVE : 0; return n < N_EXPERT_ITEMS ? n : N_EXPERT_ITEMS; }
__device__ __forceinline__ void expert_conv_first(Frame& F, int me, int nw, int cnt) {
    LAS unsigned char* stg = F.lds + RING_OFF + F.wave * 9216;
    for (int it = me; it < cnt; it += 2 * nw) {
        const float *s0, *s1; unsigned char *d0, *d1; unsigned n0, k0, n1, k1; const bool two = it + nw < cnt;
        expert_conv_desc(F, it, s0, d0, n0, k0); expert_conv_desc(F, two ? it + nw : it, s1, d1, n1, k1);
        float va[64], vb[64];
#pragma unroll
        for (int k = 0; k < 64; ++k) va[k] = s0[(unsigned)k * n0 + (unsigned)F.lane];
        if (two) {
#pragma unroll
            for (int k = 0; k < 64; ++k) vb[k] = s1[(unsigned)k * n1 + (unsigned)F.lane]; }
        expert_conv_store(d0, k0, va, F.lane, stg);
        if (two) expert_conv_store(d1, k1, vb, F.lane, stg);
    }
}
__device__ __forceinline__ void p0_prologue(Frame& F) {
    LAS float* scr = (LAS float*)(F.lds + RING_OFF + F.wave * 16384);
    const int gw = F.vcu * NWAVES + F.wave, NGW = F.G * NWAVES;
    constexpr int I_A = (NZ / 32) * 16, I_B = 2 * 32 * 8, I_C = 32 * 16, NITEMS = I_A + I_B + I_C;
    bf16* WIN = WSP(bf16, WS_WIN);
    for (int it = gw; it < NITEMS; it += NGW) {
        int r = it; const float* src; bf16* dst; int Ns, Kd; bool f8 = false;
        if (r < I_A) { const int kb = r / (NZ / 32), nb = r % (NZ / 32), T = nb >> 3, p0 = (nb & 7) * 32; dst = WIN + (size_t)(nb * 32) * DM + kb * 64;
            if (T == 12) { product_tile(F.inp(I_WIN), F.inp(I_WGUP), kb * 64, p0, dst, scr, F.lane); continue; }
            src = F.inp(I_WIN) + (size_t)(kb * 64) * DIN + win_src_col(T, p0); Ns = DIN; Kd = DM;
            if (T > 12) { f8 = true; dst = (bf16*)(WSP(unsigned char, WS_WIN8) + (size_t)((nb - 104) * 32) * DM + kb * 64); Kd = DM / 2; } }
        else if ((r -= I_A) < I_B) { const int br = r >> 8, q = r & 255, kb = q >> 5, nb = q & 31;
            src = F.inp(I_WBR) + (size_t)br * 512 * 1024 + (size_t)(kb * 64) * 1024 + nb * 32; Ns = 1024; dst = WSP(bf16, WS_WBR) + (size_t)(br * 1024 + nb * 32) * 512 + kb * 64; Kd = 512; }
        else { r -= I_B; const int kb = r >> 5, nb = r & 31;
            src = F.inp(I_WOUT) + (size_t)(kb * 64) * 1024 + nb * 32; Ns = 1024; dst = WSP(bf16, WS_WOUT) + (size_t)(nb * 32) * 1024 + kb * 64; Kd = 1024; }
        transpose_tile(src, Ns, (unsigned char*)dst, (unsigned)Kd * 2u, f8, scr, F.lane);
    }
#ifdef PROBE_K
    if (PROBE_K == 100 && blockIdx.x == 0 && F.tid == 0) ((volatile LAS unsigned long long*)(F.lds + LDSCTL_OFF + 2048))[1] = __builtin_amdgcn_s_memrealtime();
#endif
    bf16* XN = WSP(bf16, WS_R1);
    for (int m = gw; m < MROWS; m += 4 * NGW) {
        if (m + 3 * NGW < MROWS) { const float* const xr[4] = {F.inp(I_X) + (size_t)m * DM, F.inp(I_X) + (size_t)(m + NGW) * DM, F.inp(I_X) + (size_t)(m + 2 * NGW) * DM, F.inp(I_X) + (size_t)(m + 3 * NGW) * DM};
            bf16* const orr[4] = {XN + (size_t)m * DM, XN + (size_t)(m + NGW) * DM, XN + (size_t)(m + 2 * NGW) * DM, XN + (size_t)(m + 3 * NGW) * DM}; rms_rows_to_bf16<4, true>(F, xr, F.inp(I_GMIX), orr); }
        else for (int k = 0; k < 4; ++k) { const int mm = m + k * NGW; if (mm < MROWS) { const float* const xr[1] = {F.inp(I_X) + (size_t)mm * DM}; bf16* const orr[1] = {XN + (size_t)mm * DM}; rms_rows_to_bf16<1, true>(F, xr, F.inp(I_GMIX), orr); } }
    }
    for (int m = MROWS + gw; m < MZ; m += NGW) {
        if (m < MROWS + NMETA) { const float* const xr[1] = {F.inp(I_META) + (size_t)(m - MROWS) * DM}; bf16* const orr[1] = {XN + (size_t)m * DM}; rms_rows_to_bf16<1, false>(F, xr, F.inp(I_GMIX), orr); }
        else { GAS v4u* o = (GAS v4u*)(XN + (size_t)m * DM) + F.lane; o[0] = (v4u){0u, 0u, 0u, 0u}; o[64] = (v4u){0u, 0u, 0u, 0u}; }
    }
#ifdef PROBE_K
    if (PROBE_K == 101 && blockIdx.x == 0 && F.tid == 0) ((volatile LAS unsigned long long*)(F.lds + LDSCTL_OFF + 2048))[1] = __builtin_amdgcn_s_memrealtime();
#endif
    const int gt = gw * 64 + F.lane, NGT = NGW * 64;
    { float* rc = WSP(float, WS_ROPE); float* rs = rc + NPOS * 32;
      for (int i = gt; i < NPOS * 32; i += NGT) { const int pos = i >> 5, j = i & 31; const float inv = exp2f(-(float)j * 0.41524101186092029f); const float ang = (float)pos * inv;
          const double rev = (double)ang * 0.15915494309189535; const float x = (float)(rev - rint(rev));
          rc[i] = __builtin_amdgcn_cosf(x); rs[i] = __builtin_amdgcn_sinf(x); } }
}
namespace epi {
using pg8::f32x4; using pg8::u32x4; using pg8::Unit; using pg8::pack8; using pg8::HALF;
__device__ __forceinline__ unsigned pk4_fp8(float a, float b, float c, float d) { unsigned w = 0; w = __builtin_amdgcn_cvt_pk_fp8_f32(clamp8(a), clamp8(b), w, false); w = __builtin_amdgcn_cvt_pk_fp8_f32(clamp8(c), clamp8(d), w, true); return w; }
constexpr float Y8SCALE = 64.0f;
__device__ __forceinline__ float cy8(float y) { return y * Y8SCALE; }
__device__ __forceinline__ f32x4 un4_fp8(unsigned w) { typedef float f2_ __attribute__((ext_vector_type(2))); const f2_ a = __builtin_amdgcn_cvt_pk_f32_fp8(w, false), b = __builtin_amdgcn_cvt_pk_f32_fp8(w, true); return (f32x4){a[0], a[1], b[0], b[1]}; }
__device__ __forceinline__ float c8(float h) { return h * H8SCALE; }
__device__ __forceinline__ float log_sigmoid(float x) { return fminf(x, 0.f) - __logf(1.0f + __expf(-fabsf(x))); }

constexpr int EPI_STG_OFF = 3 * pg8::HTB;
__device__ __forceinline__ void st_rows16(LAS unsigned char* S, int lane, const u32x4 w0, int q0, const u32x4 w1, int q1, unsigned char* gbase, unsigned pitchB) {
    const int fr = lane & 15, rr = lane >> 3, qq = lane & 7;
    LAS unsigned char* wp = S + (fr >> 3) * 8192 + (fr & 7) * 128;
    *(LAS u32x4*)(wp + ((q0 ^ (fr & 7)) << 4)) = w0; *(LAS u32x4*)(wp + ((q1 ^ (fr & 7)) << 4)) = w1;
    asm volatile("s_waitcnt lgkmcnt(0)" ::: "memory");
    const LAS unsigned char* rp = S + rr * 128 + ((qq ^ rr) << 4);
    const u32x4 a = *(const LAS u32x4*)rp, b = *(const LAS u32x4*)(rp + 8192);
    unsigned char* gp = gbase + (unsigned)rr * pitchB + qq * 16;
    *(u32x4*)gp = a; *(u32x4*)(gp + 8 * pitchB) = b;
}
struct EpiZ {
    bf16 *Q, *K, *V, *GQ, *GK, *GV, *GR; float* LOGA;
    const float *gq, *gk, *bgate, *ropec, *ropes; LAS unsigned char* stg;
    __device__ __forceinline__ bool operator()(f32x4 (&acc)[2][2][4][2], const Unit& u, int wr, int wc, int fr, int fq) const {
        const int pn = u.pn, pm = u.pm; const bool meta = (pm == MROWS / 256);
        int oz; asm volatile("v_mov_b32 %0, 0" : "=v"(oz));
        const int r0 = wr * 64 + fr + oz, cl = wc * 32 + 8 * fq, ln = fr + 16 * fq + oz;
        const int bsh = 64 * ((pm >> 4) + 1);
        LAS unsigned char* S = stg + (wr * 4 + wc) * 1024;
        if (pn < 4) {
            const bool isq = pn < 2; if (isq && meta) return false;
            const float* gn = isq ? gq : gk;
            const f32x4 ga0 = *(const f32x4*)(gn + 8 * fq), ga1 = *(const f32x4*)(gn + 8 * fq + 4), gb0 = *(const f32x4*)(gn + 32 + 8 * fq), gb1 = *(const f32x4*)(gn + 36 + 8 * fq);
            const int hc0 = ((pn & 1) * 4 + wc) * 64, hcol = hc0 + 8 * fq;
            const float osc = isq ? 0.125f * 1.4426950408889634f : 1.0f;
#pragma unroll
            for (int ai = 0; ai < 2; ++ai)
#pragma unroll
                for (int m = 0; m < 4; ++m) {
                    if (meta && (ai != 0 || wr != 0)) continue;
                    const int r = r0 + ai * HALF + m * 16;
                    const f32x4 x1a = acc[ai][0][m][0], x1b = acc[ai][0][m][1], x2a = acc[ai][1][m][0], x2b = acc[ai][1][m][1];
                    float ss = (x1a[0] * x1a[0] + x1a[1] * x1a[1]) + (x1a[2] * x1a[2] + x1a[3] * x1a[3]) + (x1b[0] * x1b[0] + x1b[1] * x1b[1]) + (x1b[2] * x1b[2] + x1b[3] * x1b[3])
                             + (x2a[0] * x2a[0] + x2a[1] * x2a[1]) + (x2a[2] * x2a[2] + x2a[3] * x2a[3]) + (x2b[0] * x2b[0] + x2b[1] * x2b[1]) + (x2b[2] * x2b[2] + x2b[3] * x2b[3]);
                    ss += __shfl_xor(ss, 16); ss += __shfl_xor(ss, 32);
                    const float rn = 1.0f / sqrtf(ss * (1.0f / 64.0f) + EPS);
                    const int pos = meta ? r : NMETA + ((pm * 256 + r) & (SEQ - 1));
                    const f32x4 c0 = *(const f32x4*)(ropec + pos * 32 + 8 * fq), c1 = *(const f32x4*)(ropec + pos * 32 + 8 * fq + 4), s0 = *(const f32x4*)(ropes + pos * 32 + 8 * fq), s1 = *(const f32x4*)(ropes + pos * 32 + 8 * fq + 4);
                    const f32x4 y1a = x1a * rn * ga0, y1b = x1b * rn * ga1, y2a = x2a * rn * gb0, y2b = x2b * rn * gb1;
                    const f32x4 o1a = (y1a * c0 - y2a * s0) * osc, o1b = (y1b * c1 - y2b * s1) * osc, o2a = (y2a * c0 + y1a * s0) * osc, o2b = (y2b * c1 + y1b * s1) * osc;
                    const u32x4 w1 = pack8(o1a, o1b), w2 = pack8(o2a, o2b);
                    const int rg = wr * 64 + ai * HALF + m * 16;
                    if (isq) st_rows16(S, ln, w1, fq, w2, 4 + fq, (unsigned char*)(Q + (size_t)(pm * 256 + rg) * 512 + hc0), 1024u);
                    else if (!meta) st_rows16(S, ln, w1, fq, w2, 4 + fq, (unsigned char*)(K + (size_t)(pm * 256 + rg + bsh) * 512 + hc0), 1024u);
                    else { for (int b = 0; b < NBATCH; ++b) { bf16* p = K + (size_t)(b * LPB + r) * 512 + hcol; *(u32x4*)p = w1; *(u32x4*)(p + 32) = w2; } }
                    asm volatile("" ::: "memory");
                }
            return false;
        }
        if (pn < 12) {
            long long toff; int pitch, cb; float sc = 1.0f; bool wmeta = true;
            if (pn < 6) { toff = 0; pitch = 512; cb = (pn - 4) * 256; }
            else if (pn == 6) { toff = (long long)WS_GQ - (long long)WS_V; pitch = 256; cb = 0; sc = 0.125f; wmeta = false; }
            else if (pn == 7) { toff = (long long)WS_GK - (long long)WS_V; pitch = 256; cb = 0; }
            else if (pn < 10) { toff = (long long)WS_GV - (long long)WS_V; pitch = 512; cb = (pn - 8) * 256; }
            else { toff = (long long)WS_GR - (long long)WS_V; pitch = 512; cb = (pn - 10) * 256; wmeta = false; }
            bf16* T = (bf16*)((unsigned char*)V + toff);
            if (meta && !wmeta) return false;
#pragma unroll
            for (int ai = 0; ai < 2; ++ai)
#pragma unroll
                for (int m = 0; m < 4; ++m) {
                    if (meta && (ai != 0 || wr != 0)) continue;
                    const int r = r0 + ai * HALF + m * 16;
                    const u32x4 w0 = pack8(acc[ai][0][m][0] * sc, acc[ai][0][m][1] * sc), w1 = pack8(acc[ai][1][m][0] * sc, acc[ai][1][m][1] * sc); const int col = cb + 64 * wc + 8 * fq;
                    if (!meta) st_rows16(S, ln, w0, fq, w1, 4 + fq, (unsigned char*)(T + (size_t)(pm * 256 + wr * 64 + ai * HALF + m * 16 + bsh) * pitch + cb + 64 * wc), (unsigned)pitch * 2u);
                    else for (int b = 0; b < NBATCH; ++b) { bf16* p = T + (size_t)(b * LPB + r) * pitch + col; *(u32x4*)p = w0; *(u32x4*)(p + 32) = w1; }
                    asm volatile("" ::: "memory");
                }
            return false;
        }
        if (pn == 12) {
#pragma unroll
            for (int bj = 0; bj < 2; ++bj) { const int col = bj * HALF + cl; const f32x4 b0 = *(const f32x4*)(bgate + col), b1 = *(const f32x4*)(bgate + col + 4);
#pragma unroll
                for (int ai = 0; ai < 2; ++ai)
#pragma unroll
                    for (int m = 0; m < 4; ++m) {
                        if (meta && (ai != 0 || wr != 0)) continue;
                        const int r = r0 + ai * HALF + m * 16; const f32x4 a0 = acc[ai][bj][m][0] + b0, a1 = acc[ai][bj][m][1] + b1; f32x4 v0, v1;
#pragma unroll
                        for (int i = 0; i < 4; ++i) { v0[i] = log_sigmoid(a0[i]) * (1.0f / 16.0f); v1[i] = log_sigmoid(a1[i]) * (1.0f / 16.0f); }
                        if (!meta) st_rows16(S, ln, __builtin_bit_cast(u32x4, v0), 2 * fq, __builtin_bit_cast(u32x4, v1), 2 * fq + 1, (unsigned char*)(LOGA + (size_t)(pm * 256 + wr * 64 + ai * HALF + m * 16 + bsh) * 256 + bj * HALF + wc * 32), 1024u);
                        else { if (r >= NMETA) { v0 = (f32x4){0.f, 0.f, 0.f, 0.f}; v1 = v0; }
                               for (int b = 0; b < NBATCH; ++b) { float* p = LOGA + (size_t)(b * LPB + r) * 256 + col; *(f32x4*)p = v0; *(f32x4*)(p + 4) = v1; } }
                        asm volatile("" ::: "memory");
                    } }
            return false;
        }
        return false;
    }
};
struct EpiGates {
    bf16 *RATIO, *G1; const LAS float* bml; float zs;
    __device__ __forceinline__ bool operator()(f32x4 (&acc)[2][2][4][2], const Unit& u, int wr, int wc, int fr, int fq) const {
        int oz; asm volatile("v_mov_b32 %0, 0" : "=v"(oz));
        const int d = 128 * u.pn + wc * 32 + 8 * fq, ln = fr + 16 * fq + oz;
#pragma unroll
        for (int bj = 0; bj < 2; ++bj) { const f32x4 b0 = *(const LAS f32x4*)(bml + bj * DM + d), b1 = *(const LAS f32x4*)(bml + bj * DM + d + 4);
#pragma unroll
            for (int ai = 0; ai < 2; ++ai)
#pragma unroll
                for (int m = 0; m < 4; ++m) { const f32x4 x0 = acc[ai][bj][m][0] * zs + b0, x1 = acc[ai][bj][m][1] * zs + b1;
#pragma unroll
                    for (int i = 0; i < 4; ++i) { acc[ai][bj][m][0][i] = 1.0f + __expf(-x0[i]); acc[ai][bj][m][1][i] = 1.0f + __expf(-x1[i]); } }
            asm volatile("" ::: "memory"); }
#pragma unroll
        for (int ai = 0; ai < 2; ++ai)
#pragma unroll
            for (int m = 0; m < 4; ++m) { f32x4 ra, rb, ga, gb;
#pragma unroll
                for (int i = 0; i < 4; ++i) { ra[i] = acc[ai][1][m][0][i] * __builtin_amdgcn_rcpf(acc[ai][0][m][0][i]); ga[i] = __builtin_amdgcn_rcpf(acc[ai][1][m][0][i]);
                                              rb[i] = acc[ai][1][m][1][i] * __builtin_amdgcn_rcpf(acc[ai][0][m][1][i]); gb[i] = __builtin_amdgcn_rcpf(acc[ai][1][m][1][i]); }
                const size_t o = (size_t)((u.pm * 16 + wr * 4 + ai * 8 + m) * 32 + 4 * u.pn + wc) * 512 + ln * 8; *(u32x4*)(RATIO + o) = pack8(ra, rb); *(u32x4*)(G1 + o) = pack8(ga, gb); asm volatile("" ::: "memory"); }
        return false;
    }
};
struct EpiMerge {
    const bf16 *RATIO, *G1; bf16* MERGED;
    __device__ __forceinline__ bool operator()(f32x4 (&acc)[2][2][4][2], const Unit& u, int wr, int wc, int fr, int fq) const {
        const int br = u.aux, pm = u.pm - (MROWS / 256) * br, pn = u.pn - 4 * br;
        const int r0 = pm * 256 + wr * 64 + fr, c0 = pn * 256 + wc * 32 + 8 * fq;
        const bf16* src = br ? G1 : RATIO;
#pragma unroll
        for (int ai = 0; ai < 2; ++ai) { u32x4 g[4][2];
#pragma unroll
            for (int m = 0; m < 4; ++m)
#pragma unroll
                for (int bj = 0; bj < 2; ++bj) g[m][bj] = *(const u32x4*)(src + (size_t)((pm * 16 + wr * 4 + ai * 8 + m) * 32 + pn * 8 + bj * 4 + wc) * 512 + (fr + 16 * fq) * 8);
#pragma unroll
            for (int m = 0; m < 4; ++m)
#pragma unroll
                for (int bj = 0; bj < 2; ++bj) { const size_t o = (size_t)(r0 + ai * HALF + m * 16) * DM + c0 + bj * HALF; const u32x4 gg = g[m][bj];
                    const f32x4 g0 = {pg8::bf_lo(gg.x), pg8::bf_hi(gg.x), pg8::bf_lo(gg.y), pg8::bf_hi(gg.y)}, g1 = {pg8::bf_lo(gg.z), pg8::bf_hi(gg.z), pg8::bf_lo(gg.w), pg8::bf_hi(gg.w)};
                    const f32x4 v0 = acc[ai][bj][m][0] * g0, v1 = acc[ai][bj][m][1] * g1;
                    if (br) *(u32x4*)(MERGED + o) = pack8(v0, v1); else { acc[ai][bj][m][0] = v0; acc[ai][bj][m][1] = v1; } }
            asm volatile("" ::: "memory"); }
        return br == 0;
    }
};
struct EpiOut {
    const float* x; bf16* H2U; const float* gffn; unsigned char* H2U8;
    __device__ __forceinline__ bool operator()(f32x4 (&acc)[2][2][4][2], const Unit& u, int wr, int wc, int fr, int fq) const {
        const int r0 = u.pm * 256 + wr * 64 + fr, c0 = u.pn * 256 + wc * 32 + 8 * fq;
#pragma unroll
        for (int bj = 0; bj < 2; ++bj) { const f32x4 ga = *(const f32x4*)(gffn + c0 + bj * HALF), gb = *(const f32x4*)(gffn + c0 + bj * HALF + 4);
#pragma unroll
            for (int ai = 0; ai < 2; ++ai) { f32x4 xa[4], xb[4];
#pragma unroll
                for (int m = 0; m < 4; ++m) { const size_t o = (size_t)(r0 + ai * HALF + m * 16) * DM + c0 + bj * HALF; xa[m] = *(const f32x4*)(x + o); xb[m] = *(const f32x4*)(x + o + 4); }
#pragma unroll
                for (int m = 0; m < 4; ++m) { const size_t o = (size_t)(r0 + ai * HALF + m * 16) * DM + c0 + bj * HALF;
                    const f32x4 u0 = xa[m] + acc[ai][bj][m][0], u1 = xb[m] + acc[ai][bj][m][1];
                    const f32x4 h0 = u0 * ga, h1 = u1 * gb; *(u32x4*)(H2U + o) = pack8(h0, h1); *(pg8::u32x2*)(H2U8 + o) = (pg8::u32x2){pk4_fp8(h0[0], h0[1], h0[2], h0[3]), pk4_fp8(h1[0], h1[1], h1[2], h1[3])}; }
                asm volatile("" ::: "memory"); } }
        return false;
    }
};
template <bool GATHER_> struct MoeSched {
    static constexpr bool GATHER = GATHER_;
    const LAS int* tb; const LAS int* cn; const int* ltok; int seg_lo, seg_hi, G, c;
    __device__ __forceinline__ bool next(int i, Unit& u) const {
        const int t0 = __builtin_amdgcn_readfirstlane(tb[seg_lo]), t1 = __builtin_amdgcn_readfirstlane(tb[seg_hi]);
        const int U = (t1 - t0) * 4, R = U / G, r = U - R * G; int L, hf = 0;
        if (i < R) L = i * G + c;
        else if (i > R) return false;
        else if (2 * r <= G) { if (c >= 2 * r) return false; L = R * G + (c >> 1); hf = 1 + (c & 1); }
        else { if (c >= r) return false; L = R * G + c; }
        const int rt = t0 + (L >> 2), pnl = L & 3; int s = seg_lo, hi_ = seg_hi;
        while (hi_ - s > 1) { const int mid = (s + hi_) >> 1; if (__builtin_amdgcn_readfirstlane(tb[mid]) <= rt) s = mid; else hi_ = mid; }
        u.pm = rt; u.pn = (s & 31) * 4 + pnl; u.aux = s | ((rt - __builtin_amdgcn_readfirstlane(tb[s])) << 8); u.half = hf; return true;
    }
    __device__ __forceinline__ int grow(const Unit& u, int r) const { const int s = u.aux & 255, si = (u.aux >> 8) * 256 + r, last = cn[s] - 1; return ltok[(size_t)s * LCAP + (si < last ? si : last)]; }
};
struct EpiUp {
    const LAS int* cn; const float* lrs; unsigned char* HID;
    __device__ __forceinline__ bool operator()(f32x4 (&acc)[2][2][4][2], const Unit& u, int wr, int wc, int fr, int fq) const {
        const int s = u.aux & 255, rtl = u.aux >> 8, last = cn[s] - 1, pnl = u.pn & 3; float rsv[2][4];
#pragma unroll
        for (int ai = 0; ai < 2; ++ai)
#pragma unroll
            for (int m = 0; m < 4; ++m) { if (u.half == 2 - ai) { rsv[ai][m] = 0.f; continue; } const int si = rtl * 256 + wr * 64 + fr + ai * HALF + m * 16; rsv[ai][m] = lrs[(size_t)s * LCAP + (si < last ? si : last)] * (1.0f / W8SCALE); }
#pragma unroll
        for (int ai = 0; ai < 2; ++ai)
#pragma unroll
            for (int m = 0; m < 4; ++m) { if (u.half == 2 - ai) continue; const int r = wr * 64 + fr + ai * HALF + m * 16; const float rs = rsv[ai][m];
                f32x4 h0, h1;
#pragma unroll
                for (int i = 0; i < 4; ++i) { const float g0 = acc[ai][0][m][0][i] * rs, g1 = acc[ai][0][m][1][i] * rs;
                    h0[i] = g0 * __builtin_amdgcn_rcpf(1.0f + __expf(-g0)) * (acc[ai][1][m][0][i] * rs); h1[i] = g1 * __builtin_amdgcn_rcpf(1.0f + __expf(-g1)) * (acc[ai][1][m][1][i] * rs); }
                *(pg8::u32x2*)(HID + (size_t)(u.pm * 256 + r) * DEXP + pnl * 128 + wc * 32 + 8 * fq) = (pg8::u32x2){pk4_fp8(c8(h0[0]), c8(h0[1]), c8(h0[2]), c8(h0[3])), pk4_fp8(c8(h1[0]), c8(h1[1]), c8(h1[2]), c8(h1[3]))}; }
        return false;
    }
};
template <int MODE> struct EpiDown {
    const LAS int* cn; const int* ltok; const float* lw; float* out; unsigned char* Y0; float* trash; const bf16* H2U; const float* gffn;
    __device__ __forceinline__ bool operator()(f32x4 (&acc)[2][2][4][2], const Unit& u, int wr, int wc, int fr, int fq) const {
        const int s = u.aux & 255, rtl = u.aux >> 8, cnt = cn[s], pnl = u.pn & 3; int tok[2][4]; float wv[2][4];
#pragma unroll
        for (int ai = 0; ai < 2; ++ai)
#pragma unroll
            for (int m = 0; m < 4; ++m) { const int si = rtl * 256 + wr * 64 + fr + ai * HALF + m * 16, sc = si < cnt ? si : cnt - 1; tok[ai][m] = ltok[(size_t)s * LCAP + sc]; wv[ai][m] = lw[(size_t)s * LCAP + sc] * (1.0f / (W8SCALE * H8SCALE)); }
        const int cofs = pnl * 256 + wc * 32 + 8 * fq;
        f32x4 ig[2][2];
        if (MODE == 1) {
#pragma unroll
            for (int bj = 0; bj < 2; ++bj)
#pragma unroll
                for (int n = 0; n < 2; ++n) { const f32x4 g = *(const f32x4*)(gffn + cofs + bj * HALF + 4 * n); ig[bj][n] = (f32x4){__builtin_amdgcn_rcpf(g[0]), __builtin_amdgcn_rcpf(g[1]), __builtin_amdgcn_rcpf(g[2]), __builtin_amdgcn_rcpf(g[3])}; } }
#pragma unroll
        for (int ai = 0; ai < 2; ++ai)
#pragma unroll
            for (int mp = 0; mp < 4; mp += 2) { if (u.half == 2 - ai) continue; float* po[2]; unsigned char* py[2]; const bf16* ph[2]; pg8::u32x2 yv[2][2]; u32x4 hv[2][2];
#pragma unroll
                for (int k = 0; k < 2; ++k) { const int m = mp + k, si = rtl * 256 + wr * 64 + fr + ai * HALF + m * 16; const bool ok = si < cnt;
                    po[k] = ok ? out + (size_t)tok[ai][m] * DM + cofs : trash + cofs; py[k] = ok ? Y0 + (size_t)tok[ai][m] * DM + cofs : (unsigned char*)(trash + DM) + cofs; ph[k] = H2U + (size_t)tok[ai][m] * DM + cofs; }
                if (MODE == 1) {
#pragma unroll
                    for (int k = 0; k < 2; ++k)
#pragma unroll
                        for (int bj = 0; bj < 2; ++bj) { yv[k][bj] = *(const pg8::u32x2*)(py[k] + bj * HALF); hv[k][bj] = *(const u32x4*)(ph[k] + bj * HALF); } }
#pragma unroll
                for (int k = 0; k < 2; ++k) { const int m = mp + k; const float w = wv[ai][m];
#pragma unroll
                    for (int bj = 0; bj < 2; ++bj) {
                        if (MODE == 0) { const f32x4 a0 = acc[ai][bj][m][0] * w, a1 = acc[ai][bj][m][1] * w; *(pg8::u32x2*)(py[k] + bj * HALF) = (pg8::u32x2){pk4_fp8(cy8(a0[0]), cy8(a0[1]), cy8(a0[2]), cy8(a0[3])), pk4_fp8(cy8(a1[0]), cy8(a1[1]), cy8(a1[2]), cy8(a1[3]))}; }
                        else { const pg8::u32x2 y = yv[k][bj]; const u32x4 h = hv[k][bj]; float* p = po[k] + bj * HALF;
                            const f32x4 ya = un4_fp8(y.x) * (1.0f / Y8SCALE), yb = un4_fp8(y.y) * (1.0f / Y8SCALE);
                            const f32x4 ha = {pg8::bf_lo(h.x), pg8::bf_hi(h.x), pg8::bf_lo(h.y), pg8::bf_hi(h.y)}, hb = {pg8::bf_lo(h.z), pg8::bf_hi(h.z), pg8::bf_lo(h.w), pg8::bf_hi(h.w)};
                            *(f32x4*)p = (ha * ig[bj][0] + ya) + acc[ai][bj][m][0] * w; *(f32x4*)(p + 4) = (hb * ig[bj][1] + yb) + acc[ai][bj][m][1] * w; } } }
                asm volatile("" ::: "memory"); }
        return false;
    }
};
}
constexpr int GP = 144;
typedef LAS unsigned char* ldsp;
__device__ __forceinline__ pg8::bf16x8 ldfrag(ldsp base, int row, int ks, int fq) { return *(const LAS pg8::bf16x8*)(base + row * GP + ks * 64 + fq * 16); }
#define MFMA16(a, b, c) __builtin_amdgcn_mfma_f32_16x16x32_bf16((a), (b), (c), 0, 0, 0)
constexpr size_t WS_O0 = WS_DS, WS_QD = WS_DS + 32 * MiB, WS_GG = WS_DS + 48 * MiB, WS_GD = WS_DS + 56 * MiB;
__device__ __forceinline__ void gla_x(Frame& F, int unit) {
    const int bh = unit >> 3, g = unit & 7, b = bh >> 2, h = bh & 3, d = F.tid & 63, tq = F.wave, fr = F.lane & 15, fq = F.lane >> 4;
    LAS float* part = (LAS float*)(F.lds + 0); LAS float* TOT = (LAS float*)(F.lds + 2048);
    const ldsp QT = F.lds + 4096, KT = F.lds + 13312, AH = F.lds + 22528, VT = F.lds + 31744, SB = F.lds + 50176, PP = F.lds + 68608;
    for (int i = F.tid; i < 128 * GP / 4; i += NWAVES * 64) ((LAS unsigned*)SB)[i] = 0u;
    pg8::f32x4 accS[4];
#pragma unroll
    for (int db = 0; db < 4; ++db) accS[db] = (pg8::f32x4){0.f, 0.f, 0.f, 0.f};
    float cd = 1.0f;
    const int c_first = g ? 8 * g + 1 : 0, c_last = 8 * g + 8;
    bf16* QD = WSP(bf16, WS_QD); bf16* O0 = WSP(bf16, WS_O0);
    const float* LOGA = WSP(float, WS_LOGA); const bf16* GQ = WSP(bf16, WS_GQ); const bf16* GK = WSP(bf16, WS_GK); const bf16* GV = WSP(bf16, WS_GV);
    float an[8]; bf16 qn[8], kn[8]; v4u vn[2];
#define GX_LOAD(cc) do { const size_t ro_ = (size_t)(b * LPB + 64 * (cc) + 8 * tq) * 256 + h * 64 + d; \
        _Pragma("unroll") for (int i_ = 0; i_ < 8; ++i_) { an[i_] = LOGA[ro_ + i_ * 256]; qn[i_] = GQ[ro_ + i_ * 256]; kn[i_] = GK[ro_ + i_ * 256]; } \
        _Pragma("unroll") for (int j_ = 0; j_ < 2; ++j_) { const int p_ = F.tid + 512 * j_; vn[j_] = *(const GAS v4u*)(GV + (size_t)(b * LPB + 64 * (cc) + (p_ >> 4)) * 512 + h * 128 + (p_ & 15) * 8); } } while (0)
    GX_LOAD(c_first);
    for (int c = c_first; c <= c_last; ++c) {
        const int mrow0 = b * SEQ + 64 * (c - 1);
        float bt[8]; bt[0] = an[0];
#pragma unroll
        for (int i = 1; i < 8; ++i) bt[i] = bt[i - 1] + an[i];
        part[tq * 64 + d] = bt[7];
        __syncthreads();
        float off = 0.f, tot = 0.f;
#pragma unroll
        for (int j = 0; j < 8; ++j) { const float p = part[j * 64 + d]; tot += p; if (j < tq) off += p; }
        if (tq == 0) TOT[d] = tot;
        float kh[8];
#pragma unroll
        for (int i = 0; i < 8; ++i) { const float bti = bt[i] + off; const float kk = bf2f(kn[i]); const float qv = bf2f(qn[i]) * __expf(bti), kv = kk * __expf(fminf(-bti, 80.f)); kh[i] = kk * __expf(tot - bti);
            *(LAS bf16*)(QT + (8 * tq + i) * GP + d * 2) = (bf16)f2bf(qv); *(LAS bf16*)(KT + (8 * tq + i) * GP + d * 2) = (bf16)f2bf(kv);
            if (c >= 1) QD[(size_t)(mrow0 + 8 * tq + i) * 256 + h * 64 + d] = (bf16)f2bf(qv * cd); }
        { v4u w; w.x = pk2(kh[0], kh[1]); w.y = pk2(kh[2], kh[3]); w.z = pk2(kh[4], kh[5]); w.w = pk2(kh[6], kh[7]); *(LAS v4u*)(AH + d * GP + tq * 16) = w; }
        cd *= __expf(tot);
#pragma unroll
        for (int j = 0; j < 2; ++j) { const int p = F.tid + 512 * j, sv = p >> 4, ec = p & 15; const unsigned ww[4] = {vn[j].x, vn[j].y, vn[j].z, vn[j].w};
#pragma unroll
            for (int i = 0; i < 4; ++i) { *(LAS bf16*)(VT + (8 * ec + 2 * i) * GP + sv * 2) = (bf16)(ww[i] & 0xffffu); *(LAS bf16*)(VT + (8 * ec + 2 * i + 1) * GP + sv * 2) = (bf16)(ww[i] >> 16); } }
        if (c < c_last) GX_LOAD(c + 1);
        __syncthreads();
        const int tb = tq >> 1, t0 = 16 * tb, t = t0 + fr;
#pragma unroll
        for (int sbi = 0; sbi < 2; ++sbi) { const int s0 = 16 * (2 * (tq & 1) + sbi); pg8::f32x4 a = {0.f, 0.f, 0.f, 0.f};
#pragma unroll
            for (int ks = 0; ks < 2; ++ks) a = MFMA16(ldfrag(KT, s0 + fr, ks, fq), ldfrag(QT, t0 + fr, ks, fq), a);
            const int s = s0 + 4 * fq;
            const float p0 = (s + 0 <= t) ? a[0] : 0.f, p1 = (s + 1 <= t) ? a[1] : 0.f, p2 = (s + 2 <= t) ? a[2] : 0.f, p3 = (s + 3 <= t) ? a[3] : 0.f;
            *(LAS unsigned*)(PP + t * GP + s * 2) = pk2(p0, p1); *(LAS unsigned*)(PP + t * GP + s * 2 + 4) = pk2(p2, p3); }
#pragma unroll
        for (int db = 0; db < 4; ++db) { const pg8::f32x4 tv = *(const LAS pg8::f32x4*)(TOT + 16 * db + 4 * fq);
            accS[db][0] *= __expf(tv[0]); accS[db][1] *= __expf(tv[1]); accS[db][2] *= __expf(tv[2]); accS[db][3] *= __expf(tv[3]); }
#pragma unroll
        for (int ks = 0; ks < 2; ++ks) { const pg8::bf16x8 bfr = ldfrag(VT, 16 * tq + fr, ks, fq);
#pragma unroll
            for (int db = 0; db < 4; ++db) accS[db] = MFMA16(ldfrag(AH, 16 * db + fr, ks, fq), bfr, accS[db]); }
        __syncthreads();
        if (c >= 1) {
            const int eh = tq & 1; pg8::f32x4 o[4];
#pragma unroll
            for (int eb = 0; eb < 4; ++eb) o[eb] = (pg8::f32x4){0.f, 0.f, 0.f, 0.f};
#pragma unroll
            for (int ks = 0; ks < 4; ++ks) { const pg8::bf16x8 bfr = ks < 2 ? ldfrag(PP, t0 + fr, ks, fq) : ldfrag(QT, t0 + fr, ks - 2, fq);
#pragma unroll
                for (int eb = 0; eb < 4; ++eb) { const int e0 = 64 * eh + 16 * eb; o[eb] = MFMA16(ks < 2 ? ldfrag(VT, e0 + fr, ks, fq) : ldfrag(SB, e0 + fr, ks - 2, fq), bfr, o[eb]); } }
            bf16* op = O0 + (size_t)(mrow0 + t) * 512 + h * 128 + 64 * eh + 4 * fq;
#pragma unroll
            for (int eb = 0; eb < 4; ++eb) *(GAS unsigned long long*)(op + 16 * eb) = (unsigned long long)pk2(o[eb][0], o[eb][1]) | ((unsigned long long)pk2(o[eb][2], o[eb][3]) << 32);
        }
        __syncthreads();
#pragma unroll
        for (int db = 0; db < 4; ++db) { LAS unsigned* sp = (LAS unsigned*)(SB + (16 * tq + fr) * GP + (16 * db + 4 * fq) * 2); sp[0] = pk2(accS[db][0], accS[db][1]); sp[1] = pk2(accS[db][2], accS[db][3]); }
    }
#undef GX_LOAD
    float* gg = WSP(float, WS_GG) + ((size_t)(bh * 8 + g) * 128 + 16 * tq + fr) * 64;
#pragma unroll
    for (int db = 0; db < 4; ++db) *(pg8::f32x4*)(gg + 16 * db + 4 * fq) = accS[db];
    if (tq == 0) WSP(float, WS_GD)[(bh * 8 + g) * 64 + d] = cd;
    __syncthreads();
}
__device__ __forceinline__ void gla_z(Frame& F, int unit) {
    const int bh = unit >> 3, g = unit & 7, b = bh >> 2, h = bh & 3, fr = F.lane & 15, fq = F.lane >> 4;
    const ldsp SB = F.lds + 0;
    { const pg8::f32x4* G4 = WSP(pg8::f32x4, WS_GG); const float* GD = WSP(float, WS_GD);
#pragma unroll
      for (int j = 0; j < 4; ++j) { const int q = F.tid + 512 * j, e = q >> 4, d4 = (q & 15) * 4; pg8::f32x4 S = {0.f, 0.f, 0.f, 0.f}, Gv[7], Dv[7];
#pragma unroll
          for (int gp = 0; gp < 7; ++gp) if (gp < g) { Dv[gp] = *(const pg8::f32x4*)(GD + (bh * 8 + gp) * 64 + d4); Gv[gp] = G4[(size_t)(bh * 8 + gp) * 2048 + q]; }
#pragma unroll
          for (int gp = 0; gp < 7; ++gp) if (gp < g) S = Dv[gp] * S + Gv[gp];
          *(LAS unsigned*)(SB + e * GP + d4 * 2) = pk2(S.x, S.y); *(LAS unsigned*)(SB + e * GP + d4 * 2 + 4) = pk2(S.z, S.w); } }
    __syncthreads();
    const bf16* QD = WSP(bf16, WS_QD); const bf16* O0 = WSP(bf16, WS_O0); const float* gg = F.inp(I_GGLA);
    pg8::bf16x8 qf[2]; unsigned long long ow[8], rw[8];
#define GZ_LOAD(itn) do { const int tl_ = 512 * g + 128 * (itn) + 16 * F.wave + fr; const size_t mr_ = (size_t)(b * SEQ + tl_), pr_ = (size_t)(b * LPB + 64 + tl_); \
        _Pragma("unroll") for (int ks_ = 0; ks_ < 2; ++ks_) qf[ks_] = *(const pg8::bf16x8*)(QD + mr_ * 256 + h * 64 + 32 * ks_ + 8 * fq); \
        _Pragma("unroll") for (int eb_ = 0; eb_ < 8; ++eb_) { ow[eb_] = *(const GAS unsigned long long*)(O0 + mr_ * 512 + h * 128 + 16 * eb_ + 4 * fq); rw[eb_] = *(const GAS unsigned long long*)(WSP(bf16, WS_GR) + pr_ * 512 + h * 128 + 16 * eb_ + 4 * fq); } } while (0)
    GZ_LOAD(0);
    for (int it = 0; it < 4; ++it) {
        const int tl = 512 * g + 128 * it + 16 * F.wave + fr, mrow = b * SEQ + tl;
        pg8::f32x4 o[8];
#pragma unroll
        for (int eb = 0; eb < 8; ++eb) o[eb] = (pg8::f32x4){0.f, 0.f, 0.f, 0.f};
#pragma unroll
        for (int ks = 0; ks < 2; ++ks)
#pragma unroll
            for (int eb = 0; eb < 8; ++eb) o[eb] = MFMA16(ldfrag(SB, 16 * eb + fr, ks, fq), qf[ks], o[eb]);
        float ss = 0.f; float sr[8][4];
#pragma unroll
        for (int eb = 0; eb < 8; ++eb) { const unsigned long long w = ow[eb], r = rw[eb];
            o[eb][0] += __uint_as_float((unsigned)w << 16); o[eb][1] += __uint_as_float((unsigned)w & 0xffff0000u); o[eb][2] += __uint_as_float((unsigned)(w >> 32) << 16); o[eb][3] += __uint_as_float((unsigned)(w >> 32) & 0xffff0000u);
            ss += (o[eb][0] * o[eb][0] + o[eb][1] * o[eb][1]) + (o[eb][2] * o[eb][2] + o[eb][3] * o[eb][3]);
            sr[eb][0] = __uint_as_float((unsigned)r << 16); sr[eb][1] = __uint_as_float((unsigned)r & 0xffff0000u); sr[eb][2] = __uint_as_float((unsigned)(r >> 32) << 16); sr[eb][3] = __uint_as_float((unsigned)(r >> 32) & 0xffff0000u); }
        if (it < 3) GZ_LOAD(it + 1);
        ss += __shfl_xor(ss, 16); ss += __shfl_xor(ss, 32);
        const float rn = 1.0f / sqrtf(ss * (1.0f / 128.0f) + EPS);
        bf16* op = WSP(bf16, WS_OA) + (size_t)MROWS * 512 + (size_t)mrow * 512 + h * 128;
#pragma unroll
        for (int eb = 0; eb < 8; ++eb) { const int e = 16 * eb + 4 * fq; const pg8::f32x4 gv = *(const pg8::f32x4*)(gg + e);
            const float v0 = o[eb][0] * rn * gv.x * (sr[eb][0] * sigmoidf_(sr[eb][0])), v1 = o[eb][1] * rn * gv.y * (sr[eb][1] * sigmoidf_(sr[eb][1])), v2 = o[eb][2] * rn * gv.z * (sr[eb][2] * sigmoidf_(sr[eb][2])), v3 = o[eb][3] * rn * gv.w * (sr[eb][3] * sigmoidf_(sr[eb][3]));
            *(GAS unsigned long long*)(op + e) = (unsigned long long)pk2(v0, v1) | ((unsigned long long)pk2(v2, v3) << 32); }
    }
#undef GZ_LOAD
    __syncthreads();
}
__device__ __forceinline__ void router_phase(Frame& F) {
    LAS float* lgp = (LAS float*)(F.lds + 0);
    LAS float* ssp = (LAS float*)(F.lds + 49152);
    LAS int* lcnt = (LAS int*)(F.lds + 51200); LAS int* lbase = lcnt + 64;
    const bf16* H = WSP(bf16, WS_H2U); const bf16* wh = WSP(bf16, WS_WRH); const bf16* wl = WSP(bf16, WS_WRL);
    int* ltok = WSP(int, WS_LTOK); float* lrs = WSP(float, WS_LRS); float* lw = WSP(float, WS_LW);
    const int fr = F.lane & 15, kg = F.lane >> 4, rbk = F.wave & 3, kh = F.wave >> 2;
    for (int rb = F.vcu; rb < MROWS / 128; rb += F.G) {
        if (F.tid < 64) lcnt[F.tid] = 0;
        const bf16* h0 = H + (size_t)(rb * 128 + rbk * 32 + fr) * DM + kh * 512 + 8 * kg; const bf16* h1 = h0 + 16 * DM;
        const bf16* whp = wh + (size_t)fr * DM + kh * 512 + 8 * kg; const bf16* wlp = wl + (size_t)fr * DM + kh * 512 + 8 * kg;
        pg8::f32x4 acc[2][3];
#pragma unroll
        for (int a = 0; a < 2; ++a)
#pragma unroll
            for (int cb = 0; cb < 3; ++cb) acc[a][cb] = (pg8::f32x4){0.f, 0.f, 0.f, 0.f};
        float ss0 = 0.f, ss1 = 0.f; const float* ig2 = WSP(float, WS_IG2) + kh * 512 + 8 * kg;
#pragma unroll 4
        for (int s = 0; s < 16; ++s) {
            const pg8::bf16x8 a0 = *(const pg8::bf16x8*)(h0 + 32 * s), a1 = *(const pg8::bf16x8*)(h1 + 32 * s);
            { const pg8::f32x4 ia = *(const pg8::f32x4*)(ig2 + 32 * s), ib = *(const pg8::f32x4*)(ig2 + 32 * s + 4); const float iv[8] = {ia[0], ia[1], ia[2], ia[3], ib[0], ib[1], ib[2], ib[3]};
#pragma unroll
              for (int j = 0; j < 8; ++j) { const float x0 = __uint_as_float((unsigned)(unsigned short)a0[j] << 16), x1 = __uint_as_float((unsigned)(unsigned short)a1[j] << 16); ss0 += x0 * x0 * iv[j]; ss1 += x1 * x1 * iv[j]; } }
#pragma unroll
            for (int cb = 0; cb < 3; ++cb) { const pg8::bf16x8 bh = *(const pg8::bf16x8*)(whp + (size_t)(16 * cb) * DM + 32 * s), bl = *(const pg8::bf16x8*)(wlp + (size_t)(16 * cb) * DM + 32 * s);
                acc[0][cb] = MFMA16(a0, bh, acc[0][cb]); acc[0][cb] = MFMA16(a0, bl, acc[0][cb]); acc[1][cb] = MFMA16(a1, bh, acc[1][cb]); acc[1][cb] = MFMA16(a1, bl, acc[1][cb]); }
        }
#pragma unroll
        for (int a = 0; a < 2; ++a)
#pragma unroll
            for (int cb = 0; cb < 3; ++cb)
#pragma unroll
                for (int i = 0; i < 4; ++i) lgp[(kh * 128 + rbk * 32 + a * 16 + 4 * kg + i) * 48 + 16 * cb + fr] = acc[a][cb][i];
        ss0 += __shfl_xor(ss0, 16); ss0 += __shfl_xor(ss0, 32); ss1 += __shfl_xor(ss1, 16); ss1 += __shfl_xor(ss1, 32);
        if (kg == 0) { ssp[kh * 128 + rbk * 32 + fr] = ss0; ssp[kh * 128 + rbk * 32 + 16 + fr] = ss1; }
        __syncthreads();
        int seg0 = 0, seg1 = 0, rk0 = 0, rk1 = 0; float w0 = 0.f, w1 = 0.f, rs = 0.f;
        if (F.tid < 128) {
            const LAS float* L0 = lgp + F.tid * 48; const LAS float* L1 = L0 + 128 * 48; rs = 1.0f / sqrtf((ssp[F.tid] + ssp[128 + F.tid]) * (1.0f / DM) + EPS);
            float gl[4];
#pragma unroll
            for (int j = 0; j < 4; ++j) gl[j] = (L0[j] + L1[j]) * rs + F.inp(I_BRG)[j];
            int gi = 0; float gm = gl[0];
#pragma unroll
            for (int j = 1; j < 4; ++j) if (gl[j] > gm) { gm = gl[j]; gi = j; }
            float gs = 0.f;
#pragma unroll
            for (int j = 0; j < 4; ++j) gs += expf(gl[j] - gm);
            const float gw_ = 1.0f / gs;
            float v1 = -INFINITY, v2 = -INFINITY; int i1 = 0, i2 = 0;
            for (int j = 0; j < 8; ++j) { const float v = (L0[4 + gi * 8 + j] + L1[4 + gi * 8 + j]) * rs + F.inp(I_BRE)[gi * 8 + j];
                if (v > v1) { v2 = v1; i2 = i1; v1 = v; i1 = j; } else if (v > v2) { v2 = v; i2 = j; } }
            const float e1 = 1.0f / (1.0f + expf(v2 - v1));
            w0 = gw_ * e1; w1 = gw_ * (1.0f - e1); seg0 = gi * 8 + i1; seg1 = 32 + gi * 8 + i2;
            rk0 = atomicAdd((int*)(lcnt + seg0), 1); rk1 = atomicAdd((int*)(lcnt + seg1), 1);
        }
        __syncthreads();
        if (F.tid < 64) { const int n = lcnt[F.tid]; lbase[F.tid] = n ? (int)__hip_atomic_fetch_add((unsigned*)(F.ctl + CW_CNT + F.tid), (unsigned)n, RLX_AGENT) : 0; }
        __syncthreads();
        if (F.tid < 128) { const int tok = rb * 128 + F.tid; const size_t p0 = (size_t)seg0 * LCAP + lbase[seg0] + rk0, p1 = (size_t)seg1 * LCAP + lbase[seg1] + rk1;
            ltok[p0] = tok; lrs[p0] = rs; lw[p0] = w0; ltok[p1] = tok; lrs[p1] = rs; lw[p1] = w1; }
        __syncthreads();
    }
}
#ifndef MK_N_LAUNCHES
#define MK_N_LAUNCHES 1
#endif
constexpr int N_PHASES = 10;
struct Args { const float* in[25]; float* out; unsigned char* ws; int ph_lo, ph_hi; };
__global__ void __launch_bounds__(NWAVES * 64, 2) fwd_kernel(Args args) {
    extern __shared__ __attribute__((aligned(16))) unsigned char lds[];
    Frame F;
    F.lds = (LAS unsigned char*)lds;
    F.MISC = (volatile LAS unsigned*)(F.lds + MISC_OFF);
    F.tid = threadIdx.x; F.lane = F.tid & 63; F.wave = __builtin_amdgcn_readfirstlane(F.tid >> 6);
    F.G = gridDim.x; { const int bx = blockIdx.x; F.vcu = (F.G % 8 == 0) ? (bx % 8) * (F.G / 8) + bx / 8 : bx; }
    F.ws = args.ws; F.out = args.out; F.ctl = (gu32*)(args.ws + WS_CTL);
    for (int u = F.tid; u < (LDS_BYTES - LDSCTL_OFF) / 4; u += NWAVES * 64) ((LAS unsigned*)(F.lds + LDSCTL_OFF))[u] = 0u;
    __syncthreads();
    if (F.tid < 25) ((LAS unsigned long long*)(F.lds + INTAB_OFF))[F.tid] = (unsigned long long)args.in[F.tid];
    __syncthreads();
    XcdBarrier bar; bar.bar = (unsigned*)(F.ctl + CW_BAR); bar.x = 0; bar.st = nullptr;
    if (MK_N_LAUNCHES == 1) bar = xcd_barrier_post((unsigned*)(F.ctl + CW_BAR), F.MISC + 8);
    const int lo = args.ph_lo, hi = args.ph_hi;
#ifdef PROBE_K
    volatile LAS unsigned long long* prb = (volatile LAS unsigned long long*)(F.lds + LDSCTL_OFF + 2048); if (blockIdx.x == 0 && F.tid == 0) prb[0] = __builtin_amdgcn_s_memrealtime();
#define PROBE_AT(k) do { if ((k) == PROBE_K && blockIdx.x == 0 && F.tid == 0) prb[1] = __builtin_amdgcn_s_memrealtime(); } while (0)
#else
#define PROBE_AT(k) do {} while (0)
#endif
#ifndef PH_MASK
#define PH_MASK 0x3ff
#endif
#define IN(k) (((PH_MASK >> (k)) & 1) && lo <= (k) && (k) < hi)
#define SEAM(k) do { if (IN(k) && IN((k) + 1)) xcd_barrier(bar); PROBE_AT(k); } while (0)
    const LAS int* tbp = (const LAS int*)(F.lds + TB_OFF); const LAS int* cnp = (const LAS int*)(F.lds + CN_OFF);

    if (IN(0)) { p0_prologue(F); } SEAM(0);
    if (IN(1)) {
#ifdef SKEW_US
        { const unsigned long long t0_ = __builtin_amdgcn_s_memrealtime(), dl_ = (unsigned long long)(F.vcu & 7) * (SKEW_US * 100 / 8); while (__builtin_amdgcn_s_memrealtime() - t0_ < dl_) __builtin_amdgcn_s_sleep(8); }
#endif
        for (int u = F.tid; u < 2 * DM; u += NWAVES * 64) ((LAS float*)(F.lds + BML_OFF))[u] = F.inp(I_BMERGE)[u];
        __syncthreads();
        { pg8::Gemm g{WSP(pg8::bf16_t, WS_XN8), WSP(pg8::bf16_t, WS_WIN8), DM / 2}; pg8::StaticOrder S{MROWS / 256, 8, F.G, (int)blockIdx.x};
          epi::EpiGates E{(bf16*)F.out, (bf16*)F.out + (size_t)MROWS * DM, (const LAS float*)(F.lds + BML_OFF), 1.0f / (X8SCALE * W8SCALE)};
          pg8::gemm_phase<epi::EpiGates, pg8::StaticOrder, true, true>(F.lds + RING_OFF, g, S, E); }
        asm volatile("s_waitcnt vmcnt(0) lgkmcnt(0)" ::: "memory"); __syncthreads();
        pg8::Gemm g{WSP(pg8::bf16_t, WS_R1), WSP(pg8::bf16_t, WS_WIN), DM}; pg8::StaticOrder S{MZ / 256, 13, F.G, (int)blockIdx.x};
        epi::EpiZ E{WSP(bf16, WS_Q), WSP(bf16, WS_K), WSP(bf16, WS_V), WSP(bf16, WS_GQ), WSP(bf16, WS_GK), WSP(bf16, WS_GV), WSP(bf16, WS_GR), WSP(float, WS_LOGA),
                    F.inp(I_GQN), F.inp(I_GKN), F.inp(I_BGATE), WSP(float, WS_ROPE), WSP(float, WS_ROPE) + NPOS * 32, F.lds + RING_OFF + epi::EPI_STG_OFF};
        pg8::gemm_phase(F.lds + RING_OFF, g, S, E);
        if ((int)blockIdx.x >= P1_EXTRA(F.G)) { const int nidle = F.G - P1_EXTRA(F.G), j = (int)blockIdx.x - P1_EXTRA(F.G), nw = nidle * NWAVES, me = j * NWAVES + F.wave, cnt = p1_conv_items(F.G);
            late_tables(F, me * 64 + F.lane, nw * 64); expert_conv_first(F, me, nw, cnt); }
    } SEAM(1);
    if (IN(2)) {
        const attn_body::AttnTensors AT{(const attn_body::bf16*)WSP(bf16, WS_Q), (const attn_body::bf16*)WSP(bf16, WS_K), (const attn_body::bf16*)WSP(bf16, WS_V), (attn_body::bf16*)WSP(bf16, WS_R1)};
        { const float lam = expf(wave_sum(F.inp(I_LQ1)[F.lane] * F.inp(I_LK1)[F.lane])) - expf(wave_sum(F.inp(I_LQ2)[F.lane] * F.inp(I_LK2)[F.lane])) + 0.2f;
          float gqm = fabsf(F.inp(I_GQN)[F.lane]), gkm = fabsf(F.inp(I_GKN)[F.lane]);
#pragma unroll
          for (int o_ = 1; o_ < 64; o_ <<= 1) { gqm = fmaxf(gqm, __shfl_xor(gqm, o_)); gkm = fmaxf(gkm, __shfl_xor(gkm, o_)); }
          const bool fastsm = __builtin_amdgcn_readfirstlane((0.125f * 1.4426950408889634f * 64.0f) * gqm * gkm < 48.0f ? 1 : 0) != 0;
          const int nslot = 2 * ((256 + F.G - 1) / F.G);
          int i = 0;
#define ATTN_LOOP(FASTSM) for (;; ++i) { const int p = (i >> 2) * F.G + F.vcu; if (p >= 256) break; \
              if ((i & 3) == 1 || (i & 3) == 3) expert_conv_slot(F, (i >> 2) * 2 + ((i & 3) >> 1), nslot, p1_conv_items(F.G)); \
              const int bh = p >> 3, s = p & 7, b = bh >> 2, h = bh & 3, mp = i & 1, qb = (i & 2) ? 15 - s : s, hm = 2 * h + mp; \
              attn_body::attn_unit<8, FASTSM>(b, hm * 64, hm * 64, h * 128, hm * 128, qb, AT.Q, AT.K, AT.V, AT.O, (char*)lds + RING_OFF, mp, 2 * h * 128, lam, F.inp(I_GSUB), (attn_body::bf16*)WSP(bf16, WS_OA), h * 128); }
          if (fastsm) { ATTN_LOOP(true) } else { ATTN_LOOP(false) }
#undef ATTN_LOOP
          for (int sl = (i >> 2) * 2 + (((i & 3) + 1) >> 1 > 2 ? 2 : ((i & 3) + 1) >> 1); sl < nslot; ++sl) expert_conv_slot(F, sl, nslot, p1_conv_items(F.G)); }
        asm volatile("s_waitcnt vmcnt(0) lgkmcnt(0)" ::: "memory"); __syncthreads();
        for (int un = F.vcu; un < 32 * 8; un += F.G) gla_x(F, un);
    } SEAM(2);
    if (IN(3)) { for (int un = F.vcu; un < 32 * 8; un += F.G) gla_z(F, un); } SEAM(3);
    if (IN(4)) {
        pg8::Gemm g{WSP(pg8::bf16_t, WS_OA), WSP(pg8::bf16_t, WS_WBR), 512}; pg8::PairOrder S{MROWS / 256, DM / 256, F.G, (int)blockIdx.x};
        epi::EpiMerge E{(const bf16*)F.out, (const bf16*)F.out + (size_t)MROWS * DM, WSP(bf16, WS_R1)};
        pg8::gemm_phase(F.lds + RING_OFF, g, S, E);
    } SEAM(4);
    if (IN(5)) {
        pg8::Gemm g{WSP(pg8::bf16_t, WS_R1), WSP(pg8::bf16_t, WS_WOUT), DM}; pg8::StaticOrder S{MROWS / 256, DM / 256, F.G, (int)blockIdx.x};
        epi::EpiOut E{F.inp(I_X), WSP(bf16, WS_H2U), F.inp(I_GFFN), WSP(unsigned char, WS_H2U8)};
        pg8::gemm_phase(F.lds + RING_OFF, g, S, E);
    } SEAM(5);
    if (IN(6)) { router_phase(F); } SEAM(6);
    if ((PH_MASK >> 7) && hi > 7) {
        LAS int* tb = (LAS int*)(F.lds + TB_OFF); LAS int* cn = (LAS int*)(F.lds + CN_OFF);
        if (F.tid < 64) { const int c = (int)__hip_atomic_load(F.ctl + CW_CNT + F.tid, RLX_AGENT); cn[F.tid] = c;
            const int t = (c + 255) >> 8; int incl = t;
#pragma unroll
            for (int o = 1; o < 64; o <<= 1) { const int v = __shfl_up(incl, o); if (F.lane >= o) incl += v; }
            tb[F.tid] = incl - t; if (F.tid == 63) tb[64] = incl; }
        __syncthreads();
    }
    if (IN(7)) {
        pg8::Gemm g{WSP(pg8::bf16_t, WS_H2U8), WSP(pg8::bf16_t, WS_WGU), DM / 2}; epi::MoeSched<true> S{tbp, cnp, WSP(int, WS_LTOK), 0, 64, F.G, F.vcu};
        epi::EpiUp E{cnp, WSP(float, WS_LRS), WSP(unsigned char, WS_HID)};
        pg8::gemm_phase<epi::EpiUp, epi::MoeSched<true>, true>(F.lds + RING_OFF, g, S, E);
    } SEAM(7);
    if (IN(8)) {
        pg8::Gemm g{WSP(pg8::bf16_t, WS_HID), WSP(pg8::bf16_t, WS_WD), DEXP / 2}; epi::MoeSched<false> S{tbp, cnp, WSP(int, WS_LTOK), 0, 32, F.G, F.vcu};
        epi::EpiDown<0> E{cnp, WSP(int, WS_LTOK), WSP(float, WS_LW), F.out, WSP(unsigned char, WS_R1), WSP(float, WS_TRASH), WSP(bf16, WS_H2U), F.inp(I_GFFN)};
        pg8::gemm_phase<epi::EpiDown<0>, epi::MoeSched<false>, true>(F.lds + RING_OFF, g, S, E);
    } SEAM(8);
    if (IN(9)) {
        pg8::Gemm g{WSP(pg8::bf16_t, WS_HID), WSP(pg8::bf16_t, WS_WD), DEXP / 2}; epi::MoeSched<false> S{tbp, cnp, WSP(int, WS_LTOK), 32, 64, F.G, F.vcu};
        epi::EpiDown<1> E{cnp, WSP(int, WS_LTOK), WSP(float, WS_LW), F.out, WSP(unsigned char, WS_R1), WSP(float, WS_TRASH), WSP(bf16, WS_H2U), F.inp(I_GFFN)};
        pg8::gemm_phase<epi::EpiDown<1>, epi::MoeSched<false>, true>(F.lds + RING_OFF, g, S, E);
    }
#ifdef PROBE_K
    PROBE_AT(9);
    if (blockIdx.x == 0 && F.tid == 0) { const unsigned long long t1 = __builtin_amdgcn_s_memrealtime(), tgt = t1 + (unsigned long long)PROBE_MULT * (prb[1] - prb[0]);
        for (unsigned sp = 0; sp < 4000000u && __builtin_amdgcn_s_memrealtime() < tgt; ++sp) __builtin_amdgcn_s_sleep(16); }
#endif
#undef IN
#undef SEAM
}

extern "C" void kernel_launch(void* const* d_in, const int* in_sizes, int n_in, void* d_out, int out_size, void* d_ws, size_t ws_size, hipStream_t stream) {
    static int grid = 0;
    if (grid == 0) {
        if (n_in != 25 || in_sizes[0] != MROWS * DM || out_size != MROWS * DM || ws_size < WS_END) { fprintf(stderr, "kernel_launch: unexpected shapes (n_in %d, in0 %d, out %d, ws %zu)\n", n_in, n_in > 0 ? in_sizes[0] : -1, out_size, ws_size); grid = -1; return; }
        int dev = 0, cus = 0, per_cu = 0;
        if (hipGetDevice(&dev) != hipSuccess || hipDeviceGetAttribute(&cus, hipDeviceAttributeMultiprocessorCount, dev) != hipSuccess) { grid = -1; return; }
        if (hipFuncSetAttribute((const void*)fwd_kernel, hipFuncAttributeMaxDynamicSharedMemorySize, LDS_BYTES) != hipSuccess) { fprintf(stderr, "kernel_launch: hipFuncSetAttribute failed\n"); grid = -1; return; }
        if (hipOccupancyMaxActiveBlocksPerMultiprocessor(&per_cu, (const void*)fwd_kernel, NWAVES * 64, LDS_BYTES) != hipSuccess || per_cu < 1) { fprintf(stderr, "kernel_launch: occupancy query says %d\n", per_cu); }
        (void)hipGetLastError();
        grid = cus;
    }
    if (grid < 0) return;
    if (hipMemsetAsync((char*)d_ws + WS_CTL, 0, CTL_ZERO_BYTES, stream) != hipSuccess) return;
    Args a{};
    for (int i = 0; i < 25; ++i) a.in[i] = (const float*)d_in[i];
    a.out = (float*)d_out; a.ws = (unsigned char*)d_ws;
    if (MK_N_LAUNCHES == 1) { a.ph_lo = 0; a.ph_hi = N_PHASES; hipLaunchKernelGGL(fwd_kernel, dim3(grid), dim3(NWAVES * 64), LDS_BYTES, stream, a); }
    else for (int p = 0; p < N_PHASES; ++p) { a.ph_lo = p; a.ph_hi = p + 1; hipLaunchKernelGGL(fwd_kernel, dim3(grid), dim3(NWAVES * 64), LDS_BYTES, stream, a); }
}
```

```cpp
#include <hip/hip_runtime.h>
#include <hip/hip_bf16.h>
#include <cstdio>
#include <cstdint>
#include <cmath>

namespace pg8 {
#define PG8_LAS __attribute__((address_space(3)))
typedef unsigned short bf16_t;
typedef short bf16x8 __attribute__((ext_vector_type(8)));
typedef float f32x4 __attribute__((ext_vector_type(4)));
typedef float f32x2 __attribute__((ext_vector_type(2)));
typedef unsigned u32x4 __attribute__((ext_vector_type(4)));
typedef unsigned u32x2 __attribute__((ext_vector_type(2)));
typedef int v8i __attribute__((ext_vector_type(8)));
constexpr int BM = 256, BK = 64, HALF = 128, HTB = HALF * BK * 2, STAGE_BYTES = 8 * HTB, NXCD = 8, WGM = 8;

__host__ __device__ __forceinline__ int lds_byte(int r, int c) { const int st = (r >> 4) * 2 + (c >> 5), rr = r & 15, cc = c & 31, ob = rr * 64 + cc * 2; return st * 1024 + (ob ^ (((ob >> 9) & 1) << 5)); }
__host__ __device__ __forceinline__ void stage_rc(int b, int& R, int& C) { const int st = b / 1024, sb = b % 1024, swz = sb ^ (((sb >> 9) & 1) << 5); R = (st >> 1) * 16 + swz / 64; C = (st & 1) * 32 + (swz % 64) / 2; }
__host__ __device__ __forceinline__ int perm32(int rho) { const int n = rho >> 4, i = rho & 15; return 8 * (i >> 2) + 4 * n + (i & 3); }

struct Unit { int pm, pn, aux, half; };
struct Gemm { const bf16_t* A; const bf16_t* Bt; int K; };

__device__ __forceinline__ void tile_of(int L, int nM, int nN, int& pm, int& pn) {
    const int nwg = nM * nN; int wgid = L;
    { const int q = nwg / NXCD, r = nwg % NXCD, xcd = wgid % NXCD, off = wgid / NXCD; wgid = (xcd < r ? xcd * (q + 1) : r * (q + 1) + (xcd - r) * q) + off; }
    const int nig = WGM * nN, gid = wgid / nig, fm = gid * WGM, gsz = (nM - fm) < WGM ? (nM - fm) : WGM;
    pm = fm + ((wgid % nig) % gsz); pn = (wgid % nig) / gsz;
}
struct StaticOrder {
    static constexpr bool GATHER = false;
    int nM, nN, G, c;
    __device__ __forceinline__ bool next(int i, Unit& u) const { const long L = (long)i * G + c; if (L >= (long)nM * nN) return false; tile_of((int)L, nM, nN, u.pm, u.pn); u.aux = 0; u.half = 0; return true; }
    __device__ __forceinline__ int grow(const Unit&, int) const { return 0; }
};
struct PairOrder {
    static constexpr bool GATHER = false;
    int nM, nN, G, c;
    __device__ __forceinline__ bool next(int i, Unit& u) const { const long L = (long)(i >> 1) * G + c; if (L >= (long)nM * nN) return false; tile_of((int)L, nM, nN, u.pm, u.pn); const int br = i & 1; u.pm += nM * br; u.pn += nN * br; u.aux = br; u.half = 0; return true; }
    __device__ __forceinline__ int grow(const Unit&, int) const { return 0; }
};

typedef __bf16 bf16x2_cv __attribute__((ext_vector_type(2)));
__device__ __forceinline__ unsigned cvt_pk_bf16(float lo, float hi) { const f32x2 v = {lo, hi}; return __builtin_bit_cast(unsigned, __builtin_convertvector(v, bf16x2_cv)); }
__device__ __forceinline__ u32x4 pack8(const f32x4 a, const f32x4 b) { u32x4 w; w.x = cvt_pk_bf16(a[0], a[1]); w.y = cvt_pk_bf16(a[2], a[3]); w.z = cvt_pk_bf16(b[0], b[1]); w.w = cvt_pk_bf16(b[2], b[3]); return w; }
__device__ __forceinline__ float bf_lo(unsigned w) { return __uint_as_float(w << 16); }
__device__ __forceinline__ float bf_hi(unsigned w) { return __uint_as_float(w & 0xffff0000u); }

template <class Epi, class Sched, bool F8 = false, bool OPQ = false>
__device__ __forceinline__ void gemm_phase(PG8_LAS unsigned char* lds, const Gemm g, const Sched& S, const Epi& E) {
    constexpr bool GA = Sched::GATHER;
    const int tid = threadIdx.x, wid = __builtin_amdgcn_readfirstlane(tid >> 6), lane = tid & 63, wr = wid >> 2, wc = wid & 3, fr = lane & 15, fq = lane >> 4;
    const int K = g.K; int nt = K / BK; if constexpr (OPQ) asm volatile("" : "+s"(nt));
    unsigned voffA[2], voffB[2]; int RA[2], CA[2];
#pragma unroll
    for (int i = 0; i < 2; ++i) { int R, C; stage_rc(tid * 16 + i * 8192, R, C); const int Rb = (R & ~31) + perm32(R & 31);
        voffA[i] = (unsigned)(R * K + C) * 2u; voffB[i] = (unsigned)(Rb * K + C) * 2u; RA[i] = R; CA[i] = C; }
    const size_t kstep = (size_t)(BK * 2);
    const size_t hstep = (size_t)HALF * K * 2;
    const size_t tstep = 2 * hstep;
    const unsigned ldsw = (unsigned)wid * 1024u;
    const int aoff = lds_byte(wr * 64 + fr, F8 ? fq * 16 : fq * 8), boff = lds_byte(wc * 32 + fr, F8 ? fq * 16 : fq * 8);
    unsigned gc[2][2], gn[2][2];
#define PG8_SA(b, h) (((b) * 2 + (h)) * HTB)
#define PG8_SB(b, h) ((4 + (b) * 2 + (h)) * HTB)
#define PG8_GL(src, dstoff) __builtin_amdgcn_global_load_lds((const unsigned*)(src), (PG8_LAS unsigned*)(lds + (dstoff)), 16, 0, 0)
#define PG8_STAGE(bufoff, gbase, voff) do { _Pragma("unroll") for (int _i = 0; _i < 2; ++_i) PG8_GL((const char*)(gbase) + (voff)[_i], (bufoff) + ldsw + _i * 8192); } while (0)
#define PG8_STA(bufoff, kptr, h, NX) do { if constexpr (GA) { _Pragma("unroll") for (int _i = 0; _i < 2; ++_i) { const unsigned _o = (NX) ? gn[h][_i] : gc[h][_i]; PG8_GL((const char*)(kptr) + _o, (bufoff) + ldsw + _i * 8192); } } \
        else { PG8_STAGE(bufoff, (const char*)(kptr) + (h) * hstep, voffA); } } while (0)
#define PG8_GOFF(dst, un) do { _Pragma("unroll") for (int _h = 0; _h < 2; ++_h) _Pragma("unroll") for (int _i = 0; _i < 2; ++_i) dst[_h][_i] = ((unsigned)S.grow(un, _h * HALF + RA[_i]) * (unsigned)K + (unsigned)CA[_i]) * 2u; } while (0)
#define PG8_LDA(dst, b, h) do { _Pragma("unroll") for (int m = 0; m < 4; ++m) _Pragma("unroll") for (int k = 0; k < 2; ++k) dst[m][k] = *(const PG8_LAS bf16x8*)(lds + PG8_SA(b, h) + aoff + m * 2048 + (F8 ? k * 16 : k * 1024)); } while (0)
#define PG8_LDB(dst, b, h) do { _Pragma("unroll") for (int n = 0; n < 2; ++n) _Pragma("unroll") for (int k = 0; k < 2; ++k) dst[n][k] = *(const PG8_LAS bf16x8*)(lds + PG8_SB(b, h) + boff + n * 2048 + (F8 ? k * 16 : k * 1024)); } while (0)
#define PG8_F8V(X) __builtin_shufflevector(__builtin_bit_cast(u32x4, X[0]), __builtin_bit_cast(u32x4, X[1]), 0, 1, 2, 3, 4, 5, 6, 7)
#define PG8_MMA(ai, bj, At, Bt) do { __builtin_amdgcn_s_setprio(1); \
        if constexpr (F8) { _Pragma("unroll") for (int m = 0; m < 4; ++m) _Pragma("unroll") for (int n = 0; n < 2; ++n) \
            acc[ai][bj][m][n] = __builtin_amdgcn_mfma_scale_f32_16x16x128_f8f6f4(__builtin_bit_cast(v8i, PG8_F8V(Bt[n])), __builtin_bit_cast(v8i, PG8_F8V(At[m])), acc[ai][bj][m][n], 0, 0, 0, 0x7f7f7f7f, 0, 0x7f7f7f7f); } \
        else { _Pragma("unroll") for (int m = 0; m < 4; ++m) _Pragma("unroll") for (int n = 0; n < 2; ++n) _Pragma("unroll") for (int k = 0; k < 2; ++k) \
            acc[ai][bj][m][n] = __builtin_amdgcn_mfma_f32_16x16x32_bf16(Bt[n][k], At[m][k], acc[ai][bj][m][n], 0, 0, 0); } __builtin_amdgcn_s_setprio(0); } while (0)
#define PG8_WAIT_V(n) asm volatile("s_waitcnt vmcnt(" #n ")" ::: "memory")
#define PG8_WAIT_L(n) asm volatile("s_waitcnt lgkmcnt(" #n ")" ::: "memory")
#define PG8_BAR __builtin_amdgcn_s_barrier()
#define PG8_SCHED __builtin_amdgcn_sched_barrier(0)
#define PG8_ZERO() do { _Pragma("unroll") for (int a = 0; a < 2; ++a) _Pragma("unroll") for (int b = 0; b < 2; ++b) _Pragma("unroll") for (int m = 0; m < 4; ++m) _Pragma("unroll") for (int n = 0; n < 2; ++n) acc[a][b][m][n] = (f32x4){0.f, 0.f, 0.f, 0.f}; } while (0)
    Unit cur, nxt; int ui = 0;
    if (!S.next(0, cur)) return;
    f32x4 acc[2][2][4][2];
    PG8_ZERO();
    bf16x8 At[4][2], B0[2][2], B1[2][2];
    const char* cA = GA ? (const char*)g.A : (const char*)g.A + (size_t)cur.pm * tstep; const char* cB = (const char*)g.Bt + (size_t)cur.pn * tstep;
    if constexpr (GA) { PG8_GOFF(gc, cur); }
    PG8_STAGE(PG8_SB(0, 0), cB, voffB); PG8_STAGE(PG8_SB(0, 1), cB + hstep, voffB); PG8_STA(PG8_SA(0, 0), cA, 0, false); PG8_STA(PG8_SA(0, 1), cA, 1, false);
    if (wr == 1) PG8_BAR;
    PG8_WAIT_V(2); PG8_BAR;
    PG8_STAGE(PG8_SB(1, 0), cB + kstep, voffB); PG8_STA(PG8_SA(1, 0), cA + kstep, 0, false); PG8_STAGE(PG8_SB(1, 1), cB + hstep + kstep, voffB);
    PG8_WAIT_V(6); PG8_BAR;
    for (;;) {
        const bool has_next = S.next(ui + 1, nxt);
        const char* nA = GA ? (const char*)g.A : (has_next ? (const char*)g.A + (size_t)nxt.pm * tstep : cA); const char* nB = has_next ? (const char*)g.Bt + (size_t)nxt.pn * tstep : cB;
        if constexpr (GA) { if (has_next) { PG8_GOFF(gn, nxt); } else { _Pragma("unroll") for (int _h = 0; _h < 2; ++_h) _Pragma("unroll") for (int _i = 0; _i < 2; ++_i) gn[_h][_i] = gc[_h][_i]; } }
        int hf_ = cur.half; if constexpr (OPQ) asm volatile("" : "+s"(hf_));
        const bool do0 = hf_ != 2, do1 = hf_ != 1;
        for (int t = 0; t < nt; t += 2) {
            const bool last = (t == nt - 2);
            const char* a1 = cA + (size_t)(t + 1) * kstep;
            const char* a2 = last ? nA : cA + (size_t)(t + 2) * kstep; const char* b2 = last ? nB : cB + (size_t)(t + 2) * kstep;
            const char* a3 = a2 + kstep; const char* b3 = b2 + kstep;
            PG8_LDB(B0, 0, 0); PG8_LDB(B1, 0, 1); PG8_SCHED; PG8_LDA(At, 0, 0); PG8_STA(PG8_SA(1, 1), a1, 1, false);
            PG8_WAIT_V(8); PG8_WAIT_L(0); PG8_BAR; if (do0) { PG8_MMA(0, 0, At, B0); PG8_MMA(0, 1, At, B1); } PG8_BAR; PG8_SCHED;
            PG8_LDA(At, 0, 1); PG8_STAGE(PG8_SB(0, 0), b2, voffB); PG8_STAGE(PG8_SB(0, 1), b2 + hstep, voffB); PG8_STA(PG8_SA(0, 0), a2, 0, last);
            PG8_WAIT_V(8); PG8_WAIT_L(0); PG8_BAR; if (do1) { PG8_MMA(1, 0, At, B0); PG8_MMA(1, 1, At, B1); } PG8_BAR; PG8_SCHED;
            PG8_LDB(B0, 1, 0); PG8_LDB(B1, 1, 1); PG8_SCHED; PG8_LDA(At, 1, 0); PG8_STA(PG8_SA(0, 1), a2, 1, last);
            PG8_WAIT_V(8); PG8_WAIT_L(0); PG8_BAR; if (do0) { PG8_MMA(0, 0, At, B0); PG8_MMA(0, 1, At, B1); } PG8_BAR; PG8_SCHED;
            PG8_LDA(At, 1, 1); PG8_STAGE(PG8_SB(1, 0), b3, voffB); PG8_STAGE(PG8_SB(1, 1), b3 + hstep, voffB); PG8_STA(PG8_SA(1, 0), a3, 0, last);
            PG8_WAIT_V(8); PG8_WAIT_L(0); PG8_BAR; if (do1) { PG8_MMA(1, 0, At, B0); PG8_MMA(1, 1, At, B1); } PG8_BAR; PG8_SCHED;
        }
        if (wr == 0) PG8_BAR;
        const bool keep = E(acc, cur, wr, wc, fr, fq);
        if (!has_next) break;
        if (!keep) { PG8_ZERO(); }
        cur = nxt; cA = nA; cB = nB; ++ui;
        if constexpr (GA) { _Pragma("unroll") for (int _h = 0; _h < 2; ++_h) _Pragma("unroll") for (int _i = 0; _i < 2; ++_i) gc[_h][_i] = gn[_h][_i]; }
        if (wr == 1) PG8_BAR;
    }
    PG8_WAIT_V(0);
    PG8_BAR;
#undef PG8_SA
#undef PG8_SB
#undef PG8_GL
#undef PG8_STAGE
#undef PG8_STA
#undef PG8_GOFF
#undef PG8_LDA
#undef PG8_LDB
#undef PG8_MMA
#undef PG8_F8V
#undef PG8_WAIT_V
#undef PG8_WAIT_L
#undef PG8_BAR
#undef PG8_SCHED
#undef PG8_ZERO
}
}
#include <hip/hip_bf16.h>
#include <cmath>
namespace attn_body {
using bf16=__hip_bfloat16;
using bf16x8=__attribute__((ext_vector_type(8)))short;
using s16x4=__attribute__((ext_vector_type(4)))short;
using f32x16=__attribute__((ext_vector_type(16)))float;
using u32x4=__attribute__((ext_vector_type(4)))unsigned;
constexpr int D=64,QP=512,KP=512,VP=512,OP=1024,QSEQ=4096,KSEQ=4160;
constexpr int NW=8,QBLK=32,QB=QBLK*NW,KVBLK=64,NQB=QSEQ/QB;
constexpr int ATTN_UNIT_ROWS=QB;
__device__ __forceinline__ int crow(int r,int hi){return (r&3)+8*(r>>2)+4*hi;}
#define SBAR() __builtin_amdgcn_sched_barrier(0)
__device__ __forceinline__ void cmask(f32x16&p0,f32x16&p1,int jb,int qrel,int hi){
  const float NEG=-INFINITY; int kb=64*jb+4*hi;
  #pragma unroll
  for(int r=0;r<16;++r){int kv=kb+(r&3)+8*(r>>2); if(kv>qrel)p0[r]=NEG; if(kv+32>qrel)p1[r]=NEG;}
}

constexpr int NSLOT=3, SLOTB=8192;
constexpr int QSTG=4608;
constexpr int LDS_K=0, LDS_V=NSLOT*SLOTB, LDS_WS=LDS_V+NSLOT*2*SLOTB, LDS_OST=LDS_WS+NW*64*4, LDS_BYTES=LDS_OST+NW*QSTG;
constexpr float C2=0.125f*1.4426950408889634f;
__device__ __forceinline__ void glds16(const void*gsrc,unsigned lds_dst){unsigned keep;
  asm volatile("s_mov_b32 %0, m0\n\ts_mov_b32 m0, %2\n\ts_nop 0\n\tglobal_load_lds_dwordx4 %1, off\n\ts_mov_b32 m0, %0":"=&s"(keep):"v"(gsrc),"s"(lds_dst):"memory");}
__device__ __forceinline__ float max3f(float a,float b,float c){float r;asm("v_max3_f32 %0, %1, %2, %3":"=v"(r):"v"(a),"v"(b),"v"(c));return r;}
__device__ __forceinline__ float max2f(float a,float b){float r;asm("v_max_f32_e32 %0, %1, %2":"=v"(r):"v"(a),"v"(b));return r;}
__device__ __forceinline__ float fadd_s(float a,float b){float r;asm("v_add_f32_e32 %0, %1, %2":"=v"(r):"v"(a),"v"(b));return r;}
__device__ __forceinline__ float fsub_s(float a,float b){float r;asm("v_sub_f32_e32 %0, %1, %2":"=v"(r):"v"(a),"v"(b));return r;}
typedef float f32x2_t __attribute__((ext_vector_type(2))); typedef __bf16 bf16x2_t __attribute__((ext_vector_type(2)));
__device__ __forceinline__ unsigned cvtpk_s(float lo,float hi){f32x2_t v={lo,hi};bf16x2_t b=__builtin_convertvector(v,bf16x2_t);return __builtin_bit_cast(unsigned,b);}
#define WAIT_BAR(N) asm volatile("s_waitcnt vmcnt(" #N ") lgkmcnt(0)\n\ts_barrier":::"memory")

__device__ __forceinline__ void qkt(f32x16&p0,f32x16&p1,const char*Kslot,const bf16x8*qr,int r32,int hi){ const f32x16 negm=f32x16{};
  const char*kb=Kslot+hi*1024+r32*16;
  #pragma unroll
  for(int d0=0;d0<4;++d0){
    const bf16x8 b0=*reinterpret_cast<const bf16x8*>(kb+d0*2048);
    const bf16x8 b1=*reinterpret_cast<const bf16x8*>(kb+d0*2048+512);
    if(d0==0){p0=__builtin_amdgcn_mfma_f32_32x32x16_bf16(b0,qr[0],negm,0,0,0);p1=__builtin_amdgcn_mfma_f32_32x32x16_bf16(b1,qr[0],negm,0,0,0);}
    else{p0=__builtin_amdgcn_mfma_f32_32x32x16_bf16(b0,qr[d0],p0,0,0,0);p1=__builtin_amdgcn_mfma_f32_32x32x16_bf16(b1,qr[d0],p1,0,0,0);}}
}
typedef __attribute__((address_space(3))) const char* lds_cptr;
typedef short v4i16_t __attribute__((ext_vector_type(4)));
__device__ __forceinline__ void kload8(bf16x8*kf,lds_cptr kp){
  kf[0]=*(const __attribute__((address_space(3))) bf16x8*)(kp);      kf[1]=*(const __attribute__((address_space(3))) bf16x8*)(kp+512);
  kf[2]=*(const __attribute__((address_space(3))) bf16x8*)(kp+2048); kf[3]=*(const __attribute__((address_space(3))) bf16x8*)(kp+2560);
  kf[4]=*(const __attribute__((address_space(3))) bf16x8*)(kp+4096); kf[5]=*(const __attribute__((address_space(3))) bf16x8*)(kp+4608);
  kf[6]=*(const __attribute__((address_space(3))) bf16x8*)(kp+6144); kf[7]=*(const __attribute__((address_space(3))) bf16x8*)(kp+6656);
}
__device__ __forceinline__ void kload2(bf16x8*kf,lds_cptr kp,int j){ kf[2*j]=*(const __attribute__((address_space(3))) bf16x8*)(kp+j*2048); kf[2*j+1]=*(const __attribute__((address_space(3))) bf16x8*)(kp+j*2048+512); }
__device__ __forceinline__ s16x4 vtr(lds_cptr p){ return __builtin_bit_cast(s16x4,__builtin_amdgcn_ds_read_tr16_b64_v4i16((__attribute__((address_space(3))) v4i16_t*)p)); }
__device__ __forceinline__ float rowmax(const f32x16&p0,const f32x16&p1){
  float a=max3f(p0[0],p0[1],p1[0]),b=max3f(p0[2],p0[3],p1[1]);a=max3f(a,p1[2],p1[3]);
  #pragma unroll
  for(int r=4;r<16;r+=4){a=max3f(a,p0[r],p0[r+1]);b=max3f(b,p0[r+2],p0[r+3]);a=max3f(a,p1[r],p1[r+1]);b=max3f(b,p1[r+2],p1[r+3]);}
  const float m=max2f(a,b);
  auto rr=__builtin_amdgcn_permlane32_swap(__float_as_uint(m),__float_as_uint(m),false,false);
  return max2f(__uint_as_float(rr[0]),__uint_as_float(rr[1]));
}
__device__ __forceinline__ void pv(f32x16*o,int vb,bf16x8 pa0,bf16x8 pa1,bf16x8 pa2,bf16x8 pa3){
  #pragma unroll
  for(int d0=0;d0<4;++d0){s16x4 lo[4],hi[4];
    #pragma unroll
    for(int ks=0;ks<4;++ks){
      asm volatile("ds_read_b64_tr_b16 %0,%1 offset:%c2":"=&v"(lo[ks]):"v"(vb),"i"(d0*4096+ks*1024):"memory");
      asm volatile("ds_read_b64_tr_b16 %0,%1 offset:%c2":"=&v"(hi[ks]):"v"(vb),"i"(d0*4096+ks*1024+512):"memory");}
    asm volatile("s_waitcnt lgkmcnt(0)":::"memory");SBAR();
    #define PK(k) (bf16x8){lo[k][0],lo[k][1],lo[k][2],lo[k][3],hi[k][0],hi[k][1],hi[k][2],hi[k][3]}
    o[d0]=__builtin_amdgcn_mfma_f32_32x32x16_bf16(pa0,PK(0),o[d0],0,0,0);
    o[d0]=__builtin_amdgcn_mfma_f32_32x32x16_bf16(pa1,PK(1),o[d0],0,0,0);
    o[d0]=__builtin_amdgcn_mfma_f32_32x32x16_bf16(pa2,PK(2),o[d0],0,0,0);
    o[d0]=__builtin_amdgcn_mfma_f32_32x32x16_bf16(pa3,PK(3),o[d0],0,0,0);
    #undef PK
  }
}

#ifndef ATTN_STORE16
#define ATTN_STORE16(p,v) (*(u32x4*)(p)=(v))
#endif
template<int THRL,bool FAST> __device__ __forceinline__ void attn_unit(int b,int qcol,int kcol,int vcol,int ocol,int qb,const bf16*Q,const bf16*__restrict__ K,const bf16*__restrict__ V,bf16*O,char*shm,int comb,int o0col,float lam,const float*gsub,bf16*OA,int oacol){
  const int tid=threadIdx.x,lane=tid&63,r32=lane&31,hi=lane>>5; const int wid=__builtin_amdgcn_readfirstlane(tid>>6);
  const long qrow0=(long)b*QSEQ, krow0=(long)b*KSEQ; const int q0=qb*QB;
  const bf16*Qw=Q+(qrow0+q0+wid*QBLK)*QP+qcol;
  const bf16*Kh=K+krow0*KP+kcol,*Vh=V+krow0*VP+vcol;
  const unsigned lds0=(unsigned)(uintptr_t)shm;
  float*wsf=(float*)(shm+LDS_WS)+wid*64;
  const bf16*ksrc=Kh+(long)lane*KP+wid*8;
  const bf16*vsrc=Vh+(long)(16*(wid&3)+(lane>>2))*VP+(wid>>2)*32+(lane&3)*8;
  const unsigned kdst=lds0+LDS_K+wid*1024, vdst=lds0+LDS_V+wid*1024;
  #define DMA_K(t,slot) glds16(ksrc+(long)(t)*KVBLK*KP,(unsigned)__builtin_amdgcn_readfirstlane(kdst+(slot)))
  #define DMA_V(t,slot) do{ glds16(vsrc+(long)(t)*KVBLK*VP,(unsigned)__builtin_amdgcn_readfirstlane(vdst+2*(slot))); glds16(vsrc+64+(long)(t)*KVBLK*VP,(unsigned)__builtin_amdgcn_readfirstlane(vdst+2*(slot)+8192)); }while(0)
  const int vb0=(int)(lds0+LDS_V)+((lane>>4)&1)*32+(lane&3)*8+(4*hi+((lane&15)>>2))*64;
  const char*Kbase=shm+LDS_K; bf16x8 kf[8];
  const lds_cptr shm3=(lds_cptr)shm; const lds_cptr kp0=shm3+LDS_K+hi*1024+r32*16; const lds_cptr vp0=shm3+LDS_V+((lane>>4)&1)*32+(lane&3)*8+(4*hi+((lane&15)>>2))*64;
  const int NT=(q0+QB)/KVBLK+1;
  DMA_K(0,0);DMA_V(0,0);DMA_K(1,SLOTB);
  bf16x8 qr[4];
  #pragma unroll
  for(int d0=0;d0<4;++d0)qr[d0]=*reinterpret_cast<const bf16x8*>(&Qw[(long)r32*QP+d0*16+hi*8]);
  const __attribute__((address_space(3))) char* qsp=(const __attribute__((address_space(3))) char*)shm3+LDS_OST+wid*QSTG+r32*144+hi*16;
  #pragma unroll
  for(int d0=0;d0<4;++d0)*(__attribute__((address_space(3))) bf16x8*)(qsp+d0*32)=qr[d0];
  #define QV(d0) (*(const __attribute__((address_space(3))) bf16x8*)(qsp+(d0)*32))
  float mhat=0.f,l_reg=0.f;f32x16 o[4];o[0]=f32x16{};o[1]=f32x16{};o[2]=f32x16{};o[3]=f32x16{};const f32x16 zero16=f32x16{};
  const int qrel=wid*QBLK+r32;
  #define CMASK(P0,P1,t) do{int jb_=(t)-(NT-4); if(jb_>=0)cmask(P0,P1,jb_,qrel,hi);}while(0)
  bool resc=false;
  #define START(P0,P1) do{ resc=false; if constexpr(FAST){ mhat=0.f; _Pragma("unroll") for(int r=0;r<16;++r)P0[r]=__builtin_amdgcn_exp2f(P0[r]); } \
    else { const float rm=rowmax(P0,P1); mhat=rm; _Pragma("unroll") for(int r=0;r<16;++r)P0[r]=__builtin_amdgcn_exp2f(fsub_s(P0[r],mhat)); } }while(0)
  #define RESC() do{ if(resc){ asm volatile("s_waitcnt lgkmcnt(0)":::"memory"); \
      _Pragma("unroll") for(int d_=0;d_<4;++d_) _Pragma("unroll") for(int r=0;r<16;++r)o[d_][r]*=wsf[crow(r,hi)]; } }while(0)
  f32x16 pA0,pA1,pB0,pB1;
  int sl_prev=0,sl_cur=0,sl_next=SLOTB;
  #define ROT() do{sl_prev=sl_cur;sl_cur=sl_next;sl_next=(sl_next==(NSLOT-1)*SLOTB)?0:sl_next+SLOTB;}while(0)
  DMA_K(2,2*SLOTB);
  WAIT_BAR(3);
  qkt(pA0,pA1,Kbase,qr,r32,hi);asm volatile("s_nop 15\n\ts_nop 7":"+v"(pA0),"+v"(pA1));
  { _Pragma("unroll") for(int r=8;r<16;++r)pA0[r]=-INFINITY; _Pragma("unroll") for(int r=0;r<16;++r)pA1[r]=-INFINITY; }
  START(pA0,pA1);
  if constexpr(FAST){ _Pragma("unroll") for(int r=0;r<16;++r)pA1[r]=__builtin_amdgcn_exp2f(pA1[r]); } else { _Pragma("unroll") for(int r=0;r<16;++r)pA1[r]=__builtin_amdgcn_exp2f(fsub_s(pA1[r],mhat)); }
  WAIT_BAR(0);
  DMA_K(3,0);DMA_V(1,SLOTB);
  ROT();
  kload8(kf,kp0+sl_cur);
  WAIT_BAR(3);
  s16x4 vlo[8],vhi[8]; u32x4 pw0,pw1,pw2,pw3;
  #define PKW(P,B) cvtpk_s(P[B],P[B+1])
  #define PAF(k) __builtin_bit_cast(bf16x8,pw##k)
  #define VFR(i) (bf16x8){vlo[i][0],vlo[i][1],vlo[i][2],vlo[i][3],vhi[i][0],vhi[i][1],vhi[i][2],vhi[i][3]}
  #define PIN(x) asm volatile("":"+v"(x))
  #define MX3(a,b,c) __builtin_fmaxf(__builtin_fmaxf((a),(b)),(c))
  #define GAPA(MF,A0,A1,A2,A3,W0,W1,PW) do{ MF; sacc+=A0; sacc+=A1; sacc+=A2; sacc+=A3; PIN(sacc); W0; W1; PIN(PW); SBAR(); }while(0)
  #define EX(v) __builtin_amdgcn_exp2f(v)
  #define GAPB(MF,X,B) do{ MF; if constexpr(FAST){ X[B]=EX(X[B]); X[B+1]=EX(X[B+1]); } else { X[B]=EX(X[B]-mhat); X[B+1]=EX(X[B+1]-mhat); } PIN(X); SBAR(); }while(0)
  #define VOF(j) ((((j)&3)*4096)+(((j)>>2)*1024))
  #define VRD(sl,j) do{ vlo[sl]=vtr(vp_+VOF(j)); vhi[sl]=vtr(vp_+VOF(j)+512); }while(0)
  #define KRD(G,j) do{ if(G){ kload2(kf,kp0+sl_next,j); SBAR(); } }while(0)
  #define PVM(j) o[(j)&3]=__builtin_amdgcn_mfma_f32_32x32x16_bf16(PAFJ(j),VFR((j)&7),o[(j)&3],0,0,0)
  #define PAFJ(j) (((j)>>2)==0?PAF(0):((j)>>2)==1?PAF(1):((j)>>2)==2?PAF(2):PAF(3))
  #define STEP(C0,C1,P0,P1,t,GK,GV,GL) do{ SBAR(); \
    const lds_cptr vp_=vp0+2*sl_prev; \
    VRD(0,0); SBAR(); float sacc=(P0[0]+P0[1]); \
    GAPA(C0=__builtin_amdgcn_mfma_f32_32x32x16_bf16(kf[0],QV(0),zero16,0,0,0), P0[2],P0[3],P0[4],P0[5],     pw0[0]=PKW(P0,0), pw0[1]=PKW(P0,2), pw0); \
    VRD(1,1); SBAR(); GAPA(C1=__builtin_amdgcn_mfma_f32_32x32x16_bf16(kf[1],QV(0),zero16,0,0,0), P0[6],P0[7],P0[8],P0[9],     pw0[2]=PKW(P0,4), pw0[3]=PKW(P0,6), pw0); \
    VRD(2,2); SBAR(); GAPA(C0=__builtin_amdgcn_mfma_f32_32x32x16_bf16(kf[2],QV(1),C0,0,0,0),   P0[10],P0[11],P0[12],P0[13], pw1[0]=PKW(P0,8), pw1[1]=PKW(P0,10), pw1); \
    VRD(3,3); SBAR(); GAPA(C1=__builtin_amdgcn_mfma_f32_32x32x16_bf16(kf[3],QV(1),C1,0,0,0),   P0[14],P0[15],P1[0],P1[1],   pw1[2]=PKW(P0,12),pw1[3]=PKW(P0,14), pw1); \
    VRD(4,4); SBAR(); GAPA(C0=__builtin_amdgcn_mfma_f32_32x32x16_bf16(kf[4],QV(2),C0,0,0,0),   P1[2],P1[3],P1[4],P1[5],     pw2[0]=PKW(P1,0), pw2[1]=PKW(P1,2), pw2); \
    VRD(5,5); SBAR(); GAPA(C1=__builtin_amdgcn_mfma_f32_32x32x16_bf16(kf[5],QV(2),C1,0,0,0),   P1[6],P1[7],P1[8],P1[9],     pw2[2]=PKW(P1,4), pw2[3]=PKW(P1,6), pw2); \
    VRD(6,6); SBAR(); GAPA(C0=__builtin_amdgcn_mfma_f32_32x32x16_bf16(kf[6],QV(3),C0,0,0,0),   P1[10],P1[11],P1[12],P1[13], pw3[0]=PKW(P1,8), pw3[1]=PKW(P1,10), pw3); \
    VRD(7,7); SBAR(); GAPA(C1=__builtin_amdgcn_mfma_f32_32x32x16_bf16(kf[7],QV(3),C1,0,0,0),   P1[14],P1[15],0.f,0.f,       pw3[2]=PKW(P1,12),pw3[3]=PKW(P1,14), pw3); \
    l_reg+=sacc; \
    if(GK){DMA_K((t)+3,sl_cur);} if(GV){DMA_V((t)+1,sl_next);} \
    CMASK(C0,C1,t); \
    if constexpr(!FAST){ float a=MX3(C0[0],C0[1],C1[0]),b=MX3(C0[2],C0[3],C1[1]); a=MX3(a,C1[2],C1[3]); \
      _Pragma("unroll") for(int r=4;r<16;r+=4){a=MX3(a,C0[r],C0[r+1]);b=MX3(b,C0[r+2],C0[r+3]);a=MX3(a,C1[r],C1[r+1]);b=MX3(b,C1[r+2],C1[r+3]);} \
      float rm=__builtin_fmaxf(a,b); { auto rr=__builtin_amdgcn_permlane32_swap(__float_as_uint(rm),__float_as_uint(rm),false,false); rm=__builtin_fmaxf(__uint_as_float(rr[0]),__uint_as_float(rr[1])); } \
      rm-=mhat; resc=false; \
      if(__builtin_expect(__any(rm>(float)THRL),0)){ const float dl=__builtin_fmaxf(rm,0.f); mhat+=dl; \
        const float f=__builtin_amdgcn_exp2f(-dl); l_reg*=f; if(hi==0)wsf[r32]=f; resc=true; } } \
    SBAR(); \
    GAPB(PVM(0), C0,0); \
    GAPB(PVM(1), C0,2);  VRD(0,8);  SBAR(); \
    GAPB(PVM(2), C0,4);  VRD(1,9);  SBAR(); \
    GAPB(PVM(3), C0,6);  VRD(2,10); SBAR(); \
    GAPB(PVM(4), C0,8);  VRD(3,11); SBAR(); \
    GAPB(PVM(5), C0,10); VRD(4,12); SBAR(); \
    GAPB(PVM(6), C0,12); VRD(5,13); SBAR(); \
    GAPB(PVM(7), C0,14); VRD(6,14); SBAR(); \
    GAPB(PVM(8), C1,0);  VRD(7,15); SBAR(); \
    KRD(GL,0); GAPB(PVM(9),  C1,2); \
    KRD(GL,1); GAPB(PVM(10), C1,4); \
    KRD(GL,2); GAPB(PVM(11), C1,6); \
    KRD(GL,3); GAPB(PVM(12), C1,8); \
    GAPB(PVM(13), C1,10); \
    GAPB(PVM(14), C1,12); \
    GAPB(PVM(15), C1,14); \
    }while(0)
  int t=1;
  #undef CMASK
  #define CMASK(P0,P1,t) do{}while(0)
  for(;t+5<NT;t+=2){
    STEP(pB0,pB1,pA0,pA1,t,true,true,true);     WAIT_BAR(3); RESC(); ROT();
    STEP(pA0,pA1,pB0,pB1,t+1,true,true,true);   WAIT_BAR(3); RESC(); ROT();
  }
  #undef CMASK
  #define CMASK(P0,P1,t) do{int jb_=(t)-(NT-4); if(jb_>=0)cmask(P0,P1,jb_,qrel,hi);}while(0)
  #define ENDW(tt) do{ if((tt)+3<NT){WAIT_BAR(3);} else if((tt)+2<NT){WAIT_BAR(2);} else {WAIT_BAR(0);} }while(0)
  for(;t+1<NT;t+=2){
    STEP(pB0,pB1,pA0,pA1,t,(t+3<NT),(t+1<NT),(t+1<NT));       ENDW(t);   RESC(); ROT();
    STEP(pA0,pA1,pB0,pB1,t+1,(t+4<NT),(t+2<NT),(t+2<NT));     ENDW(t+1); RESC(); ROT();
  }
  { float sacc=pA0[0]+pA0[1]; _Pragma("unroll") for(int r=2;r<16;++r)sacc+=pA0[r]; _Pragma("unroll") for(int r=0;r<16;++r)sacc+=pA1[r]; l_reg+=sacc;
    pw0=(u32x4){PKW(pA0,0),PKW(pA0,2),PKW(pA0,4),PKW(pA0,6)};pw1=(u32x4){PKW(pA0,8),PKW(pA0,10),PKW(pA0,12),PKW(pA0,14)};pw2=(u32x4){PKW(pA1,0),PKW(pA1,2),PKW(pA1,4),PKW(pA1,6)};pw3=(u32x4){PKW(pA1,8),PKW(pA1,10),PKW(pA1,12),PKW(pA1,14)};
    SBAR(); pv(o,vb0+2*sl_prev,PAF(0),PAF(1),PAF(2),PAF(3)); }
  #undef PKW
  #undef PAF
  #undef VFR
  #undef PIN
  #undef MX3
  #undef GAPA
  #undef GAPB
  #undef EX
  #undef VRD
  #undef KRD
  #undef STEP
  #undef VOF
  #undef PVM
  #undef PAFJ
  #undef QV
  #undef ENDW
  {auto rr=__builtin_amdgcn_permlane32_swap(__float_as_uint(l_reg),__float_as_uint(l_reg),false,false);l_reg=__uint_as_float(rr[0])+__uint_as_float(rr[1]);}
  if(hi==0)wsf[32+r32]=l_reg;asm volatile("s_waitcnt lgkmcnt(0)":::"memory");
  float rli[16];
  #pragma unroll
  for(int r=0;r<16;++r)rli[r]=__builtin_amdgcn_rcpf(wsf[32+crow(r,hi)]);
  bf16*Ow=O+(qrow0+q0+wid*QBLK)*OP+ocol;
  { int oz_; asm volatile("v_mov_b32 %0, 0":"=v"(oz_)); const int ln=lane+oz_;
    bf16*stg=(bf16*)(shm+LDS_OST+wid*QSTG);
    if(!comb){
      #pragma unroll
      for(int hh=0;hh<2;++hh){
        #pragma unroll
        for(int r=0;r<16;++r){const int orow=crow(r,hi);
          #pragma unroll
          for(int d0=0;d0<2;++d0)stg[orow*64+d0*32+r32]=__float2bfloat16(o[2*hh+d0][r]*rli[r]);}
        asm volatile("s_waitcnt lgkmcnt(0)":::"memory");
        #pragma unroll
        for(int i=0;i<4;++i){const int row=i*8+(ln>>3),ch=ln&7; const u32x4 v=*(const u32x4*)(stg+row*64+ch*8); ATTN_STORE16(Ow+(long)row*OP+hh*64+ch*8,v);}
        asm volatile("s_waitcnt lgkmcnt(0)":::"memory"); }
    } else {
      const bf16*O0w=O+(qrow0+q0+wid*QBLK)*OP+o0col; bf16*OAw=OA+(qrow0+q0+wid*QBLK)*512+oacol;
      float ssr[4]={0.f,0.f,0.f,0.f};
      #pragma unroll
      for(int pass=0;pass<2;++pass){
        if(pass==1){
          #pragma unroll
          for(int i=0;i<4;++i){ float ss=ssr[i]; ss+=__shfl_xor(ss,1); ss+=__shfl_xor(ss,2); ss+=__shfl_xor(ss,4); ssr[i]=0.8f/sqrtf(ss*(1.0f/128.0f)+1e-6f); } }
        #pragma unroll
        for(int hh=0;hh<2;++hh){
          u32x4 v0[4];
          #pragma unroll
          for(int i=0;i<4;++i){const int row=i*8+(ln>>3),ch=ln&7; v0[i]=*(const u32x4*)(O0w+(long)row*OP+hh*64+ch*8);}
          #pragma unroll
          for(int r=0;r<16;++r){const int orow=crow(r,hi);
            #pragma unroll
            for(int d0=0;d0<2;++d0)stg[orow*64+d0*32+r32]=__float2bfloat16(o[2*hh+d0][r]*rli[r]);}
          asm volatile("s_waitcnt lgkmcnt(0)":::"memory");
          const int ch=ln&7; const float4 g0=*(const float4*)(gsub+hh*64+ch*8), g1=*(const float4*)(gsub+hh*64+ch*8+4); const float gg[8]={g0.x,g0.y,g0.z,g0.w,g1.x,g1.y,g1.z,g1.w};
          #pragma unroll
          for(int i=0;i<4;++i){const int row=i*8+(ln>>3); const u32x4 v1=*(const u32x4*)(stg+row*64+ch*8); const u32x4 a=v0[i];
            const unsigned aw[4]={a.x,a.y,a.z,a.w},bw[4]={v1.x,v1.y,v1.z,v1.w}; float dd[8];
            #pragma unroll
            for(int j=0;j<4;++j){ dd[2*j]=__uint_as_float(aw[j]<<16)-lam*__uint_as_float(bw[j]<<16); dd[2*j+1]=__uint_as_float(aw[j]&0xffff0000u)-lam*__uint_as_float(bw[j]&0xffff0000u); }
            if(pass==0){
              #pragma unroll
              for(int j=0;j<8;++j)ssr[i]+=dd[j]*dd[j]; }
            else { const float rn=ssr[i]; u32x4 w;
              w.x=cvtpk_s(dd[0]*rn*gg[0],dd[1]*rn*gg[1]); w.y=cvtpk_s(dd[2]*rn*gg[2],dd[3]*rn*gg[3]); w.z=cvtpk_s(dd[4]*rn*gg[4],dd[5]*rn*gg[5]); w.w=cvtpk_s(dd[6]*rn*gg[6],dd[7]*rn*gg[7]);
              *(u32x4*)(OAw+(long)row*512+hh*64+ch*8)=w; } }
          asm volatile("s_waitcnt lgkmcnt(0)":::"memory"); } }
    } }
  asm volatile("s_waitcnt lgkmcnt(0)\n\ts_barrier":::"memory");
  #undef DMA_K
  #undef DMA_V
  #undef CMASK
  #undef START
  #undef RESC
  #undef ROT
}
constexpr int ATTN_LDS_BYTES=LDS_BYTES;
struct AttnTensors { const bf16* Q; const bf16* K; const bf16* V; bf16* O; };
#undef SBAR
#undef WAIT_BAR
}
#define GAS __attribute__((address_space(1)))
#define LAS __attribute__((address_space(3)))
typedef unsigned short bf16;
typedef unsigned v4u __attribute__((ext_vector_type(4)));
typedef float f32x4 __attribute__((ext_vector_type(4)));
typedef short bf16x8 __attribute__((ext_vector_type(8)));
typedef GAS unsigned gu32;
typedef GAS unsigned long long gu64;
#define RLX_AGENT __ATOMIC_RELAXED, __HIP_MEMORY_SCOPE_AGENT
#define LDS_WAIT() asm volatile("s_waitcnt lgkmcnt(0)" ::: "memory")
#define VM_WAIT() asm volatile("s_waitcnt vmcnt(0)" ::: "memory")
__device__ __forceinline__ unsigned long long rt() { return __builtin_amdgcn_s_memrealtime(); }
__device__ __forceinline__ unsigned f2bf(float f) { unsigned u = __builtin_bit_cast(unsigned, f); return (u + 0x7fffu + ((u >> 16) & 1u)) >> 16; }
__device__ __forceinline__ unsigned pk2(float lo, float hi) { return f2bf(lo) | (f2bf(hi) << 16); }

#define XB_TMO      128
#define XB_XCNT(j)  (256  + 64 * (j))
#define XB_XSUB(j)  (1280 + 64 * (j))
#define XB_XGEN(j)  (2304 + 64 * (j))
#define XB_TOP      3328
#define XB_TOPGEN   3392
#define XCD_BAR_WORDS 3456
#define XB_SPIN_CAP (1u << 18)

__device__ __forceinline__ unsigned xb_ld(unsigned* p)              { return __hip_atomic_load(p, __ATOMIC_RELAXED, __HIP_MEMORY_SCOPE_AGENT); }
__device__ __forceinline__ unsigned xb_add(unsigned* p, unsigned v) { return __hip_atomic_fetch_add(p, v, __ATOMIC_RELAXED, __HIP_MEMORY_SCOPE_AGENT); }
__device__ __forceinline__ unsigned xb_xcc_id() { return (unsigned)__builtin_amdgcn_s_getreg((3 << 11) | 20) & 0xFu; }
#define XB_SPIN(cond, bar) do { unsigned _sp = 0; while (cond) { __builtin_amdgcn_s_sleep(1); \
    if ((++_sp & 255u) == 0u) { if (xb_ld(&(bar)[XB_TMO])) break; if (_sp > XB_SPIN_CAP) { atomicAdd(&(bar)[XB_TMO], 1u); break; } } } } while (0)

struct XcdBarrier {
    unsigned* bar; unsigned x;
    volatile LAS unsigned* st;
};

__device__ __forceinline__ XcdBarrier xcd_barrier_post(unsigned* bar, volatile LAS unsigned* st) {
    XcdBarrier b; b.bar = bar; b.x = xb_xcc_id(); b.st = st;
    if (threadIdx.x == 0) (void)xb_add(&bar[XB_XCNT(b.x)], 1u);
    return b;
}
__device__ __forceinline__ void xcd_barrier_complete(unsigned* bar, unsigned x, unsigned& nloc, unsigned& nx) {
    const unsigned G = gridDim.x * gridDim.y * gridDim.z;
    unsigned sum, cnt, mine, sp = 0u;
    for (;;) {
        sum = 0u; cnt = 0u; mine = 0u;
#pragma unroll
        for (unsigned j = 0; j < 16; ++j) { const unsigned c = xb_ld(&bar[XB_XCNT(j)]); sum += c; cnt += (c > 0u) ? 1u : 0u; mine = (j == x) ? c : mine; }
        if (sum == G) break;
        __builtin_amdgcn_s_sleep(1);
        if ((++sp & 255u) == 0u) { if (xb_ld(&bar[XB_TMO])) break; if (sp > XB_SPIN_CAP) { atomicAdd(&bar[XB_TMO], 1u); break; } }
    }
    nloc = mine > 0u ? mine : 1u; nx = cnt > 0u ? cnt : 1u;
}

__device__ __forceinline__ void xcd_barrier(const XcdBarrier& b) {
    asm volatile("s_waitcnt vmcnt(0)" ::: "memory");
    __syncthreads();
    if (threadIdx.x == 0) {
        unsigned* bar = b.bar;
        __builtin_amdgcn_s_waitcnt(0);
        unsigned nloc = b.st[0], nx = b.st[1];
        if (nloc == 0u) { xcd_barrier_complete(bar, b.x, nloc, nx); b.st[0] = nloc; b.st[1] = nx; }
        const unsigned old = xb_add(&bar[XB_XSUB(b.x)], 1u);
        const unsigned gen = old / nloc;
        if (old + 1u == (gen + 1u) * nloc) {
            __builtin_amdgcn_fence(__ATOMIC_RELEASE, "agent");
            asm volatile("s_waitcnt vmcnt(0)" ::: "memory");
            const unsigned og = xb_add(&bar[XB_TOP], 1u);
            const unsigned tg = og / nx;
            if (og + 1u == (tg + 1u) * nx) xb_add(&bar[XB_TOPGEN], 1u);
            else XB_SPIN(xb_ld(&bar[XB_TOPGEN]) == tg, bar);
            __builtin_amdgcn_fence(__ATOMIC_ACQUIRE, "agent");
            xb_add(&bar[XB_XGEN(b.x)], 1u);
            asm volatile("s_waitcnt vmcnt(0)" ::: "memory");
        } else {
            XB_SPIN(xb_ld(&bar[XB_XGEN(b.x)]) == gen, bar);
            __builtin_amdgcn_fence(__ATOMIC_ACQUIRE, "agent");
            asm volatile("s_waitcnt vmcnt(0)" ::: "memory");
        }
    }
    __syncthreads();
}
constexpr int NWAVES = 8;
constexpr int DM = 1024, NBATCH = 8, SEQ = 4096, NMETA = 16;
constexpr int MROWS = NBATCH * SEQ;
constexpr int LPB = SEQ + 64;
constexpr int PROWS = NBATCH * LPB + 64;
constexpr int MZ = MROWS + 256;
constexpr int NZ = 5376, DIN = 5136;
constexpr int C_DAQ = 0, C_DAK = 512, C_DAV = 1024, C_GQ = 1536, C_GK = 1792, C_GV = 2048, C_GR = 2560, C_GG = 3072, C_GL = 3088;
constexpr float EPS = 1e-6f;
constexpr int NEXP = 32, DEXP = 512, LCAP = 32768;
constexpr int NPOS = SEQ + NMETA;

constexpr size_t MiB = 1u << 20;
constexpr size_t WS_CTL = 0, CTL_ZERO_BYTES = 128 * 1024, WS_TRASH = 768 * 1024;
constexpr size_t WS_ROPE = 1 * MiB;
constexpr size_t WS_WRH = 3 * MiB, WS_WRL = 3 * MiB + 128 * 1024;
constexpr size_t WS_IG2 = 3 * MiB + 512 * 1024;
constexpr size_t WS_LTOK = 4 * MiB, WS_LRS = 12 * MiB, WS_LW = 20 * MiB;
constexpr size_t WS_WIN = 28 * MiB, WS_WBR = 39 * MiB, WS_WOUT = 41 * MiB, WS_WGU = 43 * MiB, WS_WD = 107 * MiB;
constexpr size_t WS_R1 = 139 * MiB;
constexpr size_t WS_Q = 204 * MiB, WS_K = 236 * MiB, WS_V = 269 * MiB;
constexpr size_t WS_OA = 204 * MiB, WS_H2U = 204 * MiB;
constexpr size_t WS_GQ = 302 * MiB, WS_GK = 319 * MiB, WS_GV = 336 * MiB, WS_GR = 369 * MiB, WS_LOGA = 402 * MiB;
constexpr size_t WS_HID = 302 * MiB;
constexpr size_t WS_H2U8 = 269 * MiB;
constexpr float W8SCALE = 32.0f, H8SCALE = 4.0f;
constexpr size_t WS_DS = 435 * MiB, WS_END = 500 * MiB;
constexpr size_t WS_XN8 = WS_DS, WS_WIN8 = WS_WIN + 7 * MiB;
constexpr float X8SCALE = 8.0f;
static_assert((size_t)13 * 256 * DM * 2 <= 7 * MiB && WS_WIN8 + (size_t)2048 * DM <= WS_WBR && WS_XN8 + (size_t)MROWS * DM <= WS_END, "ws map 4");
static_assert(WS_R1 + (size_t)MZ * DM * 2 <= WS_Q && WS_K + (size_t)PROWS * 512 * 2 <= WS_V && WS_V + (size_t)PROWS * 512 * 2 <= WS_GQ, "ws map 1");
static_assert(WS_GQ + (size_t)PROWS * 256 * 2 <= WS_GK && WS_GK + (size_t)PROWS * 256 * 2 <= WS_GV && WS_GV + (size_t)PROWS * 512 * 2 <= WS_GR && WS_GR + (size_t)PROWS * 512 * 2 <= WS_LOGA && WS_LOGA + (size_t)PROWS * 256 * 4 <= WS_DS, "ws map 2");
static_assert(WS_HID + (size_t)81920 * 512 * 2 <= WS_DS && WS_DS + (size_t)32 * 64 * 8192 * 4 <= WS_END && WS_WIN + (size_t)NZ * DM * 2 <= WS_WBR && WS_WD + (size_t)32 * 1024 * 512 * 2 <= WS_R1, "ws map 3");
constexpr int CW_TMO = 0, CW_BAR = 4096, CW_CNT = 16384;

constexpr int RING_OFF = 0, RING_BYTES = 131072;
constexpr int LDSCTL_OFF = RING_BYTES, MISC_OFF = LDSCTL_OFF + 320, TB_OFF = LDSCTL_OFF + 1024, CN_OFF = LDSCTL_OFF + 1536;
constexpr int INTAB_OFF = LDSCTL_OFF + 3072;
constexpr int BML_OFF = LDSCTL_OFF + 4096;
constexpr int EPISTG_OFF = 147456;
constexpr int LDS_BYTES = 163840;
struct Frame {
    LAS unsigned char* lds;
    volatile LAS unsigned* MISC;
    gu32* ctl;
    int tid, lane, wave, vcu, G;
    float* out; unsigned char* ws;
    __device__ __forceinline__ const float* inp(int i) const { const unsigned long long v = ((const LAS unsigned long long*)(lds + INTAB_OFF))[i];
        return (const float*)(((unsigned long long)(unsigned)__builtin_amdgcn_readfirstlane((int)(v >> 32)) << 32) | (unsigned)__builtin_amdgcn_readfirstlane((int)v)); }
};
enum { I_X = 0, I_META, I_GMIX, I_WIN, I_GQN, I_GKN, I_LQ1, I_LK1, I_LQ2, I_LK2, I_GSUB, I_WGUP, I_BGATE, I_GGLA, I_WBR, I_BMERGE, I_WOUT, I_GFFN, I_WRG, I_BRG, I_WRE, I_BRE, I_WEG, I_WEU, I_WED };
#define WSP(T, off) ((T*)(F.ws + (off)))

__device__ __forceinline__ float wave_sum(float v) {
#pragma unroll
    for (int o = 1; o < 64; o <<= 1) v += __shfl_xor(v, o);
    return v;
}
__device__ __forceinline__ float bf2f(bf16 v) { return __uint_as_float((unsigned)v << 16); }
__device__ __forceinline__ float sigmoidf_(float x) { return 1.0f / (1.0f + __expf(-x)); }
__device__ __forceinline__ float clamp8(float x) { return fminf(fmaxf(x, -448.0f), 448.0f); }
__device__ __forceinline__ unsigned pk4_fp8(float a, float b, float c, float d) { unsigned w = 0; w = __builtin_amdgcn_cvt_pk_fp8_f32(clamp8(a), clamp8(b), w, false); w = __builtin_amdgcn_cvt_pk_fp8_f32(clamp8(c), clamp8(d), w, true); return w; }

__device__ __forceinline__ void transpose_tile(const float* src, int Ns, unsigned char* dstb, unsigned pitch, bool f8, LAS float* scr, int lane) {
    float tv[32];
#pragma unroll
    for (int i = 0; i < 32; ++i) tv[i] = __builtin_nontemporal_load(&src[(unsigned)((2 * i + (lane >> 5)) * Ns + (lane & 31))]);
#pragma unroll
    for (int i = 0; i < 32; ++i) scr[(2 * i + (lane >> 5)) * 33 + (lane & 31)] = tv[i];
    LDS_WAIT(); asm volatile("" ::: "memory");
    const int c = lane & 7;
#pragma unroll
    for (int j = 0; j < 4; ++j) { const int n = (lane >> 3) + 8 * j; const LAS float* s = scr + (8 * c) * 33 + n;
        if (f8) { const unsigned lo = pk4_fp8(s[0 * 33] * W8SCALE, s[1 * 33] * W8SCALE, s[2 * 33] * W8SCALE, s[3 * 33] * W8SCALE), hi = pk4_fp8(s[4 * 33] * W8SCALE, s[5 * 33] * W8SCALE, s[6 * 33] * W8SCALE, s[7 * 33] * W8SCALE);
            *(GAS unsigned long long*)(dstb + (unsigned)n * pitch + 8 * c) = (unsigned long long)lo | ((unsigned long long)hi << 32); }
        else { v4u o; o.x = pk2(s[0 * 33], s[1 * 33]); o.y = pk2(s[2 * 33], s[3 * 33]); o.z = pk2(s[4 * 33], s[5 * 33]); o.w = pk2(s[6 * 33], s[7 * 33]);
            *(GAS v4u*)(dstb + (unsigned)n * pitch + 16 * c) = o; } }
    LDS_WAIT(); asm volatile("" ::: "memory");
}
__device__ __forceinline__ void product_tile(const float* win, const float* wgu, int k0, int n0, bf16* dst, LAS float* scr, int lane) {
    float wg[16];
#pragma unroll
    for (int r = 0; r < 16; ++r) wg[r] = wgu[r * 256 + n0 + (lane & 31)];
    LAS float* gb = scr + 64 * 33;
#pragma unroll
    for (int j = 0; j < 4; ++j) { const int idx = lane + 64 * j, kk = idx >> 2, q = idx & 3; *(LAS f32x4*)(gb + kk * 16 + 4 * q) = *(const GAS f32x4*)(win + (size_t)(k0 + kk) * DIN + C_GG + 4 * q); }
    LDS_WAIT(); asm volatile("" ::: "memory");
#pragma unroll 4
    for (int i = 0; i < 32; ++i) { const int kk = 2 * i + (lane >> 5); const LAS f32x4* g4 = (const LAS f32x4*)(gb + kk * 16); float s = 0.f;
#pragma unroll
        for (int q = 0; q < 4; ++q) { const f32x4 g = g4[q]; s += g.x * wg[4 * q] + g.y * wg[4 * q + 1] + g.z * wg[4 * q + 2] + g.w * wg[4 * q + 3]; }
        scr[kk * 33 + (lane & 31)] = s; }
    LDS_WAIT(); asm volatile("" ::: "memory");
    const int c = lane & 7;
#pragma unroll
    for (int j = 0; j < 4; ++j) { const int n = (lane >> 3) + 8 * j; const LAS float* s = scr + (8 * c) * 33 + n;
        v4u o; o.x = pk2(s[0 * 33], s[1 * 33]); o.y = pk2(s[2 * 33], s[3 * 33]); o.z = pk2(s[4 * 33], s[5 * 33]); o.w = pk2(s[6 * 33], s[7 * 33]);
        *(GAS v4u*)(dst + (size_t)n * DM + 8 * c) = o; }
    LDS_WAIT(); asm volatile("" ::: "memory");
}
__device__ __forceinline__ int win_src_col(int T, int p0) {
    if (T < 4) { const int bj = p0 >> 7, wc = (p0 >> 5) & 3; return (T < 2 ? C_DAQ + 256 * T : C_DAK + 256 * (T - 2)) + 64 * wc + 32 * bj; }
    const int pc = 64 * ((p0 >> 5) & 3) + 32 * (p0 >> 7);
    if (T < 6) return C_DAV + 256 * (T - 4) + pc;
    if (T == 6) return C_GQ + pc;
    if (T == 7) return C_GK + pc;
    if (T < 10) return C_GV + 256 * (T - 8) + pc;
    if (T < 12) return C_GR + 256 * (T - 10) + pc;
    const int t = T - 13; return p0 < 128 ? C_GL + 128 * t + p0 : C_GL + 1024 + 128 * t + (p0 - 128);
}
template <int NR, bool F8C> __device__ __forceinline__ void rms_rows_to_bf16(Frame& F, const float* const (&xrow)[NR], const float* gain, bf16* const (&orow)[NR]) {
    const GAS f32x4* gr = (const GAS f32x4*)gain + F.lane;
    f32x4 v[NR][4];
#pragma unroll
    for (int r = 0; r < NR; ++r) { const GAS f32x4* xr = (const GAS f32x4*)xrow[r] + F.lane;
#pragma unroll
        for (int j = 0; j < 4; ++j) v[r][j] = __builtin_nontemporal_load(&xr[64 * j]); }
#pragma unroll
    for (int r = 0; r < NR; ++r) { float s = 0.f;
#pragma unroll
        for (int j = 0; j < 4; ++j) s += (v[r][j].x * v[r][j].x + v[r][j].y * v[r][j].y) + (v[r][j].z * v[r][j].z + v[r][j].w * v[r][j].w);
        const float rstd = 1.f / sqrtf(wave_sum(s) * (1.f / DM) + EPS);
        GAS unsigned long long* o8 = (GAS unsigned long long*)orow[r] + F.lane;
        GAS unsigned* o4 = (GAS unsigned*)(F.ws + WS_XN8 + (size_t)(((const unsigned char*)orow[r] - (F.ws + WS_R1)) >> 1)) + F.lane;
#pragma unroll
        for (int j = 0; j < 4; ++j) { const f32x4 g = gr[64 * j]; const float y0 = v[r][j].x * rstd * g.x, y1 = v[r][j].y * rstd * g.y, y2 = v[r][j].z * rstd * g.z, y3 = v[r][j].w * rstd * g.w;
            o8[64 * j] = (unsigned long long)pk2(y0, y1) | ((unsigned long long)pk2(y2, y3) << 32);
            if (F8C) o4[64 * j] = pk4_fp8(y0 * X8SCALE, y1 * X8SCALE, y2 * X8SCALE, y3 * X8SCALE); } }
}
constexpr int N_EXPERT_ITEMS = NEXP * 256 + NEXP * 128;
__device__ __forceinline__ void expert_conv_desc(Frame& F, int it, const float*& src, unsigned char*& dst, unsigned& Ns, unsigned& Kd) {
    if (it < NEXP * 256) { const int e = it >> 8, q = it & 255, kb = q >> 4, nbp = q & 15, P0 = nbp * 64, pn = P0 >> 8, p = P0 & 255;
        src = (p < 128 ? F.inp(I_WEG) : F.inp(I_WEU)) + (size_t)e * 1024 * 512 + (size_t)(kb * 64) * 512 + 128 * pn + (p & 127); Ns = 512;
        dst = WSP(unsigned char, WS_WGU) + (size_t)(e * 1024 + P0) * 1024 + kb * 64; Kd = 1024; }
    else { const int r = it - NEXP * 256, e = r >> 7, q = r & 127, kb = q >> 4, nb = q & 15;
        src = F.inp(I_WED) + (size_t)e * 512 * 1024 + (size_t)(kb * 64) * 1024 + nb * 64; Ns = 1024; dst = WSP(unsigned char, WS_WD) + (size_t)(e * 1024 + nb * 64) * 512 + kb * 64; Kd = 512; }
}
__device__ __forceinline__ void expert_conv_store(unsigned char* dst, unsigned Kd, const float (&v)[64], int lane, LAS unsigned char* stg) {
#pragma unroll
    for (int kg = 0; kg < 4; ++kg) { v4u o;
        o.x = pk4_fp8(v[16 * kg] * W8SCALE, v[16 * kg + 1] * W8SCALE, v[16 * kg + 2] * W8SCALE, v[16 * kg + 3] * W8SCALE); o.y = pk4_fp8(v[16 * kg + 4] * W8SCALE, v[16 * kg + 5] * W8SCALE, v[16 * kg + 6] * W8SCALE, v[16 * kg + 7] * W8SCALE);
        o.z = pk4_fp8(v[16 * kg + 8] * W8SCALE, v[16 * kg + 9] * W8SCALE, v[16 * kg + 10] * W8SCALE, v[16 * kg + 11] * W8SCALE); o.w = pk4_fp8(v[16 * kg + 12] * W8SCALE, v[16 * kg + 13] * W8SCALE, v[16 * kg + 14] * W8SCALE, v[16 * kg + 15] * W8SCALE);
        *(LAS v4u*)(stg + lane * 80 + kg * 16) = o; }
    LDS_WAIT(); asm volatile("" ::: "memory");
#pragma unroll
    for (int i = 0; i < 4; ++i) { const int r = (lane >> 2) + 16 * i, c = lane & 3; const v4u o = *(const LAS v4u*)(stg + r * 80 + c * 16); *(GAS v4u*)(dst + (size_t)r * Kd + 16 * c) = o; }
    LDS_WAIT(); asm volatile("" ::: "memory");
}
__device__ __forceinline__ void expert_conv_range(Frame& F, int first, int me, int nw) {
    const int stride = nw; LAS unsigned char* stg = F.lds + RING_OFF + F.wave * 9216;
    for (int it = first + me; it < N_EXPERT_ITEMS; it += 2 * stride) {
        const float *s0, *s1; unsigned char *d0, *d1; unsigned n0, k0, n1, k1; const bool two = it + stride < N_EXPERT_ITEMS;
        expert_conv_desc(F, it, s0, d0, n0, k0); expert_conv_desc(F, two ? it + stride : it, s1, d1, n1, k1);
        float va[64], vb[64];
#pragma unroll
        for (int k = 0; k < 64; ++k) va[k] = __builtin_nontemporal_load(&s0[(unsigned)k * n0 + (unsigned)F.lane]);
        if (two) {
#pragma unroll
            for (int k = 0; k < 64; ++k) vb[k] = __builtin_nontemporal_load(&s1[(unsigned)k * n1 + (unsigned)F.lane]); }
        expert_conv_store(d0, k0, va, F.lane, stg);
        if (two) expert_conv_store(d1, k1, vb, F.lane, stg);
    }
    asm volatile("s_waitcnt lgkmcnt(0)" ::: "memory"); __syncthreads();
}
__device__ __forceinline__ void expert_conv_slot(Frame& F, int slot, int nslot, int first) { expert_conv_range(F, first, (slot * F.G + F.vcu) * NWAVES + F.wave, nslot * F.G * NWAVES); }
__device__ __forceinline__ void late_tables(Frame& F, int gt, int NGT) {
    { bf16* wh = WSP(bf16, WS_WRH); bf16* wl = WSP(bf16, WS_WRL);
      for (int i = gt; i < 48 * 1024; i += NGT) { const int n = i >> 10, k = i & 1023; const float v = n < 4 ? F.inp(I_WRG)[k * 4 + n] : (n < 36 ? F.inp(I_WRE)[k * 32 + (n - 4)] : 0.f);
          const unsigned h = f2bf(v); const float hf = __uint_as_float(h << 16); wh[i] = (bf16)h; wl[i] = (bf16)f2bf(v - hf); } }
    { float* ig = WSP(float, WS_IG2); for (int i = gt; i < DM; i += NGT) { const float g = F.inp(I_GFFN)[i]; ig[i] = 1.0f / (g * g); } }
    { unsigned* kz = (unsigned*)(WSP(bf16, WS_K) + (size_t)NBATCH * LPB * 512); unsigned* vz = (unsigned*)(WSP(bf16, WS_V) + (size_t)NBATCH * LPB * 512);
      for (int i = gt; i < 64 * 512 / 2; i += NGT) { kz[i] = 0u; vz[i] = 0u; } }
}
#define P1_EXTRA(G) (((MZ / 256) * 13) % (G))
constexpr int P1_TILES_PER_WAVE = 6;
__device__ __forceinline__ int p1_conv_items(int G) { const int ex = P1_EXTRA(G), n = ex ? (G - ex) * NWAVES * P1_TILES_PER_WAVE : 0; return n < N_EXPERT_ITEMS ? n : N_EXPERT_ITEMS; }
__device__ __forceinline__ void expert_conv_first(Frame& F, int me, int nw, int cnt) {
    LAS unsigned char* stg = F.lds + RING_OFF + F.wave * 9216;
    for (int it = me; it < cnt; it += 2 * nw) {
        const float *s0, *s1; unsigned char *d0, *d1; unsigned n0, k0, n1, k1; const bool two = it + nw < cnt;
        expert_conv_desc(F, it, s0, d0, n0, k0); expert_conv_desc(F, two ? it + nw : it, s1, d1, n1, k1);
        float va[64], vb[64];
#pragma unroll
        for (int k = 0; k < 64; ++k) va[k] = __builtin_nontemporal_load(&s0[(unsigned)k * n0 + (unsigned)F.lane]);
        if (two) {
#pragma unroll
            for (int k = 0; k < 64; ++k) vb[k] = __builtin_nontemporal_load(&s1[(unsigned)k * n1 + (unsigned)F.lane]); }
        expert_conv_store(d0, k0, va, F.lane, stg);
        if (two) expert_conv_store(d1, k1, vb, F.lane, stg);
    }
}
__device__ __forceinline__ void p0_prologue(Frame& F) {
    LAS float* scr = (LAS float*)(F.lds + RING_OFF + F.wave * 16384);
    const int gw = F.vcu * NWAVES + F.wave, NGW = F.G * NWAVES;
    constexpr int I_A = (NZ / 32) * 16, I_B = 2 * 32 * 8, I_C = 32 * 16, NITEMS = I_A + I_B + I_C;
    bf16* WIN = WSP(bf16, WS_WIN);
    for (int it = gw; it < NITEMS; it += NGW) {
        int r = it; const float* src; bf16* dst; int Ns, Kd; bool f8 = false;
        if (r < I_A) { const int kb = r / (NZ / 32), nb = r % (NZ / 32), T = nb >> 3, p0 = (nb & 7) * 32; dst = WIN + (size_t)(nb * 32) * DM + kb * 64;
            if (T == 12) { product_tile(F.inp(I_WIN), F.inp(I_WGUP), kb * 64, p0, dst, scr, F.lane); continue; }
            src = F.inp(I_WIN) + (size_t)(kb * 64) * DIN + win_src_col(T, p0); Ns = DIN; Kd = DM;
            if (T > 12) { f8 = true; dst = (bf16*)(WSP(unsigned char, WS_WIN8) + (size_t)((nb - 104) * 32) * DM + kb * 64); Kd = DM / 2; } }
        else if ((r -= I_A) < I_B) { const int br = r >> 8, q = r & 255, kb = q >> 5, nb = q & 31;
            src = F.inp(I_WBR) + (size_t)br * 512 * 1024 + (size_t)(kb * 64) * 1024 + (nb >> 3) * 256 + 64 * (nb & 3) + 32 * ((nb >> 2) & 1); Ns = 1024;   dst = WSP(bf16, WS_WBR) + (size_t)(br * 1024 + nb * 32) * 512 + kb * 64; Kd = 512; }
        else { r -= I_B; const int kb = r >> 5, nb = r & 31;
            src = F.inp(I_WOUT) + (size_t)(kb * 64) * 1024 + (nb >> 3) * 256 + 64 * (nb & 3) + 32 * ((nb >> 2) & 1); Ns = 1024;   dst = WSP(bf16, WS_WOUT) + (size_t)(nb * 32) * 1024 + kb * 64; Kd = 1024; }
        transpose_tile(src, Ns, (unsigned char*)dst, (unsigned)Kd * 2u, f8, scr, F.lane);
    }
#ifdef PROBE_K
    if (PROBE_K == 100 && blockIdx.x == 0 && F.tid == 0) ((volatile LAS unsigned long long*)(F.lds + LDSCTL_OFF + 2048))[1] = __builtin_amdgcn_s_memrealtime();
#endif
    bf16* XN = WSP(bf16, WS_R1);
    for (int m = gw; m < MROWS; m += 4 * NGW) {
        if (m + 3 * NGW < MROWS) { const float* const xr[4] = {F.inp(I_X) + (size_t)m * DM, F.inp(I_X) + (size_t)(m + NGW) * DM, F.inp(I_X) + (size_t)(m + 2 * NGW) * DM, F.inp(I_X) + (size_t)(m + 3 * NGW) * DM};
            bf16* const orr[4] = {XN + (size_t)m * DM, XN + (size_t)(m + NGW) * DM, XN + (size_t)(m + 2 * NGW) * DM, XN + (size_t)(m + 3 * NGW) * DM}; rms_rows_to_bf16<4, true>(F, xr, F.inp(I_GMIX), orr); }
        else for (int k = 0; k < 4; ++k) { const int mm = m + k * NGW; if (mm < MROWS) { const float* const xr[1] = {F.inp(I_X) + (size_t)mm * DM}; bf16* const orr[1] = {XN + (size_t)mm * DM}; rms_rows_to_bf16<1, true>(F, xr, F.inp(I_GMIX), orr); } }
    }
    for (int m = MROWS + gw; m < MZ; m += NGW) {
        if (m < MROWS + NMETA) { const float* const xr[1] = {F.inp(I_META) + (size_t)(m - MROWS) * DM}; bf16* const orr[1] = {XN + (size_t)m * DM}; rms_rows_to_bf16<1, false>(F, xr, F.inp(I_GMIX), orr); }
        else { GAS v4u* o = (GAS v4u*)(XN + (size_t)m * DM) + F.lane; o[0] = (v4u){0u, 0u, 0u, 0u}; o[64] = (v4u){0u, 0u, 0u, 0u}; }
    }
#ifdef PROBE_K
    if (PROBE_K == 101 && blockIdx.x == 0 && F.tid == 0) ((volatile LAS unsigned long long*)(F.lds + LDSCTL_OFF + 2048))[1] = __builtin_amdgcn_s_memrealtime();
#endif
    const int gt = gw * 64 + F.lane, NGT = NGW * 64;
    { float* rc = WSP(float, WS_ROPE);
      for (int i = gt; i < NPOS * 32; i += NGT) { const int pos = i >> 5, j = i & 31; const float inv = exp2f(-(float)j * 0.41524101186092029f); const float ang = (float)pos * inv;
          const double rev = (double)ang * 0.15915494309189535; const float x = (float)(rev - rint(rev));
          const int o = (pos >> 4) * 1024 + ((j >> 2) & 1) * 256 + ((pos & 15) + 16 * (j >> 3)) * 4 + (j & 3); rc[o] = __builtin_amdgcn_cosf(x); rc[o + 512] = __builtin_amdgcn_sinf(x); } }
}
namespace epi {
using pg8::f32x4; using pg8::u32x4; using pg8::Unit; using pg8::pack8; using pg8::HALF;
__device__ __forceinline__ unsigned pk4_fp8(float a, float b, float c, float d) { unsigned w = 0; w = __builtin_amdgcn_cvt_pk_fp8_f32(clamp8(a), clamp8(b), w, false); w = __builtin_amdgcn_cvt_pk_fp8_f32(clamp8(c), clamp8(d), w, true); return w; }
constexpr float Y8SCALE = 64.0f;
__device__ __forceinline__ float cy8(float y) { return y * Y8SCALE; }
__device__ __forceinline__ f32x4 un4_fp8(unsigned w) { typedef float f2_ __attribute__((ext_vector_type(2))); const f2_ a = __builtin_amdgcn_cvt_pk_f32_fp8(w, false), b = __builtin_amdgcn_cvt_pk_f32_fp8(w, true); return (f32x4){a[0], a[1], b[0], b[1]}; }
__device__ __forceinline__ float c8(float h) { return h * H8SCALE; }
__device__ __forceinline__ float log_sigmoid(float x) { return fminf(x, 0.f) - __logf(1.0f + __expf(-fabsf(x))); }

__device__ __forceinline__ void st_rows16(LAS unsigned char* S, int lane, const u32x4 w0, int q0, const u32x4 w1, int q1, unsigned char* gbase, unsigned pitchB) {
    const int fr = lane & 15, rr = lane >> 3, qq = lane & 7;
    LAS unsigned char* wp = S + (fr >> 3) * 1024 + (fr & 7) * 128;
    *(LAS u32x4*)(wp + ((q0 ^ (fr & 7)) << 4)) = w0; *(LAS u32x4*)(wp + ((q1 ^ (fr & 7)) << 4)) = w1;
    asm volatile("s_waitcnt lgkmcnt(0)" ::: "memory");
    const LAS unsigned char* rp = S + rr * 128 + ((qq ^ rr) << 4);
    const u32x4 a = *(const LAS u32x4*)rp, b = *(const LAS u32x4*)(rp + 1024);
    asm volatile("s_waitcnt lgkmcnt(0)" ::: "memory");
    unsigned char* gp = gbase + (unsigned)rr * pitchB + qq * 16;
    *(u32x4*)gp = a; *(u32x4*)(gp + 8 * pitchB) = b;
}
struct EpiZ {
    bf16 *Q, *K, *V, *GQ, *GK, *GV, *GR; float* LOGA;
    const float *gq, *gk, *bgate, *rope; LAS unsigned char* stg;
    __device__ __forceinline__ bool operator()(f32x4 (&acc)[2][2][4][2], const Unit& u, int wr, int wc, int fr, int fq) const {
        const int pn = u.pn, pm = u.pm; const bool meta = (pm == MROWS / 256);
        int oz; asm volatile("v_mov_b32 %0, 0" : "=v"(oz));
        const int r0 = wr * 64 + fr + oz, cl = wc * 32 + 8 * fq, ln = fr + 16 * fq + oz;
        const int bsh = 64 * ((pm >> 4) + 1);
        LAS unsigned char* S = stg + (wr * 4 + wc) * 2048;
        if (pn < 4) {
            const bool isq = pn < 2; if (isq && meta) return false;
            const float* gn = isq ? gq : gk;
            const f32x4 ga0 = *(const f32x4*)(gn + 8 * fq), ga1 = *(const f32x4*)(gn + 8 * fq + 4), gb0 = *(const f32x4*)(gn + 32 + 8 * fq), gb1 = *(const f32x4*)(gn + 36 + 8 * fq);
            const int hc0 = ((pn & 1) * 4 + wc) * 64, hcol = hc0 + 8 * fq;
            const float osc = isq ? 0.125f * 1.4426950408889634f : 1.0f;
#pragma unroll
            for (int ai = 0; ai < 2; ++ai)
#pragma unroll
                for (int m = 0; m < 4; ++m) {
                    if (meta && (ai != 0 || wr != 0)) continue;
                    const int r = r0 + ai * HALF + m * 16;
                    const f32x4 x1a = acc[ai][0][m][0], x1b = acc[ai][0][m][1], x2a = acc[ai][1][m][0], x2b = acc[ai][1][m][1];
                    float ss = (x1a[0] * x1a[0] + x1a[1] * x1a[1]) + (x1a[2] * x1a[2] + x1a[3] * x1a[3]) + (x1b[0] * x1b[0] + x1b[1] * x1b[1]) + (x1b[2] * x1b[2] + x1b[3] * x1b[3])
                             + (x2a[0] * x2a[0] + x2a[1] * x2a[1]) + (x2a[2] * x2a[2] + x2a[3] * x2a[3]) + (x2b[0] * x2b[0] + x2b[1] * x2b[1]) + (x2b[2] * x2b[2] + x2b[3] * x2b[3]);
                    ss += __shfl_xor(ss, 16); ss += __shfl_xor(ss, 32);
                    const float rn = 1.0f / sqrtf(ss * (1.0f / 64.0f) + EPS);
                    const int rg = wr * 64 + ai * HALF + m * 16;
                    const int pos0 = meta ? rg : NMETA + ((pm * 256 + rg) & (SEQ - 1));
                    const float* tb = rope + (size_t)(pos0 >> 4) * 1024 + ln * 4;
                    const f32x4 c0 = *(const f32x4*)tb, c1 = *(const f32x4*)(tb + 256), s0 = *(const f32x4*)(tb + 512), s1 = *(const f32x4*)(tb + 768);
                    const f32x4 y1a = x1a * rn * ga0, y1b = x1b * rn * ga1, y2a = x2a * rn * gb0, y2b = x2b * rn * gb1;
                    const f32x4 o1a = (y1a * c0 - y2a * s0) * osc, o1b = (y1b * c1 - y2b * s1) * osc, o2a = (y2a * c0 + y1a * s0) * osc, o2b = (y2b * c1 + y1b * s1) * osc;
                    const u32x4 w1 = pack8(o1a, o1b), w2 = pack8(o2a, o2b);
                    if (isq) st_rows16(S, ln, w1, fq, w2, 4 + fq, (unsigned char*)(Q + (size_t)(pm * 256 + rg) * 512 + hc0), 1024u);
                    else if (!meta) st_rows16(S, ln, w1, fq, w2, 4 + fq, (unsigned char*)(K + (size_t)(pm * 256 + rg + bsh) * 512 + hc0), 1024u);
                    else { for (int b = 0; b < NBATCH; ++b) { bf16* p = K + (size_t)(b * LPB + r) * 512 + hcol; *(u32x4*)p = w1; *(u32x4*)(p + 32) = w2; } }
                    asm volatile("" ::: "memory");
                }
            return false;
        }
        if (pn < 12) {
            long long toff; int pitch, cb; float sc = 1.0f; bool wmeta = true;
            if (pn < 6) { toff = 0; pitch = 512; cb = (pn - 4) * 256; }
            else if (pn == 6) { toff = (long long)WS_GQ - (long long)WS_V; pitch = 256; cb = 0; sc = 0.125f; wmeta = false; }
            else if (pn == 7) { toff = (long long)WS_GK - (long long)WS_V; pitch = 256; cb = 0; }
            else if (pn < 10) { toff = (long long)WS_GV - (long long)WS_V; pitch = 512; cb = (pn - 8) * 256; }
            else { toff = (long long)WS_GR - (long long)WS_V; pitch = 512; cb = (pn - 10) * 256; wmeta = false; }
            bf16* T = (bf16*)((unsigned char*)V + toff);
            if (meta && !wmeta) return false;
#pragma unroll
            for (int ai = 0; ai < 2; ++ai)
#pragma unroll
                for (int m = 0; m < 4; ++m) {
                    if (meta && (ai != 0 || wr != 0)) continue;
                    const int r = r0 + ai * HALF + m * 16;
                    const u32x4 w0 = pack8(acc[ai][0][m][0] * sc, acc[ai][0][m][1] * sc), w1 = pack8(acc[ai][1][m][0] * sc, acc[ai][1][m][1] * sc); const int col = cb + 64 * wc + 8 * fq;
                    if (!meta) st_rows16(S, ln, w0, fq, w1, 4 + fq, (unsigned char*)(T + (size_t)(pm * 256 + wr * 64 + ai * HALF + m * 16 + bsh) * pitch + cb + 64 * wc), (unsigned)pitch * 2u);
                    else for (int b = 0; b < NBATCH; ++b) { bf16* p = T + (size_t)(b * LPB + r) * pitch + col; *(u32x4*)p = w0; *(u32x4*)(p + 32) = w1; }
                    asm volatile("" ::: "memory");
                }
            return false;
        }
        if (pn == 12) {
#pragma unroll
            for (int bj = 0; bj < 2; ++bj) { const int col = bj * HALF + cl; const f32x4 b0 = *(const f32x4*)(bgate + col), b1 = *(const f32x4*)(bgate + col + 4);
#pragma unroll
                for (int ai = 0; ai < 2; ++ai)
#pragma unroll
                    for (int m = 0; m < 4; ++m) {
                        if (meta && (ai != 0 || wr != 0)) continue;
                        const int r = r0 + ai * HALF + m * 16; const f32x4 a0 = acc[ai][bj][m][0] + b0, a1 = acc[ai][bj][m][1] + b1; f32x4 v0, v1;
#pragma unroll
                        for (int i = 0; i < 4; ++i) { v0[i] = log_sigmoid(a0[i]) * (1.0f / 16.0f); v1[i] = log_sigmoid(a1[i]) * (1.0f / 16.0f); }
                        if (!meta) st_rows16(S, ln, __builtin_bit_cast(u32x4, v0), 2 * fq, __builtin_bit_cast(u32x4, v1), 2 * fq + 1, (unsigned char*)(LOGA + (size_t)(pm * 256 + wr * 64 + ai * HALF + m * 16 + bsh) * 256 + bj * HALF + wc * 32), 1024u);
                        else { if (r >= NMETA) { v0 = (f32x4){0.f, 0.f, 0.f, 0.f}; v1 = v0; }
                               for (int b = 0; b < NBATCH; ++b) { float* p = LOGA + (size_t)(b * LPB + r) * 256 + col; *(f32x4*)p = v0; *(f32x4*)(p + 4) = v1; } }
                        asm volatile("" ::: "memory");
                    } }
            return false;
        }
        return false;
    }
};
struct EpiGates {
    bf16 *RATIO, *G1; const LAS float* bml; float zs;
    __device__ __forceinline__ bool operator()(f32x4 (&acc)[2][2][4][2], const Unit& u, int wr, int wc, int fr, int fq) const {
        int oz; asm volatile("v_mov_b32 %0, 0" : "=v"(oz));
        const int d = 128 * u.pn + wc * 32 + 8 * fq, ln = fr + 16 * fq + oz;
#pragma unroll
        for (int bj = 0; bj < 2; ++bj) { const f32x4 b0 = *(const LAS f32x4*)(bml + bj * DM + d), b1 = *(const LAS f32x4*)(bml + bj * DM + d + 4);
#pragma unroll
            for (int ai = 0; ai < 2; ++ai)
#pragma unroll
                for (int m = 0; m < 4; ++m) { const f32x4 x0 = acc[ai][bj][m][0] * zs + b0, x1 = acc[ai][bj][m][1] * zs + b1;
#pragma unroll
                    for (int i = 0; i < 4; ++i) { acc[ai][bj][m][0][i] = 1.0f + __expf(-fminf(fmaxf(x0[i], -40.0f), 40.0f)); acc[ai][bj][m][1][i] = 1.0f + __expf(-fminf(fmaxf(x1[i], -40.0f), 40.0f)); } }
            asm volatile("" ::: "memory"); }
#pragma unroll
        for (int ai = 0; ai < 2; ++ai)
#pragma unroll
            for (int m = 0; m < 4; ++m) { f32x4 ra, rb, ga, gb;
#pragma unroll
                for (int i = 0; i < 4; ++i) { const float e0 = acc[ai][0][m][0][i], e1 = acc[ai][1][m][0][i], ri = __builtin_amdgcn_rcpf(e0 * e1); ga[i] = e0 * ri; ra[i] = e1 * (e1 * ri);
                                              const float f0 = acc[ai][0][m][1][i], f1 = acc[ai][1][m][1][i], si = __builtin_amdgcn_rcpf(f0 * f1); gb[i] = f0 * si; rb[i] = f1 * (f1 * si); }
                const size_t o = (size_t)((u.pm * 16 + wr * 4 + ai * 8 + m) * 32 + 4 * u.pn + wc) * 512 + ln * 8; *(u32x4*)(RATIO + o) = pack8(ra, rb); *(u32x4*)(G1 + o) = pack8(ga, gb); asm volatile("" ::: "memory"); }
        return false;
    }
};
struct EpiMerge {
    const bf16 *RATIO, *G1; bf16* MERGED; LAS unsigned char* stg;
    __device__ __forceinline__ bool operator()(f32x4 (&acc)[2][2][4][2], const Unit& u, int wr, int wc, int fr, int fq) const {
        const int br = u.aux, pm = u.pm - (MROWS / 256) * br, pn = u.pn - 4 * br;
        int oz; asm volatile("v_mov_b32 %0, 0" : "=v"(oz));
        const int ln = fr + 16 * fq + oz;
        const bf16* src = br ? G1 : RATIO;
        LAS unsigned char* S = stg + (wr * 4 + wc) * 2048;
#pragma unroll
        for (int ai = 0; ai < 2; ++ai) { u32x4 g[4][2];
#pragma unroll
            for (int m = 0; m < 4; ++m)
#pragma unroll
                for (int bj = 0; bj < 2; ++bj) g[m][bj] = __builtin_nontemporal_load((const u32x4*)(src + (size_t)((pm * 16 + wr * 4 + ai * 8 + m) * 32 + pn * 8 + 2 * wc + bj) * 512 + ln * 8));
#pragma unroll
            for (int m = 0; m < 4; ++m) { u32x4 w[2];
#pragma unroll
                for (int bj = 0; bj < 2; ++bj) { const u32x4 gg = g[m][bj];
                    const f32x4 g0 = {pg8::bf_lo(gg.x), pg8::bf_hi(gg.x), pg8::bf_lo(gg.y), pg8::bf_hi(gg.y)}, g1 = {pg8::bf_lo(gg.z), pg8::bf_hi(gg.z), pg8::bf_lo(gg.w), pg8::bf_hi(gg.w)};
                    const f32x4 v0 = acc[ai][bj][m][0] * g0, v1 = acc[ai][bj][m][1] * g1;
                    if (br) w[bj] = pack8(v0, v1); else { acc[ai][bj][m][0] = v0; acc[ai][bj][m][1] = v1; } }
                if (br) st_rows16(S, ln, w[0], fq, w[1], 4 + fq, (unsigned char*)(MERGED + (size_t)(pm * 256 + wr * 64 + ai * HALF + m * 16) * DM + pn * 256 + 64 * wc), 2048u); }
            asm volatile("" ::: "memory"); }
        return br == 0;
    }
};
struct EpiOut {
    const float* x; bf16* H2U; const float* gffn; unsigned char* H2U8; LAS unsigned char* stg;
    __device__ __forceinline__ bool operator()(f32x4 (&acc)[2][2][4][2], const Unit& u, int wr, int wc, int fr, int fq) const {
        int oz; asm volatile("v_mov_b32 %0, 0" : "=v"(oz));
        const int ln = fr + 16 * fq + oz, lr = ln >> 3, lq = ln & 7, f7 = ln & 7 & 7, frs = (ln & 15) & 7;
        const int cw = u.pn * 256 + 64 * wc;
        LAS unsigned char* S = stg + (wr * 4 + wc) * 2048;
        f32x4 ga[2], gb[2];
#pragma unroll
        for (int bj = 0; bj < 2; ++bj) { ga[bj] = *(const f32x4*)(gffn + cw + 32 * bj + 8 * fq); gb[bj] = *(const f32x4*)(gffn + cw + 32 * bj + 8 * fq + 4); }
        (void)f7;
#pragma unroll
        for (int ai = 0; ai < 2; ++ai)
#pragma unroll
            for (int mp = 0; mp < 4; mp += 2) { const int row0 = u.pm * 256 + wr * 64 + ai * HALF; f32x4 xl[2][2][2];
#pragma unroll
                for (int k = 0; k < 2; ++k)
#pragma unroll
                    for (int bj = 0; bj < 2; ++bj)
#pragma unroll
                        for (int hf = 0; hf < 2; ++hf) xl[k][bj][hf] = *(const f32x4*)(x + (size_t)(row0 + (mp + k) * 16 + lr + 8 * hf) * DM + cw + 32 * bj + 4 * lq);
#pragma unroll
                for (int k = 0; k < 2; ++k) { const int m = mp + k; u32x4 w[2]; pg8::u32x2 f8[2];
#pragma unroll
                    for (int bj = 0; bj < 2; ++bj) {
                        LAS unsigned char* wp = S + lr * 128 + ((lq ^ lr) << 4);
                        *(LAS f32x4*)wp = xl[k][bj][0]; *(LAS f32x4*)(wp + 1024) = xl[k][bj][1];
                        asm volatile("s_waitcnt lgkmcnt(0)" ::: "memory");
                        const LAS unsigned char* rp = S + ((ln & 15) >> 3) * 1024 + frs * 128;
                        const f32x4 xa = *(const LAS f32x4*)(rp + (((2 * (ln >> 4)) ^ frs) << 4)), xb = *(const LAS f32x4*)(rp + (((2 * (ln >> 4) + 1) ^ frs) << 4));
                        asm volatile("s_waitcnt lgkmcnt(0)" ::: "memory");
                        const f32x4 h0 = (xa + acc[ai][bj][m][0]) * ga[bj], h1 = (xb + acc[ai][bj][m][1]) * gb[bj];
                        w[bj] = pack8(h0, h1); f8[bj] = (pg8::u32x2){pk4_fp8(h0[0], h0[1], h0[2], h0[3]), pk4_fp8(h1[0], h1[1], h1[2], h1[3])}; }
                    st_rows16(S, ln, w[0], ln >> 4, w[1], 4 + (ln >> 4), (unsigned char*)(H2U + (size_t)(row0 + m * 16) * DM + cw), 2048u);
                    *(LAS pg8::u32x2*)(S + (ln & 15) * 64 + 8 * (ln >> 4)) = f8[0]; *(LAS pg8::u32x2*)(S + (ln & 15) * 64 + 32 + 8 * (ln >> 4)) = f8[1];
                    asm volatile("s_waitcnt lgkmcnt(0)" ::: "memory");
                    const u32x4 v8 = *(const LAS u32x4*)(S + ln * 16);
                    asm volatile("s_waitcnt lgkmcnt(0)" ::: "memory");
                    *(u32x4*)(H2U8 + (size_t)(row0 + m * 16 + (ln >> 2)) * DM + cw + 16 * (ln & 3)) = v8; }
                asm volatile("" ::: "memory"); }
        return false;
    }
};
template <bool GATHER_> struct MoeSched {
    static constexpr bool GATHER = GATHER_;
    const LAS int* tb; const LAS int* cn; const int* ltok; int seg_lo, seg_hi, G, c;
    __device__ __forceinline__ bool next(int i, Unit& u) const {
        const int t0 = __builtin_amdgcn_readfirstlane(tb[seg_lo]), t1 = __builtin_amdgcn_readfirstlane(tb[seg_hi]);
        const int U = (t1 - t0) * 4, R = U / G, r = U - R * G; int L, hf = 0;
        if (i < R) L = i * G + c;
        else if (i > R) return false;
        else if (2 * r <= G) { if (c >= 2 * r) return false; L = R * G + (c >> 1); hf = 1 + (c & 1); }
        else { if (c >= r) return false; L = R * G + c; }
        const int rt = t0 + (L >> 2), pnl = L & 3; int s = seg_lo, hi_ = seg_hi;
        while (hi_ - s > 1) { const int mid = (s + hi_) >> 1; if (__builtin_amdgcn_readfirstlane(tb[mid]) <= rt) s = mid; else hi_ = mid; }
        u.pm = rt; u.pn = (s & 31) * 4 + pnl; u.aux = s | ((rt - __builtin_amdgcn_readfirstlane(tb[s])) << 8); u.half = hf; return true;
    }
    __device__ __forceinline__ int grow(const Unit& u, int r) const { const int s = u.aux & 255, si = (u.aux >> 8) * 256 + r, last = cn[s] - 1; return ltok[(size_t)s * LCAP + (si < last ? si : last)]; }
};
struct EpiUp {
    const LAS int* cn; const float* lrs; unsigned char* HID; LAS unsigned char* stg;
    __device__ __forceinline__ bool operator()(f32x4 (&acc)[2][2][4][2], const Unit& u, int wr, int wc, int fr, int fq) const {
        const int s = u.aux & 255, rtl = u.aux >> 8, last = cn[s] - 1, pnl = u.pn & 3; float rsv[2][4];
#pragma unroll
        for (int ai = 0; ai < 2; ++ai)
#pragma unroll
            for (int m = 0; m < 4; ++m) { if (u.half == 2 - ai) { rsv[ai][m] = 0.f; continue; } const int si = rtl * 256 + wr * 64 + fr + ai * HALF + m * 16; rsv[ai][m] = lrs[(size_t)s * LCAP + (si < last ? si : last)] * (1.0f / W8SCALE); }
        int oz; asm volatile("v_mov_b32 %0, 0" : "=v"(oz)); const int ln = fr + 16 * fq + oz; LAS unsigned char* S = stg + (wr * 4 + wc) * 2048;
#pragma unroll
        for (int ai = 0; ai < 2; ++ai)
#pragma unroll
            for (int mp = 0; mp < 4; mp += 2) { if (u.half == 2 - ai) continue;
#pragma unroll
                for (int k = 0; k < 2; ++k) { const int m = mp + k; const float rs = rsv[ai][m];
                    f32x4 h0, h1;
#pragma unroll
                    for (int i = 0; i < 4; ++i) { const float g0 = acc[ai][0][m][0][i] * rs, g1 = acc[ai][0][m][1][i] * rs;
                        h0[i] = g0 * __builtin_amdgcn_rcpf(1.0f + __expf(-g0)) * (acc[ai][1][m][0][i] * rs); h1[i] = g1 * __builtin_amdgcn_rcpf(1.0f + __expf(-g1)) * (acc[ai][1][m][1][i] * rs); }
                    *(LAS pg8::u32x2*)(S + (k * 16 + (ln & 15)) * 32 + 8 * (ln >> 4)) = (pg8::u32x2){pk4_fp8(c8(h0[0]), c8(h0[1]), c8(h0[2]), c8(h0[3])), pk4_fp8(c8(h1[0]), c8(h1[1]), c8(h1[2]), c8(h1[3]))}; }
                asm volatile("s_waitcnt lgkmcnt(0)" ::: "memory");
                const u32x4 v = *(const LAS u32x4*)(S + ln * 16); const int j = ln >> 1;
                asm volatile("s_waitcnt lgkmcnt(0)" ::: "memory");
                *(u32x4*)(HID + (size_t)(u.pm * 256 + wr * 64 + ai * HALF + (mp + (j >> 4)) * 16 + (j & 15)) * DEXP + pnl * 128 + wc * 32 + (ln & 1) * 16) = v; }
        return false;
    }
};
template <int MODE> struct EpiDown {
    const LAS int* cn; const int* ltok; const float* lw; float* out; unsigned char* Y0; float* trash; const bf16* H2U; const float* gffn; LAS unsigned char* stg;
    __device__ __forceinline__ bool operator()(f32x4 (&acc)[2][2][4][2], const Unit& u, int wr, int wc, int fr, int fq) const {
        const int s = u.aux & 255, rtl = u.aux >> 8, cnt = cn[s], pnl = u.pn & 3; int tok[2][4]; float wv[2][4];
#pragma unroll
        for (int ai = 0; ai < 2; ++ai)
#pragma unroll
            for (int m = 0; m < 4; ++m) { const int si = rtl * 256 + wr * 64 + fr + ai * HALF + m * 16, sc = si < cnt ? si : cnt - 1; tok[ai][m] = ltok[(size_t)s * LCAP + sc]; wv[ai][m] = lw[(size_t)s * LCAP + sc] * (1.0f / (W8SCALE * H8SCALE)); }
        const int cofs = pnl * 256 + wc * 32 + 8 * fq;
        int oz; asm volatile("v_mov_b32 %0, 0" : "=v"(oz)); const int ln = fr + 16 * fq + oz;
        f32x4 ig[2][2];
        if (MODE == 1) {
#pragma unroll
            for (int bj = 0; bj < 2; ++bj)
#pragma unroll
                for (int n = 0; n < 2; ++n) { const f32x4 g = *(const f32x4*)(gffn + cofs + bj * HALF + 4 * n); ig[bj][n] = (f32x4){__builtin_amdgcn_rcpf(g[0]), __builtin_amdgcn_rcpf(g[1]), __builtin_amdgcn_rcpf(g[2]), __builtin_amdgcn_rcpf(g[3])}; } }
#pragma unroll
        for (int ai = 0; ai < 2; ++ai)
#pragma unroll
            for (int mp = 0; mp < 4; mp += 2) { if (u.half == 2 - ai) continue; float* po[2]; unsigned char* py[2]; const bf16* ph[2]; pg8::u32x2 yv[2][2]; u32x4 hv[2][2]; u32x4 hl[2][2], yl[2];
#pragma unroll
                for (int k = 0; k < 2; ++k) { const int m = mp + k, si = rtl * 256 + wr * 64 + fr + ai * HALF + m * 16; const bool ok = si < cnt;
                    po[k] = ok ? out + (size_t)tok[ai][m] * DM + cofs : trash + cofs; py[k] = ok ? Y0 + (size_t)tok[ai][m] * DM + cofs : (unsigned char*)(trash + DM) + cofs; ph[k] = H2U + (size_t)tok[ai][m] * DM + cofs; }
                float* pr[2][2];
                if (MODE == 1) {
#pragma unroll
                    for (int k = 0; k < 2; ++k)
#pragma unroll
                        for (int bj = 0; bj < 2; ++bj) { yv[k][bj] = (pg8::u32x2){0u, 0u}; hv[k][bj] = (u32x4){0u, 0u, 0u, 0u}; }
#pragma unroll
                    for (int k = 0; k < 2; ++k) { const int tk4 = __shfl(tok[ai][mp + k], ln >> 2);
#pragma unroll
                        for (int bj = 0; bj < 2; ++bj) hl[k][bj] = *(const u32x4*)(H2U + (size_t)tk4 * DM + pnl * 256 + bj * HALF + wc * 32 + 8 * (ln & 3));
                        yl[k] = *(const u32x4*)(Y0 + (size_t)tk4 * DM + pnl * 256 + ((ln >> 1) & 1) * HALF + wc * 32 + 16 * (ln & 1)); }
#pragma unroll
                    for (int k = 0; k < 2; ++k)
#pragma unroll
                        for (int hf = 0; hf < 2; ++hf) { const int m = mp + k, row = (ln >> 3) + 8 * hf, tk = __shfl(tok[ai][m], row); const bool okr = rtl * 256 + wr * 64 + ai * HALF + m * 16 + row < cnt;
                            pr[k][hf] = (okr ? out + (size_t)tk * DM : trash) + pnl * 256 + wc * 32 + 4 * (ln & 7); } }
                if (MODE == 0) {
                    LAS unsigned char* S = stg + (wr * 4 + wc) * 2048; const int j = ln >> 1, jr = j & 15, jk = j >> 4;
                    const int t0_ = __shfl(tok[ai][mp], jr), t1_ = __shfl(tok[ai][mp + 1], jr), tk = jk ? t1_ : t0_;
                    const bool okr = rtl * 256 + wr * 64 + ai * HALF + (mp + jk) * 16 + jr < cnt;
                    unsigned char* pyr = (okr ? Y0 + (size_t)tk * DM : (unsigned char*)(trash + DM)) + pnl * 256 + wc * 32 + (ln & 1) * 16;
#pragma unroll
                    for (int bj = 0; bj < 2; ++bj) {
#pragma unroll
                        for (int k = 0; k < 2; ++k) { const int m = mp + k; const float w = wv[ai][m]; const f32x4 a0 = acc[ai][bj][m][0] * w, a1 = acc[ai][bj][m][1] * w;
                            *(LAS pg8::u32x2*)(S + (k * 16 + fr) * 32 + 8 * fq) = (pg8::u32x2){pk4_fp8(cy8(a0[0]), cy8(a0[1]), cy8(a0[2]), cy8(a0[3])), pk4_fp8(cy8(a1[0]), cy8(a1[1]), cy8(a1[2]), cy8(a1[3]))}; }
                        asm volatile("s_waitcnt lgkmcnt(0)" ::: "memory");
                        const u32x4 v = *(const LAS u32x4*)(S + ln * 16);
                        asm volatile("s_waitcnt lgkmcnt(0)" ::: "memory");
                        *(u32x4*)(pyr + bj * HALF) = v; }
                    continue; }
#pragma unroll
                for (int k = 0; k < 2; ++k) { const int m = mp + k; const float w = wv[ai][m];
                    if (MODE == 1) { LAS unsigned char* S = stg + (wr * 4 + wc) * 2048;
                        *(LAS u32x4*)(S + ln * 16) = hl[k][0]; *(LAS u32x4*)(S + 1024 + ln * 16) = hl[k][1];
                        asm volatile("s_waitcnt lgkmcnt(0)" ::: "memory");
                        hv[k][0] = *(const LAS u32x4*)(S + (ln & 15) * 64 + 16 * (ln >> 4)); hv[k][1] = *(const LAS u32x4*)(S + 1024 + (ln & 15) * 64 + 16 * (ln >> 4));
                        asm volatile("s_waitcnt lgkmcnt(0)" ::: "memory");
                        *(LAS u32x4*)(S + ln * 16) = yl[k];
                        asm volatile("s_waitcnt lgkmcnt(0)" ::: "memory");
                        yv[k][0] = *(const LAS pg8::u32x2*)(S + (ln & 15) * 64 + 8 * (ln >> 4)); yv[k][1] = *(const LAS pg8::u32x2*)(S + (ln & 15) * 64 + 32 + 8 * (ln >> 4));
                        asm volatile("s_waitcnt lgkmcnt(0)" ::: "memory"); }
#pragma unroll
                    for (int bj = 0; bj < 2; ++bj) {
                        if (MODE == 0) { }
                        else { const pg8::u32x2 y = yv[k][bj]; const u32x4 h = hv[k][bj]; float* p = po[k] + bj * HALF;
                            const f32x4 ya = un4_fp8(y.x) * (1.0f / Y8SCALE), yb = un4_fp8(y.y) * (1.0f / Y8SCALE);
                            const f32x4 ha = {pg8::bf_lo(h.x), pg8::bf_hi(h.x), pg8::bf_lo(h.y), pg8::bf_hi(h.y)}, hb = {pg8::bf_lo(h.z), pg8::bf_hi(h.z), pg8::bf_lo(h.w), pg8::bf_hi(h.w)};
                            (void)p; const f32x4 o0 = (ha * ig[bj][0] + ya) + acc[ai][bj][m][0] * w, o1 = (hb * ig[bj][1] + yb) + acc[ai][bj][m][1] * w;
                            { LAS unsigned char* S = stg + (wr * 4 + wc) * 2048; const int frs = fr & 7, lr = ln >> 3, lq = ln & 7;
                              LAS unsigned char* wp = S + (fr >> 3) * 1024 + frs * 128;
                              *(LAS f32x4*)(wp + (((2 * fq) ^ frs) << 4)) = o0; *(LAS f32x4*)(wp + (((2 * fq + 1) ^ frs) << 4)) = o1;
                              asm volatile("s_waitcnt lgkmcnt(0)" ::: "memory");
                              const LAS unsigned char* rp = S + lr * 128 + ((lq ^ lr) << 4);
                              const f32x4 va = *(const LAS f32x4*)rp, vb = *(const LAS f32x4*)(rp + 1024);
                              asm volatile("s_waitcnt lgkmcnt(0)" ::: "memory");
                              *(f32x4*)(pr[k][0] + bj * HALF) = va; *(f32x4*)(pr[k][1] + bj * HALF) = vb; } } } }
                asm volatile("" ::: "memory"); }
        return false;
    }
};
}
constexpr int GP = 144;
typedef LAS unsigned char* ldsp;
__device__ __forceinline__ pg8::bf16x8 ldfrag(ldsp base, int row, int ks, int fq) { return *(const LAS pg8::bf16x8*)(base + row * GP + ks * 64 + fq * 16); }
#define MFMA16(a, b, c) __builtin_amdgcn_mfma_f32_16x16x32_bf16((a), (b), (c), 0, 0, 0)
constexpr size_t WS_O0 = WS_DS, WS_QD = WS_DS + 32 * MiB, WS_GG = WS_DS + 48 * MiB, WS_GD = WS_DS + 56 * MiB;
__device__ __forceinline__ void gla_x(Frame& F, int unit) {
    const int bh = unit >> 3, g = unit & 7, b = bh >> 2, h = bh & 3, d = F.tid & 63, tq = F.wave, fr = F.lane & 15, fq = F.lane >> 4;
    LAS float* part = (LAS float*)(F.lds + 0); LAS float* TOT = (LAS float*)(F.lds + 2048);
    const ldsp QT = F.lds + 4096, KT = F.lds + 13312, AH = F.lds + 22528, VT = F.lds + 31744, SB = F.lds + 50176, PP = F.lds + 68608;
    for (int i = F.tid; i < 128 * GP / 4; i += NWAVES * 64) ((LAS unsigned*)SB)[i] = 0u;
    pg8::f32x4 accS[4];
#pragma unroll
    for (int db = 0; db < 4; ++db) accS[db] = (pg8::f32x4){0.f, 0.f, 0.f, 0.f};
    float cd = 1.0f;
    const int c_first = g ? 8 * g + 1 : 0, c_last = 8 * g + 8;
    bf16* QD = WSP(bf16, WS_QD); bf16* O0 = WSP(bf16, WS_O0);
    const float* LOGA = WSP(float, WS_LOGA); const bf16* GQ = WSP(bf16, WS_GQ); const bf16* GK = WSP(bf16, WS_GK); const bf16* GV = WSP(bf16, WS_GV);
    float an[8]; bf16 qn[8], kn[8]; v4u vn[2];
#define GX_LOAD(cc) do { const size_t ro_ = (size_t)(b * LPB + 64 * (cc) + 8 * tq) * 256 + h * 64 + d; \
        _Pragma("unroll") for (int i_ = 0; i_ < 8; ++i_) { an[i_] = LOGA[ro_ + i_ * 256]; qn[i_] = GQ[ro_ + i_ * 256]; kn[i_] = GK[ro_ + i_ * 256]; } \
        _Pragma("unroll") for (int j_ = 0; j_ < 2; ++j_) { const int p_ = F.tid + 512 * j_; vn[j_] = __builtin_nontemporal_load((const GAS v4u*)(GV + (size_t)(b * LPB + 64 * (cc) + (p_ >> 4)) * 512 + h * 128 + (p_ & 15) * 8)); } } while (0)
    GX_LOAD(c_first);
    for (int c = c_first; c <= c_last; ++c) {
        const int mrow0 = b * SEQ + 64 * (c - 1);
        float bt[8]; bt[0] = an[0];
#pragma unroll
        for (int i = 1; i < 8; ++i) bt[i] = bt[i - 1] + an[i];
        part[tq * 64 + d] = bt[7];
        __syncthreads();
        float off = 0.f, tot = 0.f;
#pragma unroll
        for (int j = 0; j < 8; ++j) { const float p = part[j * 64 + d]; tot += p; if (j < tq) off += p; }
        if (tq == 0) TOT[d] = tot;
        float kh[8];
#pragma unroll
        for (int i = 0; i < 8; ++i) { const float bti = bt[i] + off; const float kk = bf2f(kn[i]); const float qv = bf2f(qn[i]) * __expf(bti), kv = kk * __expf(fminf(-bti, 80.f)); kh[i] = kk * __expf(tot - bti);
            *(LAS bf16*)(QT + (8 * tq + i) * GP + d * 2) = (bf16)f2bf(qv); *(LAS bf16*)(KT + (8 * tq + i) * GP + d * 2) = (bf16)f2bf(kv);
            if (c >= 1) QD[(size_t)(mrow0 + 8 * tq + i) * 256 + h * 64 + d] = (bf16)f2bf(qv * cd); }
        { v4u w; w.x = pk2(kh[0], kh[1]); w.y = pk2(kh[2], kh[3]); w.z = pk2(kh[4], kh[5]); w.w = pk2(kh[6], kh[7]); *(LAS v4u*)(AH + d * GP + tq * 16) = w; }
        cd *= __expf(tot);
#pragma unroll
        for (int j = 0; j < 2; ++j) { const int p = F.tid + 512 * j, sv = p >> 4, ec = p & 15; const unsigned ww[4] = {vn[j].x, vn[j].y, vn[j].z, vn[j].w};
#pragma unroll
            for (int i = 0; i < 4; ++i) { *(LAS bf16*)(VT + (8 * ec + 2 * i) * GP + sv * 2) = (bf16)(ww[i] & 0xffffu); *(LAS bf16*)(VT + (8 * ec + 2 * i + 1) * GP + sv * 2) = (bf16)(ww[i] >> 16); } }
        if (c < c_last) GX_LOAD(c + 1);
        __syncthreads();
        const int tb = tq >> 1, t0 = 16 * tb, t = t0 + fr;
#pragma unroll
        for (int sbi = 0; sbi < 2; ++sbi) { const int s0 = 16 * (2 * (tq & 1) + sbi); pg8::f32x4 a = {0.f, 0.f, 0.f, 0.f};
#pragma unroll
            for (int ks = 0; ks < 2; ++ks) a = MFMA16(ldfrag(KT, s0 + fr, ks, fq), ldfrag(QT, t0 + fr, ks, fq), a);
            const int s = s0 + 4 * fq;
            const float p0 = (s + 0 <= t) ? a[0] : 0.f, p1 = (s + 1 <= t) ? a[1] : 0.f, p2 = (s + 2 <= t) ? a[2] : 0.f, p3 = (s + 3 <= t) ? a[3] : 0.f;
            *(LAS unsigned*)(PP + t * GP + s * 2) = pk2(p0, p1); *(LAS unsigned*)(PP + t * GP + s * 2 + 4) = pk2(p2, p3); }
#pragma unroll
        for (int db = 0; db < 4; ++db) { const pg8::f32x4 tv = *(const LAS pg8::f32x4*)(TOT + 16 * db + 4 * fq);
            accS[db][0] *= __expf(tv[0]); accS[db][1] *= __expf(tv[1]); accS[db][2] *= __expf(tv[2]); accS[db][3] *= __expf(tv[3]); }
#pragma unroll
        for (int ks = 0; ks < 2; ++ks) { const pg8::bf16x8 bfr = ldfrag(VT, 16 * tq + fr, ks, fq);
#pragma unroll
            for (int db = 0; db < 4; ++db) accS[db] = MFMA16(ldfrag(AH, 16 * db + fr, ks, fq), bfr, accS[db]); }
        __syncthreads();
        if (c >= 1) {
            const int eh = tq & 1; pg8::f32x4 o[4];
#pragma unroll
            for (int eb = 0; eb < 4; ++eb) o[eb] = (pg8::f32x4){0.f, 0.f, 0.f, 0.f};
#pragma unroll
            for (int ks = 0; ks < 4; ++ks) { const pg8::bf16x8 bfr = ks < 2 ? ldfrag(PP, t0 + fr, ks, fq) : ldfrag(QT, t0 + fr, ks - 2, fq);
#pragma unroll
                for (int eb = 0; eb < 4; ++eb) { const int e0 = 64 * eh + 16 * eb; o[eb] = MFMA16(ks < 2 ? ldfrag(VT, e0 + fr, ks, fq) : ldfrag(SB, e0 + fr, ks - 2, fq), bfr, o[eb]); } }
            bf16* op = O0 + (size_t)(mrow0 + t) * 512 + h * 128 + 64 * eh + 4 * fq;
#pragma unroll
            for (int eb = 0; eb < 4; ++eb) *(GAS unsigned long long*)(op + 16 * eb) = (unsigned long long)pk2(o[eb][0], o[eb][1]) | ((unsigned long long)pk2(o[eb][2], o[eb][3]) << 32);
        }
        __syncthreads();
#pragma unroll
        for (int db = 0; db < 4; ++db) { LAS unsigned* sp = (LAS unsigned*)(SB + (16 * tq + fr) * GP + (16 * db + 4 * fq) * 2); sp[0] = pk2(accS[db][0], accS[db][1]); sp[1] = pk2(accS[db][2], accS[db][3]); }
    }
#undef GX_LOAD
    float* gg = WSP(float, WS_GG) + ((size_t)(bh * 8 + g) * 128 + 16 * tq + fr) * 64;
#pragma unroll
    for (int db = 0; db < 4; ++db) *(pg8::f32x4*)(gg + 16 * db + 4 * fq) = accS[db];
    if (tq == 0) WSP(float, WS_GD)[(bh * 8 + g) * 64 + d] = cd;
    __syncthreads();
}
__device__ __forceinline__ void gla_z(Frame& F, int unit) {
    const int bh = unit >> 3, g = unit & 7, b = bh >> 2, h = bh & 3, fr = F.lane & 15, fq = F.lane >> 4;
    const ldsp SB = F.lds + 0;
    { const pg8::f32x4* G4 = WSP(pg8::f32x4, WS_GG); const float* GD = WSP(float, WS_GD);
#pragma unroll
      for (int j = 0; j < 4; ++j) { const int q = F.tid + 512 * j, e = q >> 4, d4 = (q & 15) * 4; pg8::f32x4 S = {0.f, 0.f, 0.f, 0.f}, Gv[7], Dv[7];
#pragma unroll
          for (int gp = 0; gp < 7; ++gp) if (gp < g) { Dv[gp] = *(const pg8::f32x4*)(GD + (bh * 8 + gp) * 64 + d4); Gv[gp] = G4[(size_t)(bh * 8 + gp) * 2048 + q]; }
#pragma unroll
          for (int gp = 0; gp < 7; ++gp) if (gp < g) S = Dv[gp] * S + Gv[gp];
          *(LAS unsigned*)(SB + e * GP + d4 * 2) = pk2(S.x, S.y); *(LAS unsigned*)(SB + e * GP + d4 * 2 + 4) = pk2(S.z, S.w); } }
    __syncthreads();
    const bf16* QD = WSP(bf16, WS_QD); const bf16* O0 = WSP(bf16, WS_O0); const float* gg = F.inp(I_GGLA);
    pg8::bf16x8 qf[2]; unsigned long long ow[8], rw[8]; pg8::u32x4 ol[4], rl[4];
    const ldsp SO = F.lds + 32768 + F.wave * 9216, SR = SO + 4608; const int l4 = F.lane >> 4, l15 = F.lane & 15;
#define GZ_LOAD(itn) do { const int tl_ = 512 * g + 128 * (itn) + 16 * F.wave + fr; const size_t mr_ = (size_t)(b * SEQ + tl_), pr_ = (size_t)(b * LPB + 64 + tl_); \
        _Pragma("unroll") for (int ks_ = 0; ks_ < 2; ++ks_) qf[ks_] = *(const pg8::bf16x8*)(QD + mr_ * 256 + h * 64 + 32 * ks_ + 8 * fq); \
        const size_t mb_ = mr_ - fr, pb_ = pr_ - fr; \
        _Pragma("unroll") for (int j_ = 0; j_ < 4; ++j_) { ol[j_] = *(const pg8::u32x4*)(O0 + (mb_ + 4 * j_ + l4) * 512 + h * 128 + 8 * l15); rl[j_] = *(const pg8::u32x4*)(WSP(bf16, WS_GR) + (pb_ + 4 * j_ + l4) * 512 + h * 128 + 8 * l15); } } while (0)
#define GZ_UNSTAGE() do { _Pragma("unroll") for (int j_ = 0; j_ < 4; ++j_) { *(LAS pg8::u32x4*)(SO + (4 * j_ + l4) * 272 + 16 * l15) = ol[j_]; *(LAS pg8::u32x4*)(SR + (4 * j_ + l4) * 272 + 16 * l15) = rl[j_]; } \
        asm volatile("s_waitcnt lgkmcnt(0)" ::: "memory"); \
        _Pragma("unroll") for (int eb_ = 0; eb_ < 8; ++eb_) { ow[eb_] = *(const LAS unsigned long long*)(SO + fr * 272 + 32 * eb_ + 8 * fq); rw[eb_] = *(const LAS unsigned long long*)(SR + fr * 272 + 32 * eb_ + 8 * fq); } \
        asm volatile("s_waitcnt lgkmcnt(0)" ::: "memory"); } while (0)
    GZ_LOAD(0);
    for (int it = 0; it < 4; ++it) {
        const int tl = 512 * g + 128 * it + 16 * F.wave + fr, mrow = b * SEQ + tl;
        GZ_UNSTAGE();
        pg8::f32x4 o[8];
#pragma unroll
        for (int eb = 0; eb < 8; ++eb) o[eb] = (pg8::f32x4){0.f, 0.f, 0.f, 0.f};
#pragma unroll
        for (int ks = 0; ks < 2; ++ks)
#pragma unroll
            for (int eb = 0; eb < 8; ++eb) o[eb] = MFMA16(ldfrag(SB, 16 * eb + fr, ks, fq), qf[ks], o[eb]);
        float ss = 0.f; float sr[8][4];
#pragma unroll
        for (int eb = 0; eb < 8; ++eb) { const unsigned long long w = ow[eb], r = rw[eb];
            o[eb][0] += __uint_as_float((unsigned)w << 16); o[eb][1] += __uint_as_float((unsigned)w & 0xffff0000u); o[eb][2] += __uint_as_float((unsigned)(w >> 32) << 16); o[eb][3] += __uint_as_float((unsigned)(w >> 32) & 0xffff0000u);
            ss += (o[eb][0] * o[eb][0] + o[eb][1] * o[eb][1]) + (o[eb][2] * o[eb][2] + o[eb][3] * o[eb][3]);
            sr[eb][0] = __uint_as_float((unsigned)r << 16); sr[eb][1] = __uint_as_float((unsigned)r & 0xffff0000u); sr[eb][2] = __uint_as_float((unsigned)(r >> 32) << 16); sr[eb][3] = __uint_as_float((unsigned)(r >> 32) & 0xffff0000u); }
        if (it < 3) GZ_LOAD(it + 1);
        ss += __shfl_xor(ss, 16); ss += __shfl_xor(ss, 32);
        const float rn = 1.0f / sqrtf(ss * (1.0f / 128.0f) + EPS);
        bf16* op = WSP(bf16, WS_OA) + (size_t)MROWS * 512 + (size_t)mrow * 512 + h * 128;
#pragma unroll
        for (int eb = 0; eb < 8; ++eb) { const int e = 16 * eb + 4 * fq; const pg8::f32x4 gv = *(const pg8::f32x4*)(gg + e);
            const float v0 = o[eb][0] * rn * gv.x * (sr[eb][0] * sigmoidf_(sr[eb][0])), v1 = o[eb][1] * rn * gv.y * (sr[eb][1] * sigmoidf_(sr[eb][1])), v2 = o[eb][2] * rn * gv.z * (sr[eb][2] * sigmoidf_(sr[eb][2])), v3 = o[eb][3] * rn * gv.w * (sr[eb][3] * sigmoidf_(sr[eb][3]));
            *(LAS unsigned long long*)(SO + fr * 272 + 32 * eb + 8 * fq) = (unsigned long long)pk2(v0, v1) | ((unsigned long long)pk2(v2, v3) << 32); }
        asm volatile("s_waitcnt lgkmcnt(0)" ::: "memory");
        { pg8::u32x4 vv[4];
#pragma unroll
          for (int j = 0; j < 4; ++j) vv[j] = *(const LAS pg8::u32x4*)(SO + (4 * j + l4) * 272 + 16 * l15);
          asm volatile("s_waitcnt lgkmcnt(0)" ::: "memory");
#pragma unroll
          for (int j = 0; j < 4; ++j) *(pg8::u32x4*)(op - (size_t)fr * 512 + (size_t)(4 * j + l4) * 512 + 8 * l15) = vv[j]; }
    }
#undef GZ_LOAD
#undef GZ_UNSTAGE
    __syncthreads();
}
__device__ __forceinline__ void router_phase(Frame& F) {
    LAS float* lgp = (LAS float*)(F.lds + 0);
    LAS float* ssp = (LAS float*)(F.lds + 126976);
    LAS int* lcnt = (LAS int*)(F.lds + 128000); LAS int* lbase = lcnt + 64;
    const bf16* H = WSP(bf16, WS_H2U); const bf16* wh = WSP(bf16, WS_WRH); const bf16* wl = WSP(bf16, WS_WRL);
    int* ltok = WSP(int, WS_LTOK); float* lrs = WSP(float, WS_LRS); float* lw = WSP(float, WS_LW);
    const int fr = F.lane & 15, kg = F.lane >> 4, rbk = F.wave & 3, kh = F.wave >> 2;
    for (int rb = F.vcu; rb < MROWS / 128; rb += F.G) {
        if (F.tid < 64) lcnt[F.tid] = 0;
        const ldsp SA = F.lds + F.wave * 9216, SWT = F.lds + 73728; const int l4 = F.lane >> 4, l15 = F.lane & 15;
        pg8::f32x4 acc[2][3];
#pragma unroll
        for (int a = 0; a < 2; ++a)
#pragma unroll
            for (int cb = 0; cb < 3; ++cb) acc[a][cb] = (pg8::f32x4){0.f, 0.f, 0.f, 0.f};
        float ss0 = 0.f, ss1 = 0.f; const float* ig2 = WSP(float, WS_IG2) + kh * 512 + 8 * kg;
#pragma nounroll
        for (int c = 0; c < 4; ++c) {
            pg8::u32x4 va[8], vw[6];
#pragma unroll
            for (int j = 0; j < 8; ++j) va[j] = *(const pg8::u32x4*)(H + (size_t)(rb * 128 + rbk * 32 + 4 * j + l4) * DM + kh * 512 + c * 128 + 8 * l15);
#pragma unroll
            for (int i = 0; i < 6; ++i) { const int idx = F.tid + 512 * i, rp = idx >> 4, q = idx & 15, kh2 = rp / 96, hl = (rp / 48) & 1, n = rp % 48;
                vw[i] = *(const pg8::u32x4*)((hl ? wl : wh) + (size_t)n * DM + kh2 * 512 + c * 128 + 8 * q); }
            __syncthreads();
#pragma unroll
            for (int j = 0; j < 8; ++j) *(LAS pg8::u32x4*)(SA + (4 * j + l4) * 272 + 16 * l15) = va[j];
#pragma unroll
            for (int i = 0; i < 6; ++i) { const int idx = F.tid + 512 * i, rp = idx >> 4, q = idx & 15; *(LAS pg8::u32x4*)(SWT + rp * 272 + 16 * q) = vw[i]; }
            __syncthreads();
#pragma nounroll
            for (int s = 0; s < 4; ++s) {
                const pg8::bf16x8 a0 = *(const LAS pg8::bf16x8*)(SA + fr * 272 + 64 * s + 16 * kg), a1 = *(const LAS pg8::bf16x8*)(SA + (fr + 16) * 272 + 64 * s + 16 * kg);
                { const pg8::f32x4 ia = *(const pg8::f32x4*)(ig2 + c * 128 + 32 * s), ib = *(const pg8::f32x4*)(ig2 + c * 128 + 32 * s + 4); const float iv[8] = {ia[0], ia[1], ia[2], ia[3], ib[0], ib[1], ib[2], ib[3]};
#pragma unroll
                  for (int j = 0; j < 8; ++j) { const float x0 = __uint_as_float((unsigned)(unsigned short)a0[j] << 16), x1 = __uint_as_float((unsigned)(unsigned short)a1[j] << 16); ss0 += x0 * x0 * iv[j]; ss1 += x1 * x1 * iv[j]; } }
#pragma unroll
                for (int cb = 0; cb < 3; ++cb) { const pg8::bf16x8 bh = *(const LAS pg8::bf16x8*)(SWT + ((kh * 2 + 0) * 48 + 16 * cb + fr) * 272 + 64 * s + 16 * kg), bl = *(const LAS pg8::bf16x8*)(SWT + ((kh * 2 + 1) * 48 + 16 * cb + fr) * 272 + 64 * s + 16 * kg);
                    acc[0][cb] = MFMA16(a0, bh, acc[0][cb]); acc[0][cb] = MFMA16(a0, bl, acc[0][cb]); acc[1][cb] = MFMA16(a1, bh, acc[1][cb]); acc[1][cb] = MFMA16(a1, bl, acc[1][cb]); }
                asm volatile("" ::: "memory");
            }
        }
        __syncthreads();
#pragma unroll
        for (int a = 0; a < 2; ++a)
#pragma unroll
            for (int cb = 0; cb < 3; ++cb)
#pragma unroll
                for (int i = 0; i < 4; ++i) lgp[(kh * 128 + rbk * 32 + a * 16 + 4 * kg + i) * 48 + 16 * cb + fr] = acc[a][cb][i];
        ss0 += __shfl_xor(ss0, 16); ss0 += __shfl_xor(ss0, 32); ss1 += __shfl_xor(ss1, 16); ss1 += __shfl_xor(ss1, 32);
        if (kg == 0) { ssp[kh * 128 + rbk * 32 + fr] = ss0; ssp[kh * 128 + rbk * 32 + 16 + fr] = ss1; }
        __syncthreads();
        int seg0 = 0, seg1 = 0, rk0 = 0, rk1 = 0; float w0 = 0.f, w1 = 0.f, rs = 0.f;
        if (F.tid < 128) {
            const LAS float* L0 = lgp + F.tid * 48; const LAS float* L1 = L0 + 128 * 48; rs = 1.0f / sqrtf((ssp[F.tid] + ssp[128 + F.tid]) * (1.0f / DM) + EPS);
            float gl[4];
#pragma unroll
            for (int j = 0; j < 4; ++j) gl[j] = (L0[j] + L1[j]) * rs + F.inp(I_BRG)[j];
            int gi = 0; float gm = gl[0];
#pragma unroll
            for (int j = 1; j < 4; ++j) if (gl[j] > gm) { gm = gl[j]; gi = j; }
            float gs = 0.f;
#pragma unroll
            for (int j = 0; j < 4; ++j) gs += expf(gl[j] - gm);
            const float gw_ = 1.0f / gs;
            float v1 = -INFINITY, v2 = -INFINITY; int i1 = 0, i2 = 0;
            for (int j = 0; j < 8; ++j) { const float v = (L0[4 + gi * 8 + j] + L1[4 + gi * 8 + j]) * rs + F.inp(I_BRE)[gi * 8 + j];
                if (v > v1) { v2 = v1; i2 = i1; v1 = v; i1 = j; } else if (v > v2) { v2 = v; i2 = j; } }
            const float e1 = 1.0f / (1.0f + expf(v2 - v1));
            w0 = gw_ * e1; w1 = gw_ * (1.0f - e1); seg0 = gi * 8 + i1; seg1 = 32 + gi * 8 + i2;
            rk0 = atomicAdd((int*)(lcnt + seg0), 1); rk1 = atomicAdd((int*)(lcnt + seg1), 1);
        }
        __syncthreads();
        if (F.tid < 64) { const int n = lcnt[F.tid]; lbase[F.tid] = n ? (int)__hip_atomic_fetch_add((unsigned*)(F.ctl + CW_CNT + F.tid), (unsigned)n, RLX_AGENT) : 0; }
        __syncthreads();
        if (F.tid < 128) { const int tok = rb * 128 + F.tid; const size_t p0 = (size_t)seg0 * LCAP + lbase[seg0] + rk0, p1 = (size_t)seg1 * LCAP + lbase[seg1] + rk1;
            ltok[p0] = tok; lrs[p0] = rs; lw[p0] = w0; ltok[p1] = tok; lrs[p1] = rs; lw[p1] = w1; }
        __syncthreads();
    }
}
#ifndef MK_N_LAUNCHES
#define MK_N_LAUNCHES 1
#endif
constexpr int N_PHASES = 10;
struct Args { const float* in[25]; float* out; unsigned char* ws; int ph_lo, ph_hi; };
__global__ void __launch_bounds__(NWAVES * 64, 2) fwd_kernel(Args args) {
    extern __shared__ __attribute__((aligned(16))) unsigned char lds[];
    Frame F;
    F.lds = (LAS unsigned char*)lds;
    F.MISC = (volatile LAS unsigned*)(F.lds + MISC_OFF);
    F.tid = threadIdx.x; F.lane = F.tid & 63; F.wave = __builtin_amdgcn_readfirstlane(F.tid >> 6);
    F.G = gridDim.x; { const int bx = blockIdx.x; F.vcu = (F.G % 8 == 0) ? (bx % 8) * (F.G / 8) + bx / 8 : bx; }
    F.ws = args.ws; F.out = args.out; F.ctl = (gu32*)(args.ws + WS_CTL);
    for (int u = F.tid; u < (LDS_BYTES - LDSCTL_OFF) / 4; u += NWAVES * 64) ((LAS unsigned*)(F.lds + LDSCTL_OFF))[u] = 0u;
    __syncthreads();
    if (F.tid < 25) ((LAS unsigned long long*)(F.lds + INTAB_OFF))[F.tid] = (unsigned long long)args.in[F.tid];
    __syncthreads();
    XcdBarrier bar; bar.bar = (unsigned*)(F.ctl + CW_BAR); bar.x = 0; bar.st = nullptr;
    if (MK_N_LAUNCHES == 1) bar = xcd_barrier_post((unsigned*)(F.ctl + CW_BAR), F.MISC + 8);
    const int lo = args.ph_lo, hi = args.ph_hi;
#ifdef PROBE_K
    volatile LAS unsigned long long* prb = (volatile LAS unsigned long long*)(F.lds + LDSCTL_OFF + 2048); if (blockIdx.x == 0 && F.tid == 0) prb[0] = __builtin_amdgcn_s_memrealtime();
#define PROBE_AT(k) do { if ((k) == PROBE_K && blockIdx.x == 0 && F.tid == 0) prb[1] = __builtin_amdgcn_s_memrealtime(); } while (0)
#else
#define PROBE_AT(k) do {} while (0)
#endif
#ifndef PH_MASK
#define PH_MASK 0x3ff
#endif
#define IN(k) (((PH_MASK >> (k)) & 1) && lo <= (k) && (k) < hi)
#define SEAM(k) do { if (IN(k) && IN((k) + 1)) xcd_barrier(bar); PROBE_AT(k); } while (0)
    const LAS int* tbp = (const LAS int*)(F.lds + TB_OFF); const LAS int* cnp = (const LAS int*)(F.lds + CN_OFF);

    if (IN(0)) { p0_prologue(F); } SEAM(0);
    if (IN(1)) {
#ifdef SKEW_US
        { const unsigned long long t0_ = __builtin_amdgcn_s_memrealtime(), dl_ = (unsigned long long)(F.vcu & 7) * (SKEW_US * 100 / 8); while (__builtin_amdgcn_s_memrealtime() - t0_ < dl_) __builtin_amdgcn_s_sleep(8); }
#endif
        for (int u = F.tid; u < 2 * DM; u += NWAVES * 64) ((LAS float*)(F.lds + BML_OFF))[u] = F.inp(I_BMERGE)[u];
        __syncthreads();
        { pg8::Gemm g{WSP(pg8::bf16_t, WS_XN8), WSP(pg8::bf16_t, WS_WIN8), DM / 2}; pg8::StaticOrder S{MROWS / 256, 8, F.G, (int)blockIdx.x};
          epi::EpiGates E{(bf16*)F.out, (bf16*)F.out + (size_t)MROWS * DM, (const LAS float*)(F.lds + BML_OFF), 1.0f / (X8SCALE * W8SCALE)};
          pg8::gemm_phase<epi::EpiGates, pg8::StaticOrder, true, true>(F.lds + RING_OFF, g, S, E); }
        asm volatile("s_waitcnt vmcnt(0) lgkmcnt(0)" ::: "memory"); __syncthreads();
        pg8::Gemm g{WSP(pg8::bf16_t, WS_R1), WSP(pg8::bf16_t, WS_WIN), DM}; pg8::StaticOrder S{MZ / 256, 13, F.G, (int)blockIdx.x};
        epi::EpiZ E{WSP(bf16, WS_Q), WSP(bf16, WS_K), WSP(bf16, WS_V), WSP(bf16, WS_GQ), WSP(bf16, WS_GK), WSP(bf16, WS_GV), WSP(bf16, WS_GR), WSP(float, WS_LOGA),
                    F.inp(I_GQN), F.inp(I_GKN), F.inp(I_BGATE), WSP(float, WS_ROPE), F.lds + EPISTG_OFF};
        pg8::gemm_phase(F.lds + RING_OFF, g, S, E);
        if ((int)blockIdx.x >= P1_EXTRA(F.G)) { const int nidle = F.G - P1_EXTRA(F.G), j = (int)blockIdx.x - P1_EXTRA(F.G), nw = nidle * NWAVES, me = j * NWAVES + F.wave, cnt = p1_conv_items(F.G);
            late_tables(F, me * 64 + F.lane, nw * 64); expert_conv_first(F, me, nw, cnt); }
    } SEAM(1);
    if (IN(2)) {
        const attn_body::AttnTensors AT{(const attn_body::bf16*)WSP(bf16, WS_Q), (const attn_body::bf16*)WSP(bf16, WS_K), (const attn_body::bf16*)WSP(bf16, WS_V), (attn_body::bf16*)WSP(bf16, WS_R1)};
        { const float lam = expf(wave_sum(F.inp(I_LQ1)[F.lane] * F.inp(I_LK1)[F.lane])) - expf(wave_sum(F.inp(I_LQ2)[F.lane] * F.inp(I_LK2)[F.lane])) + 0.2f;
          float gqm = fabsf(F.inp(I_GQN)[F.lane]), gkm = fabsf(F.inp(I_GKN)[F.lane]);
#pragma unroll
          for (int o_ = 1; o_ < 64; o_ <<= 1) { gqm = fmaxf(gqm, __shfl_xor(gqm, o_)); gkm = fmaxf(gkm, __shfl_xor(gkm, o_)); }
          const bool fastsm = __builtin_amdgcn_readfirstlane((0.125f * 1.4426950408889634f * 64.0f) * gqm * gkm < 48.0f ? 1 : 0) != 0;
          const int nslot = 2 * ((256 + F.G - 1) / F.G);
          int i = 0;
#define ATTN_LOOP(FASTSM) for (;; ++i) { const int p = (i >> 2) * F.G + F.vcu; if (p >= 256) break; \
              if ((i & 3) == 1 || (i & 3) == 3) expert_conv_slot(F, (i >> 2) * 2 + ((i & 3) >> 1), nslot, p1_conv_items(F.G)); \
              const int bh = p >> 3, s = p & 7, b = bh >> 2, h = bh & 3, mp = i & 1, qb = (i & 2) ? 15 - s : s, hm = 2 * h + mp; \
              attn_body::attn_unit<8, FASTSM>(b, hm * 64, hm * 64, h * 128, hm * 128, qb, AT.Q, AT.K, AT.V, AT.O, (char*)lds + RING_OFF, mp, 2 * h * 128, lam, F.inp(I_GSUB), (attn_body::bf16*)WSP(bf16, WS_OA), h * 128); }
          if (fastsm) { ATTN_LOOP(true) } else { ATTN_LOOP(false) }
#undef ATTN_LOOP
          for (int sl = (i >> 2) * 2 + (((i & 3) + 1) >> 1 > 2 ? 2 : ((i & 3) + 1) >> 1); sl < nslot; ++sl) expert_conv_slot(F, sl, nslot, p1_conv_items(F.G)); }
        asm volatile("s_waitcnt vmcnt(0) lgkmcnt(0)" ::: "memory"); __syncthreads();
        for (int un = F.vcu; un < 32 * 8; un += F.G) gla_x(F, un);
    } SEAM(2);
    if (IN(3)) { for (int un = F.vcu; un < 32 * 8; un += F.G) gla_z(F, un); } SEAM(3);
    if (IN(4)) {
        pg8::Gemm g{WSP(pg8::bf16_t, WS_OA), WSP(pg8::bf16_t, WS_WBR), 512}; pg8::PairOrder S{MROWS / 256, DM / 256, F.G, (int)blockIdx.x};
        epi::EpiMerge E{(const bf16*)F.out, (const bf16*)F.out + (size_t)MROWS * DM, WSP(bf16, WS_R1), F.lds + EPISTG_OFF};
        pg8::gemm_phase(F.lds + RING_OFF, g, S, E);
    } SEAM(4);
    if (IN(5)) {
        pg8::Gemm g{WSP(pg8::bf16_t, WS_R1), WSP(pg8::bf16_t, WS_WOUT), DM}; pg8::StaticOrder S{MROWS / 256, DM / 256, F.G, (int)blockIdx.x};
        epi::EpiOut E{F.inp(I_X), WSP(bf16, WS_H2U), F.inp(I_GFFN), WSP(unsigned char, WS_H2U8), F.lds + EPISTG_OFF};
        pg8::gemm_phase(F.lds + RING_OFF, g, S, E);
    } SEAM(5);
    if (IN(6)) { router_phase(F); } SEAM(6);
    if ((PH_MASK >> 7) && hi > 7) {
        LAS int* tb = (LAS int*)(F.lds + TB_OFF); LAS int* cn = (LAS int*)(F.lds + CN_OFF);
        if (F.tid < 64) { const int c = (int)__hip_atomic_load(F.ctl + CW_CNT + F.tid, RLX_AGENT); cn[F.tid] = c;
            const int t = (c + 255) >> 8; int incl = t;
#pragma unroll
            for (int o = 1; o < 64; o <<= 1) { const int v = __shfl_up(incl, o); if (F.lane >= o) incl += v; }
            tb[F.tid] = incl - t; if (F.tid == 63) tb[64] = incl; }
        __syncthreads();
    }
    if (IN(7)) {
        pg8::Gemm g{WSP(pg8::bf16_t, WS_H2U8), WSP(pg8::bf16_t, WS_WGU), DM / 2}; epi::MoeSched<true> S{tbp, cnp, WSP(int, WS_LTOK), 0, 64, F.G, F.vcu};
        epi::EpiUp E{cnp, WSP(float, WS_LRS), WSP(unsigned char, WS_HID), F.lds + EPISTG_OFF};
        pg8::gemm_phase<epi::EpiUp, epi::MoeSched<true>, true>(F.lds + RING_OFF, g, S, E);
    } SEAM(7);
    if (IN(8)) {
        pg8::Gemm g{WSP(pg8::bf16_t, WS_HID), WSP(pg8::bf16_t, WS_WD), DEXP / 2}; epi::MoeSched<false> S{tbp, cnp, WSP(int, WS_LTOK), 0, 32, F.G, F.vcu};
        epi::EpiDown<0> E{cnp, WSP(int, WS_LTOK), WSP(float, WS_LW), F.out, WSP(unsigned char, WS_R1), WSP(float, WS_TRASH), WSP(bf16, WS_H2U), F.inp(I_GFFN), F.lds + EPISTG_OFF};
        pg8::gemm_phase<epi::EpiDown<0>, epi::MoeSched<false>, true>(F.lds + RING_OFF, g, S, E);
    } SEAM(8);
    if (IN(9)) {
        pg8::Gemm g{WSP(pg8::bf16_t, WS_HID), WSP(pg8::bf16_t, WS_WD), DEXP / 2}; epi::MoeSched<false> S{tbp, cnp, WSP(int, WS_LTOK), 32, 64, F.G, F.vcu};
        epi::EpiDown<1> E{cnp, WSP(int, WS_LTOK), WSP(float, WS_LW), F.out, WSP(unsigned char, WS_R1), WSP(float, WS_TRASH), WSP(bf16, WS_H2U), F.inp(I_GFFN), F.lds + EPISTG_OFF};
        pg8::gemm_phase<epi::EpiDown<1>, epi::MoeSched<false>, true>(F.lds + RING_OFF, g, S, E);
    }
#ifdef PROBE_K
    PROBE_AT(9);
    if (blockIdx.x == 0 && F.tid == 0) { const unsigned long long t1 = __builtin_amdgcn_s_memrealtime(), tgt = t1 + (unsigned long long)PROBE_MULT * (prb[1] - prb[0]);
        for (unsigned sp = 0; sp < 4000000u && __builtin_amdgcn_s_memrealtime() < tgt; ++sp) __builtin_amdgcn_s_sleep(16); }
#endif
#undef IN
#undef SEAM
}

extern "C" void kernel_launch(void* const* d_in, const int* in_sizes, int n_in, void* d_out, int out_size, void* d_ws, size_t ws_size, hipStream_t stream) {
    static int grid = 0;
    if (grid == 0) {
        if (n_in != 25 || in_sizes[0] != MROWS * DM || out_size != MROWS * DM || ws_size < WS_END) { fprintf(stderr, "kernel_launch: unexpected shapes (n_in %d, in0 %d, out %d, ws %zu)\n", n_in, n_in > 0 ? in_sizes[0] : -1, out_size, ws_size); grid = -1; return; }
        int dev = 0, cus = 0, per_cu = 0;
        if (hipGetDevice(&dev) != hipSuccess || hipDeviceGetAttribute(&cus, hipDeviceAttributeMultiprocessorCount, dev) != hipSuccess) { grid = -1; return; }
        if (hipFuncSetAttribute((const void*)fwd_kernel, hipFuncAttributeMaxDynamicSharedMemorySize, LDS_BYTES) != hipSuccess) { fprintf(stderr, "kernel_launch: hipFuncSetAttribute failed\n"); grid = -1; return; }
        if (hipOccupancyMaxActiveBlocksPerMultiprocessor(&per_cu, (const void*)fwd_kernel, NWAVES * 64, LDS_BYTES) != hipSuccess || per_cu < 1) { fprintf(stderr, "kernel_launch: occupancy query says %d\n", per_cu); }
        (void)hipGetLastError();
        grid = cus;
    }
    if (grid < 0) return;
    if (hipMemsetAsync((char*)d_ws + WS_CTL, 0, CTL_ZERO_BYTES, stream) != hipSuccess) return;
    Args a{};
    for (int i = 0; i < 25; ++i) a.in[i] = (const float*)d_in[i];
    a.out = (float*)d_out; a.ws = (unsigned char*)d_ws;
    if (MK_N_LAUNCHES == 1) { a.ph_lo = 0; a.ph_hi = N_PHASES; hipLaunchKernelGGL(fwd_kernel, dim3(grid), dim3(NWAVES * 64), LDS_BYTES, stream, a); }
    else for (int p = 0; p < N_PHASES; ++p) { a.ph_lo = p; a.ph_hi = p + 1; hipLaunchKernelGGL(fwd_kernel, dim3(grid), dim3(NWAVES * 64), LDS_BYTES, stream, a); }
}
```
